# Optimizing an MI355X kernel written in HIP

```python
import jax
import jax.numpy as jnp
from jax import lax
import numpy as np

D_MODEL = 4096
BATCH = 4
SEQ = 2048
DEPTH = 1

CHUNK = 64
LEFT_CHUNKS = 8
REL_CLIP = 128
N_REL = CHUNK + REL_CLIP
HEAD_DIM = 128
HEADS_A = 16
HEADS_B = 16
Q_LORA = 1024
KV_LORA = 512
NOPE_DIM = 128
ROPE_DIM = 64
V_DIM = 128
QK_B = NOPE_DIM + ROPE_DIM
ROPE_THETA = 10000.0
Q_BLOCK = 128
MEM_TOKENS = 256
MEM_HEADS = 4
MEM_HEAD_DIM = 128
N_EXPERTS = 64
N_GROUPS = 8
TOPK_GROUPS = 4
TOP_K = 8
EXPERT_FF = 512
SHARED_FF = 512
ROUTED_SCALE = 2.5
EXPERT_BLOCK = 256
EPS = 1e-6

WIDTH_A = HEADS_A * HEAD_DIM
IN_WIDTH = 3 * WIDTH_A + Q_LORA + KV_LORA + ROPE_DIM
MIX_WIDTH = WIDTH_A + HEADS_B * V_DIM

kernel_name = 'hybrid_chunked_mla_moe_block'


def rms_norm(x, g):
    xf = x.astype(jnp.float32)
    y = xf * lax.rsqrt(jnp.mean(xf * xf, axis=-1, keepdims=True) + EPS)
    return (y * g.astype(jnp.float32)).astype(x.dtype)


def rotate_half(x):
    x1, x2 = jnp.split(x, 2, axis=-1)
    return jnp.concatenate([-x2, x1], axis=-1)


def apply_rope(x, cos, sin):
    return x * cos + rotate_half(x) * sin


def rope_tables(positions, dtype):
    inv_freq = ROPE_THETA ** (-jnp.arange(0, ROPE_DIM, 2, dtype=jnp.float32) / ROPE_DIM)
    ang = positions.astype(jnp.float32)[..., None] * inv_freq
    ang = jnp.concatenate([ang, ang], axis=-1)[:, :, None, :]
    return jnp.cos(ang).astype(dtype), jnp.sin(ang).astype(dtype)


def masked_softmax(s, valid):
    return jax.nn.softmax(jnp.where(valid, s, -jnp.inf), axis=-1)


def chunk_band_attention(q, k, v, rel_bias):
    B, S, H, Dh = q.shape
    n_chunks = S // CHUNK
    pad = LEFT_CHUNKS * CHUNK
    band = pad + CHUNK
    kp = jnp.pad(k, ((0, 0), (pad, 0), (0, 0), (0, 0)))
    vp = jnp.pad(v, ((0, 0), (pad, 0), (0, 0), (0, 0)))
    i = jnp.arange(CHUNK)[:, None]
    j = jnp.arange(band)[None, :]
    dist = pad + i - j
    bias = rel_bias[:, jnp.clip(dist, -(CHUNK - 1), REL_CLIP) + CHUNK - 1].astype(jnp.float32)
    key_chunk_rel = j // CHUNK - LEFT_CHUNKS
    scale = Dh ** -0.5

    def one_chunk(c):
        qc = lax.dynamic_slice_in_dim(q, c * CHUNK, CHUNK, axis=1)
        kc = lax.dynamic_slice_in_dim(kp, c * CHUNK, band, axis=1)
        vc = lax.dynamic_slice_in_dim(vp, c * CHUNK, band, axis=1)
        s = jnp.einsum('bqhd,bkhd->bhqk', qc, kc).astype(jnp.float32) * scale + bias[None]
        valid = (c + key_chunk_rel >= 0)[None, None]
        p = masked_softmax(s, valid).astype(vc.dtype)
        return jnp.einsum('bhqk,bkhd->bqhd', p, vc)

    out = lax.map(one_chunk, jnp.arange(n_chunks))
    return out.transpose(1, 0, 2, 3, 4).reshape(B, S, H, Dh)


def mla_attention(c_q, c_kv, k_pe, cos, sin, g_cq, w_uq, g_ckv, w_ukv, g_qb, g_kb):
    B, S, _ = c_q.shape
    q = (rms_norm(c_q, g_cq) @ w_uq).reshape(B, S, HEADS_B, QK_B)
    kv = (rms_norm(c_kv, g_ckv) @ w_ukv).reshape(B, S, HEADS_B, NOPE_DIM + V_DIM)
    k_nope, v = kv[..., :NOPE_DIM], kv[..., NOPE_DIM:]
    q_nope = rms_norm(q[..., :NOPE_DIM], g_qb[:NOPE_DIM])
    q_pe = apply_rope(rms_norm(q[..., NOPE_DIM:], g_qb[NOPE_DIM:]), cos, sin)
    k_nope = rms_norm(k_nope, g_kb[:NOPE_DIM])
    k_pe = apply_rope(rms_norm(k_pe, g_kb[NOPE_DIM:])[:, :, None, :], cos, sin)
    q = jnp.concatenate([q_nope, q_pe], axis=-1)
    k = jnp.concatenate([k_nope, jnp.broadcast_to(k_pe, (B, S, HEADS_B, ROPE_DIM))], axis=-1)
    scale = QK_B ** -0.5
    outs = []
    for blk in range(S // Q_BLOCK):
        lo, hi = blk * Q_BLOCK, (blk + 1) * Q_BLOCK
        s = jnp.einsum('bqhd,bkhd->bhqk', q[:, lo:hi], k[:, :hi]).astype(jnp.float32) * scale
        q_chunk = jnp.arange(lo, hi) // CHUNK
        k_chunk = jnp.arange(hi) // CHUNK
        p = masked_softmax(s, (k_chunk[None, :] <= q_chunk[:, None])[None, None]).astype(v.dtype)
        outs.append(jnp.einsum('bhqk,bkhd->bqhd', p, v[:, :hi]))
    return jnp.concatenate(outs, axis=1)


def memory_cross_attention(h, m, w_xq, w_xkv, g_qx, g_kx, w_xo):
    B, S, _ = h.shape
    M = m.shape[1]
    q = rms_norm((h @ w_xq).reshape(B, S, MEM_HEADS, MEM_HEAD_DIM), g_qx)
    kv = (m @ w_xkv).reshape(B, M, 2, MEM_HEADS, MEM_HEAD_DIM)
    k = rms_norm(kv[:, :, 0], g_kx)
    v = kv[:, :, 1]
    s = jnp.einsum('bqhd,bkhd->bhqk', q, k).astype(jnp.float32) * MEM_HEAD_DIM ** -0.5
    p = jax.nn.softmax(s, axis=-1).astype(v.dtype)
    o = jnp.einsum('bhqk,bkhd->bqhd', p, v).reshape(B, S, MEM_HEADS * MEM_HEAD_DIM)
    return o @ w_xo


def route(t, w_router, router_bias):
    N = t.shape[0]
    scores = jax.nn.sigmoid((t @ w_router).astype(jnp.float32))
    choice = scores + router_bias.astype(jnp.float32)
    grp = choice.reshape(N, N_GROUPS, N_EXPERTS // N_GROUPS)
    grp_score = lax.top_k(grp, 2)[0].sum(-1)
    _, top_groups = lax.top_k(grp_score, TOPK_GROUPS)
    group_ok = jnp.any(top_groups[:, :, None] == jnp.arange(N_GROUPS)[None, None, :], axis=1)
    expert_ok = jnp.repeat(group_ok, N_EXPERTS // N_GROUPS, axis=1)
    _, eid = lax.top_k(jnp.where(expert_ok, choice, -jnp.inf), TOP_K)
    w = jnp.take_along_axis(scores, eid, axis=-1)
    w = w / (w.sum(-1, keepdims=True) + 1e-20) * ROUTED_SCALE
    return eid, w


def routed_experts(t, eid, gate, w_ex_gate, w_ex_up, w_ex_down):
    N, D = t.shape
    NK = N * TOP_K
    e_flat = eid.reshape(NK)
    tok_flat = jnp.repeat(jnp.arange(N, dtype=jnp.int32), TOP_K)
    order = jnp.argsort(e_flat)
    e_sorted = e_flat[order]
    counts = jnp.bincount(e_flat, length=N_EXPERTS)
    padded = (counts + EXPERT_BLOCK - 1) // EXPERT_BLOCK * EXPERT_BLOCK
    start = jnp.cumsum(counts) - counts
    pad_end = jnp.cumsum(padded)
    pad_start = pad_end - padded
    dest = pad_start[e_sorted] + jnp.arange(NK, dtype=jnp.int32) - start[e_sorted]
    P = -(-NK // EXPERT_BLOCK) * EXPERT_BLOCK + N_EXPERTS * EXPERT_BLOCK
    n_blocks = P // EXPERT_BLOCK
    tok_pad = jnp.full((P,), N, jnp.int32).at[dest].set(tok_flat[order])
    g_pad = jnp.zeros((P,), t.dtype).at[dest].set(gate.reshape(NK)[order].astype(t.dtype))
    block_e = jnp.minimum(jnp.searchsorted(pad_end, jnp.arange(n_blocks, dtype=jnp.int32) * EXPERT_BLOCK, side='right'), N_EXPERTS - 1)
    t_pad = jnp.concatenate([t, jnp.zeros((1, D), t.dtype)], axis=0)

    def block_step(y, blk):
        tok, g, e = blk
        xb = t_pad[tok]
        hb = jax.nn.silu(xb @ w_ex_gate[e]) * (xb @ w_ex_up[e])
        return y.at[tok].add((hb @ w_ex_down[e]) * g[:, None]), None

    y, _ = lax.scan(block_step, jnp.zeros((N + 1, D), t.dtype),
                    (tok_pad.reshape(n_blocks, EXPERT_BLOCK), g_pad.reshape(n_blocks, EXPERT_BLOCK), block_e))
    return y[:N]


def moe_ffn(h, w_router, router_bias, w_sh_gate, w_sh_up, w_sh_down, w_ex_gate, w_ex_up, w_ex_down):
    B, S, D = h.shape
    t = h.reshape(B * S, D)
    eid, gate = route(t, w_router, router_bias)
    shared = (jax.nn.silu(t @ w_sh_gate) * (t @ w_sh_up)) @ w_sh_down
    return (shared + routed_experts(t, eid, gate, w_ex_gate, w_ex_up, w_ex_down)).reshape(B, S, D)


def setup_inputs(seed: int = 0) -> dict:
    key = jax.random.key(seed)
    ks = jax.random.split(key, 32)
    f32 = jnp.float32

    def w(k, shape, fan_in):
        return jax.random.normal(k, shape, f32) * fan_in ** -0.5

    def gain(k, n):
        return 1.0 + 0.02 * jax.random.normal(k, (n,), f32)

    x = jax.random.normal(ks[0], (BATCH, SEQ, D_MODEL), f32)
    mem = jax.random.normal(ks[1], (BATCH, MEM_TOKENS, D_MODEL), f32)
    offset = jax.random.randint(ks[2], (BATCH, 1), 0, 4096, jnp.int32)
    positions = offset + jnp.arange(SEQ, dtype=jnp.int32)[None, :]
    return {
        'x': x, 'mem': mem, 'positions': positions,
        'g_mix': gain(ks[3], D_MODEL),
        'w_in': w(ks[4], (D_MODEL, IN_WIDTH), D_MODEL),
        'g_qa': gain(ks[5], HEAD_DIM),
        'g_ka': gain(ks[6], HEAD_DIM),
        'rel_bias': 0.1 * jax.random.normal(ks[7], (HEADS_A, N_REL), f32),
        'g_cq': gain(ks[8], Q_LORA),
        'w_uq': w(ks[9], (Q_LORA, HEADS_B * QK_B), Q_LORA),
        'g_ckv': gain(ks[10], KV_LORA),
        'w_ukv': w(ks[11], (KV_LORA, HEADS_B * (NOPE_DIM + V_DIM)), KV_LORA),
        'g_qb': gain(ks[12], QK_B),
        'g_kb': gain(ks[13], QK_B),
        'w_o': w(ks[14], (MIX_WIDTH, D_MODEL), MIX_WIDTH),
        'g_cross': gain(ks[15], D_MODEL),
        'g_mem': gain(ks[16], D_MODEL),
        'w_xq': w(ks[17], (D_MODEL, MEM_HEADS * MEM_HEAD_DIM), D_MODEL),
        'w_xkv': w(ks[18], (D_MODEL, 2 * MEM_HEADS * MEM_HEAD_DIM), D_MODEL),
        'g_qx': gain(ks[19], MEM_HEAD_DIM),
        'g_kx': gain(ks[20], MEM_HEAD_DIM),
        'w_xo': w(ks[21], (MEM_HEADS * MEM_HEAD_DIM, D_MODEL), MEM_HEADS * MEM_HEAD_DIM),
        'g_ffn': gain(ks[22], D_MODEL),
        'w_router': w(ks[23], (D_MODEL, N_EXPERTS), D_MODEL),
        'router_bias': 0.01 * jax.random.normal(ks[24], (N_EXPERTS,), f32),
        'w_sh_gate': w(ks[25], (D_MODEL, SHARED_FF), D_MODEL),
        'w_sh_up': w(ks[26], (D_MODEL, SHARED_FF), D_MODEL),
        'w_sh_down': w(ks[27], (SHARED_FF, D_MODEL), SHARED_FF),
        'w_ex_gate': w(ks[28], (N_EXPERTS, D_MODEL, EXPERT_FF), D_MODEL),
        'w_ex_up': w(ks[29], (N_EXPERTS, D_MODEL, EXPERT_FF), D_MODEL),
        'w_ex_down': w(ks[30], (N_EXPERTS, EXPERT_FF, D_MODEL), EXPERT_FF),
    }


def reference(x, mem, positions, g_mix, w_in, g_qa, g_ka, rel_bias, g_cq, w_uq, g_ckv, w_ukv, g_qb, g_kb, w_o,
              g_cross, g_mem, w_xq, w_xkv, g_qx, g_kx, w_xo, g_ffn, w_router, router_bias,
              w_sh_gate, w_sh_up, w_sh_down, w_ex_gate, w_ex_up, w_ex_down):
    B, S, D = x.shape
    cos, sin = rope_tables(positions, x.dtype)
    mem_n = rms_norm(mem, g_mem)
    split_at = [3 * WIDTH_A, 3 * WIDTH_A + Q_LORA, 3 * WIDTH_A + Q_LORA + KV_LORA]
    for _ in range(DEPTH):
        h = rms_norm(x, g_mix)
        qkv_a, c_q, c_kv, k_pe = jnp.split(h @ w_in, split_at, axis=-1)
        qkv_a = qkv_a.reshape(B, S, 3, HEADS_A, HEAD_DIM)
        o_a = chunk_band_attention(rms_norm(qkv_a[:, :, 0], g_qa), rms_norm(qkv_a[:, :, 1], g_ka),
                                   qkv_a[:, :, 2], rel_bias)
        o_b = mla_attention(c_q, c_kv, k_pe, cos, sin, g_cq, w_uq, g_ckv, w_ukv, g_qb, g_kb)
        mixed = jnp.concatenate([o_a.reshape(B, S, WIDTH_A), o_b.reshape(B, S, HEADS_B * V_DIM)], axis=-1)
        x = x + mixed @ w_o
        x = x + memory_cross_attention(rms_norm(x, g_cross), mem_n, w_xq, w_xkv, g_qx, g_kx, w_xo)
        x = x + moe_ffn(rms_norm(x, g_ffn), w_router, router_bias, w_sh_gate, w_sh_up, w_sh_down,
                        w_ex_gate, w_ex_up, w_ex_down)
    return x
```

```cpp
#include <hip/hip_runtime.h>
#include <cstdio>
#include <cstdint>

#define LAS __attribute__((address_space(3)))
typedef unsigned short bf16_t;
typedef float f32x4 __attribute__((ext_vector_type(4)));
typedef short bf16x8 __attribute__((ext_vector_type(8)));
typedef unsigned u32x4 __attribute__((ext_vector_type(4)));
typedef unsigned u32x2 __attribute__((ext_vector_type(2)));
typedef int v4i_t __attribute__((ext_vector_type(4)));
typedef int v8i_t __attribute__((ext_vector_type(8)));
#ifndef FAST_GEMM
#define FAST_GEMM 1
#endif
#ifndef FAST_MOE
#define FAST_MOE 1
#endif
#ifndef FAST_ATTN
#define FAST_ATTN 1
#endif

#ifndef ACT_F32
#define ACT_F32 0
#endif
#if ACT_F32
typedef float act_t;
#else
typedef bf16_t act_t;
#endif
#ifndef N_LAUNCH_PER_PHASE
#define N_LAUNCH_PER_PHASE 0
#endif

constexpr int NB = 4, SEQ = 2048, DM = 4096, NTOK = NB * SEQ;
constexpr int CHUNK = 64, LEFT = 8, NREL = 192;
constexpr int HD = 128, HA = 16, HB = 16, QLORA = 1024, KVLORA = 512, QKB = 192;
constexpr int MEMT = 256, MH = 4, NE = 64, EFF = 512;
constexpr int WA = HA * HD;
constexpr int INW = 3 * WA + QLORA + KVLORA + 64;
constexpr int NMEM = NB * MEMT;
constexpr int C_Q0 = 0, C_K0 = WA, C_V0 = 2 * WA, C_CQ = 3 * WA, C_CKV = 3 * WA + QLORA, C_KPE = 3 * WA + QLORA + KVLORA;
constexpr float EPS = 1e-6f;
constexpr int CAP = NTOK;

constexpr size_t MiB = 1u << 20;
constexpr size_t AS = sizeof(act_t);
constexpr size_t al(size_t x) { return (x + 255) / 256 * 256; }
constexpr size_t WS_CTL = 0, CTL_BYTES = 1 * MiB;
constexpr size_t WS_ROWTOK = 1 * MiB, WS_ROWGATE = 3 * MiB, WS_ROWDST = 5 * MiB;
constexpr int PK(int K) { return K; }
constexpr int INWP = 7936;
constexpr size_t WS_WR = 8 * MiB;
constexpr size_t WS_WIN = 12 * MiB;
constexpr size_t WS_WUQ = WS_WIN + al((size_t)INWP * PK(DM) * 2);
constexpr size_t WS_WUKV = WS_WUQ + al((size_t)3072 * PK(QLORA) * 2);
constexpr size_t WS_WO = WS_WUKV + al((size_t)4096 * PK(KVLORA) * 2);
constexpr size_t WS_WXQ = WS_WO + al((size_t)DM * PK(DM) * 2);
constexpr size_t WS_WXKV = WS_WXQ + al((size_t)512 * PK(DM) * 2);
constexpr size_t WS_WXO = WS_WXKV + al((size_t)1024 * PK(DM) * 2);
constexpr size_t WS_WGU = WS_WXO + al((size_t)DM * PK(512) * 2);
constexpr size_t WS_WD = WS_WGU + al((size_t)65 * 1024 * DM);
constexpr size_t WS_T8 = WS_WD + al((size_t)65 * DM * EFF);
constexpr size_t WS_SSP1 = WS_T8 + al((size_t)NTOK * DM);
constexpr size_t WS_SSP2 = WS_SSP1 + (size_t)NTOK * 64 * 4;
constexpr size_t WS_RS2 = WS_SSP2 + (size_t)NTOK * 64 * 4;
constexpr size_t WS_X1 = WS_RS2 + al((size_t)NTOK * 4);
constexpr size_t WS_X2 = WS_X1 + al((size_t)NTOK * DM * 4);
constexpr size_t WS_T = WS_X2 + al((size_t)NTOK * DM * 4);
constexpr int HH_ROWS = NTOK * 8 + NE * 256 + NTOK;
constexpr size_t WS_HH = WS_T + al((size_t)NTOK * DM * AS);
constexpr size_t WS_Y = WS_HH + al((size_t)HH_ROWS * EFF * AS);
constexpr size_t WS_H = WS_Y;
constexpr size_t WS_MEMN = WS_H + al((size_t)NTOK * DM * AS);
constexpr size_t WS_P1 = WS_MEMN + al((size_t)NMEM * DM * AS);
constexpr size_t WS_KVM = WS_P1 + al((size_t)NTOK * INW * AS);
constexpr size_t WS_QB = WS_KVM + al((size_t)NMEM * 1024 * AS);
constexpr size_t WS_KVB = WS_QB + al((size_t)NTOK * 3072 * AS);
constexpr size_t WS_MIXED = WS_KVB + al((size_t)NTOK * 4096 * AS);
constexpr size_t WS_HC = WS_MIXED + al((size_t)NTOK * DM * AS);
constexpr size_t WS_QXP = WS_HC + al((size_t)NTOK * DM * AS);
constexpr size_t WS_QX = WS_QXP + al((size_t)4 * NTOK * 512 * 4);
constexpr size_t WS_OX = WS_QX + al((size_t)NTOK * 512 * AS);
constexpr size_t WS_END0 = WS_OX + al((size_t)NTOK * 512 * AS);
constexpr size_t WS_YEND = WS_Y + al((size_t)NTOK * 8 * DM * 2);
constexpr size_t WS_END = WS_END0 > WS_YEND ? WS_END0 : WS_YEND;
static_assert(WS_END <= 2147483648ull, "workspace map exceeds the guaranteed 2 GiB");
constexpr int CW_BAR = 4096;
constexpr int CW_CNT = 16384;
constexpr int CW_QCONV = 26624, CW_QB = 26688, CW_QA = 26752;
constexpr int CW_SS1 = 32768, CW_SS2 = 40960;
constexpr int CW_TICKET = 24576;

constexpr int LDS_BYTES = 163840;
constexpr int LDS_MISC = LDS_BYTES - 64;

__device__ __forceinline__ unsigned f2bf(float f) { unsigned u = __builtin_bit_cast(unsigned, f); return (u + 0x7fffu + ((u >> 16) & 1u)) >> 16; }
__device__ __forceinline__ float ldf(const float* p) { return *p; }
__device__ __forceinline__ float ldf(const bf16_t* p) { return __uint_as_float(((unsigned)*p) << 16); }
__device__ __forceinline__ void stf(float* p, float v) { *p = v; }
__device__ __forceinline__ void stf(bf16_t* p, float v) { *p = (bf16_t)f2bf(v); }
__device__ __forceinline__ float wave_sum(float v) {
#pragma unroll
    for (int o = 1; o < 64; o <<= 1) v += __shfl_xor(v, o);
    return v;
}

#define XB_TMO      128
#define XB_XCNT(j)  (256  + 64 * (j))
#define XB_XSUB(j)  (1280 + 64 * (j))
#define XB_XGEN(j)  (2304 + 64 * (j))
#define XB_TOP      3328
#define XB_TOPGEN   3392
#define XCD_BAR_WORDS 3456
#define XB_SPIN_CAP (1u << 18)
__device__ __forceinline__ unsigned xb_ld(unsigned* p)              { return __hip_atomic_load(p, __ATOMIC_RELAXED, __HIP_MEMORY_SCOPE_AGENT); }
__device__ __forceinline__ unsigned xb_add(unsigned* p, unsigned v) { return __hip_atomic_fetch_add(p, v, __ATOMIC_RELAXED, __HIP_MEMORY_SCOPE_AGENT); }
__device__ __forceinline__ unsigned xb_xcc_id() { return (unsigned)__builtin_amdgcn_s_getreg((3 << 11) | 20) & 0xFu; }
#define XB_SPIN(cond, bar) do { unsigned _sp = 0; while (cond) { __builtin_amdgcn_s_sleep(1); \
    if ((++_sp & 255u) == 0u) { if (xb_ld(&(bar)[XB_TMO])) break; if (_sp > XB_SPIN_CAP) { atomicAdd(&(bar)[XB_TMO], 1u); break; } } } } while (0)
struct XcdBarrier { unsigned* bar; unsigned x; volatile LAS unsigned* st; };
__device__ __forceinline__ XcdBarrier xcd_barrier_post(unsigned* bar, volatile LAS unsigned* st) {
    XcdBarrier b; b.bar = bar; b.x = xb_xcc_id(); b.st = st;
    if (threadIdx.x == 0) (void)xb_add(&bar[XB_XCNT(b.x)], 1u);
    return b;
}
__device__ __forceinline__ void xcd_barrier_complete(unsigned* bar, unsigned x, unsigned& nloc, unsigned& nx) {
    const unsigned G = gridDim.x * gridDim.y * gridDim.z;
    unsigned sum, cnt, mine, sp = 0u;
    for (;;) {
        sum = 0u; cnt = 0u; mine = 0u;
#pragma unroll
        for (unsigned j = 0; j < 16; ++j) { const unsigned c = xb_ld(&bar[XB_XCNT(j)]); sum += c; cnt += (c > 0u) ? 1u : 0u; mine = (j == x) ? c : mine; }
        if (sum == G) break;
        __builtin_amdgcn_s_sleep(1);
        if ((++sp & 255u) == 0u) { if (xb_ld(&bar[XB_TMO])) break; if (sp > XB_SPIN_CAP) { atomicAdd(&bar[XB_TMO], 1u); break; } }
    }
    nloc = mine > 0u ? mine : 1u; nx = cnt > 0u ? cnt : 1u;
}
__device__ __forceinline__ void xcd_barrier(const XcdBarrier& b) {
    asm volatile("s_waitcnt vmcnt(0)" ::: "memory");
    __syncthreads();
    if (threadIdx.x == 0) {
        unsigned* bar = b.bar;
        __builtin_amdgcn_s_waitcnt(0);
        unsigned nloc = b.st[0], nx = b.st[1];
        if (nloc == 0u) { xcd_barrier_complete(bar, b.x, nloc, nx); b.st[0] = nloc; b.st[1] = nx; }
        const unsigned old = xb_add(&bar[XB_XSUB(b.x)], 1u);
        const unsigned gen = old / nloc;
        if (old + 1u == (gen + 1u) * nloc) {
            __builtin_amdgcn_fence(__ATOMIC_RELEASE, "agent");
            asm volatile("s_waitcnt vmcnt(0)" ::: "memory");
            const unsigned og = xb_add(&bar[XB_TOP], 1u);
            const unsigned tg = og / nx;
            if (og + 1u == (tg + 1u) * nx) xb_add(&bar[XB_TOPGEN], 1u);
            else XB_SPIN(xb_ld(&bar[XB_TOPGEN]) == tg, bar);
            __builtin_amdgcn_fence(__ATOMIC_ACQUIRE, "agent");
            xb_add(&bar[XB_XGEN(b.x)], 1u);
            asm volatile("s_waitcnt vmcnt(0)" ::: "memory");
        } else {
            XB_SPIN(xb_ld(&bar[XB_XGEN(b.x)]) == gen, bar);
            __builtin_amdgcn_fence(__ATOMIC_ACQUIRE, "agent");
            asm volatile("s_waitcnt vmcnt(0)" ::: "memory");
        }
    }
    __syncthreads();
}

struct Params {
    const float* in[31];
    float* out;
    unsigned char* ws;
    int ph_lo, ph_hi, var, pad;
};
enum { I_X = 0, I_MEM, I_POS, I_GMIX, I_WIN, I_GQA, I_GKA, I_RELB, I_GCQ, I_WUQ, I_GCKV, I_WUKV, I_GQB, I_GKB, I_WO, I_GCROSS, I_GMEM, I_WXQ, I_WXKV,
       I_GQX, I_GKX, I_WXO, I_GFFN, I_WROUTER, I_RBIAS, I_WSHG, I_WSHU, I_WSHD, I_WEXG, I_WEXU, I_WEXD };

template <class OT>
__device__ __forceinline__ void rms_row_4096(const float* x, const float* g, OT* o, int lane, float* keep  ) {
    f32x4 v[16]; float s = 0.f;
#pragma unroll
    for (int j = 0; j < 16; ++j) { v[j] = ((const f32x4*)x)[lane + 64 * j]; s += v[j].x * v[j].x + v[j].y * v[j].y + v[j].z * v[j].z + v[j].w * v[j].w; }
    s = wave_sum(s);
    const float r = 1.0f / sqrtf(s * (1.0f / 4096.f) + EPS);
#pragma unroll
    for (int j = 0; j < 16; ++j) v[j] = v[j] * r * __builtin_nontemporal_load((const f32x4*)g + lane + 64 * j);
    asm volatile("s_waitcnt vmcnt(0)" ::: "memory");
#pragma unroll
    for (int j = 0; j < 16; ++j) {
        const f32x4 y = v[j];
        const int c = (lane + 64 * j) * 4;
        stf(o + c, y.x); stf(o + c + 1, y.y); stf(o + c + 2, y.z); stf(o + c + 3, y.w);
        if (keep) { keep[c] = y.x; keep[c + 1] = y.y; keep[c + 2] = y.z; keep[c + 3] = y.w; }
    }
}
template <int N>
__device__ __forceinline__ void rms_inplace(act_t* p, const float* g, int lane) {
    float v[N / 64]; float s = 0.f;
#pragma unroll
    for (int j = 0; j < N / 64; ++j) { v[j] = ldf(p + lane + 64 * j); s += v[j] * v[j]; }
    s = wave_sum(s);
    const float r = 1.0f / sqrtf(s * (1.0f / N) + EPS);
#pragma unroll
    for (int j = 0; j < N / 64; ++j) stf(p + lane + 64 * j, v[j] * r * g[lane + 64 * j]);
}
__device__ __forceinline__ void rms_rope64_inplace(act_t* p, const float* g, int pos, int lane) {
    float v = ldf(p + lane);
    float s = wave_sum(v * v);
    const float r = 1.0f / sqrtf(s * (1.0f / 64.f) + EPS);
    v = v * r * g[lane];
    const int fi = lane & 31;
    const float inv_freq = powf(10000.0f, -(float)(2 * fi) / 64.0f);
    const float ang = (float)pos * inv_freq;
    float sn, cs; sincosf(ang, &sn, &cs);
    const float other = __shfl_xor(v, 32);
    const float y = (lane < 32) ? (v * cs - other * sn) : (v * cs + other * sn);
    stf(p + lane, y);
}

template <class AT, class BCol, class Epi>
__device__ __forceinline__ void ngemm_tile(float* lds, const AT* A, long lda, const int* rowlist, int row0, int nrows, int K, const BCol& bcol, const Epi& epi) {
    const int tid = threadIdx.x, tx = tid & 31, ty = tid >> 5;
    float* As = lds; float* Bs = lds + 16 * 132;
    const int arow = tid >> 2, akq = (tid & 3) * 4;
    int grow; { const int rr = (arow < nrows) ? arow : 0; grow = rowlist ? rowlist[row0 + rr] : (row0 + rr); }
    const AT* Ap = A + (long)grow * lda + akq;
    const int bj = tid & 127, bk = tid >> 7;
    const float* Bp = bcol(bj) + (long)bk * bcol.ldb;
    float acc[8][4];
#pragma unroll
    for (int i = 0; i < 8; ++i)
#pragma unroll
        for (int j = 0; j < 4; ++j) acc[i][j] = 0.f;
    for (int k0 = 0; k0 < K; k0 += 16) {
        float a0 = ldf(Ap + k0), a1 = ldf(Ap + k0 + 1), a2 = ldf(Ap + k0 + 2), a3 = ldf(Ap + k0 + 3);
        float b0 = Bp[(long)(k0) * bcol.ldb], b1 = Bp[(long)(k0 + 4) * bcol.ldb], b2 = Bp[(long)(k0 + 8) * bcol.ldb], b3 = Bp[(long)(k0 + 12) * bcol.ldb];
        __syncthreads();
        As[(akq + 0) * 132 + arow] = a0; As[(akq + 1) * 132 + arow] = a1; As[(akq + 2) * 132 + arow] = a2; As[(akq + 3) * 132 + arow] = a3;
        Bs[(bk + 0) * 132 + bj] = b0; Bs[(bk + 4) * 132 + bj] = b1; Bs[(bk + 8) * 132 + bj] = b2; Bs[(bk + 12) * 132 + bj] = b3;
        __syncthreads();
#pragma unroll
        for (int kk = 0; kk < 16; ++kk) {
            const f32x4 al = *(const f32x4*)(As + kk * 132 + ty * 8), ah = *(const f32x4*)(As + kk * 132 + ty * 8 + 4);
            const f32x4 b = *(const f32x4*)(Bs + kk * 132 + tx * 4);
            const float a[8] = {al.x, al.y, al.z, al.w, ah.x, ah.y, ah.z, ah.w};
#pragma unroll
            for (int i = 0; i < 8; ++i) { acc[i][0] += a[i] * b.x; acc[i][1] += a[i] * b.y; acc[i][2] += a[i] * b.z; acc[i][3] += a[i] * b.w; }
        }
    }
    __syncthreads();
#pragma unroll
    for (int i = 0; i < 8; ++i) { const int r = ty * 8 + i; if (r < nrows) epi(r, tx * 4, acc[i]); }
}
struct BGU { const float* Wg; const float* Wu; int ldb; int ff0; __device__ __forceinline__ const float* operator()(int j) const { const int ff = ff0 + (j >> 2) * 2 + (j & 1); const uintptr_t a = (uintptr_t)Wg, b = (uintptr_t)Wu; return (const float*)((j & 2) ? b : a) + ff; } };
struct BPlain { const float* B; int ldb; int col0, ncols; __device__ __forceinline__ const float* operator()(int j) const { const int c = col0 + j; return B + (c < ncols ? c : 0); } };

template <int DQK, class KeyTile, class Bias>
__device__ __forceinline__ void nattn_unit(float* lds, const act_t* Q, long ldq, const act_t* K1, long ldk1, const act_t* K2, long ldk2, const act_t* V, long ldv,
                                           int ntiles, const KeyTile& keytile, float scale, const Bias& bias, act_t* O, long ldo) {
    constexpr int QS = DQK + 4;
    float* Qs = lds; float* Ks = Qs + 64 * QS; float* Vs = Ks + 64 * QS; float* Ss = Vs + 64 * 132;
    const int tid = threadIdx.x, r = tid >> 3, s = tid & 7;
    __syncthreads();
    for (int idx = tid; idx < 64 * DQK; idx += 512) { const int row = idx / DQK, d = idx % DQK; Qs[row * QS + d] = ldf(Q + (long)row * ldq + d); }
    float m = -INFINITY, l = 0.f; float o[16];
#pragma unroll
    for (int d = 0; d < 16; ++d) o[d] = 0.f;
    for (int t = 0; t < ntiles; ++t) {
        const int k0 = keytile(t);
        __syncthreads();
        for (int idx = tid; idx < 64 * 128; idx += 512) { const int row = idx >> 7, d = idx & 127;
            Ks[row * QS + d] = ldf(K1 + (long)(k0 + row) * ldk1 + d); Vs[row * 132 + d] = ldf(V + (long)(k0 + row) * ldv + d); }
        if (DQK > 128) for (int idx = tid; idx < 64 * (DQK - 128); idx += 512) { const int row = idx / (DQK - 128), d = idx % (DQK - 128);
            Ks[row * QS + 128 + d] = ldf(K2 + (long)(k0 + row) * ldk2 + d); }
        __syncthreads();
#pragma unroll
        for (int jj = 0; jj < 8; ++jj) { const int key = s + 8 * jj; float dot = 0.f;
#pragma unroll 8
            for (int d = 0; d < DQK; d += 4) { const f32x4 q = *(const f32x4*)(Qs + r * QS + d), k = *(const f32x4*)(Ks + key * QS + d); dot += q.x * k.x + q.y * k.y + q.z * k.z + q.w * k.w; }
            Ss[r * 65 + key] = dot * scale + bias(r, t, key); }
        __syncthreads();
        float mt = -INFINITY;
        for (int k = 0; k < 64; ++k) mt = fmaxf(mt, Ss[r * 65 + k]);
        const float mn = fmaxf(m, mt), alpha = expf(m - mn);
        float ladd = 0.f;
#pragma unroll
        for (int d = 0; d < 16; ++d) o[d] *= alpha;
        for (int k = 0; k < 64; ++k) { const float pk = expf(Ss[r * 65 + k] - mn); ladd += pk;
#pragma unroll
            for (int d = 0; d < 16; d += 4) { const f32x4 v = *(const f32x4*)(Vs + k * 132 + s * 16 + d); o[d] += pk * v.x; o[d + 1] += pk * v.y; o[d + 2] += pk * v.z; o[d + 3] += pk * v.w; } }
        m = mn; l = l * alpha + ladd;
    }
    const float il = 1.0f / l;
#pragma unroll
    for (int d = 0; d < 16; ++d) stf(O + (long)r * ldo + s * 16 + d, o[d] * il);
}

struct MoeTab { int* cnt; int* mtp; int* offh; };
__device__ __forceinline__ MoeTab moe_tables(int* tab, const unsigned* gcnt, int tile_m) {
    MoeTab T; T.cnt = tab; T.mtp = tab + 80; T.offh = tab + 160;
    __syncthreads();
    if (threadIdx.x == 0) {
        int pm = 0, po = 0;
        for (int e = 0; e <= NE; ++e) { const int c = (e < NE) ? (int)gcnt[e] : NTOK; T.cnt[e] = c; T.mtp[e] = pm; T.offh[e] = po; pm += (c + tile_m - 1) / tile_m; po += c; }
        T.mtp[NE + 1] = pm;
    }
    __syncthreads();
    return T;
}

namespace fg {
constexpr int BM = 256, BK = 64, HALF = 128, HTB = HALF * BK * 2, STAGE_BYTES = 8 * HTB;
__device__ __forceinline__ int lds_byte(int r, int c) { const int st = (r >> 4) * 2 + (c >> 5), rr = r & 15, cc = c & 31, ob = rr * 64 + cc * 2; return st * 1024 + (ob ^ (((ob >> 9) & 1) << 5)); }
__device__ __forceinline__ void stage_rc(int b, int& R, int& C) { const int st = b / 1024, sb = b % 1024, swz = sb ^ (((sb >> 9) & 1) << 5); R = (st >> 1) * 16 + swz / 64; C = (st & 1) * 32 + (swz % 64) / 2; }
__device__ __forceinline__ int perm32(int rho) { const int n = rho >> 4, i = rho & 15; return 8 * (i >> 2) + 4 * n + (i & 3); }
__device__ __forceinline__ unsigned cvt_pk_bf16(float lo, float hi) { unsigned r; asm volatile("v_cvt_pk_bf16_f32 %0, %1, %2" : "=v"(r) : "v"(lo), "v"(hi)); return r; }

__device__ __forceinline__ unsigned pk4_fp8(float a, float b, float c, float d) { int w = 0; w = __builtin_amdgcn_cvt_pk_fp8_f32(a, b, w, false); w = __builtin_amdgcn_cvt_pk_fp8_f32(c, d, w, true); return (unsigned)w; }
constexpr float H_SCALE = 4.0f, WD_SCALE = 32.0f, WGU_SCALE = 64.0f, T_SCALE = 2.0f, Y_SCALE = 16.0f;
struct Unit { const char* A; const char* B; const int* rows; int nkt, nvalid, pm, pn, e, arow0; };

template <class Epi, class Sched, bool GATHER, bool FP8 = false, bool SP2 = false>
__device__ __forceinline__ void gemm_phase(LAS unsigned char* lds, const Sched& S, const Epi& E, const int lda, const int ldb, const int var_in = 0) {
#ifdef PROBE_PH
    const int var = var_in;
#else
    constexpr int var = 0; (void)var_in;
#endif
    int tid = threadIdx.x; asm volatile("" : "+v"(tid));
    const int wid = __builtin_amdgcn_readfirstlane(tid >> 6), lane = tid & 63, wr = wid >> 2, wc = wid & 3, fr = lane & 15, fq = lane >> 4;
    unsigned voffB[2][2], voffA[2][2];
#pragma unroll
    for (int i = 0; i < 2; ++i) { int sR, sC; stage_rc(tid * 16 + i * 8192, sR, sC);
#pragma unroll
        for (int hb = 0; hb < 2; ++hb) { int Rb;
            if (Epi::PERM == 2) Rb = 64 * (sR >> 5) + 16 * ((sR >> 2) & 3) + 8 * hb + 4 * ((sR >> 4) & 1) + (sR & 3);
            else Rb = 128 * hb + (Epi::PERM == 1 ? ((sR & ~31) + perm32(sR & 31)) : sR);
            voffB[hb][i] = (unsigned)((Rb >> 6) * ldb * 64 + (Rb & 63) * 64 + sC) * 2u; }
#pragma unroll
        for (int h = 0; h < 2; ++h) voffA[h][i] = (unsigned)((sR + HALF * h) * lda + sC) * 2u; }
    const size_t kstep = (size_t)(BK * 2), kstepB = 8192;
    const unsigned ldsw = (unsigned)wid * 1024u;
    const int aoff = FP8 ? lds_byte(wr * 64 + fr, fq * 16) : lds_byte(wr * 64 + fr, fq * 8), boff = FP8 ? lds_byte(wc * 32 + fr, fq * 16) : lds_byte(wc * 32 + fr, fq * 8);
#define FG_SA(b, h) (((b) * 2 + (h)) * HTB)
#define FG_SB(b, h) ((4 + (b) * 2 + (h)) * HTB)
#define FG_STAGE2(bufoff, gbase, v0, v1) do { \
        __builtin_amdgcn_global_load_lds((const unsigned*)((const char*)(gbase) + (v0)), (LAS unsigned*)(lds + (bufoff) + ldsw), 16, 0, 0); \
        __builtin_amdgcn_global_load_lds((const unsigned*)((const char*)(gbase) + (v1)), (LAS unsigned*)(lds + (bufoff) + ldsw + 8192), 16, 0, 0); } while (0)
#define FG_STAGEB(bufoff, gbase, hb) FG_STAGE2(bufoff, gbase, voffB[hb][0], voffB[hb][1])
#define FG_STAGEA(bufoff, gbase, h) FG_STAGE2(bufoff, gbase, voffA[h][0], voffA[h][1])
#define FG_LD8(base_) __builtin_shufflevector(*(const LAS v4i_t*)(base_), *(const LAS v4i_t*)((base_) + 16), 0, 1, 2, 3, 4, 5, 6, 7)
#define FG_LDA(dst, b, h) do { if (FP8) { _Pragma("unroll") for (int m = 0; m < 4; ++m) dst##8[m] = FG_LD8(lds + FG_SA(b, h) + aoff + m * 2048); } \
      else { _Pragma("unroll") for (int m = 0; m < 4; ++m) _Pragma("unroll") for (int k = 0; k < 2; ++k) dst[m][k] = *(const LAS bf16x8*)(lds + FG_SA(b, h) + aoff + m * 2048 + k * 1024); } } while (0)
#define FG_LDB(dst, b, h) do { if (FP8) { _Pragma("unroll") for (int n = 0; n < 2; ++n) dst##8[n] = FG_LD8(lds + FG_SB(b, h) + boff + n * 2048); } \
      else { _Pragma("unroll") for (int n = 0; n < 2; ++n) _Pragma("unroll") for (int k = 0; k < 2; ++k) dst[n][k] = *(const LAS bf16x8*)(lds + FG_SB(b, h) + boff + n * 2048 + k * 1024); } } while (0)
#define FG_MMA(ai, bj, At, Bt) do { __builtin_amdgcn_s_setprio(1); if (FP8) { _Pragma("unroll") for (int m = 0; m < 4; ++m) _Pragma("unroll") for (int n = 0; n < 2; ++n) \
        asm volatile("v_mfma_scale_f32_16x16x128_f8f6f4 %0, %1, %2, %0, %3, %3 op_sel_hi:[0,0,0]" : "+v"(acc[ai][bj][m][n]) : "v"(Bt##8[n]), "v"(At##8[m]), "v"(sc127)); } \
      else { _Pragma("unroll") for (int m = 0; m < 4; ++m) _Pragma("unroll") for (int n = 0; n < 2; ++n) _Pragma("unroll") for (int k = 0; k < 2; ++k) \
        acc[ai][bj][m][n] = __builtin_amdgcn_mfma_f32_16x16x32_bf16(Bt[n][k], At[m][k], acc[ai][bj][m][n], 0, 0, 0); } __builtin_amdgcn_s_setprio(0); } while (0)
#define FG_WAIT_V(n) asm volatile("s_waitcnt vmcnt(" #n ")" ::: "memory")
#define FG_WAIT_L(n) asm volatile("s_waitcnt lgkmcnt(" #n ")" ::: "memory")
#define FG_BAR __builtin_amdgcn_s_barrier()
#define FG_SCHED __builtin_amdgcn_sched_barrier(0)
#define FG_GATHER(dst, u) do { if (GATHER) { int tz = threadIdx.x; asm volatile("" : "+v"(tz)); _Pragma("unroll") for (int i = 0; i < 2; ++i) { int sR, sC; stage_rc(tz * 16 + i * 8192, sR, sC); \
        _Pragma("unroll") for (int h = 0; h < 2; ++h) { int rr = sR + HALF * h; rr = rr < (u).nvalid ? rr : 0; const int tok = (u).rows ? (u).rows[rr] : ((u).arow0 + rr); dst[h][i] = (unsigned)(tok * lda + sC) * 2u; } } } } while (0)
    Unit cur, nxt; int ui = 0;
    if (!S.next(0, cur)) return;
    f32x4 acc[2][2][4][2];
#pragma unroll
    for (int a = 0; a < 2; ++a)
#pragma unroll
        for (int b = 0; b < 2; ++b)
#pragma unroll
            for (int m = 0; m < 4; ++m)
#pragma unroll
                for (int n = 0; n < 2; ++n) acc[a][b][m][n] = (f32x4){0.f, 0.f, 0.f, 0.f};
    const int sc127 = 127;
    bf16x8 At[4][2], B0[2][2], B1[2][2]; v8i_t At8[4], B08[2], B18[2];
    const char* cA = cur.A; const char* cB = cur.B;
    typename Epi::Pre pre; E.prefetch(pre, cur, wr, fr);
    FG_GATHER(voffA, cur);
    if (SP2) {
    FG_STAGEB(FG_SB(0, 0), cB, 0); FG_STAGEB(FG_SB(0, 1), cB, 1); FG_STAGEA(FG_SA(0, 0), cA, 0); FG_STAGEA(FG_SA(0, 1), cA, 1);
    if (wr == 1) FG_BAR;
    FG_WAIT_V(2); FG_BAR;
    FG_STAGEB(FG_SB(1, 0), cB + kstepB, 0); FG_STAGEA(FG_SA(1, 0), cA + kstep, 0); FG_STAGEB(FG_SB(1, 1), cB + kstepB, 1);
    FG_WAIT_V(6); FG_BAR;
    } else {
    FG_STAGEB(FG_SB(0, 0), cB, 0); FG_STAGEA(FG_SA(0, 0), cA, 0); FG_STAGEB(FG_SB(0, 1), cB, 1); FG_STAGEA(FG_SA(0, 1), cA, 1);
    if (wr == 1) FG_BAR;
    FG_WAIT_V(4); FG_BAR;
    FG_STAGEB(FG_SB(1, 0), cB + kstepB, 0); FG_STAGEA(FG_SA(1, 0), cA + kstep, 0); FG_STAGEB(FG_SB(1, 1), cB + kstepB, 1);
    FG_WAIT_V(6); FG_BAR;
    }
    for (;;) {
        const bool has_next = S.next(ui + 1, nxt);
        const char* nA = has_next ? nxt.A : cA; const char* nB = has_next ? nxt.B : cB;
        const int nt = cur.nkt;
#pragma unroll 1
        for (int t = 0; t < nt; t += 2) {
            const bool last = (t == nt - 2);
            const char* a1 = cA + (size_t)(t + 1) * kstep;
            const char* a2 = last ? nA : cA + (size_t)(t + 2) * kstep; const char* b2 = last ? nB : cB + (size_t)(t + 2) * kstepB;
            const char* a3 = a2 + kstep; const char* b3 = b2 + kstepB;
            if (SP2) {
            FG_LDB(B0, 0, 0); FG_LDB(B1, 0, 1); FG_SCHED; FG_LDA(At, 0, 0); FG_STAGEA(FG_SA(1, 1), a1, 1);
            if (GATHER && last && has_next) { FG_GATHER(voffA, nxt); }
            FG_WAIT_V(8); FG_WAIT_L(0); FG_BAR; FG_MMA(0, 0, At, B0); FG_MMA(0, 1, At, B1); FG_BAR; FG_SCHED;
            FG_LDA(At, 0, 1); FG_STAGEB(FG_SB(0, 0), b2, 0); FG_STAGEB(FG_SB(0, 1), b2, 1); FG_STAGEA(FG_SA(0, 0), a2, 0);
            FG_WAIT_V(8); FG_WAIT_L(0); FG_BAR; FG_MMA(1, 0, At, B0); FG_MMA(1, 1, At, B1); FG_BAR; FG_SCHED;
            FG_LDB(B0, 1, 0); FG_LDB(B1, 1, 1); FG_SCHED; FG_LDA(At, 1, 0); FG_STAGEA(FG_SA(0, 1), a2, 1);
            FG_WAIT_V(8); FG_WAIT_L(0); FG_BAR; FG_MMA(0, 0, At, B0); FG_MMA(0, 1, At, B1); FG_BAR; FG_SCHED;
            FG_LDA(At, 1, 1); FG_STAGEB(FG_SB(1, 0), b3, 0); FG_STAGEB(FG_SB(1, 1), b3, 1); FG_STAGEA(FG_SA(1, 0), a3, 0);
            FG_WAIT_V(8); FG_WAIT_L(0); FG_BAR; FG_MMA(1, 0, At, B0); FG_MMA(1, 1, At, B1); FG_BAR; FG_SCHED;
            } else {
            FG_LDB(B0, 0, 0); FG_SCHED; FG_LDA(At, 0, 0); FG_STAGEA(FG_SA(1, 1), a1, 1);
            if (GATHER && last && has_next) { FG_GATHER(voffA, nxt); }
            FG_WAIT_L(8); FG_BAR; FG_WAIT_L(0); if (var < 4) FG_MMA(0, 0, At, B0); FG_BAR; FG_SCHED;
            FG_LDB(B1, 0, 1); FG_STAGEB(FG_SB(0, 0), b2, 0);
            FG_BAR; FG_WAIT_L(0); if (var < 3) FG_MMA(0, 1, At, B1); FG_BAR;
            FG_LDA(At, 0, 1); FG_STAGEA(FG_SA(0, 0), a2, 0);
            FG_BAR; FG_WAIT_L(0); if (var < 4) FG_MMA(1, 0, At, B0); FG_BAR; FG_SCHED;
            FG_STAGEB(FG_SB(0, 1), b2, 1);
            FG_WAIT_V(6); FG_BAR; if (var < 3) FG_MMA(1, 1, At, B1); FG_BAR;
            FG_LDB(B0, 1, 0); FG_SCHED; FG_LDA(At, 1, 0); FG_STAGEA(FG_SA(0, 1), a2, 1);
            FG_WAIT_L(8); FG_BAR; FG_WAIT_L(0); if (var < 4) FG_MMA(0, 0, At, B0); FG_BAR; FG_SCHED;
            FG_LDB(B1, 1, 1); FG_STAGEB(FG_SB(1, 0), b3, 0);
            FG_BAR; FG_WAIT_L(0); if (var < 3) FG_MMA(0, 1, At, B1); FG_BAR;
            FG_LDA(At, 1, 1); FG_STAGEA(FG_SA(1, 0), a3, 0);
            FG_BAR; FG_WAIT_L(0); if (var < 4) FG_MMA(1, 0, At, B0); FG_BAR; FG_SCHED;
            FG_STAGEB(FG_SB(1, 1), b3, 1);
            FG_WAIT_V(6); FG_BAR; if (var < 3) FG_MMA(1, 1, At, B1); FG_BAR;
                    }
}
        if (SP2) { if (wr == 0) FG_BAR; }
        { int tz = threadIdx.x; asm volatile("" : "+v"(tz));
          const int wz = __builtin_amdgcn_readfirstlane(tz >> 6), lz = tz & 63; if (var != 2 && var != 9) E(acc, cur, wz >> 2, wz & 3, lz & 15, lz >> 4, pre); }
        if (!has_next) break;
#pragma unroll
        for (int a = 0; a < 2; ++a)
#pragma unroll
            for (int b = 0; b < 2; ++b)
#pragma unroll
                for (int m = 0; m < 4; ++m)
#pragma unroll
                    for (int n = 0; n < 2; ++n) acc[a][b][m][n] = (f32x4){0.f, 0.f, 0.f, 0.f};
        cur = nxt; cA = nA; cB = nB; ++ui;
        { int tz = threadIdx.x; asm volatile("" : "+v"(tz)); E.prefetch(pre, cur, __builtin_amdgcn_readfirstlane(tz >> 6) >> 2, tz & 15); }
        if (SP2) { if (wr == 1) FG_BAR; }
    }
    FG_WAIT_V(0);
    if (!SP2) { if (wr == 0) FG_BAR; }
    FG_BAR;
#undef FG_SA
#undef FG_SB
#undef FG_STAGE2
#undef FG_STAGEB
#undef FG_STAGEA
#undef FG_STAGEAX
#undef FG_LDA
#undef FG_LDB
#undef FG_MMA
#undef FG_LD8
#undef FG_WAIT_V
#undef FG_WAIT_L
#undef FG_BAR
#undef FG_SCHED
#undef FG_GATHER
}

struct DenseSched {
    const char* A; const char* B; int lda, ldb, nM, nN, nS, nkt, G, c, first;
    __device__ __forceinline__ bool next(int i, Unit& u) const {
        const int total = nM * nN * nS; const int per = (total + 7) / 8;
        int L;
        if (first == 1) {
            const int x = c & 7, r = c >> 3; if (r >= 16) { if (i >= 3) return false; L = x * 64 + (r - 16) * 3 + i; } else { if (i >= 1) return false; L = x * 64 + 48 + r; }
        } else {
        const int j = i * G + c; const int x = j & 7, q = j >> 3;
        if (q >= per) return false; L = x * per + q; if (L >= total) return false; }
        const int ks = L % nS, t2 = L / nS;
        const int nig = 8 * nN, gid = t2 / nig, fm = gid * 8, gsz = (nM - fm) < 8 ? (nM - fm) : 8;
        const int pm = fm + (t2 % nig) % gsz, pn = (t2 % nig) / gsz;
        u.A = A + ((size_t)pm * BM * lda + (size_t)ks * nkt * BK) * 2; u.B = B + ((size_t)pn * BM * ldb + (size_t)ks * nkt * 4096) * 2;
        if (first == 2) { u.A = A; u.B = B; }
        u.rows = nullptr; u.nkt = nkt; u.nvalid = BM; u.pm = pm; u.pn = pn; u.e = ks; u.arow0 = pm * BM; return true;
    }
};
struct NoPre {};
struct EpiBf16 {
    static constexpr int PERM = 1; typedef NoPre Pre; __device__ __forceinline__ void prefetch(Pre&, const Unit&, int, int) const {}
    bf16_t* O; int ldc, ncols; float scale;
    __device__ __forceinline__ void operator()(const f32x4 (&acc)[2][2][4][2], const Unit& u, int wr, int wc, int fr, int fq, const Pre& pre) const {
        const int row0 = u.pm * BM + wr * 64 + fr, col0 = u.pn * BM + wc * 32 + 8 * fq;
#pragma unroll
        for (int ai = 0; ai < 2; ++ai)
#pragma unroll
            for (int m = 0; m < 4; ++m) { bf16_t* rowp = O + (size_t)(row0 + ai * HALF + m * 16) * ldc + col0;
#pragma unroll
                for (int bj = 0; bj < 2; ++bj) { const f32x4 v0 = acc[ai][bj][m][0] * scale, v1 = acc[ai][bj][m][1] * scale;
                    u32x4 w; w.x = cvt_pk_bf16(v0[0], v0[1]); w.y = cvt_pk_bf16(v0[2], v0[3]); w.z = cvt_pk_bf16(v1[0], v1[1]); w.w = cvt_pk_bf16(v1[2], v1[3]);
                    if (col0 + bj * HALF + 8 <= ncols) *(u32x4*)(rowp + bj * HALF) = w; } }
    }
};
template <bool HAS_RES> struct EpiF32Res {
    static constexpr int PERM = 0; typedef NoPre Pre; __device__ __forceinline__ void prefetch(Pre&, const Unit&, int, int) const {}
    float* __restrict__ C; const float* __restrict__ res; int ldc; size_t slab; float scale;
    __device__ __forceinline__ void operator()(const f32x4 (&acc)[2][2][4][2], const Unit& u, int wr, int wc, int fr, int fq, const Pre& pre) const {
        const int row0 = u.pm * BM + wr * 64 + fr, col0 = u.pn * BM + wc * 32 + 4 * fq;
        float* __restrict__ Cb = C + (size_t)u.e * slab;
#pragma unroll
        for (int ai = 0; ai < 2; ++ai) {
            f32x4 r[4][2][2];
            if (HAS_RES) {
#pragma unroll
                for (int m = 0; m < 4; ++m) { const size_t o = (size_t)(row0 + ai * HALF + m * 16) * ldc + col0;
#pragma unroll
                    for (int bj = 0; bj < 2; ++bj)
#pragma unroll
                        for (int n = 0; n < 2; ++n) r[m][bj][n] = __builtin_nontemporal_load((const f32x4*)(res + o + bj * HALF + n * 16)); }
            }
#pragma unroll
            for (int m = 0; m < 4; ++m) { const size_t o = (size_t)(row0 + ai * HALF + m * 16) * ldc + col0;
#pragma unroll
                for (int bj = 0; bj < 2; ++bj)
#pragma unroll
                    for (int n = 0; n < 2; ++n) { f32x4 v = acc[ai][bj][m][n] * scale; if (HAS_RES) v = v + r[m][bj][n]; *(f32x4*)(Cb + o + bj * HALF + n * 16) = v; } }
        }
    }
};
struct MoeTabs { const LAS int* cnt; const LAS int* mtp; };
template <int PHASE  >
struct MoeSched {
    MoeTabs T; const char* A; const char* B; const int* rowtok; int G, c;
    __device__ __forceinline__ bool next(int i, Unit& u) const {
        constexpr int NT = (PHASE == 1) ? 4 : 16;
        const int nm = T.mtp[(PHASE == 1) ? 65 : 64], total = nm * NT, per = (total + 7) / 8;
        const int j = i * G + c, x = j & 7, q = j >> 3;
        if (q >= per) return false; const int L = x * per + q; if (L >= total) return false;
        int mti, pn;
        if (PHASE == 1) { mti = L / NT; pn = L % NT; }
        else { mti = L / NT; pn = 0; }
        int e = 0;
#pragma unroll 1
        for (int s2 = 32; s2 >= 1; s2 >>= 1) { if (e + s2 <= 64 && T.mtp[e + s2] <= mti) e += s2; }
        while (T.mtp[e + 1] <= mti) ++e;
        e = __builtin_amdgcn_readfirstlane(e);
        int mt = mti - T.mtp[e];
        if (PHASE == 2) {
            const int nme = T.mtp[e + 1] - T.mtp[e], r = L - T.mtp[e] * NT, ph = r / (nme * 8), r2 = r % (nme * 8);
            mt = r2 >> 3; pn = ph * 8 + (r2 & 7); mti = T.mtp[e] + mt; }
        int nv = T.cnt[e] - mt * 256; nv = nv < 256 ? nv : 256;
        u.nvalid = nv; u.pm = mti; u.pn = pn; u.e = e;
        if (PHASE == 1) { u.A = A; u.B = B + ((size_t)e * 1024 + (size_t)pn * 256) * DM; u.rows = (e < NE) ? rowtok + e * CAP + mt * 256 : nullptr; u.arow0 = mt * 256; u.nkt = DM / 128; }
        else { u.A = A + (size_t)mti * 256 * EFF; u.B = B + ((size_t)e * DM + (size_t)pn * 256) * EFF; u.rows = nullptr; u.arow0 = mt * 256; u.nkt = EFF / 128; }
        return true;
    }
};
struct EpiSwiglu {
    static constexpr int PERM = 1;
    struct Pre { float ssv[2][4]; };
    bf16_t* H; const float* ss;
    __device__ __forceinline__ void prefetch(Pre& pre, const Unit& u, int wr, int fr) const {
        const int r0 = wr * 64 + fr;
#pragma unroll
        for (int ai = 0; ai < 2; ++ai)
#pragma unroll
            for (int m = 0; m < 4; ++m) { int rr = r0 + ai * HALF + m * 16; rr = rr < u.nvalid ? rr : 0; const int tok = u.rows ? u.rows[rr] : (u.arow0 + rr); pre.ssv[ai][m] = ss[tok]; } }
    __device__ __forceinline__ void operator()(const f32x4 (&acc)[2][2][4][2], const Unit& u, int wr, int wc, int fr, int fq, const Pre& pre) const {
        const int r0 = wr * 64 + fr, col0 = u.pn * 128 + wc * 32 + 8 * fq;
#pragma unroll
        for (int ai = 0; ai < 2; ++ai)
#pragma unroll
            for (int m = 0; m < 4; ++m) { const int r = r0 + ai * HALF + m * 16;
                const float rs = pre.ssv[ai][m] * (1.0f / (T_SCALE * WGU_SCALE));
                float h[8];
#pragma unroll
                for (int n = 0; n < 2; ++n)
#pragma unroll
                    for (int j = 0; j < 4; ++j) { const float g = acc[ai][0][m][n][j] * rs, up = acc[ai][1][m][n][j] * rs; h[n * 4 + j] = g * __builtin_amdgcn_rcpf(1.0f + __expf(-g)) * up; }
                u32x2 w; w.x = pk4_fp8(h[0] * H_SCALE, h[1] * H_SCALE, h[2] * H_SCALE, h[3] * H_SCALE); w.y = pk4_fp8(h[4] * H_SCALE, h[5] * H_SCALE, h[6] * H_SCALE, h[7] * H_SCALE);
                if (r < u.nvalid) *(u32x2*)((unsigned char*)H + ((size_t)u.pm * 256 + r) * EFF + col0) = w; }
    }
};
struct EpiScatter {
    static constexpr int PERM = 2;
    struct Pre { int dst[2][4]; float gt[2][4]; };
    unsigned char* Y; const int* rowdst; const float* rowgate; const LAS int* mtp;
    __device__ __forceinline__ void prefetch(Pre& pre, const Unit& u, int wr, int fr) const {
        const int r0 = wr * 64 + fr, lbase = u.e * CAP + (u.pm - mtp[u.e]) * 256;
#pragma unroll
        for (int ai = 0; ai < 2; ++ai)
#pragma unroll
            for (int m = 0; m < 4; ++m) { const int r = r0 + ai * HALF + m * 16; const bool ok = r < u.nvalid; pre.dst[ai][m] = ok ? rowdst[lbase + r] : -1; pre.gt[ai][m] = ok ? rowgate[lbase + r] : 0.f; } }
    __device__ __forceinline__ void operator()(const f32x4 (&acc)[2][2][4][2], const Unit& u, int wr, int wc, int fr, int fq, const Pre& pre) const {
        const int col0 = u.pn * BM + wc * 64 + 16 * fq;
#pragma unroll
        for (int ai = 0; ai < 2; ++ai)
#pragma unroll
            for (int m = 0; m < 4; ++m) { if (pre.dst[ai][m] >= 0) { const float g = pre.gt[ai][m] * (Y_SCALE / (H_SCALE * WD_SCALE));
                const f32x4 v0 = acc[ai][0][m][0] * g, v1 = acc[ai][0][m][1] * g, v2 = acc[ai][1][m][0] * g, v3 = acc[ai][1][m][1] * g;
                u32x4 w; w.x = pk4_fp8(v0[0], v0[1], v0[2], v0[3]); w.y = pk4_fp8(v1[0], v1[1], v1[2], v1[3]); w.z = pk4_fp8(v2[0], v2[1], v2[2], v2[3]); w.w = pk4_fp8(v3[0], v3[1], v3[2], v3[3]);
                *(u32x4*)(Y + (size_t)pre.dst[ai][m] * DM + col0) = w; } }
    }
};
struct EpiShared {
    static constexpr int PERM = 2; typedef NoPre Pre; __device__ __forceinline__ void prefetch(Pre&, const Unit&, int, int) const {}
    unsigned char* Y9;
    __device__ __forceinline__ void operator()(const f32x4 (&acc)[2][2][4][2], const Unit& u, int wr, int wc, int fr, int fq, const Pre& pre) const {
        const int col0 = u.pn * BM + wc * 64 + 16 * fq; const float g = Y_SCALE / (H_SCALE * WD_SCALE);
#pragma unroll
        for (int ai = 0; ai < 2; ++ai)
#pragma unroll
            for (int m = 0; m < 4; ++m) { const int row = u.pm * BM + ai * HALF + wr * 64 + m * 16 + fr;
                const f32x4 v0 = acc[ai][0][m][0] * g, v1 = acc[ai][0][m][1] * g, v2 = acc[ai][1][m][0] * g, v3 = acc[ai][1][m][1] * g;
                u32x4 w; w.x = pk4_fp8(v0[0], v0[1], v0[2], v0[3]); w.y = pk4_fp8(v1[0], v1[1], v1[2], v1[3]); w.z = pk4_fp8(v2[0], v2[1], v2[2], v2[3]); w.w = pk4_fp8(v3[0], v3[1], v3[2], v3[3]);
                *(u32x4*)(Y9 + (size_t)row * DM + col0) = w; }
    }
};
struct EpiResStat {
    static constexpr int PERM = 0; typedef NoPre Pre; __device__ __forceinline__ void prefetch(Pre&, const Unit&, int, int) const {}
    float* __restrict__ C; const float* __restrict__ res; bf16_t* __restrict__ Xb; const float* __restrict__ g; float* ss; int ldc; float scale;
    __device__ __forceinline__ void operator()(const f32x4 (&acc)[2][2][4][2], const Unit& u, int wr, int wc, int fr, int fq, const Pre& pre) const {
        const int row0 = u.pm * BM + wr * 64 + fr, col0 = u.pn * BM + wc * 32 + 4 * fq;
        f32x4 gv[2][2];
#pragma unroll
        for (int bj = 0; bj < 2; ++bj)
#pragma unroll
            for (int n = 0; n < 2; ++n) gv[bj][n] = *(const f32x4*)(g + col0 + bj * HALF + n * 16);
#pragma unroll
        for (int ah = 0; ah < 4; ++ah) { const int ai = ah >> 1, mb = (ah & 1) * 2;
            f32x4 r[4][2][2];
#pragma unroll
            for (int m = mb; m < mb + 2; ++m) { const size_t o = (size_t)(row0 + ai * HALF + m * 16) * ldc + col0;
#pragma unroll
                for (int bj = 0; bj < 2; ++bj)
#pragma unroll
                    for (int n = 0; n < 2; ++n) r[m][bj][n] = __builtin_nontemporal_load((const f32x4*)(res + o + bj * HALF + n * 16)); }
#pragma unroll
            for (int m = mb; m < mb + 2; ++m) { const int row = row0 + ai * HALF + m * 16; const size_t o = (size_t)row * ldc + col0; float sq = 0.f;
#pragma unroll
                for (int bj = 0; bj < 2; ++bj)
#pragma unroll
                    for (int n = 0; n < 2; ++n) { const f32x4 v = acc[ai][bj][m][n] * scale + r[m][bj][n]; *(f32x4*)(C + o + bj * HALF + n * 16) = v;
                        sq += (v.x * v.x + v.y * v.y) + (v.z * v.z + v.w * v.w);
                        const f32x4 w = v * gv[bj][n]; u32x2 pk; pk.x = cvt_pk_bf16(w.x, w.y); pk.y = cvt_pk_bf16(w.z, w.w); *(u32x2*)(Xb + o + bj * HALF + n * 16) = pk; }
                sq += __shfl_xor(sq, 16); sq += __shfl_xor(sq, 32);
                if (fq == 0) ss[(size_t)row * 64 + u.pn * 4 + wc] = sq; }
        }
    }
};
struct EpiX2 {
    static constexpr int PERM = 1; typedef NoPre Pre; __device__ __forceinline__ void prefetch(Pre&, const Unit&, int, int) const {}
    float* __restrict__ C; const float* __restrict__ res; bf16_t* __restrict__ Th; bf16_t* __restrict__ Tl; unsigned char* __restrict__ T8; const float* __restrict__ g; float* ss; int ldc;
    __device__ __forceinline__ void operator()(const f32x4 (&acc)[2][2][4][2], const Unit& u, int wr, int wc, int fr, int fq, const Pre& pre) const {
        const int row0 = u.pm * BM + wr * 64 + fr, col0 = u.pn * BM + wc * 32 + 8 * fq;
        f32x4 gv[2][2];
#pragma unroll
        for (int bj = 0; bj < 2; ++bj)
#pragma unroll
            for (int n = 0; n < 2; ++n) gv[bj][n] = *(const f32x4*)(g + col0 + bj * HALF + n * 4);
#pragma unroll
        for (int ah = 0; ah < 4; ++ah) { const int ai = ah >> 1, mb = (ah & 1) * 2;
            f32x4 r[4][2][2];
#pragma unroll
            for (int m = mb; m < mb + 2; ++m) { const size_t o = (size_t)(row0 + ai * HALF + m * 16) * ldc + col0;
#pragma unroll
                for (int bj = 0; bj < 2; ++bj)
#pragma unroll
                    for (int n = 0; n < 2; ++n) r[m][bj][n] = __builtin_nontemporal_load((const f32x4*)(res + o + bj * HALF + n * 4)); }
#pragma unroll
            for (int m = mb; m < mb + 2; ++m) { const int row = row0 + ai * HALF + m * 16; const size_t o = (size_t)row * ldc + col0; float sq = 0.f;
#pragma unroll
                for (int bj = 0; bj < 2; ++bj) {
                    const f32x4 v0 = acc[ai][bj][m][0] + r[m][bj][0], v1 = acc[ai][bj][m][1] + r[m][bj][1];
                    *(f32x4*)(C + o + bj * HALF) = v0; *(f32x4*)(C + o + bj * HALF + 4) = v1;
                    sq += (v0.x * v0.x + v0.y * v0.y) + (v0.z * v0.z + v0.w * v0.w) + (v1.x * v1.x + v1.y * v1.y) + (v1.z * v1.z + v1.w * v1.w);
                    const f32x4 w0 = v0 * gv[bj][0], w1 = v1 * gv[bj][1];
                    u32x4 h; h.x = cvt_pk_bf16(w0.x, w0.y); h.y = cvt_pk_bf16(w0.z, w0.w); h.z = cvt_pk_bf16(w1.x, w1.y); h.w = cvt_pk_bf16(w1.z, w1.w);
                    u32x4 l; l.x = cvt_pk_bf16(w0.x - __uint_as_float(h.x << 16), w0.y - __uint_as_float(h.x & 0xffff0000u)); l.y = cvt_pk_bf16(w0.z - __uint_as_float(h.y << 16), w0.w - __uint_as_float(h.y & 0xffff0000u));
                    l.z = cvt_pk_bf16(w1.x - __uint_as_float(h.z << 16), w1.y - __uint_as_float(h.z & 0xffff0000u)); l.w = cvt_pk_bf16(w1.z - __uint_as_float(h.w << 16), w1.w - __uint_as_float(h.w & 0xffff0000u));
                    u32x2 q8; q8.x = pk4_fp8(w0.x * T_SCALE, w0.y * T_SCALE, w0.z * T_SCALE, w0.w * T_SCALE); q8.y = pk4_fp8(w1.x * T_SCALE, w1.y * T_SCALE, w1.z * T_SCALE, w1.w * T_SCALE);
                    *(u32x4*)(Th + o + bj * HALF) = h; *(u32x4*)(Tl + o + bj * HALF) = l; *(u32x2*)(T8 + o + bj * HALF) = q8; }
                sq += __shfl_xor(sq, 16); sq += __shfl_xor(sq, 32);
                if (fq == 0) ss[(size_t)row * 64 + u.pn * 4 + wc] = sq; }
        }
    }
};
}

namespace fa {
typedef short s16x4 __attribute__((ext_vector_type(4)));
typedef float f32x16 __attribute__((ext_vector_type(16)));
constexpr int SHM_V = 16384, SHM_K = 16384, SHM_K2 = 8192;
constexpr int OFF_V = 0, OFF_K = 2 * SHM_V, OFF_K2 = OFF_K + 2 * SHM_K, OFF_WS = OFF_K2 + 2 * SHM_K2, OFF_TBL = OFF_WS + 8 * 64 * 4, OFF_QPE = OFF_TBL + 1024, LDS_ATTN = OFF_QPE + 8 * 4096;
#define KSWZ(row, colB) ((row) * 256 + ((colB) ^ (((row) & 7) << 4)))
#define KSWZ2(row, colB) ((row) * 128 + ((colB) ^ (((row) & 7) << 4)))
#define SBAR() __builtin_amdgcn_sched_barrier(0)
__device__ __forceinline__ int crow(int r, int hi) { return (r & 3) + 8 * (r >> 2) + 4 * hi; }
__device__ __forceinline__ unsigned cvtpk(float lo, float hi) { unsigned r; asm volatile("v_cvt_pk_bf16_f32 %0, %1, %2" : "=v"(r) : "v"(lo), "v"(hi)); return r; }
constexpr float MIX_SCALE = 64.0f;
__device__ __forceinline__ unsigned fg_pk4_fp8(float a, float b, float c, float d) { int w = 0; w = __builtin_amdgcn_cvt_pk_fp8_f32(a, b, w, false); w = __builtin_amdgcn_cvt_pk_fp8_f32(c, d, w, true); return (unsigned)w; }
template <int MODE> struct Cf { static constexpr float SCALE = (MODE == 1) ? 0.07216878364870323f : 0.08838834764831845f; static constexpr float C = SCALE * 1.4426950408889634f; static constexpr float THRS = 8.0f / SCALE; };

template <int MODE>
__device__ __forceinline__ void partialSM(f32x16& p0, f32x16& p1, float& m_reg, float& mn, float& alpha) {
  constexpr float C = Cf<MODE>::C;
  float pmax = p0[0];
#pragma unroll
  for (int r = 1; r < 16; ++r) pmax = fmaxf(pmax, p0[r]);
#pragma unroll
  for (int r = 0; r < 16; ++r) pmax = fmaxf(pmax, p1[r]);
  { auto rr = __builtin_amdgcn_permlane32_swap(__float_as_uint(pmax), __float_as_uint(pmax), false, false);
    pmax = fmaxf(__uint_as_float(rr[0]), __uint_as_float(rr[1])); }
  if (__builtin_expect(__all(pmax - m_reg <= Cf<MODE>::THRS), 1)) { mn = m_reg; alpha = 1.f; }
  else { mn = fmaxf(m_reg, pmax); alpha = __builtin_amdgcn_exp2f((m_reg - mn) * C); m_reg = mn; }
  const float mnC = -mn * C;
#pragma unroll
  for (int r = 0; r < 16; ++r) p0[r] = fmaf(p0[r], C, mnC);
#pragma unroll
  for (int r = 0; r < 16; ++r) p1[r] = fmaf(p1[r], C, mnC);
#pragma unroll
  for (int r = 0; r < 16; ++r) p0[r] = __builtin_amdgcn_exp2f(p0[r]);
}
__device__ __forceinline__ void finishSM(f32x16& p0, f32x16& p1, float alpha, float& l_reg, bf16x8& pa0, bf16x8& pa1, bf16x8& pa2, bf16x8& pa3) {
#pragma unroll
  for (int r = 0; r < 16; ++r) p1[r] = __builtin_amdgcn_exp2f(p1[r]);
  float ps = 0;
#pragma unroll
  for (int r = 0; r < 16; ++r) ps += p0[r];
#pragma unroll
  for (int r = 0; r < 16; ++r) ps += p1[r];
  { auto rr = __builtin_amdgcn_permlane32_swap(__float_as_uint(ps), __float_as_uint(ps), false, false);
    ps = __uint_as_float(rr[0]) + __uint_as_float(rr[1]); }
  l_reg = l_reg * alpha + ps;
#define PK4(P, BASE, OUT) do { unsigned a0 = cvtpk(P[BASE + 0], P[BASE + 1]), a1 = cvtpk(P[BASE + 2], P[BASE + 3]);   \
    unsigned b0 = cvtpk(P[BASE + 4], P[BASE + 5]), b1 = cvtpk(P[BASE + 6], P[BASE + 7]);                              \
    auto r0 = __builtin_amdgcn_permlane32_swap(a0, b0, false, false); auto r1 = __builtin_amdgcn_permlane32_swap(a1, b1, false, false); \
    u32x4 w = {r0[0], r1[0], r0[1], r1[1]}; OUT = *reinterpret_cast<bf16x8*>(&w); } while (0)
  PK4(p0, 0, pa0); PK4(p0, 8, pa1); PK4(p1, 0, pa2); PK4(p1, 8, pa3);
#undef PK4
}
template <int MODE>
__device__ __forceinline__ void qkt(f32x16& p0, f32x16& p1, const LAS char* Ks, const LAS char* K2s, const bf16x8* qr, int r32, int hi, const LAS char* qpe) {
  p0 = f32x16{}; p1 = f32x16{};
#pragma unroll
  for (int d0 = 0; d0 < 8; ++d0) { const int cb = (d0 * 16 + hi * 8) * 2;
    const bf16x8 b0 = *reinterpret_cast<const LAS bf16x8*>(Ks + KSWZ(r32, cb));
    const bf16x8 b1 = *reinterpret_cast<const LAS bf16x8*>(Ks + KSWZ(32 + r32, cb));
    p0 = __builtin_amdgcn_mfma_f32_32x32x16_bf16(b0, qr[d0], p0, 0, 0, 0);
    p1 = __builtin_amdgcn_mfma_f32_32x32x16_bf16(b1, qr[d0], p1, 0, 0, 0); }
  if (MODE == 1) {
#pragma unroll
    for (int d0 = 0; d0 < 4; ++d0) { const int cb = (d0 * 16 + hi * 8) * 2;
      const bf16x8 b0 = *reinterpret_cast<const LAS bf16x8*>(K2s + KSWZ2(r32, cb));
      const bf16x8 b1 = *reinterpret_cast<const LAS bf16x8*>(K2s + KSWZ2(32 + r32, cb));
      const bf16x8 qp = *reinterpret_cast<const LAS bf16x8*>(qpe + d0 * 1024);
      p0 = __builtin_amdgcn_mfma_f32_32x32x16_bf16(b0, qp, p0, 0, 0, 0);
      p1 = __builtin_amdgcn_mfma_f32_32x32x16_bf16(b1, qp, p1, 0, 0, 0); }
  }
}
__device__ __forceinline__ int v_st(int k, int c) { const int kk = (k & ~0xC) | ((k & 4) << 1) | ((k & 8) >> 1); return ((kk >> 3) * 4 + (c >> 5)) * 512 + ((kk & 7) * 32 + (c & 31)) * 2; }
__device__ __forceinline__ int v_rd_base(int lane) { return ((lane & 3) << 3) | (((lane >> 2) & 3) << 6) | (((lane >> 4) & 1) << 5) | (((lane >> 5) & 1) << 8); }
constexpr int v_rd_off(int d0, int ks, int half) { return d0 * 512 + ks * 4096 + half * 2048; }
template <int OFF> __device__ __forceinline__ s16x4 tr_read(int vb) { s16x4 r; asm volatile("ds_read_b64_tr_b16 %0, %1 offset:%2" : "=&v"(r) : "v"(vb), "i"(OFF) : "memory"); return r; }
template <int D0> __device__ __forceinline__ void pv_one(f32x16& od, int vb, bf16x8 pa0, bf16x8 pa1, bf16x8 pa2, bf16x8 pa3) {
  const s16x4 l0 = tr_read<v_rd_off(D0, 0, 0)>(vb), h0 = tr_read<v_rd_off(D0, 0, 1)>(vb), l1 = tr_read<v_rd_off(D0, 1, 0)>(vb), h1 = tr_read<v_rd_off(D0, 1, 1)>(vb);
  const s16x4 l2 = tr_read<v_rd_off(D0, 2, 0)>(vb), h2 = tr_read<v_rd_off(D0, 2, 1)>(vb), l3 = tr_read<v_rd_off(D0, 3, 0)>(vb), h3 = tr_read<v_rd_off(D0, 3, 1)>(vb);
  asm volatile("s_waitcnt lgkmcnt(0)" ::: "memory"); SBAR();
#define PK(L, H) (bf16x8){L[0], L[1], L[2], L[3], H[0], H[1], H[2], H[3]}
  od = __builtin_amdgcn_mfma_f32_32x32x16_bf16(pa0, PK(l0, h0), od, 0, 0, 0);
  od = __builtin_amdgcn_mfma_f32_32x32x16_bf16(pa1, PK(l1, h1), od, 0, 0, 0);
  od = __builtin_amdgcn_mfma_f32_32x32x16_bf16(pa2, PK(l2, h2), od, 0, 0, 0);
  od = __builtin_amdgcn_mfma_f32_32x32x16_bf16(pa3, PK(l3, h3), od, 0, 0, 0);
#undef PK
}
__device__ __forceinline__ void pv_d0(f32x16* o, int vb, bf16x8 pa0, bf16x8 pa1, bf16x8 pa2, bf16x8 pa3) {
  pv_one<0>(o[0], vb, pa0, pa1, pa2, pa3); pv_one<1>(o[1], vb, pa0, pa1, pa2, pa3); pv_one<2>(o[2], vb, pa0, pa1, pa2, pa3); pv_one<3>(o[3], vb, pa0, pa1, pa2, pa3);
}
struct Args { const bf16_t* Q; const bf16_t* K1; const bf16_t* K2; const bf16_t* V; bf16_t* O; int kt0, NT, qch0; };
template <int MODE> struct St {
    static constexpr int LDQ = (MODE == 0) ? INW : (MODE == 1 ? 3072 : 512), LDK1 = (MODE == 0) ? INW : (MODE == 1 ? 4096 : 1024), LDK2 = INW, LDV = LDK1, LDO = (MODE == 2) ? 512 : DM; };
template <int MODE>
__device__ __forceinline__ void mask_bias(f32x16& p0, f32x16& p1, int qch, int kch, int qpos, int hi, const LAS float* tbl) {
  const bool valid = (MODE == 2) || ((kch <= qch) && (MODE == 1 || kch >= qch - 8));
  if (!valid) {
#pragma unroll
    for (int r = 0; r < 16; ++r) { p0[r] = -INFINITY; p1[r] = -INFINITY; }
  } else if (MODE == 0) {
    if (qch - kch >= 3) { const float b = tbl[191];
#pragma unroll
      for (int r = 0; r < 16; ++r) { p0[r] += b; p1[r] += b; }
    } else { const int base = qpos - kch * 64 + 63 - 4 * hi;
#pragma unroll
      for (int g = 0; g < 4; ++g) {
#pragma unroll
        for (int r = 4 * g; r < 4 * g + 4; ++r) { int d0 = base - ((r & 3) + 8 * (r >> 2)), d1 = d0 - 32;
          d0 = d0 < 0 ? 0 : (d0 > 191 ? 191 : d0); d1 = d1 < 0 ? 0 : (d1 > 191 ? 191 : d1);
          p0[r] += tbl[d0]; p1[r] += tbl[d1]; }
        SBAR();
      }
    }
  }
}
template <int MODE>
__device__ __forceinline__ void attn_body(const Args& a, LAS char* lds) {
  constexpr int NQ = 8;
  int tid = threadIdx.x; asm volatile("" : "+v"(tid));
  const int wid = tid >> 6, lane = tid & 63, r32 = lane & 31, hi = lane >> 5;
  LAS char* V_lds = lds + OFF_V; LAS char* K_lds = lds + OFF_K; LAS char* K2_lds = lds + OFF_K2;
  LAS float* ws = (LAS float*)(lds + OFF_WS) + wid * 64; LAS float* li_l = ws; LAS float* al_l = ws + 32;
  const LAS float* tbl = (const LAS float*)(lds + OFF_TBL);
  float m_reg = -1e30f, l_reg = 0; f32x16 o[4] = {}; bf16x8 qr[NQ];
  const bf16_t* Qw = a.Q + (wid * 32 + r32) * St<MODE>::LDQ + hi * 8;
#pragma unroll
  for (int d0 = 0; d0 < NQ; ++d0) qr[d0] = *reinterpret_cast<const bf16x8*>(Qw + d0 * 16);
  const LAS char* qpe = lds + OFF_QPE + wid * 4096 + lane * 16;
  if (MODE == 1) {
#pragma unroll
    for (int d0 = 0; d0 < 4; ++d0) *(LAS bf16x8*)(lds + OFF_QPE + wid * 4096 + lane * 16 + d0 * 1024) = *reinterpret_cast<const bf16x8*>(Qw + 128 + d0 * 16);
  }
  const int sr = tid >> 4, sc = (tid & 15) * 8, vst0 = v_st(sr, sc), vst1 = v_st(32 + sr, sc);
  const int s2r = tid >> 3, s2c = (tid & 7) * 8;
  const int vb0 = (int)(uintptr_t)V_lds + v_rd_base(lane);
  const int qch = a.qch0 + (wid >> 1), qpos = a.qch0 * 64 + wid * 32 + r32;
  bf16x8 vs0, vs1, ks0, ks1, k2s;
  const unsigned ovk = (unsigned)(sr * St<MODE>::LDK1 + sc) * 2u, ok2 = (unsigned)(s2r * St<MODE>::LDK2 + s2c) * 2u;
#define SLOAD(j) do { const size_t k0_ = (size_t)(a.kt0 + (j)) * 64; \
    const char* vt_ = (const char*)(a.V + k0_ * St<MODE>::LDV); const char* kt_ = (const char*)(a.K1 + k0_ * St<MODE>::LDK1); \
    vs0 = *reinterpret_cast<const bf16x8*>(vt_ + ovk); vs1 = *reinterpret_cast<const bf16x8*>(vt_ + 64 * St<MODE>::LDV + ovk); \
    ks0 = *reinterpret_cast<const bf16x8*>(kt_ + ovk); ks1 = *reinterpret_cast<const bf16x8*>(kt_ + 64 * St<MODE>::LDK1 + ovk); \
    if (MODE == 1) k2s = *reinterpret_cast<const bf16x8*>((const char*)(a.K2 + k0_ * St<MODE>::LDK2) + ok2); } while (0)
#define SWRITE(b) do { *(LAS bf16x8*)(V_lds + (b) * SHM_V + vst0) = vs0; *(LAS bf16x8*)(V_lds + (b) * SHM_V + vst1) = vs1; const int kc = sc * 2; \
    *(LAS bf16x8*)(K_lds + (b) * SHM_K + KSWZ(sr, kc)) = ks0; *(LAS bf16x8*)(K_lds + (b) * SHM_K + KSWZ(32 + sr, kc)) = ks1; \
    if (MODE == 1) *(LAS bf16x8*)(K2_lds + (b) * SHM_K2 + KSWZ2(s2r, s2c * 2)) = k2s; } while (0)
#define SWAIT() asm volatile("s_waitcnt vmcnt(0)" ::: "memory")
#define RESC(al) do { if (__any((al) < 1.f)) { if (hi == 0) al_l[r32] = (al); asm volatile("s_waitcnt lgkmcnt(0)" ::: "memory"); \
    _Pragma("unroll") for (int d = 0; d < 4; ++d) _Pragma("unroll") for (int r = 0; r < 16; ++r) o[d][r] *= al_l[crow(r, hi)]; } } while (0)
  f32x16 pA0, pA1, pB0, pB1; float mnA, mnB, alA, alB; bf16x8 pa0, pa1, pa2, pa3; const int NT = a.NT;
  SLOAD(0); SWAIT(); SWRITE(0); __syncthreads();
  qkt<MODE>(pA0, pA1, K_lds, K2_lds, qr, r32, hi, qpe); mask_bias<MODE>(pA0, pA1, qch, a.kt0, qpos, hi, tbl); partialSM<MODE>(pA0, pA1, m_reg, mnA, alA);
  SLOAD(1);
  SWAIT(); SWRITE(1); __syncthreads();
  for (int j = 1; j + 1 < NT; j += 2) {
    SBAR(); qkt<MODE>(pB0, pB1, K_lds + SHM_K, K2_lds + SHM_K2, qr, r32, hi, qpe); mask_bias<MODE>(pB0, pB1, qch, a.kt0 + j, qpos, hi, tbl);
    finishSM(pA0, pA1, alA, l_reg, pa0, pa1, pa2, pa3); SBAR();
    SLOAD(j + 1); SBAR();
    pv_d0(o, vb0, pa0, pa1, pa2, pa3); partialSM<MODE>(pB0, pB1, m_reg, mnB, alB);
    __syncthreads(); SWAIT(); SWRITE(0);
    RESC(alB); __syncthreads();
    SBAR(); qkt<MODE>(pA0, pA1, K_lds, K2_lds, qr, r32, hi, qpe); mask_bias<MODE>(pA0, pA1, qch, a.kt0 + j + 1, qpos, hi, tbl);
    finishSM(pB0, pB1, alB, l_reg, pa0, pa1, pa2, pa3); SBAR();
    SLOAD(j + 2); SBAR();
    pv_d0(o, vb0 + SHM_V, pa0, pa1, pa2, pa3); partialSM<MODE>(pA0, pA1, m_reg, mnA, alA);
    __syncthreads(); SWAIT(); SWRITE(1);
    RESC(alA); __syncthreads();
  }
  SBAR(); qkt<MODE>(pB0, pB1, K_lds + SHM_K, K2_lds + SHM_K2, qr, r32, hi, qpe); mask_bias<MODE>(pB0, pB1, qch, a.kt0 + NT - 1, qpos, hi, tbl);
  finishSM(pA0, pA1, alA, l_reg, pa0, pa1, pa2, pa3); SBAR();
  pv_d0(o, vb0, pa0, pa1, pa2, pa3); partialSM<MODE>(pB0, pB1, m_reg, mnB, alB);
  __syncthreads(); RESC(alB);
  finishSM(pB0, pB1, alB, l_reg, pa0, pa1, pa2, pa3); SBAR();
  pv_d0(o, vb0 + SHM_V, pa0, pa1, pa2, pa3);
  if (hi == 0) li_l[r32] = l_reg; asm volatile("s_waitcnt lgkmcnt(0)" ::: "memory");
  if (MODE != 2) {
    unsigned char* Ow8 = (unsigned char*)a.O + (size_t)(wid * 32) * DM;
    const int qi = lane & 3;
#pragma unroll
    for (int rg = 0; rg < 4; ++rg) {
      float rl[4];
#pragma unroll
      for (int j = 0; j < 4; ++j) rl[j] = __builtin_amdgcn_rcpf(li_l[crow(4 * rg + j, hi)]) * MIX_SCALE;
#pragma unroll
      for (int d0 = 0; d0 < 4; ++d0) { float v[4];
#pragma unroll
        for (int j = 0; j < 4; ++j) v[j] = o[d0][4 * rg + j] * rl[j];
        { const float s0 = (qi & 1) ? v[0] : v[1], s1 = (qi & 1) ? v[2] : v[3]; const float t0 = __shfl_xor(s0, 1), t1 = __shfl_xor(s1, 1);
          if (qi & 1) { v[0] = t0; v[2] = t1; } else { v[1] = t0; v[3] = t1; } }
        { const float s0 = (qi & 2) ? v[0] : v[2], s1 = (qi & 2) ? v[1] : v[3]; const float t0 = __shfl_xor(s0, 2), t1 = __shfl_xor(s1, 2);
          if (qi & 2) { v[0] = t0; v[1] = t1; } else { v[2] = t0; v[3] = t1; } }
        const int orow = 8 * rg + 4 * hi + qi;
        *(unsigned*)(Ow8 + (size_t)orow * DM + d0 * 32 + (r32 & ~3)) = fg_pk4_fp8(v[0], v[1], v[2], v[3]); } }
  } else {
  bf16_t* Ow = a.O + (wid * 32) * St<MODE>::LDO;
  const int odd = lane & 1;
#pragma unroll
  for (int r = 0; r < 16; r += 2) { const float ra = __builtin_amdgcn_rcpf(li_l[crow(r, hi)]), rb = __builtin_amdgcn_rcpf(li_l[crow(r + 1, hi)]);
#pragma unroll
    for (int d0 = 0; d0 < 4; ++d0) { const float vA = o[d0][r] * ra, vB = o[d0][r + 1] * rb;
      const float pA = __shfl_xor(vA, 1), pB = __shfl_xor(vB, 1);
      const unsigned w = odd ? cvtpk(pB, vB) : cvtpk(vA, pA);
      const int orow = odd ? crow(r + 1, hi) : crow(r, hi);
      *(unsigned*)(Ow + orow * St<MODE>::LDO + d0 * 32 + (r32 & ~1)) = w; } }
  }
  __syncthreads();
#undef SLOAD
#undef SWRITE
#undef SWAIT
#undef RESC
}
#undef KSWZ
#undef KSWZ2
#undef SBAR
template <int MODE> __device__ __forceinline__ void attn_call(const bf16_t* Q, const bf16_t* K1, const bf16_t* K2, const bf16_t* V, bf16_t* O, int kt0, int NT, int qch0, LAS char* lds) {
  Args a{Q, K1, K2, V, O, kt0, NT, qch0}; attn_body<MODE>(a, lds);
}
}

#ifndef TVAR
#define TVAR 0
#endif
template <int VAR = 0>
__device__ __forceinline__ void transpose_item(const float* W, int K, int N, bf16_t* WT, int k0, int n0, int drow0, LAS float* scr, int lane) {
    float v[64];
    const float* src = W + (size_t)k0 * N + n0 + lane;
#pragma unroll
    for (int i = 0; i < 64; ++i) v[i] = __builtin_nontemporal_load(src + (size_t)i * N);
    if (VAR == 1) {
#pragma unroll
        for (int i = 0; i < 64; ++i) asm volatile("" :: "v"(v[i]));
        return; }
#pragma unroll
    for (int i = 0; i < 64; ++i) scr[i * 65 + lane] = v[i];
    asm volatile("s_waitcnt lgkmcnt(0)" ::: "memory");
    if (VAR == 2) { drow0 = 0; k0 = 0; }
    const int c = lane & 7;
#pragma unroll
    for (int j = 0; j < 8; ++j) { const int n = (lane >> 3) + 8 * j; const LAS float* sp = scr + (8 * c) * 65 + n;
        u32x4 o; o.x = fg::cvt_pk_bf16(sp[0 * 65], sp[1 * 65]); o.y = fg::cvt_pk_bf16(sp[2 * 65], sp[3 * 65]); o.z = fg::cvt_pk_bf16(sp[4 * 65], sp[5 * 65]); o.w = fg::cvt_pk_bf16(sp[6 * 65], sp[7 * 65]);
        *(u32x4*)(WT + ((size_t)(drow0 >> 6) * (K >> 6) + (k0 >> 6)) * 4096 + n * 64 + 8 * c) = o; }
    asm volatile("s_waitcnt lgkmcnt(0)" ::: "memory");
}
__device__ __forceinline__ fg::MoeTabs moe_tables_fast(LAS int* tab, const unsigned* gcnt) {
    fg::MoeTabs T; T.cnt = tab; T.mtp = tab + 80;
    __syncthreads();
    if (threadIdx.x == 0) { int pm = 0;
        for (int e = 0; e <= NE; ++e) { const int c = (e < NE) ? (int)gcnt[64 * e] : NTOK; tab[e] = c; tab[80 + e] = pm; pm += (c + 255) / 256; }
        tab[80 + NE + 1] = pm; }
    __syncthreads();
    return T;
}
__device__ __forceinline__ void transpose_item_fp8(const float* W, int K, int N, unsigned char* WT, int k0, int n0, int drow0, float scale, LAS float* scr, int lane) {
    float v[64];
    const float* src = W + (size_t)k0 * N + n0 + lane;
#pragma unroll
    for (int i = 0; i < 64; ++i) v[i] = __builtin_nontemporal_load(src + (size_t)i * N);
#pragma unroll
    for (int i = 0; i < 64; ++i) scr[i * 65 + lane] = v[i] * scale;
    asm volatile("s_waitcnt lgkmcnt(0)" ::: "memory");
    const int c = lane & 3;
    unsigned char* tile = WT + ((size_t)(drow0 >> 6) * (K >> 7) + (k0 >> 7)) * 8192 + (k0 & 64);
#pragma unroll
    for (int j = 0; j < 4; ++j) { const int n = (lane >> 2) + 16 * j; const LAS float* sp = scr + (16 * c) * 65 + n;
        u32x4 o; o.x = fg::pk4_fp8(sp[0 * 65], sp[1 * 65], sp[2 * 65], sp[3 * 65]); o.y = fg::pk4_fp8(sp[4 * 65], sp[5 * 65], sp[6 * 65], sp[7 * 65]);
        o.z = fg::pk4_fp8(sp[8 * 65], sp[9 * 65], sp[10 * 65], sp[11 * 65]); o.w = fg::pk4_fp8(sp[12 * 65], sp[13 * 65], sp[14 * 65], sp[15 * 65]);
        *(u32x4*)(tile + n * 128 + 16 * c) = o; }
    asm volatile("s_waitcnt lgkmcnt(0)" ::: "memory");
}
__device__ __forceinline__ void transpose_item_hilo(const float* W, int K, bf16_t* WH, bf16_t* WL, int k0, LAS float* scr, int lane) {
    float v[64];
    const float* src = W + (size_t)k0 * 64 + lane;
#pragma unroll
    for (int i = 0; i < 64; ++i) v[i] = src[(size_t)i * 64];
#pragma unroll
    for (int i = 0; i < 64; ++i) scr[i * 65 + lane] = v[i];
    asm volatile("s_waitcnt lgkmcnt(0)" ::: "memory");
    const int c = lane & 7;
#pragma unroll
    for (int j = 0; j < 8; ++j) { const int n = (lane >> 3) + 8 * j; const LAS float* sp = scr + (8 * c) * 65 + n;
        float f[8], l[8];
#pragma unroll
        for (int q = 0; q < 8; ++q) f[q] = sp[q * 65];
        u32x4 o; o.x = fg::cvt_pk_bf16(f[0], f[1]); o.y = fg::cvt_pk_bf16(f[2], f[3]); o.z = fg::cvt_pk_bf16(f[4], f[5]); o.w = fg::cvt_pk_bf16(f[6], f[7]);
        l[0] = f[0] - __uint_as_float(o.x << 16); l[1] = f[1] - __uint_as_float(o.x & 0xffff0000u); l[2] = f[2] - __uint_as_float(o.y << 16); l[3] = f[3] - __uint_as_float(o.y & 0xffff0000u);
        l[4] = f[4] - __uint_as_float(o.z << 16); l[5] = f[5] - __uint_as_float(o.z & 0xffff0000u); l[6] = f[6] - __uint_as_float(o.w << 16); l[7] = f[7] - __uint_as_float(o.w & 0xffff0000u);
        u32x4 ol; ol.x = fg::cvt_pk_bf16(l[0], l[1]); ol.y = fg::cvt_pk_bf16(l[2], l[3]); ol.z = fg::cvt_pk_bf16(l[4], l[5]); ol.w = fg::cvt_pk_bf16(l[6], l[7]);
        const size_t off = (size_t)(k0 >> 6) * 4096 + n * 64 + 8 * c;
        *(u32x4*)(WH + off) = o; *(u32x4*)(WL + off) = ol; }
    asm volatile("s_waitcnt lgkmcnt(0)" ::: "memory");
}
constexpr int N_EXPERT_ITEMS = 65 * 1536;
__device__ __forceinline__ void expert_item(const Params& p, unsigned char* ws, int r0, LAS float* scr, int lane) {
    bf16_t* wguT = (bf16_t*)(ws + WS_WGU); bf16_t* wdT = (bf16_t*)(ws + WS_WD);
    const int e = r0 / 1536, r = r0 % 1536, mat = r >> 9, item = r & 511;
    if (mat < 2) { const float* W = (e < NE) ? p.in[mat ? I_WEXU : I_WEXG] + (size_t)e * DM * EFF : p.in[mat ? I_WSHU : I_WSHG];
        const int kb = (item & 7) + 8 * (item >> 6), nb = (item >> 3) & 7, n0 = nb * 64;
        transpose_item_fp8(W, DM, EFF, (unsigned char*)wguT + (size_t)e * 1024 * DM, kb * 64, n0, (n0 >> 7) * 256 + mat * 128 + (n0 & 127), fg::WGU_SCALE, scr, lane);
    } else { const float* W = (e < NE) ? p.in[I_WEXD] + (size_t)e * EFF * DM : p.in[I_WSHD];
        const int kb = item & 7, nb = item >> 3;
        transpose_item_fp8(W, EFF, DM, (unsigned char*)wdT + (size_t)e * DM * EFF, kb * 64, nb * 64, nb * 64, fg::WD_SCALE, scr, lane); }
}
__device__ __forceinline__ void expert_conv_loop(const Params& p, unsigned char* ws, unsigned* qhead, LAS float* scr, int lane) {
    for (;;) {
        unsigned start = 0; if (lane == 0) start = xb_add(qhead, 8u);
        start = (unsigned)__builtin_amdgcn_readfirstlane((int)start);
        if (start >= (unsigned)N_EXPERT_ITEMS) break;
        for (int q = 0; q < 8; ++q) expert_item(p, ws, (int)start + q, scr, lane);
    }
}
template <int VAR>
__device__ __forceinline__ void p0_items(const Params& p, unsigned char* ws, LAS float* scr, int lane, int gw, int NGW) {
    bf16_t* winT = (bf16_t*)(ws + WS_WIN); bf16_t* wuqT = (bf16_t*)(ws + WS_WUQ); bf16_t* wukvT = (bf16_t*)(ws + WS_WUKV); bf16_t* woT = (bf16_t*)(ws + WS_WO);
    bf16_t* wxqT = (bf16_t*)(ws + WS_WXQ); bf16_t* wxkvT = (bf16_t*)(ws + WS_WXKV); bf16_t* wxoT = (bf16_t*)(ws + WS_WXO); bf16_t* wguT = (bf16_t*)(ws + WS_WGU); bf16_t* wdT = (bf16_t*)(ws + WS_WD);
            constexpr int I0 = (DM / 64) * (INW / 64), I1 = I0 + (DM / 64) * (DM / 64), I2 = I1 + (QLORA / 64) * (3072 / 64), I3 = I2 + (KVLORA / 64) * (4096 / 64),
                          I4 = I3 + (DM / 64) * (512 / 64), I5 = I4 + (DM / 64) * (1024 / 64), I6 = I5 + (512 / 64) * (DM / 64);
            constexpr int IR = I6, ITOT = IR + DM / 64;
            for (int it = gw; it < ITOT; it += NGW) {
                if (it < I0) { const int nb = it % (INW / 64), kb = it / (INW / 64); transpose_item_fp8(p.in[I_WIN], DM, INW, (unsigned char*)winT, kb * 64, nb * 64, nb * 64, 64.0f, scr, lane); }
                else if (it < I1) { const int r = it - I0, nb = r % 64, kb = r / 64; transpose_item_fp8(p.in[I_WO], DM, DM, (unsigned char*)woT, kb * 64, nb * 64, nb * 64, 64.0f, scr, lane); }
                else if (it < I2) { const int r = it - I1, nb = r % 48, kb = r / 48; transpose_item<VAR>(p.in[I_WUQ], QLORA, 3072, wuqT, kb * 64, nb * 64, nb * 64, scr, lane); }
                else if (it < I3) { const int r = it - I2, nb = r % 64, kb = r / 64; transpose_item<VAR>(p.in[I_WUKV], KVLORA, 4096, wukvT, kb * 64, nb * 64, nb * 64, scr, lane); }
                else if (it < I4) { const int r = it - I3, nb = r % 8, kb = r / 8; transpose_item<VAR>(p.in[I_WXQ], DM, 512, wxqT, kb * 64, nb * 64, nb * 64, scr, lane); }
                else if (it < I5) { const int r = it - I4, nb = r % 16, kb = r / 16; transpose_item<VAR>(p.in[I_WXKV], DM, 1024, wxkvT, kb * 64, nb * 64, nb * 64, scr, lane); }
                else if (it < I6) { const int r = it - I5, nb = r % 64, kb = r / 64; transpose_item<VAR>(p.in[I_WXO], 512, DM, wxoT, kb * 64, nb * 64, nb * 64, scr, lane); }
                else if (it >= IR) { transpose_item_hilo(p.in[I_WROUTER], DM, (bf16_t*)(ws + WS_WR), (bf16_t*)(ws + WS_WR + 2 * MiB), (it - IR) * 64, scr, lane); }
            }
}
__device__ __forceinline__ void unpack8(const u32x4 w, float (&f)[8]) {
    f[0] = __uint_as_float(w.x << 16); f[1] = __uint_as_float(w.x & 0xffff0000u); f[2] = __uint_as_float(w.y << 16); f[3] = __uint_as_float(w.y & 0xffff0000u);
    f[4] = __uint_as_float(w.z << 16); f[5] = __uint_as_float(w.z & 0xffff0000u); f[6] = __uint_as_float(w.w << 16); f[7] = __uint_as_float(w.w & 0xffff0000u); }
__device__ __forceinline__ u32x4 pack8(const float (&f)[8]) { u32x4 w; w.x = fg::cvt_pk_bf16(f[0], f[1]); w.y = fg::cvt_pk_bf16(f[2], f[3]); w.z = fg::cvt_pk_bf16(f[4], f[5]); w.w = fg::cvt_pk_bf16(f[6], f[7]); return w; }
__device__ __forceinline__ float sumsq8(const float (&f)[8]) { return (f[0] * f[0] + f[1] * f[1]) + (f[2] * f[2] + f[3] * f[3]) + (f[4] * f[4] + f[5] * f[5]) + (f[6] * f[6] + f[7] * f[7]); }
template <int W> __device__ __forceinline__ float group_sum(float v) {
#pragma unroll
    for (int o = 1; o < W; o <<= 1) v += __shfl_xor(v, o);
    return v;
}
__device__ __forceinline__ void load8f(const float* g, float (&f)[8]) { const f32x4 a = *(const f32x4*)g, b = *(const f32x4*)(g + 4); f[0] = a.x; f[1] = a.y; f[2] = a.z; f[3] = a.w; f[4] = b.x; f[5] = b.y; f[6] = b.z; f[7] = b.w; }
__device__ __forceinline__ void scale8(float (&f)[8], float r, const float (&g)[8]) {
#pragma unroll
    for (int i = 0; i < 8; ++i) f[i] = f[i] * r * g[i]; }
        struct RouterSched { const char* th; const char* tl; const char* wh; const char* wl; int G, c;
            __device__ __forceinline__ bool next(int i, fg::Unit& u) const {
                const int total = (NTOK / 256) * 12, per = (total + 7) / 8; const int j = i * G + c, x = j & 7, q = j >> 3;
                if (q >= per) return false; const int L = x * per + q; if (L >= total) return false;
                const int pm = L / 12, slab = L % 12, term = slab >> 2, kq = slab & 3;
                u.A = (term == 1 ? tl : th) + ((size_t)pm * 256 * DM + (size_t)kq * 1024) * 2; u.B = (term == 2 ? wl : wh) + (size_t)kq * 16 * 8192;
                u.rows = nullptr; u.nkt = 16; u.nvalid = 256; u.pm = pm; u.pn = 0; u.e = slab; u.arow0 = pm * 256; return true; } };
        struct EpiLogits { static constexpr int PERM = 0; typedef fg::NoPre Pre; __device__ __forceinline__ void prefetch(Pre&, const fg::Unit&, int, int) const {} float* C;
            __device__ __forceinline__ void operator()(const f32x4 (&acc)[2][2][4][2], const fg::Unit& u, int wr, int wc, int fr, int fq, const Pre& pre) const {
                if (wc < 2) { float* Cb = C + (size_t)u.e * NTOK * 64;
#pragma unroll
                    for (int ai = 0; ai < 2; ++ai)
#pragma unroll
                        for (int m = 0; m < 4; ++m)
#pragma unroll
                            for (int n = 0; n < 2; ++n) *(f32x4*)(Cb + (size_t)(u.pm * 256 + ai * 128 + wr * 64 + m * 16 + fr) * 64 + wc * 32 + n * 16 + 4 * fq) = acc[ai][0][m][n]; } } };
constexpr int NPHASE = 18;
template <unsigned PMASK>
__global__ void __launch_bounds__(512, 2) fwd(Params p) {
    extern __shared__ __attribute__((aligned(16))) unsigned char lds_raw[];
    float* ldsf = (float*)lds_raw;
    const int tid = threadIdx.x, lane = tid & 63, wave = tid >> 6;
    const int G = gridDim.x; int bid = blockIdx.x;
    const int gw = bid * 8 + wave, NGW = G * 8;
    unsigned char* ws = p.ws;
    unsigned* ctl = (unsigned*)(ws + WS_CTL);
    volatile LAS unsigned* misc = (volatile LAS unsigned*)((LAS unsigned char*)lds_raw + LDS_MISC);
    if (tid < 16) misc[tid] = 0u;
    __syncthreads();
    XcdBarrier bar = xcd_barrier_post(ctl + CW_BAR, misc);
    const int lo = p.ph_lo, hi = p.ph_hi;
    if (tid == 0) { const unsigned x = xb_xcc_id() & 15u; misc[4] = x; misc[5] = xb_add(ctl + CW_TICKET + 64 * x, 1u); }
#define IN(k) (((PMASK >> (k)) & 1u) && lo <= (k) && (k) < hi)
#ifndef DUP_PHASE
#define DUP_PHASE -1
#endif
#define REP(k) for (int rep_ = 0; rep_ < ((DUP_PHASE == (k)) ? 2 : 1); ++rep_)
#define SEAM(k) do { if (IN(k) && IN((k) + 1)) xcd_barrier(bar); } while (0)

    const float* x = p.in[I_X];
    act_t* hbuf = (act_t*)(ws + WS_H); act_t* memn = (act_t*)(ws + WS_MEMN); act_t* p1 = (act_t*)(ws + WS_P1); act_t* kvm = (act_t*)(ws + WS_KVM);
    act_t* qb = (act_t*)(ws + WS_QB); act_t* kvb = (act_t*)(ws + WS_KVB); act_t* mixed = (act_t*)(ws + WS_MIXED); float* x1 = (float*)(ws + WS_X1);
    act_t* hc = (act_t*)(ws + WS_HC); act_t* qx = (act_t*)(ws + WS_QX); act_t* ox = (act_t*)(ws + WS_OX); float* x2 = (float*)(ws + WS_X2);
    act_t* tb = (act_t*)(ws + WS_T); act_t* hh = (act_t*)(ws + WS_HH);
    LAS unsigned char* lds = (LAS unsigned char*)lds_raw;
    bf16_t* winT = (bf16_t*)(ws + WS_WIN); bf16_t* wuqT = (bf16_t*)(ws + WS_WUQ); bf16_t* wukvT = (bf16_t*)(ws + WS_WUKV); bf16_t* woT = (bf16_t*)(ws + WS_WO);
    bf16_t* wxqT = (bf16_t*)(ws + WS_WXQ); bf16_t* wxkvT = (bf16_t*)(ws + WS_WXKV); bf16_t* wxoT = (bf16_t*)(ws + WS_WXO); bf16_t* wguT = (bf16_t*)(ws + WS_WGU); bf16_t* wdT = (bf16_t*)(ws + WS_WD);
    float* qxp = (float*)(ws + WS_QXP); bf16_t* ybuf = (bf16_t*)(ws + WS_Y);
    int* rowtok = (int*)(ws + WS_ROWTOK); float* rowgate = (float*)(ws + WS_ROWGATE); int* rowdst = (int*)(ws + WS_ROWDST);
    unsigned* gcnt = ctl + CW_CNT;
    const int* positions = (const int*)p.in[I_POS];

    if (IN(0)) REP(0) {
        for (int m = gw; m < NTOK; m += NGW) {
            const float* xr = x + (size_t)m * DM; f32x4 v[16]; float ssq = 0.f;
#pragma unroll
            for (int j = 0; j < 16; ++j) { v[j] = __builtin_nontemporal_load((const f32x4*)xr + lane + 64 * j); ssq += v[j].x * v[j].x + v[j].y * v[j].y + v[j].z * v[j].z + v[j].w * v[j].w; }
            ssq = wave_sum(ssq); const float r = 2.0f / sqrtf(ssq * (1.0f / 4096.f) + EPS);
#pragma unroll
            for (int j = 0; j < 16; ++j) v[j] = v[j] * r * __builtin_nontemporal_load((const f32x4*)p.in[I_GMIX] + lane + 64 * j);
            asm volatile("s_waitcnt vmcnt(0)" ::: "memory");
#pragma unroll
            for (int j = 0; j < 16; ++j) *(unsigned*)((unsigned char*)hbuf + (size_t)m * DM + (lane + 64 * j) * 4) = fg::pk4_fp8(v[j].x, v[j].y, v[j].z, v[j].w);
        }
        for (int m = gw; m < NMEM; m += NGW) rms_row_4096<act_t>(p.in[I_MEM] + (size_t)m * DM, p.in[I_GMEM], memn + (size_t)m * DM, lane, nullptr);
#if FAST_GEMM
        {
            LAS float* scr = (LAS float*)(lds + wave * 16640);
            p0_items<0>(p, ws, scr, lane, gw, NGW);
        }
#endif
    }
    SEAM(0);
    if (IN(0) && IN(1) && G == 256) {
        if (tid == 0) { bool even = true;
            for (int j2 = 0; j2 < 8; ++j2) even = even && (xb_ld(ctl + CW_TICKET + 64 * j2) == 32u);
            misc[6] = (even && misc[4] < 8u && misc[5] < 32u) ? (misc[4] + 8u * misc[5]) : (unsigned)blockIdx.x; }
        __syncthreads();
        bid = (int)misc[6];
    }
    if (IN(1)) REP(1) {
#if FAST_GEMM
        { fg::DenseSched S{(const char*)hbuf, (const char*)winT, DM / 2, DM / 2, NTOK / 256, INWP / 256, 1, DM / 128, G, bid, (p.var == 10) ? 2 : 0};
          fg::EpiBf16 E{p1, INW, INW, 1.0f / (2.0f * 64.0f)};
          fg::gemm_phase<fg::EpiBf16, fg::DenseSched, false, true, true>(lds, S, E, DM / 2, DM / 2, p.var); }
        { fg::DenseSched S{(const char*)memn, (const char*)wxkvT, DM, PK(DM), NMEM / 256, 1024 / 256, 1, DM / 64, G, (bid + G - 224) % G, 0};
          fg::EpiBf16 E{kvm, 1024, 1024, 1.0f};
          fg::gemm_phase<fg::EpiBf16, fg::DenseSched, false, false, true>(lds, S, E, DM, PK(DM)); }
#else
        constexpr int NT1 = (INW + 127) / 128, U1 = (NTOK / 128) * NT1, U2 = (NMEM / 128) * (1024 / 128);
        for (int u = bid; u < U1 + U2; u += G) {
            if (u < U1) { const int mt = u / NT1, nt = u % NT1;
                BPlain bc{p.in[I_WIN], INW, nt * 128, INW};
                auto epi = [&](int r, int c, const float (&v)[4]) { const int col = nt * 128 + c; if (col < INW) { act_t* o = p1 + (size_t)(mt * 128 + r) * INW + col; stf(o, v[0]); stf(o + 1, v[1]); stf(o + 2, v[2]); stf(o + 3, v[3]); } };
                ngemm_tile<act_t>(ldsf, hbuf, DM, nullptr, mt * 128, 128, DM, bc, epi);
            } else { const int v2 = u - U1, mt = v2 / 8, nt = v2 % 8;
                BPlain bc{p.in[I_WXKV], 1024, nt * 128, 1024};
                auto epi = [&](int r, int c, const float (&v)[4]) { act_t* o = kvm + (size_t)(mt * 128 + r) * 1024 + nt * 128 + c; stf(o, v[0]); stf(o + 1, v[1]); stf(o + 2, v[2]); stf(o + 3, v[3]); };
                ngemm_tile<act_t>(ldsf, memn, DM, nullptr, mt * 128, 128, DM, bc, epi);
            }
        }
    #endif
    }
    SEAM(1);
    if (IN(2)) {
#if FAST_GEMM
        {
            float gqa[8], gka[8], gcq0[8], gcq1[8], gckv[8];
            load8f(p.in[I_GQA] + (lane & 15) * 8, gqa); load8f(p.in[I_GKA] + (lane & 15) * 8, gka);
            load8f(p.in[I_GCQ] + lane * 8, gcq0); load8f(p.in[I_GCQ] + 512 + lane * 8, gcq1); load8f(p.in[I_GCKV] + lane * 8, gckv);
            for (int m = gw; m < NTOK; m += NGW) {
                act_t* row = p1 + (size_t)m * INW;
                u32x4 qk[8], cq[2], ckv;
#pragma unroll
                for (int j = 0; j < 8; ++j) qk[j] = *(const u32x4*)(row + j * 512 + lane * 8);
                cq[0] = *(const u32x4*)(row + C_CQ + lane * 8); cq[1] = *(const u32x4*)(row + C_CQ + 512 + lane * 8); ckv = *(const u32x4*)(row + C_CKV + lane * 8);
                const int pos = positions[m];
                asm volatile("s_waitcnt vmcnt(0)" ::: "memory");
#pragma unroll
                for (int j = 0; j < 8; ++j) { float f[8]; unpack8(qk[j], f); const float ss = group_sum<16>(sumsq8(f)); const float r = 1.0f / sqrtf(ss * (1.0f / 128.f) + EPS);
                    if (j < 4) scale8(f, r, gqa); else scale8(f, r, gka); qk[j] = pack8(f); }
                { float f0[8], f1[8]; unpack8(cq[0], f0); unpack8(cq[1], f1); const float ss = wave_sum(sumsq8(f0) + sumsq8(f1)); const float r = 1.0f / sqrtf(ss * (1.0f / 1024.f) + EPS);
                  scale8(f0, r, gcq0); scale8(f1, r, gcq1); cq[0] = pack8(f0); cq[1] = pack8(f1); }
                { float f[8]; unpack8(ckv, f); const float ss = wave_sum(sumsq8(f)); const float r = 1.0f / sqrtf(ss * (1.0f / 512.f) + EPS); scale8(f, r, gckv); ckv = pack8(f); }
#pragma unroll
                for (int j = 0; j < 8; ++j) *(u32x4*)(row + j * 512 + lane * 8) = qk[j];
                *(u32x4*)(row + C_CQ + lane * 8) = cq[0]; *(u32x4*)(row + C_CQ + 512 + lane * 8) = cq[1]; *(u32x4*)(row + C_CKV + lane * 8) = ckv;
                rms_rope64_inplace(row + C_KPE, p.in[I_GKB] + 128, pos, lane);
            }
            float gkx[8]; load8f(p.in[I_GKX] + (lane & 15) * 8, gkx);
            for (int m = gw; m < NMEM; m += NGW) { act_t* row = kvm + (size_t)m * 1024;
                u32x4 w = *(const u32x4*)(row + lane * 8); float f[8]; unpack8(w, f); const float ss = group_sum<16>(sumsq8(f)); const float r = 1.0f / sqrtf(ss * (1.0f / 128.f) + EPS);
                scale8(f, r, gkx); *(u32x4*)(row + lane * 8) = pack8(f); }
        }
#else
        for (int m = gw; m < NTOK; m += NGW) {
            act_t* row = p1 + (size_t)m * INW;
            for (int h = 0; h < HA; ++h) { rms_inplace<128>(row + C_Q0 + h * HD, p.in[I_GQA], lane); rms_inplace<128>(row + C_K0 + h * HD, p.in[I_GKA], lane); }
            rms_inplace<QLORA>(row + C_CQ, p.in[I_GCQ], lane);
            rms_inplace<KVLORA>(row + C_CKV, p.in[I_GCKV], lane);
            rms_rope64_inplace(row + C_KPE, p.in[I_GKB] + 128, positions[m], lane);
        }
        for (int m = gw; m < NMEM; m += NGW) for (int h = 0; h < MH; ++h) rms_inplace<128>(kvm + (size_t)m * 1024 + h * 128, p.in[I_GKX], lane);
#endif
    }
    SEAM(2);
    if (IN(3)) REP(3) {
#if FAST_GEMM
        { fg::DenseSched S{(const char*)(p1 + C_CQ), (const char*)wuqT, INW, PK(QLORA), NTOK / 256, 3072 / 256, 1, QLORA / 64, G, bid, 0};
          fg::EpiBf16 E{qb, 3072, 3072, 1.0f};
          fg::gemm_phase<fg::EpiBf16, fg::DenseSched, false, false, true>(lds, S, E, INW, PK(QLORA)); }
        { fg::DenseSched S{(const char*)(p1 + C_CKV), (const char*)wukvT, INW, PK(KVLORA), NTOK / 256, 4096 / 256, 1, KVLORA / 64, G, bid, (G == 256) ? 1 : 0};
          fg::EpiBf16 E{kvb, 4096, 4096, 1.0f};
          fg::gemm_phase<fg::EpiBf16, fg::DenseSched, false, false, true>(lds, S, E, INW, PK(KVLORA)); }
#else
        constexpr int UA = (NTOK / 128) * (3072 / 128), UB = (NTOK / 128) * (4096 / 128);
        for (int u = bid; u < UA + UB; u += G) {
            if (u < UA) { const int mt = u / 24, nt = u % 24;
                BPlain bc{p.in[I_WUQ], 3072, nt * 128, 3072};
                auto epi = [&](int r, int c, const float (&v)[4]) { act_t* o = qb + (size_t)(mt * 128 + r) * 3072 + nt * 128 + c; stf(o, v[0]); stf(o + 1, v[1]); stf(o + 2, v[2]); stf(o + 3, v[3]); };
                ngemm_tile<act_t>(ldsf, p1 + C_CQ, INW, nullptr, mt * 128, 128, QLORA, bc, epi);
            } else { const int v2 = u - UA, mt = v2 / 32, nt = v2 % 32;
                BPlain bc{p.in[I_WUKV], 4096, nt * 128, 4096};
                auto epi = [&](int r, int c, const float (&v)[4]) { act_t* o = kvb + (size_t)(mt * 128 + r) * 4096 + nt * 128 + c; stf(o, v[0]); stf(o + 1, v[1]); stf(o + 2, v[2]); stf(o + 3, v[3]); };
                ngemm_tile<act_t>(ldsf, p1 + C_CKV, INW, nullptr, mt * 128, 128, KVLORA, bc, epi);
            }
        }
    #endif
    }
    SEAM(3);
    if (IN(4)) {
#if FAST_GEMM
        {
            float gqn[8], gqp[8], gkn[8];
            load8f(p.in[I_GQB] + (lane & 15) * 8, gqn); load8f(p.in[I_GQB] + 128 + (lane & 7) * 8, gqp); load8f(p.in[I_GKB] + (lane & 15) * 8, gkn);
            for (int m = gw; m < NTOK; m += NGW) {
                act_t* qrow = qb + (size_t)m * 3072; act_t* krow = kvb + (size_t)m * 4096;
                u32x4 qn[4], qp[2], kn[4];
#pragma unroll
                for (int j = 0; j < 4; ++j) { qn[j] = *(const u32x4*)(qrow + (j * 4 + (lane >> 4)) * QKB + (lane & 15) * 8); kn[j] = *(const u32x4*)(krow + (j * 4 + (lane >> 4)) * 256 + (lane & 15) * 8); }
#pragma unroll
                for (int j = 0; j < 2; ++j) qp[j] = *(const u32x4*)(qrow + (j * 8 + (lane >> 3)) * QKB + 128 + (lane & 7) * 8);
                float cs[8], sn[8];
                { const int fi = lane & 31; const float inv_freq = powf(10000.0f, -(float)(2 * fi) / 64.0f); const float ang = (float)positions[m] * inv_freq; float s1, c1; sincosf(ang, &s1, &c1);
#pragma unroll
                  for (int i = 0; i < 8; ++i) { const int src = ((lane & 3) * 8 + i); cs[i] = __shfl(c1, src); sn[i] = __shfl(s1, src); } }
                asm volatile("s_waitcnt vmcnt(0)" ::: "memory");
#pragma unroll
                for (int j = 0; j < 4; ++j) { float f[8]; unpack8(qn[j], f); float ss = group_sum<16>(sumsq8(f)); float r = 1.0f / sqrtf(ss * (1.0f / 128.f) + EPS); scale8(f, r, gqn); qn[j] = pack8(f);
                    unpack8(kn[j], f); ss = group_sum<16>(sumsq8(f)); r = 1.0f / sqrtf(ss * (1.0f / 128.f) + EPS); scale8(f, r, gkn); kn[j] = pack8(f); }
#pragma unroll
                for (int j = 0; j < 2; ++j) { float f[8]; unpack8(qp[j], f); const float ss = group_sum<8>(sumsq8(f)); const float r = 1.0f / sqrtf(ss * (1.0f / 64.f) + EPS); scale8(f, r, gqp);
                    const bool lowhalf = ((lane & 7) < 4);
#pragma unroll
                    for (int i = 0; i < 8; ++i) { const float other = __shfl_xor(f[i], 4); f[i] = lowhalf ? (f[i] * cs[i] - other * sn[i]) : (f[i] * cs[i] + other * sn[i]); }
                    qp[j] = pack8(f); }
#pragma unroll
                for (int j = 0; j < 4; ++j) { *(u32x4*)(qrow + (j * 4 + (lane >> 4)) * QKB + (lane & 15) * 8) = qn[j]; *(u32x4*)(krow + (j * 4 + (lane >> 4)) * 256 + (lane & 15) * 8) = kn[j]; }
#pragma unroll
                for (int j = 0; j < 2; ++j) *(u32x4*)(qrow + (j * 8 + (lane >> 3)) * QKB + 128 + (lane & 7) * 8) = qp[j];
            }
        }
#else
        for (int m = gw; m < NTOK; m += NGW) {
            const int pos = positions[m];
            for (int h = 0; h < HB; ++h) {
                rms_inplace<128>(qb + (size_t)m * 3072 + h * QKB, p.in[I_GQB], lane);
                rms_rope64_inplace(qb + (size_t)m * 3072 + h * QKB + 128, p.in[I_GQB] + 128, pos, lane);
                rms_inplace<128>(kvb + (size_t)m * 4096 + h * 256, p.in[I_GKB], lane);
            }
        }
#endif
    }
    SEAM(4);
    if (IN(5)) {
#if FAST_ATTN
        {
            constexpr int NA_BLK = 176;
            LAS char* al = (LAS char*)lds;
            LAS float* scr = (LAS float*)(lds + wave * 16640);
            if (bid >= NA_BLK) { expert_conv_loop(p, ws, ctl + CW_QCONV, scr, lane); }
            for (;;) {
                __syncthreads(); if (tid == 0) misc[7] = xb_add(ctl + CW_QB, 1u); __syncthreads();
                const int q = (int)misc[7]; if (q >= 512) break;
                const int grp = q >> 8, idx = q & 255, pair = idx >> 2, qbk = (grp == 0 ? 7 : 3) - (idx & 3), b = pair >> 4, h = pair & 15;
                const int c0 = qbk * 4; const size_t tok0 = (size_t)b * SEQ + (size_t)qbk * 256;
                const act_t* kb = kvb + (size_t)b * SEQ * 4096;
                fa::attn_call<1>(qb + tok0 * 3072 + h * QKB, kb + h * 256, p1 + (size_t)b * SEQ * INW + C_KPE, kb + h * 256 + 128, (bf16_t*)((unsigned char*)mixed + tok0 * DM + WA + h * HD), 0, c0 + 4, c0, al);
            }
            for (;;) {
                __syncthreads(); if (tid == 0) misc[7] = xb_add(ctl + CW_QA, 1u); __syncthreads();
                const int q = (int)misc[7]; if (q >= 512) break;
                const int grp = q >> 8, idx = q & 255, pair = idx >> 2, qbk = (grp == 0 ? 7 : 3) - (idx & 3), b = pair >> 4, h = pair & 15;
                { LAS float* tbl = (LAS float*)(al + fa::OFF_TBL); if (tid < NREL) tbl[tid] = p.in[I_RELB][h * NREL + tid] * 11.313708498984761f; }
                const int c0 = qbk * 4; const size_t tok0 = (size_t)b * SEQ + (size_t)qbk * 256;
                const int kt0 = (c0 - LEFT) > 0 ? (c0 - LEFT) : 0;
                const act_t* base = p1 + (size_t)b * SEQ * INW;
                fa::attn_call<0>(p1 + tok0 * INW + C_Q0 + h * HD, base + C_K0 + h * HD, nullptr, base + C_V0 + h * HD, (bf16_t*)((unsigned char*)mixed + tok0 * DM + h * HD), kt0, c0 + 4 - kt0, c0, al);
            }
            __syncthreads();
            expert_conv_loop(p, ws, ctl + CW_QCONV, scr, lane);
        }
#else
        for (int u = bid; u < 4096; u += G) {
            const int c = 31 - (u >> 7), rem = u & 127, type = rem >> 6, b = (rem >> 4) & 3, h = rem & 15;
            const size_t tok0 = (size_t)b * SEQ + (size_t)c * CHUNK;
            if (type == 0) {
                const int t0 = (c - LEFT) > 0 ? (c - LEFT) : 0, nt = c - t0 + 1;
                const float* rb = p.in[I_RELB] + h * NREL;
                auto keytile = [&](int t) { return (t0 + t) * CHUNK; };
                auto bias = [&](int r, int t, int key) { int dist = (c * CHUNK + r) - ((t0 + t) * CHUNK + key); dist = dist < -(CHUNK - 1) ? -(CHUNK - 1) : (dist > 128 ? 128 : dist); return rb[dist + CHUNK - 1]; };
                const act_t* base = p1 + (size_t)b * SEQ * INW;
                nattn_unit<128>(ldsf, p1 + tok0 * INW + C_Q0 + h * HD, INW, base + C_K0 + h * HD, INW, nullptr, 0, base + C_V0 + h * HD, INW,
                                nt, keytile, 0.08838834764831845f, bias, mixed + tok0 * DM + h * HD, DM);
            } else {
                auto keytile = [&](int t) { return t * CHUNK; };
                auto bias = [&](int, int, int) { return 0.f; };
                const act_t* kb = kvb + (size_t)b * SEQ * 4096;
                nattn_unit<192>(ldsf, qb + tok0 * 3072 + h * QKB, 3072, kb + h * 256, 4096, p1 + (size_t)b * SEQ * INW + C_KPE, INW, kb + h * 256 + 128, 4096,
                                c + 1, keytile, 0.07216878364870323f, bias, mixed + tok0 * DM + WA + h * HD, DM);
            }
        }
    #endif
    }
    SEAM(5);
    if (IN(6)) REP(6) {
#if FAST_GEMM
        { fg::DenseSched S{(const char*)mixed, (const char*)woT, DM / 2, DM / 2, NTOK / 256, DM / 256, 1, DM / 128, G, bid, 0};
          fg::EpiResStat E{x1, x, hc, p.in[I_GCROSS], (float*)(ws + WS_SSP1), DM, 1.0f / (fa::MIX_SCALE * 64.0f)};
          fg::gemm_phase<fg::EpiResStat, fg::DenseSched, false, true, true>(lds, S, E, DM / 2, DM / 2); }
#else
        for (int u = bid; u < (NTOK / 128) * (DM / 128); u += G) { const int mt = u / 32, nt = u % 32;
            BPlain bc{p.in[I_WO], DM, nt * 128, DM};
            auto epi = [&](int r, int c, const float (&v)[4]) { const size_t o = (size_t)(mt * 128 + r) * DM + nt * 128 + c;
                const f32x4 xv = *(const f32x4*)(x + o); *(f32x4*)(x1 + o) = (f32x4){xv.x + v[0], xv.y + v[1], xv.z + v[2], xv.w + v[3]}; };
            ngemm_tile<act_t>(ldsf, mixed, DM, nullptr, mt * 128, 128, DM, bc, epi);
        }
    #endif
    }
    SEAM(6);
    if (IN(8)) REP(8) {
#if FAST_GEMM
        { fg::DenseSched S{(const char*)hc, (const char*)wxqT, DM, PK(DM), NTOK / 256, 512 / 256, 4, DM / 64 / 4, G, bid, 0};
          fg::EpiF32Res<false> E{qxp, nullptr, 512, (size_t)NTOK * 512, 1.0f};
          fg::gemm_phase<fg::EpiF32Res<false>, fg::DenseSched, false, false, true>(lds, S, E, DM, PK(DM)); }
#else
        for (int u = bid; u < (NTOK / 128) * 4; u += G) { const int mt = u / 4, nt = u % 4;
            BPlain bc{p.in[I_WXQ], 512, nt * 128, 512};
            auto epi = [&](int r, int c, const float (&v)[4]) { act_t* o = qx + (size_t)(mt * 128 + r) * 512 + nt * 128 + c; stf(o, v[0]); stf(o + 1, v[1]); stf(o + 2, v[2]); stf(o + 3, v[3]); };
            ngemm_tile<act_t>(ldsf, hc, DM, nullptr, mt * 128, 128, DM, bc, epi);
        }
    #endif
    }
    SEAM(8);
    if (IN(9)) {
#if FAST_GEMM
        { float gqx[8]; load8f(p.in[I_GQX] + (lane & 15) * 8, gqx);
          for (int m = gw; m < NTOK; m += NGW) {
            f32x4 a[4][2];
#pragma unroll
            for (int sl = 0; sl < 4; ++sl) { const float* src = qxp + (size_t)sl * NTOK * 512 + (size_t)m * 512 + lane * 8; a[sl][0] = *(const f32x4*)src; a[sl][1] = *(const f32x4*)(src + 4); }
            const float rs1 = 1.0f / sqrtf(wave_sum(((const float*)(ws + WS_SSP1))[(size_t)m * 64 + lane]) * (1.0f / 4096.f) + EPS);
            const f32x4 lo = ((a[0][0] + a[1][0]) + (a[2][0] + a[3][0])) * rs1, hi4 = ((a[0][1] + a[1][1]) + (a[2][1] + a[3][1])) * rs1;
            float f[8] = {lo.x, lo.y, lo.z, lo.w, hi4.x, hi4.y, hi4.z, hi4.w};
            const float ss = group_sum<16>(sumsq8(f)); const float r = 1.0f / sqrtf(ss * (1.0f / 128.f) + EPS); scale8(f, r, gqx);
            *(u32x4*)(qx + (size_t)m * 512 + lane * 8) = pack8(f); } }
#else
        for (int m = gw; m < NTOK; m += NGW) for (int h = 0; h < MH; ++h) rms_inplace<128>(qx + (size_t)m * 512 + h * 128, p.in[I_GQX], lane);
#endif
    }
    SEAM(9);
    if (IN(10)) REP(10) {
#if FAST_ATTN
        for (int u = bid; u < NB * MH * (SEQ / 256); u += G) { const int qbk = u & 7, h = (u >> 3) & 3, b = u >> 5;
            const size_t tok0 = (size_t)b * SEQ + (size_t)qbk * 256;
            const act_t* kb = kvm + (size_t)b * MEMT * 1024;
            fa::attn_call<2>(qx + tok0 * 512 + h * 128, kb + h * 128, nullptr, kb + 512 + h * 128, ox + tok0 * 512 + h * 128, 0, 4, 0, (LAS char*)lds);
        }
#else
        for (int u = bid; u < NB * MH * (SEQ / 64); u += G) { const int c = u & 31, h = (u >> 5) & 3, b = u >> 7;
            const size_t tok0 = (size_t)b * SEQ + (size_t)c * 64;
            auto keytile = [&](int t) { return t * 64; };
            auto bias = [&](int, int, int) { return 0.f; };
            const act_t* kb = kvm + (size_t)b * MEMT * 1024;
            nattn_unit<128>(ldsf, qx + tok0 * 512 + h * 128, 512, kb + h * 128, 1024, nullptr, 0, kb + 512 + h * 128, 1024, 4, keytile, 0.08838834764831845f, bias, ox + tok0 * 512 + h * 128, 512);
        }
    #endif
    }
    SEAM(10);
    if (IN(11)) REP(11) {
#if FAST_GEMM
        { fg::DenseSched S{(const char*)ox, (const char*)wxoT, 512, PK(512), NTOK / 256, DM / 256, 1, 512 / 64, G, bid, 0};
          fg::EpiX2 E{x2, x1, tb, (bf16_t*)hh, ws + WS_T8, p.in[I_GFFN], (float*)(ws + WS_SSP2), DM};
          fg::gemm_phase<fg::EpiX2, fg::DenseSched, false, false, true>(lds, S, E, 512, PK(512)); }
#else
        for (int u = bid; u < (NTOK / 128) * (DM / 128); u += G) { const int mt = u / 32, nt = u % 32;
            BPlain bc{p.in[I_WXO], DM, nt * 128, DM};
            auto epi = [&](int r, int c, const float (&v)[4]) { const size_t o = (size_t)(mt * 128 + r) * DM + nt * 128 + c;
                const f32x4 xv = *(const f32x4*)(x1 + o); const f32x4 y = (f32x4){xv.x + v[0], xv.y + v[1], xv.z + v[2], xv.w + v[3]}; *(f32x4*)(x2 + o) = y; *(f32x4*)(p.out + o) = y; };
            ngemm_tile<act_t>(ldsf, ox, 512, nullptr, mt * 128, 128, 512, bc, epi);
        }
    #endif
    }
    SEAM(11);
    if (IN(13)) {
        RouterSched S{(const char*)tb, (const char*)hh, (const char*)(ws + WS_WR), (const char*)(ws + WS_WR + 2 * MiB), G, bid};
        EpiLogits E{(float*)(ws + WS_Y)};
        fg::gemm_phase<EpiLogits, RouterSched, false, false, true>(lds, S, E, DM, DM);
    }
    SEAM(13);
    if (IN(14)) {
        const float* lgp = (const float*)(ws + WS_Y);
        const float rb = p.in[I_RBIAS][lane];
        const int g = lane >> 3;
        float lgA[12];
#pragma unroll
        for (int sl = 0; sl < 12; ++sl) lgA[sl] = (gw < NTOK) ? lgp[((size_t)sl * NTOK + gw) * 64 + lane] : 0.f;
        int pm_ = -1, psel = 0, prank = 0; float pgate = 0.f; unsigned ppos = 0u;
        for (int m = gw; m < NTOK; m += NGW) {
            float lgB[12]; const int mn = m + NGW;
#pragma unroll
            for (int sl = 0; sl < 12; ++sl) lgB[sl] = (mn < NTOK) ? lgp[((size_t)sl * NTOK + mn) * 64 + lane] : 0.f;
            const float rs2 = 1.0f / sqrtf(wave_sum(((const float*)(ws + WS_SSP2))[(size_t)m * 64 + lane]) * (1.0f / 4096.f) + EPS);
            if (lane == 0) ((float*)(ws + WS_RS2))[m] = rs2;
            const float logit = (((lgA[0] + lgA[1]) + (lgA[2] + lgA[3])) + ((lgA[4] + lgA[5]) + (lgA[6] + lgA[7])) + ((lgA[8] + lgA[9]) + (lgA[10] + lgA[11]))) * rs2;
            const float score = 1.0f / (1.0f + expf(-logit));
            const float choice = score + rb;
            float gm1 = fmaxf(choice, __shfl_xor(choice, 1)); gm1 = fmaxf(gm1, __shfl_xor(gm1, 2)); gm1 = fmaxf(gm1, __shfl_xor(gm1, 4));
            const unsigned long long eq = __ballot(choice == gm1);
            const unsigned gbits = (unsigned)(eq >> (8 * g)) & 0xffu;
            const bool is_first = (lane & 7) == (__builtin_ctz(gbits | 0x100u));
            float v2 = is_first ? -INFINITY : choice;
            v2 = fmaxf(v2, __shfl_xor(v2, 1)); v2 = fmaxf(v2, __shfl_xor(v2, 2)); v2 = fmaxf(v2, __shfl_xor(v2, 4));
            const float gscore = gm1 + v2;
            int grank = 0;
#pragma unroll
            for (int j2 = 0; j2 < 8; ++j2) { const float gj = __int_as_float(__builtin_amdgcn_readlane(__float_as_int(gscore), 8 * j2)); grank += ((gj > gscore) || (gj == gscore && j2 < g)) ? 1 : 0; }
            const bool gsel = grank < 4;
            const float mv = gsel ? choice : -INFINITY;
            int rank = 0;
#pragma unroll
            for (int i2 = 0; i2 < 64; ++i2) { const float vi = __int_as_float(__builtin_amdgcn_readlane(__float_as_int(mv), i2)); rank += ((vi > mv) || (vi == mv && i2 < lane)) ? 1 : 0; }
            const bool sel = gsel && rank < 8;
            const float wsum = wave_sum(sel ? score : 0.f);
            if (pm_ >= 0 && psel) { rowtok[lane * CAP + ppos] = pm_; rowgate[lane * CAP + ppos] = pgate; rowdst[lane * CAP + ppos] = pm_ * 8 + prank; }
            ppos = 0u; if (sel) ppos = atomicAdd(&gcnt[64 * lane], 1u);
            pm_ = m; psel = sel ? 1 : 0; prank = rank; pgate = score * 2.5f / (wsum + 1e-20f);
#pragma unroll
            for (int sl = 0; sl < 12; ++sl) lgA[sl] = lgB[sl];
        }
        if (pm_ >= 0 && psel) { rowtok[lane * CAP + ppos] = pm_; rowgate[lane * CAP + ppos] = pgate; rowdst[lane * CAP + ppos] = pm_ * 8 + prank; }
    }
    SEAM(14);
    if (IN(15)) REP(15) {
#if FAST_MOE
        { const fg::MoeTabs T = moe_tables_fast((LAS int*)(lds + 131072), gcnt);
          fg::MoeSched<1> S{T, (const char*)(ws + WS_T8), (const char*)wguT, rowtok, G, bid};
          fg::EpiSwiglu E{hh, (const float*)(ws + WS_RS2)};
          fg::gemm_phase<fg::EpiSwiglu, fg::MoeSched<1>, true, true, true>(lds, S, E, DM / 2, DM / 2, p.var); }
#else
        int* tab = (int*)(ldsf + 2 * 16 * 132);
        const MoeTab T = moe_tables(tab, gcnt, 128);
        const int nunits = T.mtp[NE + 1] * 8;
        for (int u = bid; u < nunits; u += G) {
            const int mti = u >> 3, nt = u & 7; int e = 0; while (T.mtp[e + 1] <= mti) ++e;
            const int mt = mti - T.mtp[e], nrows = (T.cnt[e] - mt * 128) < 128 ? (T.cnt[e] - mt * 128) : 128;
            const float* Wg = (e < NE) ? p.in[I_WEXG] + (size_t)e * DM * EFF : p.in[I_WSHG];
            const float* Wu = (e < NE) ? p.in[I_WEXU] + (size_t)e * DM * EFF : p.in[I_WSHU];
            BGU bc{Wg, Wu, EFF, nt * 64};
            const size_t hrow0 = (size_t)T.offh[e] + (size_t)mt * 128;
            auto epi = [&](int r, int c, const float (&v)[4]) { act_t* o = hh + (hrow0 + r) * EFF + nt * 64 + (c >> 2) * 2;
                stf(o, v[0] / (1.0f + expf(-v[0])) * v[2]); stf(o + 1, v[1] / (1.0f + expf(-v[1])) * v[3]); };
            ngemm_tile<act_t>(ldsf, tb, DM, (e < NE) ? rowtok + e * CAP : nullptr, mt * 128, nrows, DM, bc, epi);
        }
    #endif
    }
    SEAM(15);
    if (IN(16)) REP(16) {
#if FAST_MOE
        { const fg::MoeTabs T = moe_tables_fast((LAS int*)(lds + 131072), gcnt);
          { fg::MoeSched<2> S{T, (const char*)hh, (const char*)wdT, rowtok, G, bid};
            fg::EpiScatter E{(unsigned char*)ybuf, rowdst, rowgate, T.mtp};
            fg::gemm_phase<fg::EpiScatter, fg::MoeSched<2>, false, true, true>(lds, S, E, EFF / 2, EFF / 2, p.var); }
          { fg::DenseSched S{(const char*)hh + (size_t)T.mtp[64] * 256 * EFF, (const char*)wdT + (size_t)64 * DM * EFF, EFF / 2, EFF / 2, NTOK / 256, DM / 256, 1, EFF / 128, G, bid, 0};
            fg::EpiShared E{(unsigned char*)ybuf + (size_t)NTOK * 8 * DM};
            fg::gemm_phase<fg::EpiShared, fg::DenseSched, false, true, true>(lds, S, E, EFF / 2, EFF / 2); } }
#else
        int* tab = (int*)(ldsf + 2 * 16 * 132);
        const MoeTab T = moe_tables(tab, gcnt, 128);
        const int nunits = T.mtp[NE + 1] * 32;
        for (int u = bid; u < nunits; u += G) {
            const int mti = u >> 5, nt = u & 31; int e = 0; while (T.mtp[e + 1] <= mti) ++e;
            const int mt = mti - T.mtp[e], nrows = (T.cnt[e] - mt * 128) < 128 ? (T.cnt[e] - mt * 128) : 128;
            const float* Wd = (e < NE) ? p.in[I_WEXD] + (size_t)e * EFF * DM : p.in[I_WSHD];
            BPlain bc{Wd, DM, nt * 128, DM};
            const int hrow0 = T.offh[e] + mt * 128;
            auto epi = [&](int r, int c, const float (&v)[4]) {
                int tok; float g; if (e < NE) { tok = rowtok[e * CAP + mt * 128 + r]; g = rowgate[e * CAP + mt * 128 + r]; } else { tok = mt * 128 + r; g = 1.0f; }
                float* o = p.out + (size_t)tok * DM + nt * 128 + c;
                atomicAdd(o, v[0] * g); atomicAdd(o + 1, v[1] * g); atomicAdd(o + 2, v[2] * g); atomicAdd(o + 3, v[3] * g); };
            ngemm_tile<act_t>(ldsf, hh, EFF, nullptr, hrow0, nrows, EFF, bc, epi);
        }
    #endif
    }
    SEAM(16);
    if (IN(17)) REP(17) {
#if FAST_MOE
        for (int m = gw; m < NTOK; m += NGW) {
            const unsigned char* y8 = (const unsigned char*)ybuf + (size_t)m * 8 * DM;
#pragma unroll 2
            for (int j = 0; j < 4; ++j) { const int c0 = lane * 16 + 1024 * j;
                const float* sp = x2 + (size_t)m * DM + c0; float* op = p.out + (size_t)m * DM + c0;
                f32x4 sv[4];
#pragma unroll
                for (int q = 0; q < 4; ++q) sv[q] = __builtin_nontemporal_load((const f32x4*)(sp + 4 * q));
                u32x4 y[9];
#pragma unroll
                for (int k = 0; k < 8; ++k) y[k] = __builtin_nontemporal_load((const u32x4*)(y8 + (size_t)k * DM + c0));
                y[8] = __builtin_nontemporal_load((const u32x4*)((const unsigned char*)ybuf + (size_t)NTOK * 8 * DM + (size_t)m * DM + c0));
                float a[16];
#pragma unroll
                for (int q = 0; q < 16; ++q) a[q] = 0.f;
#pragma unroll
                for (int k = 0; k < 9; ++k) {
#pragma unroll
                    for (int q = 0; q < 4; ++q) { const int w = (int)y[k][q]; const auto lo = __builtin_amdgcn_cvt_pk_f32_fp8(w, false); const auto hi2 = __builtin_amdgcn_cvt_pk_f32_fp8(w, true);
                        a[4 * q] += lo[0]; a[4 * q + 1] += lo[1]; a[4 * q + 2] += hi2[0]; a[4 * q + 3] += hi2[1]; } }
#pragma unroll
                for (int q = 0; q < 4; ++q) { f32x4 o; o.x = sv[q].x + a[4 * q] * (1.0f / fg::Y_SCALE); o.y = sv[q].y + a[4 * q + 1] * (1.0f / fg::Y_SCALE); o.z = sv[q].z + a[4 * q + 2] * (1.0f / fg::Y_SCALE); o.w = sv[q].w + a[4 * q + 3] * (1.0f / fg::Y_SCALE);
                    *(f32x4*)(op + 4 * q) = o; } }
        }
#endif
    }
#undef IN
#undef SEAM
}

#if TVAR
__global__ void __launch_bounds__(512, 2) probe_k(Params p) {
    extern __shared__ __attribute__((aligned(16))) unsigned char lds_raw[];
    const int tid = threadIdx.x, lane = tid & 63, wave = tid >> 6;
    p0_items<TVAR>(p, p.ws, (LAS float*)((LAS unsigned char*)lds_raw + wave * 16640), lane, blockIdx.x * 8 + wave, gridDim.x * 8);
}
#endif
typedef void (*kern_t)(Params);
template <int PH> struct KTab { static void fill(kern_t* t) { t[PH] = fwd<(1u << PH)>; KTab<PH - 1>::fill(t); } };
template <> struct KTab<-1> { static void fill(kern_t*) {} };
extern "C" void kernel_launch(void* const* d_in, const int* in_sizes, int n_in, void* d_out, int out_size, void* d_ws, size_t ws_size, hipStream_t stream) {
    static int grid = 0;
    static kern_t ktab[NPHASE + 1];
    if (grid == 0) {
        if (n_in != 31 || out_size != NTOK * DM || ws_size < WS_END) { fprintf(stderr, "kernel_launch: bad shapes n_in %d out %d ws %zu (need %zu)\n", n_in, out_size, ws_size, (size_t)WS_END); grid = -1; return; }
        int dev = 0, cus = 0;
        if (hipGetDevice(&dev) != hipSuccess || hipDeviceGetAttribute(&cus, hipDeviceAttributeMultiprocessorCount, dev) != hipSuccess) { grid = -1; return; }
#if N_LAUNCH_PER_PHASE
        KTab<NPHASE - 1>::fill(ktab);
#else
        ktab[NPHASE] = fwd<0xFFFFFFFFu>;
#endif
#if N_LAUNCH_PER_PHASE
        for (int i = 0; i < NPHASE; ++i)
#else
        for (int i = NPHASE; i <= NPHASE; ++i)
#endif
            if (hipFuncSetAttribute((const void*)ktab[i], hipFuncAttributeMaxDynamicSharedMemorySize, LDS_BYTES) != hipSuccess) { fprintf(stderr, "kernel_launch: hipFuncSetAttribute failed\n"); grid = -1; return; }
        (void)hipGetLastError();
        grid = cus;
    }
    if (grid < 0) return;
    (void)hipMemsetAsync((char*)d_ws + WS_CTL, 0, CTL_BYTES, stream);
    Params p{};
    for (int i = 0; i < 31; ++i) p.in[i] = (const float*)d_in[i];
    p.out = (float*)d_out; p.ws = (unsigned char*)d_ws;
#if TVAR
    { static int once = 0; if (!once) { (void)hipFuncSetAttribute((const void*)probe_k, hipFuncAttributeMaxDynamicSharedMemorySize, LDS_BYTES); once = 1; } p.ph_lo = 0; p.ph_hi = 0; hipLaunchKernelGGL(probe_k, dim3(grid), dim3(512), LDS_BYTES, stream, p); }
#endif
#if N_LAUNCH_PER_PHASE
    for (int ph = 0; ph < NPHASE; ++ph) { p.ph_lo = ph; p.ph_hi = ph + 1; hipLaunchKernelGGL(ktab[ph], dim3(grid), dim3(512), LDS_BYTES, stream, p); }
#else
    p.ph_lo = 0; p.ph_hi = NPHASE; hipLaunchKernelGGL(ktab[NPHASE], dim3(grid), dim3(512), LDS_BYTES, stream, p);
#endif
#ifdef PROBE_PH
#ifndef PROBE_VAR
#define PROBE_VAR 0
#endif
    (void)hipMemsetAsync((char*)d_ws + WS_CTL + (size_t)CW_QCONV * 4, 0, 1024, stream);
    (void)hipMemsetAsync((char*)d_ws + WS_CTL + (size_t)CW_QCONV * 4, 0, 1024, stream);
    p.ph_lo = PROBE_PH; p.ph_hi = PROBE_PH + 1; p.var = PROBE_VAR; hipLaunchKernelGGL(ktab[NPHASE], dim3(grid), dim3(512), LDS_BYTES, stream, p);
#endif
    const hipError_t le = hipPeekAtLastError();
    if (le != hipSuccess) fprintf(stderr, "kernel_launch: launch failed: %s\n", hipGetErrorName(le));
}
```

```cpp
#include <hip/hip_runtime.h>
#include <cstdio>
#include <cstdint>

#define LAS __attribute__((address_space(3)))
typedef unsigned short bf16_t;
typedef float f32x4 __attribute__((ext_vector_type(4)));
typedef short bf16x8 __attribute__((ext_vector_type(8)));
typedef unsigned u32x4 __attribute__((ext_vector_type(4)));
typedef unsigned u32x2 __attribute__((ext_vector_type(2)));
typedef int v4i_t __attribute__((ext_vector_type(4)));
typedef int v8i_t __attribute__((ext_vector_type(8)));
#ifndef FAST_GEMM
#define FAST_GEMM 1
#endif
#ifndef FAST_MOE
#define FAST_MOE 1
#endif
#ifndef FAST_ATTN
#define FAST_ATTN 1
#endif

#ifndef ACT_F32
#define ACT_F32 0
#endif
#if ACT_F32
typedef float act_t;
#else
typedef bf16_t act_t;
#endif
#ifndef N_LAUNCH_PER_PHASE
#define N_LAUNCH_PER_PHASE 0
#endif

constexpr int NB = 4, SEQ = 2048, DM = 4096, NTOK = NB * SEQ;
constexpr int CHUNK = 64, LEFT = 8, NREL = 192;
constexpr int HD = 128, HA = 16, HB = 16, QLORA = 1024, KVLORA = 512, QKB = 192;
constexpr int MEMT = 256, MH = 4, NE = 64, EFF = 512;
constexpr int WA = HA * HD;
constexpr int INW = 3 * WA + QLORA + KVLORA + 64;
constexpr int NMEM = NB * MEMT;
constexpr int C_Q0 = 0, C_K0 = WA, C_V0 = 2 * WA, C_CQ = 3 * WA, C_CKV = 3 * WA + QLORA, C_KPE = 3 * WA + QLORA + KVLORA;
constexpr float EPS = 1e-6f;
constexpr int CAP = NTOK;

constexpr size_t MiB = 1u << 20;
constexpr size_t AS = sizeof(act_t);
constexpr size_t al(size_t x) { return (x + 255) / 256 * 256; }
constexpr size_t WS_CTL = 0, CTL_BYTES = 1 * MiB;
constexpr size_t WS_ROWTOK = 1 * MiB, WS_ROWGATE = 3 * MiB, WS_ROWDST = 5 * MiB;
constexpr int PK(int K) { return K; }
constexpr int INWP = 7936;
constexpr size_t WS_WR = 8 * MiB;
constexpr size_t WS_WIN = 12 * MiB;
constexpr size_t WS_WUQ = WS_WIN + al((size_t)INWP * PK(DM) * 2);
constexpr size_t WS_WUKV = WS_WUQ + al((size_t)3072 * PK(QLORA) * 2);
constexpr size_t WS_WO = WS_WUKV + al((size_t)4096 * PK(KVLORA) * 2);
constexpr size_t WS_WXQ = WS_WO + al((size_t)DM * PK(DM) * 2);
constexpr size_t WS_WXKV = WS_WXQ + al((size_t)512 * PK(DM) * 2);
constexpr size_t WS_WXO = WS_WXKV + al((size_t)1024 * PK(DM) * 2);
constexpr size_t WS_WGU = WS_WXO + al((size_t)DM * PK(512) * 2);
constexpr size_t WS_WD = WS_WGU + al((size_t)65 * 1024 * DM);
constexpr size_t WS_T8 = WS_WD + al((size_t)65 * DM * EFF);
constexpr size_t WS_SSP1 = WS_T8 + al((size_t)NTOK * DM);
constexpr size_t WS_SSP2 = WS_SSP1 + (size_t)NTOK * 64 * 4;
constexpr size_t WS_RS2 = WS_SSP2 + (size_t)NTOK * 64 * 4;
constexpr size_t WS_X1 = WS_RS2 + al((size_t)NTOK * 4);
constexpr size_t WS_X2 = WS_X1 + al((size_t)NTOK * DM * 4);
constexpr size_t WS_T = WS_X2 + al((size_t)NTOK * DM * 4);
constexpr int HH_ROWS = NTOK * 8 + NE * 256 + NTOK;
constexpr size_t WS_HH = WS_T + al((size_t)NTOK * DM * AS);
constexpr size_t WS_Y = WS_HH + al((size_t)HH_ROWS * EFF * AS);
constexpr size_t WS_H = WS_Y;
constexpr size_t WS_MEMN = WS_H + al((size_t)NTOK * DM * AS);
constexpr size_t WS_P1 = WS_MEMN + al((size_t)NMEM * DM * AS);
constexpr size_t WS_KVM = WS_P1 + al((size_t)NTOK * INW * AS);
constexpr size_t WS_QB = WS_KVM + al((size_t)NMEM * 1024 * AS);
constexpr size_t WS_KVB = WS_QB + al((size_t)NTOK * 3072 * AS);
constexpr size_t WS_MIXED = WS_KVB + al((size_t)NTOK * 4096 * AS);
constexpr size_t WS_HC = WS_MIXED + al((size_t)NTOK * DM * AS);
constexpr size_t WS_QXP = WS_HC + al((size_t)NTOK * DM * AS);
constexpr size_t WS_QX = WS_QXP + al((size_t)4 * NTOK * 512 * 4);
constexpr size_t WS_OX = WS_QX + al((size_t)NTOK * 512 * AS);
constexpr size_t WS_END0 = WS_OX + al((size_t)NTOK * 512 * AS);
constexpr size_t WS_YEND = WS_Y + al((size_t)NTOK * 8 * DM * 2);
constexpr size_t WS_END = WS_END0 > WS_YEND ? WS_END0 : WS_YEND;
static_assert(WS_END <= 2147483648ull, "workspace map exceeds the guaranteed 2 GiB");
constexpr int CW_BAR = 4096;
constexpr int CW_CNT = 16384;
constexpr int CW_QCONV = 26624, CW_QB = 26688, CW_QA = 26752;
constexpr int CW_SS1 = 32768, CW_SS2 = 40960;
constexpr int CW_TICKET = 24576;

constexpr int LDS_BYTES = 163840;
constexpr int LDS_MISC = LDS_BYTES - 64;

__device__ __forceinline__ unsigned f2bf(float f) { unsigned u = __builtin_bit_cast(unsigned, f); return (u + 0x7fffu + ((u >> 16) & 1u)) >> 16; }
__device__ __forceinline__ float ldf(const float* p) { return *p; }
__device__ __forceinline__ float ldf(const bf16_t* p) { return __uint_as_float(((unsigned)*p) << 16); }
__device__ __forceinline__ void stf(float* p, float v) { *p = v; }
__device__ __forceinline__ void stf(bf16_t* p, float v) { *p = (bf16_t)f2bf(v); }
__device__ __forceinline__ float wave_sum(float v) {
#pragma unroll
    for (int o = 1; o < 64; o <<= 1) v += __shfl_xor(v, o);
    return v;
}

#define XB_TMO      128
#define XB_XCNT(j)  (256  + 64 * (j))
#define XB_XSUB(j)  (1280 + 64 * (j))
#define XB_XGEN(j)  (2304 + 64 * (j))
#define XB_TOP      3328
#define XB_TOPGEN   3392
#define XCD_BAR_WORDS 3456
#define XB_SPIN_CAP (1u << 18)
__device__ __forceinline__ unsigned xb_ld(unsigned* p)              { return __hip_atomic_load(p, __ATOMIC_RELAXED, __HIP_MEMORY_SCOPE_AGENT); }
__device__ __forceinline__ unsigned xb_add(unsigned* p, unsigned v) { return __hip_atomic_fetch_add(p, v, __ATOMIC_RELAXED, __HIP_MEMORY_SCOPE_AGENT); }
__device__ __forceinline__ unsigned xb_xcc_id() { return (unsigned)__builtin_amdgcn_s_getreg((3 << 11) | 20) & 0xFu; }
#define XB_SPIN(cond, bar) do { unsigned _sp = 0; while (cond) { __builtin_amdgcn_s_sleep(1); \
    if ((++_sp & 255u) == 0u) { if (xb_ld(&(bar)[XB_TMO])) break; if (_sp > XB_SPIN_CAP) { atomicAdd(&(bar)[XB_TMO], 1u); break; } } } } while (0)
struct XcdBarrier { unsigned* bar; unsigned x; volatile LAS unsigned* st; };
__device__ __forceinline__ XcdBarrier xcd_barrier_post(unsigned* bar, volatile LAS unsigned* st) {
    XcdBarrier b; b.bar = bar; b.x = xb_xcc_id(); b.st = st;
    if (threadIdx.x == 0) (void)xb_add(&bar[XB_XCNT(b.x)], 1u);
    return b;
}
__device__ __forceinline__ void xcd_barrier_complete(unsigned* bar, unsigned x, unsigned& nloc, unsigned& nx) {
    const unsigned G = gridDim.x * gridDim.y * gridDim.z;
    unsigned sum, cnt, mine, sp = 0u;
    for (;;) {
        sum = 0u; cnt = 0u; mine = 0u;
#pragma unroll
        for (unsigned j = 0; j < 16; ++j) { const unsigned c = xb_ld(&bar[XB_XCNT(j)]); sum += c; cnt += (c > 0u) ? 1u : 0u; mine = (j == x) ? c : mine; }
        if (sum == G) break;
        __builtin_amdgcn_s_sleep(1);
        if ((++sp & 255u) == 0u) { if (xb_ld(&bar[XB_TMO])) break; if (sp > XB_SPIN_CAP) { atomicAdd(&bar[XB_TMO], 1u); break; } }
    }
    nloc = mine > 0u ? mine : 1u; nx = cnt > 0u ? cnt : 1u;
}
__device__ __forceinline__ void xcd_barrier(const XcdBarrier& b) {
    asm volatile("s_waitcnt vmcnt(0)" ::: "memory");
    __syncthreads();
    if (threadIdx.x == 0) {
        unsigned* bar = b.bar;
        __builtin_amdgcn_s_waitcnt(0);
        unsigned nloc = b.st[0], nx = b.st[1];
        if (nloc == 0u) { xcd_barrier_complete(bar, b.x, nloc, nx); b.st[0] = nloc; b.st[1] = nx; }
        const unsigned old = xb_add(&bar[XB_XSUB(b.x)], 1u);
        const unsigned gen = old / nloc;
        if (old + 1u == (gen + 1u) * nloc) {
            __builtin_amdgcn_fence(__ATOMIC_RELEASE, "agent");
            asm volatile("s_waitcnt vmcnt(0)" ::: "memory");
            const unsigned og = xb_add(&bar[XB_TOP], 1u);
            const unsigned tg = og / nx;
            if (og + 1u == (tg + 1u) * nx) xb_add(&bar[XB_TOPGEN], 1u);
            else XB_SPIN(xb_ld(&bar[XB_TOPGEN]) == tg, bar);
            __builtin_amdgcn_fence(__ATOMIC_ACQUIRE, "agent");
            xb_add(&bar[XB_XGEN(b.x)], 1u);
            asm volatile("s_waitcnt vmcnt(0)" ::: "memory");
        } else {
            XB_SPIN(xb_ld(&bar[XB_XGEN(b.x)]) == gen, bar);
            __builtin_amdgcn_fence(__ATOMIC_ACQUIRE, "agent");
            asm volatile("s_waitcnt vmcnt(0)" ::: "memory");
        }
    }
    __syncthreads();
}

struct Params {
    const float* in[31];
    float* out;
    unsigned char* ws;
    int ph_lo, ph_hi, var, pad;
};
enum { I_X = 0, I_MEM, I_POS, I_GMIX, I_WIN, I_GQA, I_GKA, I_RELB, I_GCQ, I_WUQ, I_GCKV, I_WUKV, I_GQB, I_GKB, I_WO, I_GCROSS, I_GMEM, I_WXQ, I_WXKV,
       I_GQX, I_GKX, I_WXO, I_GFFN, I_WROUTER, I_RBIAS, I_WSHG, I_WSHU, I_WSHD, I_WEXG, I_WEXU, I_WEXD };

template <class OT>
__device__ __forceinline__ void rms_row_4096(const float* x, const float* g, OT* o, int lane, float* keep  ) {
    f32x4 v[16]; float s = 0.f;
#pragma unroll
    for (int j = 0; j < 16; ++j) { v[j] = ((const f32x4*)x)[lane + 64 * j]; s += v[j].x * v[j].x + v[j].y * v[j].y + v[j].z * v[j].z + v[j].w * v[j].w; }
    s = wave_sum(s);
    const float r = 1.0f / sqrtf(s * (1.0f / 4096.f) + EPS);
#pragma unroll
    for (int j = 0; j < 16; ++j) v[j] = v[j] * r * __builtin_nontemporal_load((const f32x4*)g + lane + 64 * j);
    asm volatile("s_waitcnt vmcnt(0)" ::: "memory");
#pragma unroll
    for (int j = 0; j < 16; ++j) {
        const f32x4 y = v[j];
        const int c = (lane + 64 * j) * 4;
        stf(o + c, y.x); stf(o + c + 1, y.y); stf(o + c + 2, y.z); stf(o + c + 3, y.w);
        if (keep) { keep[c] = y.x; keep[c + 1] = y.y; keep[c + 2] = y.z; keep[c + 3] = y.w; }
    }
}
template <int N>
__device__ __forceinline__ void rms_inplace(act_t* p, const float* g, int lane) {
    float v[N / 64]; float s = 0.f;
#pragma unroll
    for (int j = 0; j < N / 64; ++j) { v[j] = ldf(p + lane + 64 * j); s += v[j] * v[j]; }
    s = wave_sum(s);
    const float r = 1.0f / sqrtf(s * (1.0f / N) + EPS);
#pragma unroll
    for (int j = 0; j < N / 64; ++j) stf(p + lane + 64 * j, v[j] * r * g[lane + 64 * j]);
}
__device__ __forceinline__ void rms_rope64_inplace(act_t* p, const float* g, int pos, int lane) {
    float v = ldf(p + lane);
    float s = wave_sum(v * v);
    const float r = 1.0f / sqrtf(s * (1.0f / 64.f) + EPS);
    v = v * r * g[lane];
    const int fi = lane & 31;
    const float inv_freq = powf(10000.0f, -(float)(2 * fi) / 64.0f);
    const float ang = (float)pos * inv_freq;
    float sn, cs; sincosf(ang, &sn, &cs);
    const float other = __shfl_xor(v, 32);
    const float y = (lane < 32) ? (v * cs - other * sn) : (v * cs + other * sn);
    stf(p + lane, y);
}

template <class AT, class BCol, class Epi>
__device__ __forceinline__ void ngemm_tile(float* lds, const AT* A, long lda, const int* rowlist, int row0, int nrows, int K, const BCol& bcol, const Epi& epi) {
    const int tid = threadIdx.x, tx = tid & 31, ty = tid >> 5;
    float* As = lds; float* Bs = lds + 16 * 132;
    const int arow = tid >> 2, akq = (tid & 3) * 4;
    int grow; { const int rr = (arow < nrows) ? arow : 0; grow = rowlist ? rowlist[row0 + rr] : (row0 + rr); }
    const AT* Ap = A + (long)grow * lda + akq;
    const int bj = tid & 127, bk = tid >> 7;
    const float* Bp = bcol(bj) + (long)bk * bcol.ldb;
    float acc[8][4];
#pragma unroll
    for (int i = 0; i < 8; ++i)
#pragma unroll
        for (int j = 0; j < 4; ++j) acc[i][j] = 0.f;
    for (int k0 = 0; k0 < K; k0 += 16) {
        float a0 = ldf(Ap + k0), a1 = ldf(Ap + k0 + 1), a2 = ldf(Ap + k0 + 2), a3 = ldf(Ap + k0 + 3);
        float b0 = Bp[(long)(k0) * bcol.ldb], b1 = Bp[(long)(k0 + 4) * bcol.ldb], b2 = Bp[(long)(k0 + 8) * bcol.ldb], b3 = Bp[(long)(k0 + 12) * bcol.ldb];
        __syncthreads();
        As[(akq + 0) * 132 + arow] = a0; As[(akq + 1) * 132 + arow] = a1; As[(akq + 2) * 132 + arow] = a2; As[(akq + 3) * 132 + arow] = a3;
        Bs[(bk + 0) * 132 + bj] = b0; Bs[(bk + 4) * 132 + bj] = b1; Bs[(bk + 8) * 132 + bj] = b2; Bs[(bk + 12) * 132 + bj] = b3;
        __syncthreads();
#pragma unroll
        for (int kk = 0; kk < 16; ++kk) {
            const f32x4 al = *(const f32x4*)(As + kk * 132 + ty * 8), ah = *(const f32x4*)(As + kk * 132 + ty * 8 + 4);
            const f32x4 b = *(const f32x4*)(Bs + kk * 132 + tx * 4);
            const float a[8] = {al.x, al.y, al.z, al.w, ah.x, ah.y, ah.z, ah.w};
#pragma unroll
            for (int i = 0; i < 8; ++i) { acc[i][0] += a[i] * b.x; acc[i][1] += a[i] * b.y; acc[i][2] += a[i] * b.z; acc[i][3] += a[i] * b.w; }
        }
    }
    __syncthreads();
#pragma unroll
    for (int i = 0; i < 8; ++i) { const int r = ty * 8 + i; if (r < nrows) epi(r, tx * 4, acc[i]); }
}
struct BGU { const float* Wg; const float* Wu; int ldb; int ff0; __device__ __forceinline__ const float* operator()(int j) const { const int ff = ff0 + (j >> 2) * 2 + (j & 1); const uintptr_t a = (uintptr_t)Wg, b = (uintptr_t)Wu; return (const float*)((j & 2) ? b : a) + ff; } };
struct BPlain { const float* B; int ldb; int col0, ncols; __device__ __forceinline__ const float* operator()(int j) const { const int c = col0 + j; return B + (c < ncols ? c : 0); } };

template <int DQK, class KeyTile, class Bias>
__device__ __forceinline__ void nattn_unit(float* lds, const act_t* Q, long ldq, const act_t* K1, long ldk1, const act_t* K2, long ldk2, const act_t* V, long ldv,
                                           int ntiles, const KeyTile& keytile, float scale, const Bias& bias, act_t* O, long ldo) {
    constexpr int QS = DQK + 4;
    float* Qs = lds; float* Ks = Qs + 64 * QS; float* Vs = Ks + 64 * QS; float* Ss = Vs + 64 * 132;
    const int tid = threadIdx.x, r = tid >> 3, s = tid & 7;
    __syncthreads();
    for (int idx = tid; idx < 64 * DQK; idx += 512) { const int row = idx / DQK, d = idx % DQK; Qs[row * QS + d] = ldf(Q + (long)row * ldq + d); }
    float m = -INFINITY, l = 0.f; float o[16];
#pragma unroll
    for (int d = 0; d < 16; ++d) o[d] = 0.f;
    for (int t = 0; t < ntiles; ++t) {
        const int k0 = keytile(t);
        __syncthreads();
        for (int idx = tid; idx < 64 * 128; idx += 512) { const int row = idx >> 7, d = idx & 127;
            Ks[row * QS + d] = ldf(K1 + (long)(k0 + row) * ldk1 + d); Vs[row * 132 + d] = ldf(V + (long)(k0 + row) * ldv + d); }
        if (DQK > 128) for (int idx = tid; idx < 64 * (DQK - 128); idx += 512) { const int row = idx / (DQK - 128), d = idx % (DQK - 128);
            Ks[row * QS + 128 + d] = ldf(K2 + (long)(k0 + row) * ldk2 + d); }
        __syncthreads();
#pragma unroll
        for (int jj = 0; jj < 8; ++jj) { const int key = s + 8 * jj; float dot = 0.f;
#pragma unroll 8
            for (int d = 0; d < DQK; d += 4) { const f32x4 q = *(const f32x4*)(Qs + r * QS + d), k = *(const f32x4*)(Ks + key * QS + d); dot += q.x * k.x + q.y * k.y + q.z * k.z + q.w * k.w; }
            Ss[r * 65 + key] = dot * scale + bias(r, t, key); }
        __syncthreads();
        float mt = -INFINITY;
        for (int k = 0; k < 64; ++k) mt = fmaxf(mt, Ss[r * 65 + k]);
        const float mn = fmaxf(m, mt), alpha = expf(m - mn);
        float ladd = 0.f;
#pragma unroll
        for (int d = 0; d < 16; ++d) o[d] *= alpha;
        for (int k = 0; k < 64; ++k) { const float pk = expf(Ss[r * 65 + k] - mn); ladd += pk;
#pragma unroll
            for (int d = 0; d < 16; d += 4) { const f32x4 v = *(const f32x4*)(Vs + k * 132 + s * 16 + d); o[d] += pk * v.x; o[d + 1] += pk * v.y; o[d + 2] += pk * v.z; o[d + 3] += pk * v.w; } }
        m = mn; l = l * alpha + ladd;
    }
    const float il = 1.0f / l;
#pragma unroll
    for (int d = 0; d < 16; ++d) stf(O + (long)r * ldo + s * 16 + d, o[d] * il);
}

struct MoeTab { int* cnt; int* mtp; int* offh; };
__device__ __forceinline__ MoeTab moe_tables(int* tab, const unsigned* gcnt, int tile_m) {
    MoeTab T; T.cnt = tab; T.mtp = tab + 80; T.offh = tab + 160;
    __syncthreads();
    if (threadIdx.x == 0) {
        int pm = 0, po = 0;
        for (int e = 0; e <= NE; ++e) { const int c = (e < NE) ? (int)gcnt[e] : NTOK; T.cnt[e] = c; T.mtp[e] = pm; T.offh[e] = po; pm += (c + tile_m - 1) / tile_m; po += c; }
        T.mtp[NE + 1] = pm;
    }
    __syncthreads();
    return T;
}

namespace fg {
constexpr int BM = 256, BK = 64, HALF = 128, HTB = HALF * BK * 2, STAGE_BYTES = 8 * HTB;
__device__ __forceinline__ int lds_byte(int r, int c) { const int st = (r >> 4) * 2 + (c >> 5), rr = r & 15, cc = c & 31, ob = rr * 64 + cc * 2; return st * 1024 + (ob ^ (((ob >> 9) & 1) << 5)); }
__device__ __forceinline__ void stage_rc(int b, int& R, int& C) { const int st = b / 1024, sb = b % 1024, swz = sb ^ (((sb >> 9) & 1) << 5); R = (st >> 1) * 16 + swz / 64; C = (st & 1) * 32 + (swz % 64) / 2; }
__device__ __forceinline__ int perm32(int rho) { const int n = rho >> 4, i = rho & 15; return 8 * (i >> 2) + 4 * n + (i & 3); }
__device__ __forceinline__ unsigned cvt_pk_bf16(float lo, float hi) { unsigned r; asm volatile("v_cvt_pk_bf16_f32 %0, %1, %2" : "=v"(r) : "v"(lo), "v"(hi)); return r; }

__device__ __forceinline__ unsigned pk4_fp8(float a, float b, float c, float d) { int w = 0; w = __builtin_amdgcn_cvt_pk_fp8_f32(a, b, w, false); w = __builtin_amdgcn_cvt_pk_fp8_f32(c, d, w, true); return (unsigned)w; }
constexpr float H_SCALE = 4.0f, WD_SCALE = 32.0f, WGU_SCALE = 64.0f, T_SCALE = 2.0f, Y_SCALE = 16.0f;
struct Unit { const char* A; const char* B; const int* rows; int nkt, nvalid, pm, pn, e, arow0; };

template <class Epi, class Sched, bool GATHER, bool FP8 = false, bool SP2 = false>
__device__ __forceinline__ void gemm_phase(LAS unsigned char* lds, const Sched& S, const Epi& E, const int lda, const int ldb, const int var_in = 0) {
#ifdef PROBE_PH
    const int var = var_in;
#else
    constexpr int var = 0; (void)var_in;
#endif
    int tid = threadIdx.x; asm volatile("" : "+v"(tid));
    const int wid = __builtin_amdgcn_readfirstlane(tid >> 6), lane = tid & 63, wr = wid >> 2, wc = wid & 3, fr = lane & 15, fq = lane >> 4;
    unsigned voffB[2][2], voffA[2][2];
#pragma unroll
    for (int i = 0; i < 2; ++i) { int sR, sC; stage_rc(tid * 16 + i * 8192, sR, sC);
#pragma unroll
        for (int hb = 0; hb < 2; ++hb) { int Rb;
            if (Epi::PERM == 2) Rb = 64 * (sR >> 5) + 16 * ((sR >> 2) & 3) + 8 * hb + 4 * ((sR >> 4) & 1) + (sR & 3);
            else Rb = 128 * hb + (Epi::PERM == 1 ? ((sR & ~31) + perm32(sR & 31)) : sR);
            voffB[hb][i] = (unsigned)((Rb >> 6) * ldb * 64 + (Rb & 63) * 64 + sC) * 2u; }
#pragma unroll
        for (int h = 0; h < 2; ++h) voffA[h][i] = (unsigned)((sR + HALF * h) * lda + sC) * 2u; }
    const size_t kstep = (size_t)(BK * 2), kstepB = 8192;
    const unsigned ldsw = (unsigned)wid * 1024u;
    const int aoff = FP8 ? lds_byte(wr * 64 + fr, fq * 16) : lds_byte(wr * 64 + fr, fq * 8), boff = FP8 ? lds_byte(wc * 32 + fr, fq * 16) : lds_byte(wc * 32 + fr, fq * 8);
#define FG_SA(b, h) (((b) * 2 + (h)) * HTB)
#define FG_SB(b, h) ((4 + (b) * 2 + (h)) * HTB)
#define FG_STAGE2(bufoff, gbase, v0, v1) do { \
        __builtin_amdgcn_global_load_lds((const unsigned*)((const char*)(gbase) + (v0)), (LAS unsigned*)(lds + (bufoff) + ldsw), 16, 0, 0); \
        __builtin_amdgcn_global_load_lds((const unsigned*)((const char*)(gbase) + (v1)), (LAS unsigned*)(lds + (bufoff) + ldsw + 8192), 16, 0, 0); } while (0)
#define FG_STAGEB(bufoff, gbase, hb) FG_STAGE2(bufoff, gbase, voffB[hb][0], voffB[hb][1])
#define FG_STAGEA(bufoff, gbase, h) FG_STAGE2(bufoff, gbase, voffA[h][0], voffA[h][1])
#define FG_LD8(base_) __builtin_shufflevector(*(const LAS v4i_t*)(base_), *(const LAS v4i_t*)((base_) + 16), 0, 1, 2, 3, 4, 5, 6, 7)
#define FG_LDA(dst, b, h) do { if (FP8) { _Pragma("unroll") for (int m = 0; m < 4; ++m) dst##8[m] = FG_LD8(lds + FG_SA(b, h) + aoff + m * 2048); } \
      else { _Pragma("unroll") for (int m = 0; m < 4; ++m) _Pragma("unroll") for (int k = 0; k < 2; ++k) dst[m][k] = *(const LAS bf16x8*)(lds + FG_SA(b, h) + aoff + m * 2048 + k * 1024); } } while (0)
#define FG_LDB(dst, b, h) do { if (FP8) { _Pragma("unroll") for (int n = 0; n < 2; ++n) dst##8[n] = FG_LD8(lds + FG_SB(b, h) + boff + n * 2048); } \
      else { _Pragma("unroll") for (int n = 0; n < 2; ++n) _Pragma("unroll") for (int k = 0; k < 2; ++k) dst[n][k] = *(const LAS bf16x8*)(lds + FG_SB(b, h) + boff + n * 2048 + k * 1024); } } while (0)
#define FG_MMA(ai, bj, At, Bt) do { __builtin_amdgcn_s_setprio(1); if (FP8) { _Pragma("unroll") for (int m = 0; m < 4; ++m) _Pragma("unroll") for (int n = 0; n < 2; ++n) \
        asm volatile("v_mfma_scale_f32_16x16x128_f8f6f4 %0, %1, %2, %0, %3, %3 op_sel_hi:[0,0,0]" : "+v"(acc[ai][bj][m][n]) : "v"(Bt##8[n]), "v"(At##8[m]), "v"(sc127)); } \
      else { _Pragma("unroll") for (int m = 0; m < 4; ++m) _Pragma("unroll") for (int n = 0; n < 2; ++n) _Pragma("unroll") for (int k = 0; k < 2; ++k) \
        acc[ai][bj][m][n] = __builtin_amdgcn_mfma_f32_16x16x32_bf16(Bt[n][k], At[m][k], acc[ai][bj][m][n], 0, 0, 0); } __builtin_amdgcn_s_setprio(0); } while (0)
#define FG_WAIT_V(n) asm volatile("s_waitcnt vmcnt(" #n ")" ::: "memory")
#define FG_WAIT_L(n) asm volatile("s_waitcnt lgkmcnt(" #n ")" ::: "memory")
#define FG_BAR __builtin_amdgcn_s_barrier()
#define FG_SCHED __builtin_amdgcn_sched_barrier(0)
#define FG_GATHER(dst, u) do { if (GATHER) { int tz = threadIdx.x; asm volatile("" : "+v"(tz)); _Pragma("unroll") for (int i = 0; i < 2; ++i) { int sR, sC; stage_rc(tz * 16 + i * 8192, sR, sC); \
        _Pragma("unroll") for (int h = 0; h < 2; ++h) { int rr = sR + HALF * h; rr = rr < (u).nvalid ? rr : 0; const int tok = (u).rows ? (u).rows[rr] : ((u).arow0 + rr); dst[h][i] = (unsigned)(tok * lda + sC) * 2u; } } } } while (0)
    Unit cur, nxt; int ui = 0;
    if (!S.next(0, cur)) return;
    f32x4 acc[2][2][4][2];
#pragma unroll
    for (int a = 0; a < 2; ++a)
#pragma unroll
        for (int b = 0; b < 2; ++b)
#pragma unroll
            for (int m = 0; m < 4; ++m)
#pragma unroll
                for (int n = 0; n < 2; ++n) acc[a][b][m][n] = (f32x4){0.f, 0.f, 0.f, 0.f};
    const int sc127 = 127;
    bf16x8 At[4][2], B0[2][2], B1[2][2]; v8i_t At8[4], B08[2], B18[2];
    const char* cA = cur.A; const char* cB = cur.B;
    typename Epi::Pre pre; E.prefetch(pre, cur, wr, fr);
    FG_GATHER(voffA, cur);
    if (SP2) {
    FG_STAGEB(FG_SB(0, 0), cB, 0); FG_STAGEB(FG_SB(0, 1), cB, 1); FG_STAGEA(FG_SA(0, 0), cA, 0); FG_STAGEA(FG_SA(0, 1), cA, 1);
    if (wr == 1) FG_BAR;
    FG_WAIT_V(2); FG_BAR;
    FG_STAGEB(FG_SB(1, 0), cB + kstepB, 0); FG_STAGEA(FG_SA(1, 0), cA + kstep, 0); FG_STAGEB(FG_SB(1, 1), cB + kstepB, 1);
    FG_WAIT_V(6); FG_BAR;
    } else {
    FG_STAGEB(FG_SB(0, 0), cB, 0); FG_STAGEA(FG_SA(0, 0), cA, 0); FG_STAGEB(FG_SB(0, 1), cB, 1); FG_STAGEA(FG_SA(0, 1), cA, 1);
    if (wr == 1) FG_BAR;
    FG_WAIT_V(4); FG_BAR;
    FG_STAGEB(FG_SB(1, 0), cB + kstepB, 0); FG_STAGEA(FG_SA(1, 0), cA + kstep, 0); FG_STAGEB(FG_SB(1, 1), cB + kstepB, 1);
    FG_WAIT_V(6); FG_BAR;
    }
    for (;;) {
        const bool has_next = S.next(ui + 1, nxt);
        const char* nA = has_next ? nxt.A : cA; const char* nB = has_next ? nxt.B : cB;
        const int nt = cur.nkt;
#pragma unroll 1
        for (int t = 0; t < nt; t += 2) {
            const bool last = (t == nt - 2);
            const char* a1 = cA + (size_t)(t + 1) * kstep;
            const char* a2 = last ? nA : cA + (size_t)(t + 2) * kstep; const char* b2 = last ? nB : cB + (size_t)(t + 2) * kstepB;
            const char* a3 = a2 + kstep; const char* b3 = b2 + kstepB;
            if (SP2) {
            FG_LDB(B0, 0, 0); FG_LDB(B1, 0, 1); FG_SCHED; FG_LDA(At, 0, 0); FG_STAGEA(FG_SA(1, 1), a1, 1);
            if (GATHER && last && has_next) { FG_GATHER(voffA, nxt); }
            FG_WAIT_V(8); FG_WAIT_L(0); FG_BAR; FG_MMA(0, 0, At, B0); FG_MMA(0, 1, At, B1); FG_BAR; FG_SCHED;
            FG_LDA(At, 0, 1); FG_STAGEB(FG_SB(0, 0), b2, 0); FG_STAGEB(FG_SB(0, 1), b2, 1); FG_STAGEA(FG_SA(0, 0), a2, 0);
            FG_WAIT_V(8); FG_WAIT_L(0); FG_BAR; FG_MMA(1, 0, At, B0); FG_MMA(1, 1, At, B1); FG_BAR; FG_SCHED;
            FG_LDB(B0, 1, 0); FG_LDB(B1, 1, 1); FG_SCHED; FG_LDA(At, 1, 0); FG_STAGEA(FG_SA(0, 1), a2, 1);
            FG_WAIT_V(8); FG_WAIT_L(0); FG_BAR; FG_MMA(0, 0, At, B0); FG_MMA(0, 1, At, B1); FG_BAR; FG_SCHED;
            FG_LDA(At, 1, 1); FG_STAGEB(FG_SB(1, 0), b3, 0); FG_STAGEB(FG_SB(1, 1), b3, 1); FG_STAGEA(FG_SA(1, 0), a3, 0);
            FG_WAIT_V(8); FG_WAIT_L(0); FG_BAR; FG_MMA(1, 0, At, B0); FG_MMA(1, 1, At, B1); FG_BAR; FG_SCHED;
            } else {
            FG_LDB(B0, 0, 0); FG_SCHED; FG_LDA(At, 0, 0); FG_STAGEA(FG_SA(1, 1), a1, 1);
            if (GATHER && last && has_next) { FG_GATHER(voffA, nxt); }
            FG_WAIT_L(8); FG_BAR; FG_WAIT_L(0); if (var < 4) FG_MMA(0, 0, At, B0); FG_BAR; FG_SCHED;
            FG_LDB(B1, 0, 1); FG_STAGEB(FG_SB(0, 0), b2, 0);
            FG_BAR; FG_WAIT_L(0); if (var < 3) FG_MMA(0, 1, At, B1); FG_BAR;
            FG_LDA(At, 0, 1); FG_STAGEA(FG_SA(0, 0), a2, 0);
            FG_BAR; FG_WAIT_L(0); if (var < 4) FG_MMA(1, 0, At, B0); FG_BAR; FG_SCHED;
            FG_STAGEB(FG_SB(0, 1), b2, 1);
            FG_WAIT_V(6); FG_BAR; if (var < 3) FG_MMA(1, 1, At, B1); FG_BAR;
            FG_LDB(B0, 1, 0); FG_SCHED; FG_LDA(At, 1, 0); FG_STAGEA(FG_SA(0, 1), a2, 1);
            FG_WAIT_L(8); FG_BAR; FG_WAIT_L(0); if (var < 4) FG_MMA(0, 0, At, B0); FG_BAR; FG_SCHED;
            FG_LDB(B1, 1, 1); FG_STAGEB(FG_SB(1, 0), b3, 0);
            FG_BAR; FG_WAIT_L(0); if (var < 3) FG_MMA(0, 1, At, B1); FG_BAR;
            FG_LDA(At, 1, 1); FG_STAGEA(FG_SA(1, 0), a3, 0);
            FG_BAR; FG_WAIT_L(0); if (var < 4) FG_MMA(1, 0, At, B0); FG_BAR; FG_SCHED;
            FG_STAGEB(FG_SB(1, 1), b3, 1);
            FG_WAIT_V(6); FG_BAR; if (var < 3) FG_MMA(1, 1, At, B1); FG_BAR;
                    }
}
        if (SP2) { if (wr == 0) FG_BAR; }
        { int tz = threadIdx.x; asm volatile("" : "+v"(tz));
          const int wz = __builtin_amdgcn_readfirstlane(tz >> 6), lz = tz & 63; if (var != 2 && var != 9) E(acc, cur, wz >> 2, wz & 3, lz & 15, lz >> 4, pre); }
        if (!has_next) break;
#pragma unroll
        for (int a = 0; a < 2; ++a)
#pragma unroll
            for (int b = 0; b < 2; ++b)
#pragma unroll
                for (int m = 0; m < 4; ++m)
#pragma unroll
                    for (int n = 0; n < 2; ++n) acc[a][b][m][n] = (f32x4){0.f, 0.f, 0.f, 0.f};
        cur = nxt; cA = nA; cB = nB; ++ui;
        { int tz = threadIdx.x; asm volatile("" : "+v"(tz)); E.prefetch(pre, cur, __builtin_amdgcn_readfirstlane(tz >> 6) >> 2, tz & 15); }
        if (SP2) { if (wr == 1) FG_BAR; }
    }
    FG_WAIT_V(0);
    if (!SP2) { if (wr == 0) FG_BAR; }
    FG_BAR;
#undef FG_SA
#undef FG_SB
#undef FG_STAGE2
#undef FG_STAGEB
#undef FG_STAGEA
#undef FG_STAGEAX
#undef FG_LDA
#undef FG_LDB
#undef FG_MMA
#undef FG_LD8
#undef FG_WAIT_V
#undef FG_WAIT_L
#undef FG_BAR
#undef FG_SCHED
#undef FG_GATHER
}

struct DenseSched {
    const char* A; const char* B; int lda, ldb, nM, nN, nS, nkt, G, c, first;
    __device__ __forceinline__ bool next(int i, Unit& u) const {
        const int total = nM * nN * nS; const int per = (total + 7) / 8;
        int L;
        if (first == 1) {
            const int x = c & 7, r = c >> 3; if (r >= 16) { if (i >= 3) return false; L = x * 64 + (r - 16) * 3 + i; } else { if (i >= 1) return false; L = x * 64 + 48 + r; }
        } else {
        const int j = i * G + c; const int x = j & 7, q = j >> 3;
        if (q >= per) return false; L = x * per + q; if (L >= total) return false; }
        const int ks = L % nS, t2 = L / nS;
        const int nig = 8 * nN, gid = t2 / nig, fm = gid * 8, gsz = (nM - fm) < 8 ? (nM - fm) : 8;
        const int pm = fm + (t2 % nig) % gsz, pn = (t2 % nig) / gsz;
        u.A = A + ((size_t)pm * BM * lda + (size_t)ks * nkt * BK) * 2; u.B = B + ((size_t)pn * BM * ldb + (size_t)ks * nkt * 4096) * 2;
        if (first == 2) { u.A = A; u.B = B; }
        u.rows = nullptr; u.nkt = nkt; u.nvalid = BM; u.pm = pm; u.pn = pn; u.e = ks; u.arow0 = pm * BM; return true;
    }
};
struct NoPre {};
struct EpiBf16 {
    static constexpr int PERM = 1; typedef NoPre Pre; __device__ __forceinline__ void prefetch(Pre&, const Unit&, int, int) const {}
    bf16_t* O; int ldc, ncols; float scale;
    __device__ __forceinline__ void operator()(const f32x4 (&acc)[2][2][4][2], const Unit& u, int wr, int wc, int fr, int fq, const Pre& pre) const {
        const int row0 = u.pm * BM + wr * 64 + fr, col0 = u.pn * BM + wc * 32 + 8 * fq;
#pragma unroll
        for (int ai = 0; ai < 2; ++ai)
#pragma unroll
            for (int m = 0; m < 4; ++m) { bf16_t* rowp = O + (size_t)(row0 + ai * HALF + m * 16) * ldc + col0;
#pragma unroll
                for (int bj = 0; bj < 2; ++bj) { const f32x4 v0 = acc[ai][bj][m][0] * scale, v1 = acc[ai][bj][m][1] * scale;
                    u32x4 w; w.x = cvt_pk_bf16(v0[0], v0[1]); w.y = cvt_pk_bf16(v0[2], v0[3]); w.z = cvt_pk_bf16(v1[0], v1[1]); w.w = cvt_pk_bf16(v1[2], v1[3]);
                    if (col0 + bj * HALF + 8 <= ncols) *(u32x4*)(rowp + bj * HALF) = w; } }
    }
};
struct EpiBf16N {
    static constexpr int PERM = 1; typedef NoPre Pre; __device__ __forceinline__ void prefetch(Pre&, const Unit&, int, int) const {}
    bf16_t* O; int ldc, ncols; float scale;
    const float* gA; int pnA_end; const float* gB; int pnB_end; int half0_only; LAS float* part;
    __device__ __forceinline__ void operator()(const f32x4 (&acc)[2][2][4][2], const Unit& u, int wr, int wc, int fr, int fq, const Pre& pre) const {
        const int rt0 = wr * 64 + fr, row0 = u.pm * BM + rt0, col0 = u.pn * BM + wc * 32 + 8 * fq;
        const bool do_norm = u.pn < pnB_end;
        if (do_norm) {
#pragma unroll
            for (int ai = 0; ai < 2; ++ai)
#pragma unroll
                for (int m = 0; m < 4; ++m)
#pragma unroll
                    for (int bj = 0; bj < 2; ++bj) { if (half0_only && bj == 1) continue;
                        const f32x4 v0 = acc[ai][bj][m][0] * scale, v1 = acc[ai][bj][m][1] * scale;
                        float ss = (v0.x * v0.x + v0.y * v0.y) + (v0.z * v0.z + v0.w * v0.w) + (v1.x * v1.x + v1.y * v1.y) + (v1.z * v1.z + v1.w * v1.w);
                        ss += __shfl_xor(ss, 16); ss += __shfl_xor(ss, 32);
                        if (fq == 0) part[((rt0 + ai * HALF + m * 16) * 2 + bj) * 4 + wc] = ss; }
            asm volatile("s_waitcnt lgkmcnt(0)" ::: "memory"); __builtin_amdgcn_s_barrier(); asm volatile("" ::: "memory");
        }
        const float* g = (u.pn < pnA_end) ? gA : gB;
        f32x4 g0 = (f32x4){1.f, 1.f, 1.f, 1.f}, g1 = g0;
        if (do_norm) { g0 = *(const f32x4*)(g + wc * 32 + 8 * fq); g1 = *(const f32x4*)(g + wc * 32 + 8 * fq + 4); }
#pragma unroll
        for (int ai = 0; ai < 2; ++ai)
#pragma unroll
            for (int m = 0; m < 4; ++m) { const int rt = rt0 + ai * HALF + m * 16; bf16_t* rowp = O + (size_t)(row0 + ai * HALF + m * 16) * ldc + col0;
#pragma unroll
                for (int bj = 0; bj < 2; ++bj) { f32x4 v0 = acc[ai][bj][m][0] * scale, v1 = acc[ai][bj][m][1] * scale;
                    if (do_norm && !(half0_only && bj == 1)) { const f32x4 p4 = *(const LAS f32x4*)(part + (rt * 2 + bj) * 4);
                        const float r = 1.0f / sqrtf(((p4.x + p4.y) + (p4.z + p4.w)) * (1.0f / 128.f) + 1e-6f); v0 = v0 * r * g0; v1 = v1 * r * g1; }
                    u32x4 w; w.x = cvt_pk_bf16(v0[0], v0[1]); w.y = cvt_pk_bf16(v0[2], v0[3]); w.z = cvt_pk_bf16(v1[0], v1[1]); w.w = cvt_pk_bf16(v1[2], v1[3]);
                    if (col0 + bj * HALF + 8 <= ncols) *(u32x4*)(rowp + bj * HALF) = w; } }
    }
};
template <bool HAS_RES> struct EpiF32Res {
    static constexpr int PERM = 0; typedef NoPre Pre; __device__ __forceinline__ void prefetch(Pre&, const Unit&, int, int) const {}
    float* __restrict__ C; const float* __restrict__ res; int ldc; size_t slab; float scale;
    __device__ __forceinline__ void operator()(const f32x4 (&acc)[2][2][4][2], const Unit& u, int wr, int wc, int fr, int fq, const Pre& pre) const {
        const int row0 = u.pm * BM + wr * 64 + fr, col0 = u.pn * BM + wc * 32 + 4 * fq;
        float* __restrict__ Cb = C + (size_t)u.e * slab;
#pragma unroll
        for (int ai = 0; ai < 2; ++ai) {
            f32x4 r[4][2][2];
            if (HAS_RES) {
#pragma unroll
                for (int m = 0; m < 4; ++m) { const size_t o = (size_t)(row0 + ai * HALF + m * 16) * ldc + col0;
#pragma unroll
                    for (int bj = 0; bj < 2; ++bj)
#pragma unroll
                        for (int n = 0; n < 2; ++n) r[m][bj][n] = __builtin_nontemporal_load((const f32x4*)(res + o + bj * HALF + n * 16)); }
            }
#pragma unroll
            for (int m = 0; m < 4; ++m) { const size_t o = (size_t)(row0 + ai * HALF + m * 16) * ldc + col0;
#pragma unroll
                for (int bj = 0; bj < 2; ++bj)
#pragma unroll
                    for (int n = 0; n < 2; ++n) { f32x4 v = acc[ai][bj][m][n] * scale; if (HAS_RES) v = v + r[m][bj][n]; *(f32x4*)(Cb + o + bj * HALF + n * 16) = v; } }
        }
    }
};
struct MoeTabs { const LAS int* cnt; const LAS int* mtp; };
template <int PHASE  >
struct MoeSched {
    MoeTabs T; const char* A; const char* B; const int* rowtok; int G, c;
    __device__ __forceinline__ bool next(int i, Unit& u) const {
        constexpr int NT = (PHASE == 1) ? 4 : 16;
        const int nm = T.mtp[(PHASE == 1) ? 65 : 64], total = nm * NT, per = (total + 7) / 8;
        const int j = i * G + c, x = j & 7, q = j >> 3;
        if (q >= per) return false; const int L = x * per + q; if (L >= total) return false;
        int mti, pn;
        if (PHASE == 1) { mti = L / NT; pn = L % NT; }
        else { mti = L / NT; pn = 0; }
        int e = 0;
#pragma unroll 1
        for (int s2 = 32; s2 >= 1; s2 >>= 1) { if (e + s2 <= 64 && T.mtp[e + s2] <= mti) e += s2; }
        while (T.mtp[e + 1] <= mti) ++e;
        e = __builtin_amdgcn_readfirstlane(e);
        int mt = mti - T.mtp[e];
        if (PHASE == 2) {
            const int nme = T.mtp[e + 1] - T.mtp[e], r = L - T.mtp[e] * NT, ph = r / (nme * 8), r2 = r % (nme * 8);
            mt = r2 >> 3; pn = ph * 8 + (r2 & 7); mti = T.mtp[e] + mt; }
        int nv = T.cnt[e] - mt * 256; nv = nv < 256 ? nv : 256;
        u.nvalid = nv; u.pm = mti; u.pn = pn; u.e = e;
        if (PHASE == 1) { u.A = A; u.B = B + ((size_t)e * 1024 + (size_t)pn * 256) * DM; u.rows = (e < NE) ? rowtok + e * CAP + mt * 256 : nullptr; u.arow0 = mt * 256; u.nkt = DM / 128; }
        else { u.A = A + (size_t)mti * 256 * EFF; u.B = B + ((size_t)e * DM + (size_t)pn * 256) * EFF; u.rows = nullptr; u.arow0 = mt * 256; u.nkt = EFF / 128; }
        return true;
    }
};
struct EpiSwiglu {
    static constexpr int PERM = 1;
    struct Pre { float ssv[2][4]; };
    bf16_t* H; const float* ss;
    __device__ __forceinline__ void prefetch(Pre& pre, const Unit& u, int wr, int fr) const {
        const int r0 = wr * 64 + fr;
#pragma unroll
        for (int ai = 0; ai < 2; ++ai)
#pragma unroll
            for (int m = 0; m < 4; ++m) { int rr = r0 + ai * HALF + m * 16; rr = rr < u.nvalid ? rr : 0; const int tok = u.rows ? u.rows[rr] : (u.arow0 + rr); pre.ssv[ai][m] = ss[tok]; } }
    __device__ __forceinline__ void operator()(const f32x4 (&acc)[2][2][4][2], const Unit& u, int wr, int wc, int fr, int fq, const Pre& pre) const {
        const int r0 = wr * 64 + fr, col0 = u.pn * 128 + wc * 32 + 8 * fq;
#pragma unroll
        for (int ai = 0; ai < 2; ++ai)
#pragma unroll
            for (int m = 0; m < 4; ++m) { const int r = r0 + ai * HALF + m * 16;
                const float rs = pre.ssv[ai][m] * (1.0f / (T_SCALE * WGU_SCALE));
                float h[8];
#pragma unroll
                for (int n = 0; n < 2; ++n)
#pragma unroll
                    for (int j = 0; j < 4; ++j) { const float g = acc[ai][0][m][n][j] * rs, up = acc[ai][1][m][n][j] * rs; h[n * 4 + j] = g * __builtin_amdgcn_rcpf(1.0f + __expf(-g)) * up; }
                u32x2 w; w.x = pk4_fp8(h[0] * H_SCALE, h[1] * H_SCALE, h[2] * H_SCALE, h[3] * H_SCALE); w.y = pk4_fp8(h[4] * H_SCALE, h[5] * H_SCALE, h[6] * H_SCALE, h[7] * H_SCALE);
                if (r < u.nvalid) *(u32x2*)((unsigned char*)H + ((size_t)u.pm * 256 + r) * EFF + col0) = w; }
    }
};
struct EpiScatter {
    static constexpr int PERM = 2;
    struct Pre { int dst[2][4]; float gt[2][4]; };
    unsigned char* Y; const int* rowdst; const float* rowgate; const LAS int* mtp;
    __device__ __forceinline__ void prefetch(Pre& pre, const Unit& u, int wr, int fr) const {
        const int r0 = wr * 64 + fr, lbase = u.e * CAP + (u.pm - mtp[u.e]) * 256;
#pragma unroll
        for (int ai = 0; ai < 2; ++ai)
#pragma unroll
            for (int m = 0; m < 4; ++m) { const int r = r0 + ai * HALF + m * 16; const bool ok = r < u.nvalid; pre.dst[ai][m] = ok ? rowdst[lbase + r] : -1; pre.gt[ai][m] = ok ? rowgate[lbase + r] : 0.f; } }
    __device__ __forceinline__ void operator()(const f32x4 (&acc)[2][2][4][2], const Unit& u, int wr, int wc, int fr, int fq, const Pre& pre) const {
        const int col0 = u.pn * BM + wc * 64 + 16 * fq;
#pragma unroll
        for (int ai = 0; ai < 2; ++ai)
#pragma unroll
            for (int m = 0; m < 4; ++m) { if (pre.dst[ai][m] >= 0) { const float g = pre.gt[ai][m] * (Y_SCALE / (H_SCALE * WD_SCALE));
                const f32x4 v0 = acc[ai][0][m][0] * g, v1 = acc[ai][0][m][1] * g, v2 = acc[ai][1][m][0] * g, v3 = acc[ai][1][m][1] * g;
                u32x4 w; w.x = pk4_fp8(v0[0], v0[1], v0[2], v0[3]); w.y = pk4_fp8(v1[0], v1[1], v1[2], v1[3]); w.z = pk4_fp8(v2[0], v2[1], v2[2], v2[3]); w.w = pk4_fp8(v3[0], v3[1], v3[2], v3[3]);
                *(u32x4*)(Y + (size_t)pre.dst[ai][m] * DM + col0) = w; } }
    }
};
struct EpiShared {
    static constexpr int PERM = 2; typedef NoPre Pre; __device__ __forceinline__ void prefetch(Pre&, const Unit&, int, int) const {}
    unsigned char* Y9;
    __device__ __forceinline__ void operator()(const f32x4 (&acc)[2][2][4][2], const Unit& u, int wr, int wc, int fr, int fq, const Pre& pre) const {
        const int col0 = u.pn * BM + wc * 64 + 16 * fq; const float g = Y_SCALE / (H_SCALE * WD_SCALE);
#pragma unroll
        for (int ai = 0; ai < 2; ++ai)
#pragma unroll
            for (int m = 0; m < 4; ++m) { const int row = u.pm * BM + ai * HALF + wr * 64 + m * 16 + fr;
                const f32x4 v0 = acc[ai][0][m][0] * g, v1 = acc[ai][0][m][1] * g, v2 = acc[ai][1][m][0] * g, v3 = acc[ai][1][m][1] * g;
                u32x4 w; w.x = pk4_fp8(v0[0], v0[1], v0[2], v0[3]); w.y = pk4_fp8(v1[0], v1[1], v1[2], v1[3]); w.z = pk4_fp8(v2[0], v2[1], v2[2], v2[3]); w.w = pk4_fp8(v3[0], v3[1], v3[2], v3[3]);
                *(u32x4*)(Y9 + (size_t)row * DM + col0) = w; }
    }
};
struct EpiResStat {
    static constexpr int PERM = 0; typedef NoPre Pre; __device__ __forceinline__ void prefetch(Pre&, const Unit&, int, int) const {}
    float* __restrict__ C; const float* __restrict__ res; bf16_t* __restrict__ Xb; const float* __restrict__ g; float* ss; int ldc; float scale;
    __device__ __forceinline__ void operator()(const f32x4 (&acc)[2][2][4][2], const Unit& u, int wr, int wc, int fr, int fq, const Pre& pre) const {
        const int row0 = u.pm * BM + wr * 64 + fr, col0 = u.pn * BM + wc * 32 + 4 * fq;
        f32x4 gv[2][2];
#pragma unroll
        for (int bj = 0; bj < 2; ++bj)
#pragma unroll
            for (int n = 0; n < 2; ++n) gv[bj][n] = *(const f32x4*)(g + col0 + bj * HALF + n * 16);
#pragma unroll
        for (int ah = 0; ah < 4; ++ah) { const int ai = ah >> 1, mb = (ah & 1) * 2;
            f32x4 r[4][2][2];
#pragma unroll
            for (int m = mb; m < mb + 2; ++m) { const size_t o = (size_t)(row0 + ai * HALF + m * 16) * ldc + col0;
#pragma unroll
                for (int bj = 0; bj < 2; ++bj)
#pragma unroll
                    for (int n = 0; n < 2; ++n) r[m][bj][n] = __builtin_nontemporal_load((const f32x4*)(res + o + bj * HALF + n * 16)); }
#pragma unroll
            for (int m = mb; m < mb + 2; ++m) { const int row = row0 + ai * HALF + m * 16; const size_t o = (size_t)row * ldc + col0; float sq = 0.f;
#pragma unroll
                for (int bj = 0; bj < 2; ++bj)
#pragma unroll
                    for (int n = 0; n < 2; ++n) { const f32x4 v = acc[ai][bj][m][n] * scale + r[m][bj][n]; *(f32x4*)(C + o + bj * HALF + n * 16) = v;
                        sq += (v.x * v.x + v.y * v.y) + (v.z * v.z + v.w * v.w);
                        const f32x4 w = v * gv[bj][n]; u32x2 pk; pk.x = cvt_pk_bf16(w.x, w.y); pk.y = cvt_pk_bf16(w.z, w.w); *(u32x2*)(Xb + o + bj * HALF + n * 16) = pk; }
                sq += __shfl_xor(sq, 16); sq += __shfl_xor(sq, 32);
                if (fq == 0) ss[(size_t)row * 64 + u.pn * 4 + wc] = sq; }
        }
    }
};
struct EpiX2 {
    static constexpr int PERM = 1; typedef NoPre Pre; __device__ __forceinline__ void prefetch(Pre&, const Unit&, int, int) const {}
    float* __restrict__ C; const float* __restrict__ res; bf16_t* __restrict__ Th; bf16_t* __restrict__ Tl; unsigned char* __restrict__ T8; const float* __restrict__ g; float* ss; int ldc;
    __device__ __forceinline__ void operator()(const f32x4 (&acc)[2][2][4][2], const Unit& u, int wr, int wc, int fr, int fq, const Pre& pre) const {
        const int row0 = u.pm * BM + wr * 64 + fr, col0 = u.pn * BM + wc * 32 + 8 * fq;
        f32x4 gv[2][2];
#pragma unroll
        for (int bj = 0; bj < 2; ++bj)
#pragma unroll
            for (int n = 0; n < 2; ++n) gv[bj][n] = *(const f32x4*)(g + col0 + bj * HALF + n * 4);
#pragma unroll
        for (int ah = 0; ah < 4; ++ah) { const int ai = ah >> 1, mb = (ah & 1) * 2;
            f32x4 r[4][2][2];
#pragma unroll
            for (int m = mb; m < mb + 2; ++m) { const size_t o = (size_t)(row0 + ai * HALF + m * 16) * ldc + col0;
#pragma unroll
                for (int bj = 0; bj < 2; ++bj)
#pragma unroll
                    for (int n = 0; n < 2; ++n) r[m][bj][n] = __builtin_nontemporal_load((const f32x4*)(res + o + bj * HALF + n * 4)); }
#pragma unroll
            for (int m = mb; m < mb + 2; ++m) { const int row = row0 + ai * HALF + m * 16; const size_t o = (size_t)row * ldc + col0; float sq = 0.f;
#pragma unroll
                for (int bj = 0; bj < 2; ++bj) {
                    const f32x4 v0 = acc[ai][bj][m][0] + r[m][bj][0], v1 = acc[ai][bj][m][1] + r[m][bj][1];
                    *(f32x4*)(C + o + bj * HALF) = v0; *(f32x4*)(C + o + bj * HALF + 4) = v1;
                    sq += (v0.x * v0.x + v0.y * v0.y) + (v0.z * v0.z + v0.w * v0.w) + (v1.x * v1.x + v1.y * v1.y) + (v1.z * v1.z + v1.w * v1.w);
                    const f32x4 w0 = v0 * gv[bj][0], w1 = v1 * gv[bj][1];
                    u32x4 h; h.x = cvt_pk_bf16(w0.x, w0.y); h.y = cvt_pk_bf16(w0.z, w0.w); h.z = cvt_pk_bf16(w1.x, w1.y); h.w = cvt_pk_bf16(w1.z, w1.w);
                    u32x4 l; l.x = cvt_pk_bf16(w0.x - __uint_as_float(h.x << 16), w0.y - __uint_as_float(h.x & 0xffff0000u)); l.y = cvt_pk_bf16(w0.z - __uint_as_float(h.y << 16), w0.w - __uint_as_float(h.y & 0xffff0000u));
                    l.z = cvt_pk_bf16(w1.x - __uint_as_float(h.z << 16), w1.y - __uint_as_float(h.z & 0xffff0000u)); l.w = cvt_pk_bf16(w1.z - __uint_as_float(h.w << 16), w1.w - __uint_as_float(h.w & 0xffff0000u));
                    u32x2 q8; q8.x = pk4_fp8(w0.x * T_SCALE, w0.y * T_SCALE, w0.z * T_SCALE, w0.w * T_SCALE); q8.y = pk4_fp8(w1.x * T_SCALE, w1.y * T_SCALE, w1.z * T_SCALE, w1.w * T_SCALE);
                    *(u32x4*)(Th + o + bj * HALF) = h; *(u32x4*)(Tl + o + bj * HALF) = l; *(u32x2*)(T8 + o + bj * HALF) = q8; }
                sq += __shfl_xor(sq, 16); sq += __shfl_xor(sq, 32);
                if (fq == 0) ss[(size_t)row * 64 + u.pn * 4 + wc] = sq; }
        }
    }
};
}

namespace fa {
typedef short s16x4 __attribute__((ext_vector_type(4)));
typedef float f32x16 __attribute__((ext_vector_type(16)));
constexpr int SHM_V = 16384, SHM_K = 16384, SHM_K2 = 8192;
constexpr int OFF_V = 0, OFF_K = 2 * SHM_V, OFF_K2 = OFF_K + 2 * SHM_K, OFF_WS = OFF_K2 + 2 * SHM_K2, OFF_TBL = OFF_WS + 8 * 64 * 4, OFF_QPE = OFF_TBL + 1024, LDS_ATTN = OFF_QPE + 8 * 4096;
#define KSWZ(row, colB) ((row) * 256 + ((colB) ^ (((row) & 7) << 4)))
#define KSWZ2(row, colB) ((row) * 128 + ((colB) ^ (((row) & 7) << 4)))
#define SBAR() __builtin_amdgcn_sched_barrier(0)
__device__ __forceinline__ int crow(int r, int hi) { return (r & 3) + 8 * (r >> 2) + 4 * hi; }
__device__ __forceinline__ unsigned cvtpk(float lo, float hi) { unsigned r; asm volatile("v_cvt_pk_bf16_f32 %0, %1, %2" : "=v"(r) : "v"(lo), "v"(hi)); return r; }
constexpr float MIX_SCALE = 64.0f;
__device__ __forceinline__ unsigned fg_pk4_fp8(float a, float b, float c, float d) { int w = 0; w = __builtin_amdgcn_cvt_pk_fp8_f32(a, b, w, false); w = __builtin_amdgcn_cvt_pk_fp8_f32(c, d, w, true); return (unsigned)w; }
template <int MODE> struct Cf { static constexpr float SCALE = (MODE == 1) ? 0.07216878364870323f : 0.08838834764831845f; static constexpr float C = SCALE * 1.4426950408889634f; static constexpr float THRS = 8.0f / SCALE; };

template <int MODE>
__device__ __forceinline__ void partialSM(f32x16& p0, f32x16& p1, float& m_reg, float& mn, float& alpha) {
  constexpr float C = Cf<MODE>::C;
  float pmax = p0[0];
#pragma unroll
  for (int r = 1; r < 16; ++r) pmax = fmaxf(pmax, p0[r]);
#pragma unroll
  for (int r = 0; r < 16; ++r) pmax = fmaxf(pmax, p1[r]);
  { auto rr = __builtin_amdgcn_permlane32_swap(__float_as_uint(pmax), __float_as_uint(pmax), false, false);
    pmax = fmaxf(__uint_as_float(rr[0]), __uint_as_float(rr[1])); }
  if (__builtin_expect(__all(pmax - m_reg <= Cf<MODE>::THRS), 1)) { mn = m_reg; alpha = 1.f; }
  else { mn = fmaxf(m_reg, pmax); alpha = __builtin_amdgcn_exp2f((m_reg - mn) * C); m_reg = mn; }
  const float mnC = -mn * C;
#pragma unroll
  for (int r = 0; r < 16; ++r) p0[r] = fmaf(p0[r], C, mnC);
#pragma unroll
  for (int r = 0; r < 16; ++r) p1[r] = fmaf(p1[r], C, mnC);
#pragma unroll
  for (int r = 0; r < 16; ++r) p0[r] = __builtin_amdgcn_exp2f(p0[r]);
}
__device__ __forceinline__ void finishSM(f32x16& p0, f32x16& p1, float alpha, float& l_reg, bf16x8& pa0, bf16x8& pa1, bf16x8& pa2, bf16x8& pa3) {
#pragma unroll
  for (int r = 0; r < 16; ++r) p1[r] = __builtin_amdgcn_exp2f(p1[r]);
  float ps = 0;
#pragma unroll
  for (int r = 0; r < 16; ++r) ps += p0[r];
#pragma unroll
  for (int r = 0; r < 16; ++r) ps += p1[r];
  { auto rr = __builtin_amdgcn_permlane32_swap(__float_as_uint(ps), __float_as_uint(ps), false, false);
    ps = __uint_as_float(rr[0]) + __uint_as_float(rr[1]); }
  l_reg = l_reg * alpha + ps;
#define PK4(P, BASE, OUT) do { unsigned a0 = cvtpk(P[BASE + 0], P[BASE + 1]), a1 = cvtpk(P[BASE + 2], P[BASE + 3]);   \
    unsigned b0 = cvtpk(P[BASE + 4], P[BASE + 5]), b1 = cvtpk(P[BASE + 6], P[BASE + 7]);                              \
    auto r0 = __builtin_amdgcn_permlane32_swap(a0, b0, false, false); auto r1 = __builtin_amdgcn_permlane32_swap(a1, b1, false, false); \
    u32x4 w = {r0[0], r1[0], r0[1], r1[1]}; OUT = *reinterpret_cast<bf16x8*>(&w); } while (0)
  PK4(p0, 0, pa0); PK4(p0, 8, pa1); PK4(p1, 0, pa2); PK4(p1, 8, pa3);
#undef PK4
}
template <int MODE>
__device__ __forceinline__ void qkt(f32x16& p0, f32x16& p1, const LAS char* Ks, const LAS char* K2s, const bf16x8* qr, int r32, int hi, const LAS char* qpe) {
  p0 = f32x16{}; p1 = f32x16{};
#pragma unroll
  for (int d0 = 0; d0 < 8; ++d0) { const int cb = (d0 * 16 + hi * 8) * 2;
    const bf16x8 b0 = *reinterpret_cast<const LAS bf16x8*>(Ks + KSWZ(r32, cb));
    const bf16x8 b1 = *reinterpret_cast<const LAS bf16x8*>(Ks + KSWZ(32 + r32, cb));
    p0 = __builtin_amdgcn_mfma_f32_32x32x16_bf16(b0, qr[d0], p0, 0, 0, 0);
    p1 = __builtin_amdgcn_mfma_f32_32x32x16_bf16(b1, qr[d0], p1, 0, 0, 0); }
  if (MODE == 1) {
#pragma unroll
    for (int d0 = 0; d0 < 4; ++d0) { const int cb = (d0 * 16 + hi * 8) * 2;
      const bf16x8 b0 = *reinterpret_cast<const LAS bf16x8*>(K2s + KSWZ2(r32, cb));
      const bf16x8 b1 = *reinterpret_cast<const LAS bf16x8*>(K2s + KSWZ2(32 + r32, cb));
      const bf16x8 qp = *reinterpret_cast<const LAS bf16x8*>(qpe + d0 * 1024);
      p0 = __builtin_amdgcn_mfma_f32_32x32x16_bf16(b0, qp, p0, 0, 0, 0);
      p1 = __builtin_amdgcn_mfma_f32_32x32x16_bf16(b1, qp, p1, 0, 0, 0); }
  }
}
__device__ __forceinline__ int v_st(int k, int c) { const int kk = (k & ~0xC) | ((k & 4) << 1) | ((k & 8) >> 1); return ((kk >> 3) * 4 + (c >> 5)) * 512 + ((kk & 7) * 32 + (c & 31)) * 2; }
__device__ __forceinline__ int v_rd_base(int lane) { return ((lane & 3) << 3) | (((lane >> 2) & 3) << 6) | (((lane >> 4) & 1) << 5) | (((lane >> 5) & 1) << 8); }
constexpr int v_rd_off(int d0, int ks, int half) { return d0 * 512 + ks * 4096 + half * 2048; }
template <int OFF> __device__ __forceinline__ s16x4 tr_read(int vb) { s16x4 r; asm volatile("ds_read_b64_tr_b16 %0, %1 offset:%2" : "=&v"(r) : "v"(vb), "i"(OFF) : "memory"); return r; }
template <int D0> __device__ __forceinline__ void pv_one(f32x16& od, int vb, bf16x8 pa0, bf16x8 pa1, bf16x8 pa2, bf16x8 pa3) {
  const s16x4 l0 = tr_read<v_rd_off(D0, 0, 0)>(vb), h0 = tr_read<v_rd_off(D0, 0, 1)>(vb), l1 = tr_read<v_rd_off(D0, 1, 0)>(vb), h1 = tr_read<v_rd_off(D0, 1, 1)>(vb);
  const s16x4 l2 = tr_read<v_rd_off(D0, 2, 0)>(vb), h2 = tr_read<v_rd_off(D0, 2, 1)>(vb), l3 = tr_read<v_rd_off(D0, 3, 0)>(vb), h3 = tr_read<v_rd_off(D0, 3, 1)>(vb);
  asm volatile("s_waitcnt lgkmcnt(0)" ::: "memory"); SBAR();
#define PK(L, H) (bf16x8){L[0], L[1], L[2], L[3], H[0], H[1], H[2], H[3]}
  od = __builtin_amdgcn_mfma_f32_32x32x16_bf16(pa0, PK(l0, h0), od, 0, 0, 0);
  od = __builtin_amdgcn_mfma_f32_32x32x16_bf16(pa1, PK(l1, h1), od, 0, 0, 0);
  od = __builtin_amdgcn_mfma_f32_32x32x16_bf16(pa2, PK(l2, h2), od, 0, 0, 0);
  od = __builtin_amdgcn_mfma_f32_32x32x16_bf16(pa3, PK(l3, h3), od, 0, 0, 0);
#undef PK
}
__device__ __forceinline__ void pv_d0(f32x16* o, int vb, bf16x8 pa0, bf16x8 pa1, bf16x8 pa2, bf16x8 pa3) {
  pv_one<0>(o[0], vb, pa0, pa1, pa2, pa3); pv_one<1>(o[1], vb, pa0, pa1, pa2, pa3); pv_one<2>(o[2], vb, pa0, pa1, pa2, pa3); pv_one<3>(o[3], vb, pa0, pa1, pa2, pa3);
}
struct Args { const bf16_t* Q; const bf16_t* K1; const bf16_t* K2; const bf16_t* V; bf16_t* O; int kt0, NT, qch0; };
template <int MODE> struct St {
    static constexpr int LDQ = (MODE == 0) ? INW : (MODE == 1 ? 3072 : 512), LDK1 = (MODE == 0) ? INW : (MODE == 1 ? 4096 : 1024), LDK2 = INW, LDV = LDK1, LDO = (MODE == 2) ? 512 : DM; };
template <int MODE>
__device__ __forceinline__ void mask_bias(f32x16& p0, f32x16& p1, int qch, int kch, int qpos, int hi, const LAS float* tbl) {
  const bool valid = (MODE == 2) || ((kch <= qch) && (MODE == 1 || kch >= qch - 8));
  if (!valid) {
#pragma unroll
    for (int r = 0; r < 16; ++r) { p0[r] = -INFINITY; p1[r] = -INFINITY; }
  } else if (MODE == 0) {
    if (qch - kch >= 3) { const float b = tbl[191];
#pragma unroll
      for (int r = 0; r < 16; ++r) { p0[r] += b; p1[r] += b; }
    } else { const int base = qpos - kch * 64 + 63 - 4 * hi;
#pragma unroll
      for (int g = 0; g < 4; ++g) {
#pragma unroll
        for (int r = 4 * g; r < 4 * g + 4; ++r) { int d0 = base - ((r & 3) + 8 * (r >> 2)), d1 = d0 - 32;
          d0 = d0 < 0 ? 0 : (d0 > 191 ? 191 : d0); d1 = d1 < 0 ? 0 : (d1 > 191 ? 191 : d1);
          p0[r] += tbl[d0]; p1[r] += tbl[d1]; }
        SBAR();
      }
    }
  }
}
template <int MODE>
__device__ __forceinline__ void attn_body(const Args& a, LAS char* lds) {
  constexpr int NQ = 8;
  int tid = threadIdx.x; asm volatile("" : "+v"(tid));
  const int wid = tid >> 6, lane = tid & 63, r32 = lane & 31, hi = lane >> 5;
  LAS char* V_lds = lds + OFF_V; LAS char* K_lds = lds + OFF_K; LAS char* K2_lds = lds + OFF_K2;
  LAS float* ws = (LAS float*)(lds + OFF_WS) + wid * 64; LAS float* li_l = ws; LAS float* al_l = ws + 32;
  const LAS float* tbl = (const LAS float*)(lds + OFF_TBL);
  float m_reg = -1e30f, l_reg = 0; f32x16 o[4] = {}; bf16x8 qr[NQ];
  const bf16_t* Qw = a.Q + (wid * 32 + r32) * St<MODE>::LDQ + hi * 8;
#pragma unroll
  for (int d0 = 0; d0 < NQ; ++d0) qr[d0] = *reinterpret_cast<const bf16x8*>(Qw + d0 * 16);
  const LAS char* qpe = lds + OFF_QPE + wid * 4096 + lane * 16;
  if (MODE == 1) {
#pragma unroll
    for (int d0 = 0; d0 < 4; ++d0) *(LAS bf16x8*)(lds + OFF_QPE + wid * 4096 + lane * 16 + d0 * 1024) = *reinterpret_cast<const bf16x8*>(Qw + 128 + d0 * 16);
  }
  const int sr = tid >> 4, sc = (tid & 15) * 8, vst0 = v_st(sr, sc), vst1 = v_st(32 + sr, sc);
  const int s2r = tid >> 3, s2c = (tid & 7) * 8;
  const int vb0 = (int)(uintptr_t)V_lds + v_rd_base(lane);
  const int qch = a.qch0 + (wid >> 1), qpos = a.qch0 * 64 + wid * 32 + r32;
  bf16x8 vs0, vs1, ks0, ks1, k2s;
  const unsigned ovk = (unsigned)(sr * St<MODE>::LDK1 + sc) * 2u, ok2 = (unsigned)(s2r * St<MODE>::LDK2 + s2c) * 2u;
#define SLOAD(j) do { const size_t k0_ = (size_t)(a.kt0 + (j)) * 64; \
    const char* vt_ = (const char*)(a.V + k0_ * St<MODE>::LDV); const char* kt_ = (const char*)(a.K1 + k0_ * St<MODE>::LDK1); \
    vs0 = *reinterpret_cast<const bf16x8*>(vt_ + ovk); vs1 = *reinterpret_cast<const bf16x8*>(vt_ + 64 * St<MODE>::LDV + ovk); \
    ks0 = *reinterpret_cast<const bf16x8*>(kt_ + ovk); ks1 = *reinterpret_cast<const bf16x8*>(kt_ + 64 * St<MODE>::LDK1 + ovk); \
    if (MODE == 1) k2s = *reinterpret_cast<const bf16x8*>((const char*)(a.K2 + k0_ * St<MODE>::LDK2) + ok2); } while (0)
#define SWRITE(b) do { *(LAS bf16x8*)(V_lds + (b) * SHM_V + vst0) = vs0; *(LAS bf16x8*)(V_lds + (b) * SHM_V + vst1) = vs1; const int kc = sc * 2; \
    *(LAS bf16x8*)(K_lds + (b) * SHM_K + KSWZ(sr, kc)) = ks0; *(LAS bf16x8*)(K_lds + (b) * SHM_K + KSWZ(32 + sr, kc)) = ks1; \
    if (MODE == 1) *(LAS bf16x8*)(K2_lds + (b) * SHM_K2 + KSWZ2(s2r, s2c * 2)) = k2s; } while (0)
#define SWAIT() asm volatile("s_waitcnt vmcnt(0)" ::: "memory")
#define RESC(al) do { if (__any((al) < 1.f)) { if (hi == 0) al_l[r32] = (al); asm volatile("s_waitcnt lgkmcnt(0)" ::: "memory"); \
    _Pragma("unroll") for (int d = 0; d < 4; ++d) _Pragma("unroll") for (int r = 0; r < 16; ++r) o[d][r] *= al_l[crow(r, hi)]; } } while (0)
  f32x16 pA0, pA1, pB0, pB1; float mnA, mnB, alA, alB; bf16x8 pa0, pa1, pa2, pa3; const int NT = a.NT;
  SLOAD(0); SWAIT(); SWRITE(0); __syncthreads();
  qkt<MODE>(pA0, pA1, K_lds, K2_lds, qr, r32, hi, qpe); mask_bias<MODE>(pA0, pA1, qch, a.kt0, qpos, hi, tbl); partialSM<MODE>(pA0, pA1, m_reg, mnA, alA);
  SLOAD(1);
  SWAIT(); SWRITE(1); __syncthreads();
  for (int j = 1; j + 1 < NT; j += 2) {
    SBAR(); qkt<MODE>(pB0, pB1, K_lds + SHM_K, K2_lds + SHM_K2, qr, r32, hi, qpe); mask_bias<MODE>(pB0, pB1, qch, a.kt0 + j, qpos, hi, tbl);
    finishSM(pA0, pA1, alA, l_reg, pa0, pa1, pa2, pa3); SBAR();
    SLOAD(j + 1); SBAR();
    pv_d0(o, vb0, pa0, pa1, pa2, pa3); partialSM<MODE>(pB0, pB1, m_reg, mnB, alB);
    __syncthreads(); SWAIT(); SWRITE(0);
    RESC(alB); __syncthreads();
    SBAR(); qkt<MODE>(pA0, pA1, K_lds, K2_lds, qr, r32, hi, qpe); mask_bias<MODE>(pA0, pA1, qch, a.kt0 + j + 1, qpos, hi, tbl);
    finishSM(pB0, pB1, alB, l_reg, pa0, pa1, pa2, pa3); SBAR();
    SLOAD(j + 2); SBAR();
    pv_d0(o, vb0 + SHM_V, pa0, pa1, pa2, pa3); partialSM<MODE>(pA0, pA1, m_reg, mnA, alA);
    __syncthreads(); SWAIT(); SWRITE(1);
    RESC(alA); __syncthreads();
  }
  SBAR(); qkt<MODE>(pB0, pB1, K_lds + SHM_K, K2_lds + SHM_K2, qr, r32, hi, qpe); mask_bias<MODE>(pB0, pB1, qch, a.kt0 + NT - 1, qpos, hi, tbl);
  finishSM(pA0, pA1, alA, l_reg, pa0, pa1, pa2, pa3); SBAR();
  pv_d0(o, vb0, pa0, pa1, pa2, pa3); partialSM<MODE>(pB0, pB1, m_reg, mnB, alB);
  __syncthreads(); RESC(alB);
  finishSM(pB0, pB1, alB, l_reg, pa0, pa1, pa2, pa3); SBAR();
  pv_d0(o, vb0 + SHM_V, pa0, pa1, pa2, pa3);
  if (hi == 0) li_l[r32] = l_reg; asm volatile("s_waitcnt lgkmcnt(0)" ::: "memory");
  if (MODE != 2) {
    unsigned char* Ow8 = (unsigned char*)a.O + (size_t)(wid * 32) * DM;
    const int qi = lane & 3;
#pragma unroll
    for (int rg = 0; rg < 4; ++rg) {
      float rl[4];
#pragma unroll
      for (int j = 0; j < 4; ++j) rl[j] = __builtin_amdgcn_rcpf(li_l[crow(4 * rg + j, hi)]) * MIX_SCALE;
#pragma unroll
      for (int d0 = 0; d0 < 4; ++d0) { float v[4];
#pragma unroll
        for (int j = 0; j < 4; ++j) v[j] = o[d0][4 * rg + j] * rl[j];
        { const float s0 = (qi & 1) ? v[0] : v[1], s1 = (qi & 1) ? v[2] : v[3]; const float t0 = __shfl_xor(s0, 1), t1 = __shfl_xor(s1, 1);
          if (qi & 1) { v[0] = t0; v[2] = t1; } else { v[1] = t0; v[3] = t1; } }
        { const float s0 = (qi & 2) ? v[0] : v[2], s1 = (qi & 2) ? v[1] : v[3]; const float t0 = __shfl_xor(s0, 2), t1 = __shfl_xor(s1, 2);
          if (qi & 2) { v[0] = t0; v[1] = t1; } else { v[2] = t0; v[3] = t1; } }
        const int orow = 8 * rg + 4 * hi + qi;
        *(unsigned*)(Ow8 + (size_t)orow * DM + d0 * 32 + (r32 & ~3)) = fg_pk4_fp8(v[0], v[1], v[2], v[3]); } }
  } else {
  bf16_t* Ow = a.O + (wid * 32) * St<MODE>::LDO;
  const int odd = lane & 1;
#pragma unroll
  for (int r = 0; r < 16; r += 2) { const float ra = __builtin_amdgcn_rcpf(li_l[crow(r, hi)]), rb = __builtin_amdgcn_rcpf(li_l[crow(r + 1, hi)]);
#pragma unroll
    for (int d0 = 0; d0 < 4; ++d0) { const float vA = o[d0][r] * ra, vB = o[d0][r + 1] * rb;
      const float pA = __shfl_xor(vA, 1), pB = __shfl_xor(vB, 1);
      const unsigned w = odd ? cvtpk(pB, vB) : cvtpk(vA, pA);
      const int orow = odd ? crow(r + 1, hi) : crow(r, hi);
      *(unsigned*)(Ow + orow * St<MODE>::LDO + d0 * 32 + (r32 & ~1)) = w; } }
  }
  __syncthreads();
#undef SLOAD
#undef SWRITE
#undef SWAIT
#undef RESC
}
#undef KSWZ
#undef KSWZ2
#undef SBAR
template <int MODE> __device__ __forceinline__ void attn_call(const bf16_t* Q, const bf16_t* K1, const bf16_t* K2, const bf16_t* V, bf16_t* O, int kt0, int NT, int qch0, LAS char* lds) {
  Args a{Q, K1, K2, V, O, kt0, NT, qch0}; attn_body<MODE>(a, lds);
}
}

#ifndef TVAR
#define TVAR 0
#endif
template <int VAR = 0>
__device__ __forceinline__ void transpose_item(const float* W, int K, int N, bf16_t* WT, int k0, int n0, int drow0, LAS float* scr, int lane) {
    float v[64];
    const float* src = W + (size_t)k0 * N + n0 + lane;
#pragma unroll
    for (int i = 0; i < 64; ++i) v[i] = __builtin_nontemporal_load(src + (size_t)i * N);
    if (VAR == 1) {
#pragma unroll
        for (int i = 0; i < 64; ++i) asm volatile("" :: "v"(v[i]));
        return; }
#pragma unroll
    for (int i = 0; i < 64; ++i) scr[i * 65 + lane] = v[i];
    asm volatile("s_waitcnt lgkmcnt(0)" ::: "memory");
    if (VAR == 2) { drow0 = 0; k0 = 0; }
    const int c = lane & 7;
#pragma unroll
    for (int j = 0; j < 8; ++j) { const int n = (lane >> 3) + 8 * j; const LAS float* sp = scr + (8 * c) * 65 + n;
        u32x4 o; o.x = fg::cvt_pk_bf16(sp[0 * 65], sp[1 * 65]); o.y = fg::cvt_pk_bf16(sp[2 * 65], sp[3 * 65]); o.z = fg::cvt_pk_bf16(sp[4 * 65], sp[5 * 65]); o.w = fg::cvt_pk_bf16(sp[6 * 65], sp[7 * 65]);
        *(u32x4*)(WT + ((size_t)(drow0 >> 6) * (K >> 6) + (k0 >> 6)) * 4096 + n * 64 + 8 * c) = o; }
    asm volatile("s_waitcnt lgkmcnt(0)" ::: "memory");
}
__device__ __forceinline__ fg::MoeTabs moe_tables_fast(LAS int* tab, const unsigned* gcnt) {
    fg::MoeTabs T; T.cnt = tab; T.mtp = tab + 80;
    __syncthreads();
    if (threadIdx.x == 0) { int pm = 0;
        for (int e = 0; e <= NE; ++e) { const int c = (e < NE) ? (int)gcnt[64 * e] : NTOK; tab[e] = c; tab[80 + e] = pm; pm += (c + 255) / 256; }
        tab[80 + NE + 1] = pm; }
    __syncthreads();
    return T;
}
__device__ __forceinline__ void transpose_item_fp8(const float* W, int K, int N, unsigned char* WT, int k0, int n0, int drow0, float scale, LAS float* scr, int lane) {
    float v[64];
    const float* src = W + (size_t)k0 * N + n0 + lane;
#pragma unroll
    for (int i = 0; i < 64; ++i) v[i] = __builtin_nontemporal_load(src + (size_t)i * N);
#pragma unroll
    for (int i = 0; i < 64; ++i) scr[i * 65 + lane] = v[i] * scale;
    asm volatile("s_waitcnt lgkmcnt(0)" ::: "memory");
    const int c = lane & 3;
    unsigned char* tile = WT + ((size_t)(drow0 >> 6) * (K >> 7) + (k0 >> 7)) * 8192 + (k0 & 64);
#pragma unroll
    for (int j = 0; j < 4; ++j) { const int n = (lane >> 2) + 16 * j; const LAS float* sp = scr + (16 * c) * 65 + n;
        u32x4 o; o.x = fg::pk4_fp8(sp[0 * 65], sp[1 * 65], sp[2 * 65], sp[3 * 65]); o.y = fg::pk4_fp8(sp[4 * 65], sp[5 * 65], sp[6 * 65], sp[7 * 65]);
        o.z = fg::pk4_fp8(sp[8 * 65], sp[9 * 65], sp[10 * 65], sp[11 * 65]); o.w = fg::pk4_fp8(sp[12 * 65], sp[13 * 65], sp[14 * 65], sp[15 * 65]);
        *(u32x4*)(tile + n * 128 + 16 * c) = o; }
    asm volatile("s_waitcnt lgkmcnt(0)" ::: "memory");
}
__device__ __forceinline__ void transpose_item_hilo(const float* W, int K, bf16_t* WH, bf16_t* WL, int k0, LAS float* scr, int lane) {
    float v[64];
    const float* src = W + (size_t)k0 * 64 + lane;
#pragma unroll
    for (int i = 0; i < 64; ++i) v[i] = src[(size_t)i * 64];
#pragma unroll
    for (int i = 0; i < 64; ++i) scr[i * 65 + lane] = v[i];
    asm volatile("s_waitcnt lgkmcnt(0)" ::: "memory");
    const int c = lane & 7;
#pragma unroll
    for (int j = 0; j < 8; ++j) { const int n = (lane >> 3) + 8 * j; const LAS float* sp = scr + (8 * c) * 65 + n;
        float f[8], l[8];
#pragma unroll
        for (int q = 0; q < 8; ++q) f[q] = sp[q * 65];
        u32x4 o; o.x = fg::cvt_pk_bf16(f[0], f[1]); o.y = fg::cvt_pk_bf16(f[2], f[3]); o.z = fg::cvt_pk_bf16(f[4], f[5]); o.w = fg::cvt_pk_bf16(f[6], f[7]);
        l[0] = f[0] - __uint_as_float(o.x << 16); l[1] = f[1] - __uint_as_float(o.x & 0xffff0000u); l[2] = f[2] - __uint_as_float(o.y << 16); l[3] = f[3] - __uint_as_float(o.y & 0xffff0000u);
        l[4] = f[4] - __uint_as_float(o.z << 16); l[5] = f[5] - __uint_as_float(o.z & 0xffff0000u); l[6] = f[6] - __uint_as_float(o.w << 16); l[7] = f[7] - __uint_as_float(o.w & 0xffff0000u);
        u32x4 ol; ol.x = fg::cvt_pk_bf16(l[0], l[1]); ol.y = fg::cvt_pk_bf16(l[2], l[3]); ol.z = fg::cvt_pk_bf16(l[4], l[5]); ol.w = fg::cvt_pk_bf16(l[6], l[7]);
        const size_t off = (size_t)(k0 >> 6) * 4096 + n * 64 + 8 * c;
        *(u32x4*)(WH + off) = o; *(u32x4*)(WL + off) = ol; }
    asm volatile("s_waitcnt lgkmcnt(0)" ::: "memory");
}
constexpr int N_EXPERT_ITEMS = 65 * 1536;
__device__ __forceinline__ void expert_item(const Params& p, unsigned char* ws, int r0, LAS float* scr, int lane) {
    bf16_t* wguT = (bf16_t*)(ws + WS_WGU); bf16_t* wdT = (bf16_t*)(ws + WS_WD);
    const int e = r0 / 1536, r = r0 % 1536, mat = r >> 9, item = r & 511;
    if (mat < 2) { const float* W = (e < NE) ? p.in[mat ? I_WEXU : I_WEXG] + (size_t)e * DM * EFF : p.in[mat ? I_WSHU : I_WSHG];
        const int kb = (item & 7) + 8 * (item >> 6), nb = (item >> 3) & 7, n0 = nb * 64;
        transpose_item_fp8(W, DM, EFF, (unsigned char*)wguT + (size_t)e * 1024 * DM, kb * 64, n0, (n0 >> 7) * 256 + mat * 128 + (n0 & 127), fg::WGU_SCALE, scr, lane);
    } else { const float* W = (e < NE) ? p.in[I_WEXD] + (size_t)e * EFF * DM : p.in[I_WSHD];
        const int kb = item & 7, nb = item >> 3;
        transpose_item_fp8(W, EFF, DM, (unsigned char*)wdT + (size_t)e * DM * EFF, kb * 64, nb * 64, nb * 64, fg::WD_SCALE, scr, lane); }
}
__device__ __forceinline__ void expert_conv_loop(const Params& p, unsigned char* ws, unsigned* qhead, LAS float* scr, int lane) {
    for (;;) {
        unsigned start = 0; if (lane == 0) start = xb_add(qhead, 8u);
        start = (unsigned)__builtin_amdgcn_readfirstlane((int)start);
        if (start >= (unsigned)N_EXPERT_ITEMS) break;
        for (int q = 0; q < 8; ++q) expert_item(p, ws, (int)start + q, scr, lane);
    }
}
template <int VAR>
__device__ __forceinline__ void p0_items(const Params& p, unsigned char* ws, LAS float* scr, int lane, int gw, int NGW) {
    bf16_t* winT = (bf16_t*)(ws + WS_WIN); bf16_t* wuqT = (bf16_t*)(ws + WS_WUQ); bf16_t* wukvT = (bf16_t*)(ws + WS_WUKV); bf16_t* woT = (bf16_t*)(ws + WS_WO);
    bf16_t* wxqT = (bf16_t*)(ws + WS_WXQ); bf16_t* wxkvT = (bf16_t*)(ws + WS_WXKV); bf16_t* wxoT = (bf16_t*)(ws + WS_WXO); bf16_t* wguT = (bf16_t*)(ws + WS_WGU); bf16_t* wdT = (bf16_t*)(ws + WS_WD);
            constexpr int I0 = (DM / 64) * (INW / 64), I1 = I0 + (DM / 64) * (DM / 64), I2 = I1 + (QLORA / 64) * (3072 / 64), I3 = I2 + (KVLORA / 64) * (4096 / 64),
                          I4 = I3 + (DM / 64) * (512 / 64), I5 = I4 + (DM / 64) * (1024 / 64), I6 = I5 + (512 / 64) * (DM / 64);
            constexpr int IR = I6, ITOT = IR + DM / 64;
            for (int it = gw; it < ITOT; it += NGW) {
                if (it < I0) { const int nb = it % (INW / 64), kb = it / (INW / 64); transpose_item_fp8(p.in[I_WIN], DM, INW, (unsigned char*)winT, kb * 64, nb * 64, nb * 64, 64.0f, scr, lane); }
                else if (it < I1) { const int r = it - I0, nb = r % 64, kb = r / 64; transpose_item_fp8(p.in[I_WO], DM, DM, (unsigned char*)woT, kb * 64, nb * 64, nb * 64, 64.0f, scr, lane); }
                else if (it < I2) { const int r = it - I1, nb = r % 48, kb = r / 48; transpose_item<VAR>(p.in[I_WUQ], QLORA, 3072, wuqT, kb * 64, nb * 64, nb * 64, scr, lane); }
                else if (it < I3) { const int r = it - I2, nb = r % 64, kb = r / 64; transpose_item<VAR>(p.in[I_WUKV], KVLORA, 4096, wukvT, kb * 64, nb * 64, nb * 64, scr, lane); }
                else if (it < I4) { const int r = it - I3, nb = r % 8, kb = r / 8; transpose_item<VAR>(p.in[I_WXQ], DM, 512, wxqT, kb * 64, nb * 64, nb * 64, scr, lane); }
                else if (it < I5) { const int r = it - I4, nb = r % 16, kb = r / 16; transpose_item<VAR>(p.in[I_WXKV], DM, 1024, wxkvT, kb * 64, nb * 64, nb * 64, scr, lane); }
                else if (it < I6) { const int r = it - I5, nb = r % 64, kb = r / 64; transpose_item<VAR>(p.in[I_WXO], 512, DM, wxoT, kb * 64, nb * 64, nb * 64, scr, lane); }
                else if (it >= IR) { transpose_item_hilo(p.in[I_WROUTER], DM, (bf16_t*)(ws + WS_WR), (bf16_t*)(ws + WS_WR + 2 * MiB), (it - IR) * 64, scr, lane); }
            }
}
__device__ __forceinline__ void unpack8(const u32x4 w, float (&f)[8]) {
    f[0] = __uint_as_float(w.x << 16); f[1] = __uint_as_float(w.x & 0xffff0000u); f[2] = __uint_as_float(w.y << 16); f[3] = __uint_as_float(w.y & 0xffff0000u);
    f[4] = __uint_as_float(w.z << 16); f[5] = __uint_as_float(w.z & 0xffff0000u); f[6] = __uint_as_float(w.w << 16); f[7] = __uint_as_float(w.w & 0xffff0000u); }
__device__ __forceinline__ u32x4 pack8(const float (&f)[8]) { u32x4 w; w.x = fg::cvt_pk_bf16(f[0], f[1]); w.y = fg::cvt_pk_bf16(f[2], f[3]); w.z = fg::cvt_pk_bf16(f[4], f[5]); w.w = fg::cvt_pk_bf16(f[6], f[7]); return w; }
__device__ __forceinline__ float sumsq8(const float (&f)[8]) { return (f[0] * f[0] + f[1] * f[1]) + (f[2] * f[2] + f[3] * f[3]) + (f[4] * f[4] + f[5] * f[5]) + (f[6] * f[6] + f[7] * f[7]); }
template <int W> __device__ __forceinline__ float group_sum(float v) {
#pragma unroll
    for (int o = 1; o < W; o <<= 1) v += __shfl_xor(v, o);
    return v;
}
__device__ __forceinline__ void load8f(const float* g, float (&f)[8]) { const f32x4 a = *(const f32x4*)g, b = *(const f32x4*)(g + 4); f[0] = a.x; f[1] = a.y; f[2] = a.z; f[3] = a.w; f[4] = b.x; f[5] = b.y; f[6] = b.z; f[7] = b.w; }
__device__ __forceinline__ void scale8(float (&f)[8], float r, const float (&g)[8]) {
#pragma unroll
    for (int i = 0; i < 8; ++i) f[i] = f[i] * r * g[i]; }
        struct RouterSched { const char* th; const char* tl; const char* wh; const char* wl; int G, c;
            __device__ __forceinline__ bool next(int i, fg::Unit& u) const {
                const int total = (NTOK / 256) * 12, per = (total + 7) / 8; const int j = i * G + c, x = j & 7, q = j >> 3;
                if (q >= per) return false; const int L = x * per + q; if (L >= total) return false;
                const int pm = L / 12, slab = L % 12, term = slab >> 2, kq = slab & 3;
                u.A = (term == 1 ? tl : th) + ((size_t)pm * 256 * DM + (size_t)kq * 1024) * 2; u.B = (term == 2 ? wl : wh) + (size_t)kq * 16 * 8192;
                u.rows = nullptr; u.nkt = 16; u.nvalid = 256; u.pm = pm; u.pn = 0; u.e = slab; u.arow0 = pm * 256; return true; } };
        struct EpiLogits { static constexpr int PERM = 0; typedef fg::NoPre Pre; __device__ __forceinline__ void prefetch(Pre&, const fg::Unit&, int, int) const {} float* C;
            __device__ __forceinline__ void operator()(const f32x4 (&acc)[2][2][4][2], const fg::Unit& u, int wr, int wc, int fr, int fq, const Pre& pre) const {
                if (wc < 2) { float* Cb = C + (size_t)u.e * NTOK * 64;
#pragma unroll
                    for (int ai = 0; ai < 2; ++ai)
#pragma unroll
                        for (int m = 0; m < 4; ++m)
#pragma unroll
                            for (int n = 0; n < 2; ++n) *(f32x4*)(Cb + (size_t)(u.pm * 256 + ai * 128 + wr * 64 + m * 16 + fr) * 64 + wc * 32 + n * 16 + 4 * fq) = acc[ai][0][m][n]; } } };
constexpr int NPHASE = 18;
template <unsigned PMASK>
__global__ void __launch_bounds__(512, 2) fwd(Params p) {
    extern __shared__ __attribute__((aligned(16))) unsigned char lds_raw[];
    float* ldsf = (float*)lds_raw;
    const int tid = threadIdx.x, lane = tid & 63, wave = tid >> 6;
    const int G = gridDim.x; int bid = blockIdx.x;
    const int gw = bid * 8 + wave, NGW = G * 8;
    unsigned char* ws = p.ws;
    unsigned* ctl = (unsigned*)(ws + WS_CTL);
    volatile LAS unsigned* misc = (volatile LAS unsigned*)((LAS unsigned char*)lds_raw + LDS_MISC);
    if (tid < 16) misc[tid] = 0u;
    __syncthreads();
    XcdBarrier bar = xcd_barrier_post(ctl + CW_BAR, misc);
    const int lo = p.ph_lo, hi = p.ph_hi;
    if (tid == 0) { const unsigned x = xb_xcc_id() & 15u; misc[4] = x; misc[5] = xb_add(ctl + CW_TICKET + 64 * x, 1u); }
#define IN(k) (((PMASK >> (k)) & 1u) && lo <= (k) && (k) < hi)
#ifndef DUP_PHASE
#define DUP_PHASE -1
#endif
#define REP(k) for (int rep_ = 0; rep_ < ((DUP_PHASE == (k)) ? 2 : 1); ++rep_)
#define SEAM(k) do { if (IN(k) && IN((k) + 1)) xcd_barrier(bar); } while (0)

    const float* x = p.in[I_X];
    act_t* hbuf = (act_t*)(ws + WS_H); act_t* memn = (act_t*)(ws + WS_MEMN); act_t* p1 = (act_t*)(ws + WS_P1); act_t* kvm = (act_t*)(ws + WS_KVM);
    act_t* qb = (act_t*)(ws + WS_QB); act_t* kvb = (act_t*)(ws + WS_KVB); act_t* mixed = (act_t*)(ws + WS_MIXED); float* x1 = (float*)(ws + WS_X1);
    act_t* hc = (act_t*)(ws + WS_HC); act_t* qx = (act_t*)(ws + WS_QX); act_t* ox = (act_t*)(ws + WS_OX); float* x2 = (float*)(ws + WS_X2);
    act_t* tb = (act_t*)(ws + WS_T); act_t* hh = (act_t*)(ws + WS_HH);
    LAS unsigned char* lds = (LAS unsigned char*)lds_raw;
    bf16_t* winT = (bf16_t*)(ws + WS_WIN); bf16_t* wuqT = (bf16_t*)(ws + WS_WUQ); bf16_t* wukvT = (bf16_t*)(ws + WS_WUKV); bf16_t* woT = (bf16_t*)(ws + WS_WO);
    bf16_t* wxqT = (bf16_t*)(ws + WS_WXQ); bf16_t* wxkvT = (bf16_t*)(ws + WS_WXKV); bf16_t* wxoT = (bf16_t*)(ws + WS_WXO); bf16_t* wguT = (bf16_t*)(ws + WS_WGU); bf16_t* wdT = (bf16_t*)(ws + WS_WD);
    float* qxp = (float*)(ws + WS_QXP); bf16_t* ybuf = (bf16_t*)(ws + WS_Y);
    int* rowtok = (int*)(ws + WS_ROWTOK); float* rowgate = (float*)(ws + WS_ROWGATE); int* rowdst = (int*)(ws + WS_ROWDST);
    unsigned* gcnt = ctl + CW_CNT;
    const int* positions = (const int*)p.in[I_POS];

    if (IN(0)) REP(0) {
        for (int m = gw; m < NTOK; m += NGW) {
            const float* xr = x + (size_t)m * DM; f32x4 v[16]; float ssq = 0.f;
#pragma unroll
            for (int j = 0; j < 16; ++j) { v[j] = __builtin_nontemporal_load((const f32x4*)xr + lane + 64 * j); ssq += v[j].x * v[j].x + v[j].y * v[j].y + v[j].z * v[j].z + v[j].w * v[j].w; }
            ssq = wave_sum(ssq); const float r = 2.0f / sqrtf(ssq * (1.0f / 4096.f) + EPS);
#pragma unroll
            for (int j = 0; j < 16; ++j) v[j] = v[j] * r * __builtin_nontemporal_load((const f32x4*)p.in[I_GMIX] + lane + 64 * j);
            asm volatile("s_waitcnt vmcnt(0)" ::: "memory");
#pragma unroll
            for (int j = 0; j < 16; ++j) *(unsigned*)((unsigned char*)hbuf + (size_t)m * DM + (lane + 64 * j) * 4) = fg::pk4_fp8(v[j].x, v[j].y, v[j].z, v[j].w);
        }
        for (int m = gw; m < NMEM; m += NGW) rms_row_4096<act_t>(p.in[I_MEM] + (size_t)m * DM, p.in[I_GMEM], memn + (size_t)m * DM, lane, nullptr);
#if FAST_GEMM
        {
            LAS float* scr = (LAS float*)(lds + wave * 16640);
            p0_items<0>(p, ws, scr, lane, gw, NGW);
        }
#endif
    }
    SEAM(0);
    if (IN(0) && IN(1) && G == 256) {
        if (tid == 0) { bool even = true;
            for (int j2 = 0; j2 < 8; ++j2) even = even && (xb_ld(ctl + CW_TICKET + 64 * j2) == 32u);
            misc[6] = (even && misc[4] < 8u && misc[5] < 32u) ? (misc[4] + 8u * misc[5]) : (unsigned)blockIdx.x; }
        __syncthreads();
        bid = (int)misc[6];
    }
    if (IN(1)) REP(1) {
#if FAST_GEMM
        { fg::DenseSched S{(const char*)hbuf, (const char*)winT, DM / 2, DM / 2, NTOK / 256, INWP / 256, 1, DM / 128, G, bid, (p.var == 10) ? 2 : 0};
          fg::EpiBf16N E{p1, INW, INW, 1.0f / (2.0f * 64.0f), p.in[I_GQA], 8, p.in[I_GKA], 16, 0, (LAS float*)(lds + 131072 + 2048)};
          fg::gemm_phase<fg::EpiBf16N, fg::DenseSched, false, true, true>(lds, S, E, DM / 2, DM / 2, p.var); }
        { fg::DenseSched S{(const char*)memn, (const char*)wxkvT, DM, PK(DM), NMEM / 256, 1024 / 256, 1, DM / 64, G, (bid + G - 224) % G, 0};
          fg::EpiBf16 E{kvm, 1024, 1024, 1.0f};
          fg::gemm_phase<fg::EpiBf16, fg::DenseSched, false, false, true>(lds, S, E, DM, PK(DM)); }
#else
        constexpr int NT1 = (INW + 127) / 128, U1 = (NTOK / 128) * NT1, U2 = (NMEM / 128) * (1024 / 128);
        for (int u = bid; u < U1 + U2; u += G) {
            if (u < U1) { const int mt = u / NT1, nt = u % NT1;
                BPlain bc{p.in[I_WIN], INW, nt * 128, INW};
                auto epi = [&](int r, int c, const float (&v)[4]) { const int col = nt * 128 + c; if (col < INW) { act_t* o = p1 + (size_t)(mt * 128 + r) * INW + col; stf(o, v[0]); stf(o + 1, v[1]); stf(o + 2, v[2]); stf(o + 3, v[3]); } };
                ngemm_tile<act_t>(ldsf, hbuf, DM, nullptr, mt * 128, 128, DM, bc, epi);
            } else { const int v2 = u - U1, mt = v2 / 8, nt = v2 % 8;
                BPlain bc{p.in[I_WXKV], 1024, nt * 128, 1024};
                auto epi = [&](int r, int c, const float (&v)[4]) { act_t* o = kvm + (size_t)(mt * 128 + r) * 1024 + nt * 128 + c; stf(o, v[0]); stf(o + 1, v[1]); stf(o + 2, v[2]); stf(o + 3, v[3]); };
                ngemm_tile<act_t>(ldsf, memn, DM, nullptr, mt * 128, 128, DM, bc, epi);
            }
        }
    #endif
    }
    SEAM(1);
    if (IN(2)) {
#if FAST_GEMM
        {
            float gcq0[8], gcq1[8], gckv[8];
            load8f(p.in[I_GCQ] + lane * 8, gcq0); load8f(p.in[I_GCQ] + 512 + lane * 8, gcq1); load8f(p.in[I_GCKV] + lane * 8, gckv);
            for (int m = gw; m < NTOK; m += NGW) {
                act_t* row = p1 + (size_t)m * INW;
                u32x4 cq[2], ckv;
                cq[0] = *(const u32x4*)(row + C_CQ + lane * 8); cq[1] = *(const u32x4*)(row + C_CQ + 512 + lane * 8); ckv = *(const u32x4*)(row + C_CKV + lane * 8);
                const int pos = positions[m];
                asm volatile("s_waitcnt vmcnt(0)" ::: "memory");
                { float f0[8], f1[8]; unpack8(cq[0], f0); unpack8(cq[1], f1); const float ss = wave_sum(sumsq8(f0) + sumsq8(f1)); const float r = 1.0f / sqrtf(ss * (1.0f / 1024.f) + EPS);
                  scale8(f0, r, gcq0); scale8(f1, r, gcq1); cq[0] = pack8(f0); cq[1] = pack8(f1); }
                { float f[8]; unpack8(ckv, f); const float ss = wave_sum(sumsq8(f)); const float r = 1.0f / sqrtf(ss * (1.0f / 512.f) + EPS); scale8(f, r, gckv); ckv = pack8(f); }
                *(u32x4*)(row + C_CQ + lane * 8) = cq[0]; *(u32x4*)(row + C_CQ + 512 + lane * 8) = cq[1]; *(u32x4*)(row + C_CKV + lane * 8) = ckv;
                rms_rope64_inplace(row + C_KPE, p.in[I_GKB] + 128, pos, lane);
            }
            float gkx[8]; load8f(p.in[I_GKX] + (lane & 15) * 8, gkx);
            for (int m = gw; m < NMEM; m += NGW) { act_t* row = kvm + (size_t)m * 1024;
                u32x4 w = *(const u32x4*)(row + lane * 8); float f[8]; unpack8(w, f); const float ss = group_sum<16>(sumsq8(f)); const float r = 1.0f / sqrtf(ss * (1.0f / 128.f) + EPS);
                scale8(f, r, gkx); *(u32x4*)(row + lane * 8) = pack8(f); }
        }
#else
        for (int m = gw; m < NTOK; m += NGW) {
            act_t* row = p1 + (size_t)m * INW;
            for (int h = 0; h < HA; ++h) { rms_inplace<128>(row + C_Q0 + h * HD, p.in[I_GQA], lane); rms_inplace<128>(row + C_K0 + h * HD, p.in[I_GKA], lane); }
            rms_inplace<QLORA>(row + C_CQ, p.in[I_GCQ], lane);
            rms_inplace<KVLORA>(row + C_CKV, p.in[I_GCKV], lane);
            rms_rope64_inplace(row + C_KPE, p.in[I_GKB] + 128, positions[m], lane);
        }
        for (int m = gw; m < NMEM; m += NGW) for (int h = 0; h < MH; ++h) rms_inplace<128>(kvm + (size_t)m * 1024 + h * 128, p.in[I_GKX], lane);
#endif
    }
    SEAM(2);
    if (IN(3)) REP(3) {
#if FAST_GEMM
        { fg::DenseSched S{(const char*)(p1 + C_CQ), (const char*)wuqT, INW, PK(QLORA), NTOK / 256, 3072 / 256, 1, QLORA / 64, G, bid, 0};
          fg::EpiBf16 E{qb, 3072, 3072, 1.0f};
          fg::gemm_phase<fg::EpiBf16, fg::DenseSched, false, false, true>(lds, S, E, INW, PK(QLORA)); }
        { fg::DenseSched S{(const char*)(p1 + C_CKV), (const char*)wukvT, INW, PK(KVLORA), NTOK / 256, 4096 / 256, 1, KVLORA / 64, G, bid, (G == 256) ? 1 : 0};
          fg::EpiBf16N E{kvb, 4096, 4096, 1.0f, p.in[I_GKB], 16, p.in[I_GKB], 16, 1, (LAS float*)(lds + 131072 + 2048)};
          fg::gemm_phase<fg::EpiBf16N, fg::DenseSched, false, false, true>(lds, S, E, INW, PK(KVLORA)); }
#else
        constexpr int UA = (NTOK / 128) * (3072 / 128), UB = (NTOK / 128) * (4096 / 128);
        for (int u = bid; u < UA + UB; u += G) {
            if (u < UA) { const int mt = u / 24, nt = u % 24;
                BPlain bc{p.in[I_WUQ], 3072, nt * 128, 3072};
                auto epi = [&](int r, int c, const float (&v)[4]) { act_t* o = qb + (size_t)(mt * 128 + r) * 3072 + nt * 128 + c; stf(o, v[0]); stf(o + 1, v[1]); stf(o + 2, v[2]); stf(o + 3, v[3]); };
                ngemm_tile<act_t>(ldsf, p1 + C_CQ, INW, nullptr, mt * 128, 128, QLORA, bc, epi);
            } else { const int v2 = u - UA, mt = v2 / 32, nt = v2 % 32;
                BPlain bc{p.in[I_WUKV], 4096, nt * 128, 4096};
                auto epi = [&](int r, int c, const float (&v)[4]) { act_t* o = kvb + (size_t)(mt * 128 + r) * 4096 + nt * 128 + c; stf(o, v[0]); stf(o + 1, v[1]); stf(o + 2, v[2]); stf(o + 3, v[3]); };
                ngemm_tile<act_t>(ldsf, p1 + C_CKV, INW, nullptr, mt * 128, 128, KVLORA, bc, epi);
            }
        }
    #endif
    }
    SEAM(3);
    if (IN(4)) {
#if FAST_GEMM
        {
            float gqn[8], gqp[8];
            load8f(p.in[I_GQB] + (lane & 15) * 8, gqn); load8f(p.in[I_GQB] + 128 + (lane & 7) * 8, gqp);
            for (int m = gw; m < NTOK; m += NGW) {
                act_t* qrow = qb + (size_t)m * 3072;
                u32x4 qn[4], qp[2];
#pragma unroll
                for (int j = 0; j < 4; ++j) qn[j] = *(const u32x4*)(qrow + (j * 4 + (lane >> 4)) * QKB + (lane & 15) * 8);
#pragma unroll
                for (int j = 0; j < 2; ++j) qp[j] = *(const u32x4*)(qrow + (j * 8 + (lane >> 3)) * QKB + 128 + (lane & 7) * 8);
                float cs[8], sn[8];
                { const int fi = lane & 31; const float inv_freq = powf(10000.0f, -(float)(2 * fi) / 64.0f); const float ang = (float)positions[m] * inv_freq; float s1, c1; sincosf(ang, &s1, &c1);
#pragma unroll
                  for (int i = 0; i < 8; ++i) { const int src = ((lane & 3) * 8 + i); cs[i] = __shfl(c1, src); sn[i] = __shfl(s1, src); } }
                asm volatile("s_waitcnt vmcnt(0)" ::: "memory");
#pragma unroll
                for (int j = 0; j < 4; ++j) { float f[8]; unpack8(qn[j], f); const float ss = group_sum<16>(sumsq8(f)); const float r = 1.0f / sqrtf(ss * (1.0f / 128.f) + EPS); scale8(f, r, gqn); qn[j] = pack8(f); }
#pragma unroll
                for (int j = 0; j < 2; ++j) { float f[8]; unpack8(qp[j], f); const float ss = group_sum<8>(sumsq8(f)); const float r = 1.0f / sqrtf(ss * (1.0f / 64.f) + EPS); scale8(f, r, gqp);
                    const bool lowhalf = ((lane & 7) < 4);
#pragma unroll
                    for (int i = 0; i < 8; ++i) { const float other = __shfl_xor(f[i], 4); f[i] = lowhalf ? (f[i] * cs[i] - other * sn[i]) : (f[i] * cs[i] + other * sn[i]); }
                    qp[j] = pack8(f); }
#pragma unroll
                for (int j = 0; j < 4; ++j) *(u32x4*)(qrow + (j * 4 + (lane >> 4)) * QKB + (lane & 15) * 8) = qn[j];
#pragma unroll
                for (int j = 0; j < 2; ++j) *(u32x4*)(qrow + (j * 8 + (lane >> 3)) * QKB + 128 + (lane & 7) * 8) = qp[j];
            }
        }
#else
        for (int m = gw; m < NTOK; m += NGW) {
            const int pos = positions[m];
            for (int h = 0; h < HB; ++h) {
                rms_inplace<128>(qb + (size_t)m * 3072 + h * QKB, p.in[I_GQB], lane);
                rms_rope64_inplace(qb + (size_t)m * 3072 + h * QKB + 128, p.in[I_GQB] + 128, pos, lane);
                rms_inplace<128>(kvb + (size_t)m * 4096 + h * 256, p.in[I_GKB], lane);
            }
        }
#endif
    }
    SEAM(4);
    if (IN(5)) {
#if FAST_ATTN
        {
            constexpr int NA_BLK = 176;
            LAS char* al = (LAS char*)lds;
            LAS float* scr = (LAS float*)(lds + wave * 16640);
            if (bid >= NA_BLK) { expert_conv_loop(p, ws, ctl + CW_QCONV, scr, lane); }
            for (;;) {
                __syncthreads(); if (tid == 0) misc[7] = xb_add(ctl + CW_QB, 1u); __syncthreads();
                const int q = (int)misc[7]; if (q >= 512) break;
                const int grp = q >> 8, idx = q & 255, pair = idx >> 2, qbk = (grp == 0 ? 7 : 3) - (idx & 3), b = pair >> 4, h = pair & 15;
                const int c0 = qbk * 4; const size_t tok0 = (size_t)b * SEQ + (size_t)qbk * 256;
                const act_t* kb = kvb + (size_t)b * SEQ * 4096;
                fa::attn_call<1>(qb + tok0 * 3072 + h * QKB, kb + h * 256, p1 + (size_t)b * SEQ * INW + C_KPE, kb + h * 256 + 128, (bf16_t*)((unsigned char*)mixed + tok0 * DM + WA + h * HD), 0, c0 + 4, c0, al);
            }
            for (;;) {
                __syncthreads(); if (tid == 0) misc[7] = xb_add(ctl + CW_QA, 1u); __syncthreads();
                const int q = (int)misc[7]; if (q >= 512) break;
                const int grp = q >> 8, idx = q & 255, pair = idx >> 2, qbk = (grp == 0 ? 7 : 3) - (idx & 3), b = pair >> 4, h = pair & 15;
                { LAS float* tbl = (LAS float*)(al + fa::OFF_TBL); if (tid < NREL) tbl[tid] = p.in[I_RELB][h * NREL + tid] * 11.313708498984761f; }
                const int c0 = qbk * 4; const size_t tok0 = (size_t)b * SEQ + (size_t)qbk * 256;
                const int kt0 = (c0 - LEFT) > 0 ? (c0 - LEFT) : 0;
                const act_t* base = p1 + (size_t)b * SEQ * INW;
                fa::attn_call<0>(p1 + tok0 * INW + C_Q0 + h * HD, base + C_K0 + h * HD, nullptr, base + C_V0 + h * HD, (bf16_t*)((unsigned char*)mixed + tok0 * DM + h * HD), kt0, c0 + 4 - kt0, c0, al);
            }
            __syncthreads();
            expert_conv_loop(p, ws, ctl + CW_QCONV, scr, lane);
        }
#else
        for (int u = bid; u < 4096; u += G) {
            const int c = 31 - (u >> 7), rem = u & 127, type = rem >> 6, b = (rem >> 4) & 3, h = rem & 15;
            const size_t tok0 = (size_t)b * SEQ + (size_t)c * CHUNK;
            if (type == 0) {
                const int t0 = (c - LEFT) > 0 ? (c - LEFT) : 0, nt = c - t0 + 1;
                const float* rb = p.in[I_RELB] + h * NREL;
                auto keytile = [&](int t) { return (t0 + t) * CHUNK; };
                auto bias = [&](int r, int t, int key) { int dist = (c * CHUNK + r) - ((t0 + t) * CHUNK + key); dist = dist < -(CHUNK - 1) ? -(CHUNK - 1) : (dist > 128 ? 128 : dist); return rb[dist + CHUNK - 1]; };
                const act_t* base = p1 + (size_t)b * SEQ * INW;
                nattn_unit<128>(ldsf, p1 + tok0 * INW + C_Q0 + h * HD, INW, base + C_K0 + h * HD, INW, nullptr, 0, base + C_V0 + h * HD, INW,
                                nt, keytile, 0.08838834764831845f, bias, mixed + tok0 * DM + h * HD, DM);
            } else {
                auto keytile = [&](int t) { return t * CHUNK; };
                auto bias = [&](int, int, int) { return 0.f; };
                const act_t* kb = kvb + (size_t)b * SEQ * 4096;
                nattn_unit<192>(ldsf, qb + tok0 * 3072 + h * QKB, 3072, kb + h * 256, 4096, p1 + (size_t)b * SEQ * INW + C_KPE, INW, kb + h * 256 + 128, 4096,
                                c + 1, keytile, 0.07216878364870323f, bias, mixed + tok0 * DM + WA + h * HD, DM);
            }
        }
    #endif
    }
    SEAM(5);
    if (IN(6)) REP(6) {
#if FAST_GEMM
        { fg::DenseSched S{(const char*)mixed, (const char*)woT, DM / 2, DM / 2, NTOK / 256, DM / 256, 1, DM / 128, G, bid, 0};
          fg::EpiResStat E{x1, x, hc, p.in[I_GCROSS], (float*)(ws + WS_SSP1), DM, 1.0f / (fa::MIX_SCALE * 64.0f)};
          fg::gemm_phase<fg::EpiResStat, fg::DenseSched, false, true, true>(lds, S, E, DM / 2, DM / 2); }
#else
        for (int u = bid; u < (NTOK / 128) * (DM / 128); u += G) { const int mt = u / 32, nt = u % 32;
            BPlain bc{p.in[I_WO], DM, nt * 128, DM};
            auto epi = [&](int r, int c, const float (&v)[4]) { const size_t o = (size_t)(mt * 128 + r) * DM + nt * 128 + c;
                const f32x4 xv = *(const f32x4*)(x + o); *(f32x4*)(x1 + o) = (f32x4){xv.x + v[0], xv.y + v[1], xv.z + v[2], xv.w + v[3]}; };
            ngemm_tile<act_t>(ldsf, mixed, DM, nullptr, mt * 128, 128, DM, bc, epi);
        }
    #endif
    }
    SEAM(6);
    if (IN(8)) REP(8) {
#if FAST_GEMM
        { fg::DenseSched S{(const char*)hc, (const char*)wxqT, DM, PK(DM), NTOK / 256, 512 / 256, 4, DM / 64 / 4, G, bid, 0};
          fg::EpiF32Res<false> E{qxp, nullptr, 512, (size_t)NTOK * 512, 1.0f};
          fg::gemm_phase<fg::EpiF32Res<false>, fg::DenseSched, false, false, true>(lds, S, E, DM, PK(DM)); }
#else
        for (int u = bid; u < (NTOK / 128) * 4; u += G) { const int mt = u / 4, nt = u % 4;
            BPlain bc{p.in[I_WXQ], 512, nt * 128, 512};
            auto epi = [&](int r, int c, const float (&v)[4]) { act_t* o = qx + (size_t)(mt * 128 + r) * 512 + nt * 128 + c; stf(o, v[0]); stf(o + 1, v[1]); stf(o + 2, v[2]); stf(o + 3, v[3]); };
            ngemm_tile<act_t>(ldsf, hc, DM, nullptr, mt * 128, 128, DM, bc, epi);
        }
    #endif
    }
    SEAM(8);
    if (IN(9)) {
#if FAST_GEMM
        { float gqx[8]; load8f(p.in[I_GQX] + (lane & 15) * 8, gqx);
          for (int m = gw; m < NTOK; m += NGW) {
            f32x4 a[4][2];
#pragma unroll
            for (int sl = 0; sl < 4; ++sl) { const float* src = qxp + (size_t)sl * NTOK * 512 + (size_t)m * 512 + lane * 8; a[sl][0] = *(const f32x4*)src; a[sl][1] = *(const f32x4*)(src + 4); }
            const float rs1 = 1.0f / sqrtf(wave_sum(((const float*)(ws + WS_SSP1))[(size_t)m * 64 + lane]) * (1.0f / 4096.f) + EPS);
            const f32x4 lo = ((a[0][0] + a[1][0]) + (a[2][0] + a[3][0])) * rs1, hi4 = ((a[0][1] + a[1][1]) + (a[2][1] + a[3][1])) * rs1;
            float f[8] = {lo.x, lo.y, lo.z, lo.w, hi4.x, hi4.y, hi4.z, hi4.w};
            const float ss = group_sum<16>(sumsq8(f)); const float r = 1.0f / sqrtf(ss * (1.0f / 128.f) + EPS); scale8(f, r, gqx);
            *(u32x4*)(qx + (size_t)m * 512 + lane * 8) = pack8(f); } }
#else
        for (int m = gw; m < NTOK; m += NGW) for (int h = 0; h < MH; ++h) rms_inplace<128>(qx + (size_t)m * 512 + h * 128, p.in[I_GQX], lane);
#endif
    }
    SEAM(9);
    if (IN(10)) REP(10) {
#if FAST_ATTN
        for (int u = bid; u < NB * MH * (SEQ / 256); u += G) { const int qbk = u & 7, h = (u >> 3) & 3, b = u >> 5;
            const size_t tok0 = (size_t)b * SEQ + (size_t)qbk * 256;
            const act_t* kb = kvm + (size_t)b * MEMT * 1024;
            fa::attn_call<2>(qx + tok0 * 512 + h * 128, kb + h * 128, nullptr, kb + 512 + h * 128, ox + tok0 * 512 + h * 128, 0, 4, 0, (LAS char*)lds);
        }
#else
        for (int u = bid; u < NB * MH * (SEQ / 64); u += G) { const int c = u & 31, h = (u >> 5) & 3, b = u >> 7;
            const size_t tok0 = (size_t)b * SEQ + (size_t)c * 64;
            auto keytile = [&](int t) { return t * 64; };
            auto bias = [&](int, int, int) { return 0.f; };
            const act_t* kb = kvm + (size_t)b * MEMT * 1024;
            nattn_unit<128>(ldsf, qx + tok0 * 512 + h * 128, 512, kb + h * 128, 1024, nullptr, 0, kb + 512 + h * 128, 1024, 4, keytile, 0.08838834764831845f, bias, ox + tok0 * 512 + h * 128, 512);
        }
    #endif
    }
    SEAM(10);
    if (IN(11)) REP(11) {
#if FAST_GEMM
        { fg::DenseSched S{(const char*)ox, (const char*)wxoT, 512, PK(512), NTOK / 256, DM / 256, 1, 512 / 64, G, bid, 0};
          fg::EpiX2 E{x2, x1, tb, (bf16_t*)hh, ws + WS_T8, p.in[I_GFFN], (float*)(ws + WS_SSP2), DM};
          fg::gemm_phase<fg::EpiX2, fg::DenseSched, false, false, true>(lds, S, E, 512, PK(512)); }
#else
        for (int u = bid; u < (NTOK / 128) * (DM / 128); u += G) { const int mt = u / 32, nt = u % 32;
            BPlain bc{p.in[I_WXO], DM, nt * 128, DM};
            auto epi = [&](int r, int c, const float (&v)[4]) { const size_t o = (size_t)(mt * 128 + r) * DM + nt * 128 + c;
                const f32x4 xv = *(const f32x4*)(x1 + o); const f32x4 y = (f32x4){xv.x + v[0], xv.y + v[1], xv.z + v[2], xv.w + v[3]}; *(f32x4*)(x2 + o) = y; *(f32x4*)(p.out + o) = y; };
            ngemm_tile<act_t>(ldsf, ox, 512, nullptr, mt * 128, 128, 512, bc, epi);
        }
    #endif
    }
    SEAM(11);
    if (IN(13)) {
        RouterSched S{(const char*)tb, (const char*)hh, (const char*)(ws + WS_WR), (const char*)(ws + WS_WR + 2 * MiB), G, bid};
        EpiLogits E{(float*)(ws + WS_Y)};
        fg::gemm_phase<EpiLogits, RouterSched, false, false, true>(lds, S, E, DM, DM);
    }
    SEAM(13);
    if (IN(14)) {
        const float* lgp = (const float*)(ws + WS_Y);
        const float rb = p.in[I_RBIAS][lane];
        const int g = lane >> 3;
        float lgA[12];
#pragma unroll
        for (int sl = 0; sl < 12; ++sl) lgA[sl] = (gw < NTOK) ? lgp[((size_t)sl * NTOK + gw) * 64 + lane] : 0.f;
        int pm_ = -1, psel = 0, prank = 0; float pgate = 0.f; unsigned ppos = 0u;
        for (int m = gw; m < NTOK; m += NGW) {
            float lgB[12]; const int mn = m + NGW;
#pragma unroll
            for (int sl = 0; sl < 12; ++sl) lgB[sl] = (mn < NTOK) ? lgp[((size_t)sl * NTOK + mn) * 64 + lane] : 0.f;
            const float rs2 = 1.0f / sqrtf(wave_sum(((const float*)(ws + WS_SSP2))[(size_t)m * 64 + lane]) * (1.0f / 4096.f) + EPS);
            if (lane == 0) ((float*)(ws + WS_RS2))[m] = rs2;
            const float logit = (((lgA[0] + lgA[1]) + (lgA[2] + lgA[3])) + ((lgA[4] + lgA[5]) + (lgA[6] + lgA[7])) + ((lgA[8] + lgA[9]) + (lgA[10] + lgA[11]))) * rs2;
            const float score = 1.0f / (1.0f + expf(-logit));
            const float choice = score + rb;
            float gm1 = fmaxf(choice, __shfl_xor(choice, 1)); gm1 = fmaxf(gm1, __shfl_xor(gm1, 2)); gm1 = fmaxf(gm1, __shfl_xor(gm1, 4));
            const unsigned long long eq = __ballot(choice == gm1);
            const unsigned gbits = (unsigned)(eq >> (8 * g)) & 0xffu;
            const bool is_first = (lane & 7) == (__builtin_ctz(gbits | 0x100u));
            float v2 = is_first ? -INFINITY : choice;
            v2 = fmaxf(v2, __shfl_xor(v2, 1)); v2 = fmaxf(v2, __shfl_xor(v2, 2)); v2 = fmaxf(v2, __shfl_xor(v2, 4));
            const float gscore = gm1 + v2;
            int grank = 0;
#pragma unroll
            for (int j2 = 0; j2 < 8; ++j2) { const float gj = __int_as_float(__builtin_amdgcn_readlane(__float_as_int(gscore), 8 * j2)); grank += ((gj > gscore) || (gj == gscore && j2 < g)) ? 1 : 0; }
            const bool gsel = grank < 4;
            const float mv = gsel ? choice : -INFINITY;
            int rank = 0;
#pragma unroll
            for (int i2 = 0; i2 < 64; ++i2) { const float vi = __int_as_float(__builtin_amdgcn_readlane(__float_as_int(mv), i2)); rank += ((vi > mv) || (vi == mv && i2 < lane)) ? 1 : 0; }
            const bool sel = gsel && rank < 8;
            const float wsum = wave_sum(sel ? score : 0.f);
            if (pm_ >= 0 && psel) { rowtok[lane * CAP + ppos] = pm_; rowgate[lane * CAP + ppos] = pgate; rowdst[lane * CAP + ppos] = pm_ * 8 + prank; }
            ppos = 0u; if (sel) ppos = atomicAdd(&gcnt[64 * lane], 1u);
            pm_ = m; psel = sel ? 1 : 0; prank = rank; pgate = score * 2.5f / (wsum + 1e-20f);
#pragma unroll
            for (int sl = 0; sl < 12; ++sl) lgA[sl] = lgB[sl];
        }
        if (pm_ >= 0 && psel) { rowtok[lane * CAP + ppos] = pm_; rowgate[lane * CAP + ppos] = pgate; rowdst[lane * CAP + ppos] = pm_ * 8 + prank; }
    }
    SEAM(14);
    if (IN(15)) REP(15) {
#if FAST_MOE
        { const fg::MoeTabs T = moe_tables_fast((LAS int*)(lds + 131072), gcnt);
          fg::MoeSched<1> S{T, (const char*)(ws + WS_T8), (const char*)wguT, rowtok, G, bid};
          fg::EpiSwiglu E{hh, (const float*)(ws + WS_RS2)};
          fg::gemm_phase<fg::EpiSwiglu, fg::MoeSched<1>, true, true, true>(lds, S, E, DM / 2, DM / 2, p.var); }
#else
        int* tab = (int*)(ldsf + 2 * 16 * 132);
        const MoeTab T = moe_tables(tab, gcnt, 128);
        const int nunits = T.mtp[NE + 1] * 8;
        for (int u = bid; u < nunits; u += G) {
            const int mti = u >> 3, nt = u & 7; int e = 0; while (T.mtp[e + 1] <= mti) ++e;
            const int mt = mti - T.mtp[e], nrows = (T.cnt[e] - mt * 128) < 128 ? (T.cnt[e] - mt * 128) : 128;
            const float* Wg = (e < NE) ? p.in[I_WEXG] + (size_t)e * DM * EFF : p.in[I_WSHG];
            const float* Wu = (e < NE) ? p.in[I_WEXU] + (size_t)e * DM * EFF : p.in[I_WSHU];
            BGU bc{Wg, Wu, EFF, nt * 64};
            const size_t hrow0 = (size_t)T.offh[e] + (size_t)mt * 128;
            auto epi = [&](int r, int c, const float (&v)[4]) { act_t* o = hh + (hrow0 + r) * EFF + nt * 64 + (c >> 2) * 2;
                stf(o, v[0] / (1.0f + expf(-v[0])) * v[2]); stf(o + 1, v[1] / (1.0f + expf(-v[1])) * v[3]); };
            ngemm_tile<act_t>(ldsf, tb, DM, (e < NE) ? rowtok + e * CAP : nullptr, mt * 128, nrows, DM, bc, epi);
        }
    #endif
    }
    SEAM(15);
    if (IN(16)) REP(16) {
#if FAST_MOE
        { const fg::MoeTabs T = moe_tables_fast((LAS int*)(lds + 131072), gcnt);
          { fg::MoeSched<2> S{T, (const char*)hh, (const char*)wdT, rowtok, G, bid};
            fg::EpiScatter E{(unsigned char*)ybuf, rowdst, rowgate, T.mtp};
            fg::gemm_phase<fg::EpiScatter, fg::MoeSched<2>, false, true, true>(lds, S, E, EFF / 2, EFF / 2, p.var); }
          { fg::DenseSched S{(const char*)hh + (size_t)T.mtp[64] * 256 * EFF, (const char*)wdT + (size_t)64 * DM * EFF, EFF / 2, EFF / 2, NTOK / 256, DM / 256, 1, EFF / 128, G, bid, 0};
            fg::EpiShared E{(unsigned char*)ybuf + (size_t)NTOK * 8 * DM};
            fg::gemm_phase<fg::EpiShared, fg::DenseSched, false, true, true>(lds, S, E, EFF / 2, EFF / 2); } }
#else
        int* tab = (int*)(ldsf + 2 * 16 * 132);
        const MoeTab T = moe_tables(tab, gcnt, 128);
        const int nunits = T.mtp[NE + 1] * 32;
        for (int u = bid; u < nunits; u += G) {
            const int mti = u >> 5, nt = u & 31; int e = 0; while (T.mtp[e + 1] <= mti) ++e;
            const int mt = mti - T.mtp[e], nrows = (T.cnt[e] - mt * 128) < 128 ? (T.cnt[e] - mt * 128) : 128;
            const float* Wd = (e < NE) ? p.in[I_WEXD] + (size_t)e * EFF * DM : p.in[I_WSHD];
            BPlain bc{Wd, DM, nt * 128, DM};
            const int hrow0 = T.offh[e] + mt * 128;
            auto epi = [&](int r, int c, const float (&v)[4]) {
                int tok; float g; if (e < NE) { tok = rowtok[e * CAP + mt * 128 + r]; g = rowgate[e * CAP + mt * 128 + r]; } else { tok = mt * 128 + r; g = 1.0f; }
                float* o = p.out + (size_t)tok * DM + nt * 128 + c;
                atomicAdd(o, v[0] * g); atomicAdd(o + 1, v[1] * g); atomicAdd(o + 2, v[2] * g); atomicAdd(o + 3, v[3] * g); };
            ngemm_tile<act_t>(ldsf, hh, EFF, nullptr, hrow0, nrows, EFF, bc, epi);
        }
    #endif
    }
    SEAM(16);
    if (IN(17)) REP(17) {
#if FAST_MOE
        for (int m = gw; m < NTOK; m += NGW) {
            const unsigned char* y8 = (const unsigned char*)ybuf + (size_t)m * 8 * DM;
#pragma unroll 2
            for (int j = 0; j < 4; ++j) { const int c0 = lane * 16 + 1024 * j;
                const float* sp = x2 + (size_t)m * DM + c0; float* op = p.out + (size_t)m * DM + c0;
                f32x4 sv[4];
#pragma unroll
                for (int q = 0; q < 4; ++q) sv[q] = __builtin_nontemporal_load((const f32x4*)(sp + 4 * q));
                u32x4 y[9];
#pragma unroll
                for (int k = 0; k < 8; ++k) y[k] = __builtin_nontemporal_load((const u32x4*)(y8 + (size_t)k * DM + c0));
                y[8] = __builtin_nontemporal_load((const u32x4*)((const unsigned char*)ybuf + (size_t)NTOK * 8 * DM + (size_t)m * DM + c0));
                float a[16];
#pragma unroll
                for (int q = 0; q < 16; ++q) a[q] = 0.f;
#pragma unroll
                for (int k = 0; k < 9; ++k) {
#pragma unroll
                    for (int q = 0; q < 4; ++q) { const int w = (int)y[k][q]; const auto lo = __builtin_amdgcn_cvt_pk_f32_fp8(w, false); const auto hi2 = __builtin_amdgcn_cvt_pk_f32_fp8(w, true);
                        a[4 * q] += lo[0]; a[4 * q + 1] += lo[1]; a[4 * q + 2] += hi2[0]; a[4 * q + 3] += hi2[1]; } }
#pragma unroll
                for (int q = 0; q < 4; ++q) { f32x4 o; o.x = sv[q].x + a[4 * q] * (1.0f / fg::Y_SCALE); o.y = sv[q].y + a[4 * q + 1] * (1.0f / fg::Y_SCALE); o.z = sv[q].z + a[4 * q + 2] * (1.0f / fg::Y_SCALE); o.w = sv[q].w + a[4 * q + 3] * (1.0f / fg::Y_SCALE);
                    *(f32x4*)(op + 4 * q) = o; } }
        }
#endif
    }
#undef IN
#undef SEAM
}

#if TVAR
__global__ void __launch_bounds__(512, 2) probe_k(Params p) {
    extern __shared__ __attribute__((aligned(16))) unsigned char lds_raw[];
    const int tid = threadIdx.x, lane = tid & 63, wave = tid >> 6;
    p0_items<TVAR>(p, p.ws, (LAS float*)((LAS unsigned char*)lds_raw + wave * 16640), lane, blockIdx.x * 8 + wave, gridDim.x * 8);
}
#endif
typedef void (*kern_t)(Params);
template <int PH> struct KTab { static void fill(kern_t* t) { t[PH] = fwd<(1u << PH)>; KTab<PH - 1>::fill(t); } };
template <> struct KTab<-1> { static void fill(kern_t*) {} };
extern "C" void kernel_launch(void* const* d_in, const int* in_sizes, int n_in, void* d_out, int out_size, void* d_ws, size_t ws_size, hipStream_t stream) {
    static int grid = 0;
    static kern_t ktab[NPHASE + 1];
    if (grid == 0) {
        if (n_in != 31 || out_size != NTOK * DM || ws_size < WS_END) { fprintf(stderr, "kernel_launch: bad shapes n_in %d out %d ws %zu (need %zu)\n", n_in, out_size, ws_size, (size_t)WS_END); grid = -1; return; }
        int dev = 0, cus = 0;
        if (hipGetDevice(&dev) != hipSuccess || hipDeviceGetAttribute(&cus, hipDeviceAttributeMultiprocessorCount, dev) != hipSuccess) { grid = -1; return; }
#if N_LAUNCH_PER_PHASE
        KTab<NPHASE - 1>::fill(ktab);
#else
        ktab[NPHASE] = fwd<0xFFFFFFFFu>;
#endif
#if N_LAUNCH_PER_PHASE
        for (int i = 0; i < NPHASE; ++i)
#else
        for (int i = NPHASE; i <= NPHASE; ++i)
#endif
            if (hipFuncSetAttribute((const void*)ktab[i], hipFuncAttributeMaxDynamicSharedMemorySize, LDS_BYTES) != hipSuccess) { fprintf(stderr, "kernel_launch: hipFuncSetAttribute failed\n"); grid = -1; return; }
        (void)hipGetLastError();
        grid = cus;
    }
    if (grid < 0) return;
    (void)hipMemsetAsync((char*)d_ws + WS_CTL, 0, CTL_BYTES, stream);
    Params p{};
    for (int i = 0; i < 31; ++i) p.in[i] = (const float*)d_in[i];
    p.out = (float*)d_out; p.ws = (unsigned char*)d_ws;
#if TVAR
    { static int once = 0; if (!once) { (void)hipFuncSetAttribute((const void*)probe_k, hipFuncAttributeMaxDynamicSharedMemorySize, LDS_BYTES); once = 1; } p.ph_lo = 0; p.ph_hi = 0; hipLaunchKernelGGL(probe_k, dim3(grid), dim3(512), LDS_BYTES, stream, p); }
#endif
#if N_LAUNCH_PER_PHASE
    for (int ph = 0; ph < NPHASE; ++ph) { p.ph_lo = ph; p.ph_hi = ph + 1; hipLaunchKernelGGL(ktab[ph], dim3(grid), dim3(512), LDS_BYTES, stream, p); }
#else
    p.ph_lo = 0; p.ph_hi = NPHASE; hipLaunchKernelGGL(ktab[NPHASE], dim3(grid), dim3(512), LDS_BYTES, stream, p);
#endif
#ifdef PROBE_PH
#ifndef PROBE_VAR
#define PROBE_VAR 0
#endif
    (void)hipMemsetAsync((char*)d_ws + WS_CTL + (size_t)CW_QCONV * 4, 0, 1024, stream);
    (void)hipMemsetAsync((char*)d_ws + WS_CTL + (size_t)CW_QCONV * 4, 0, 1024, stream);
    p.ph_lo = PROBE_PH; p.ph_hi = PROBE_PH + 1; p.var = PROBE_VAR; hipLaunchKernelGGL(ktab[NPHASE], dim3(grid), dim3(512), LDS_BYTES, stream, p);
#endif
    const hipError_t le = hipPeekAtLastError();
    if (le != hipSuccess) fprintf(stderr, "kernel_launch: launch failed: %s\n", hipGetErrorName(le));
}
```

```cpp
#include <hip/hip_runtime.h>
#include <cstdio>
#include <cstdint>

#define LAS __attribute__((address_space(3)))
typedef unsigned short bf16_t;
typedef float f32x4 __attribute__((ext_vector_type(4)));
typedef short bf16x8 __attribute__((ext_vector_type(8)));
typedef unsigned u32x4 __attribute__((ext_vector_type(4)));
typedef unsigned u32x2 __attribute__((ext_vector_type(2)));
typedef int v4i_t __attribute__((ext_vector_type(4)));
typedef int v8i_t __attribute__((ext_vector_type(8)));
#ifndef FAST_GEMM
#define FAST_GEMM 1
#endif
#ifndef FAST_MOE
#define FAST_MOE 1
#endif
#ifndef FAST_ATTN
#define FAST_ATTN 1
#endif

#ifndef ACT_F32
#define ACT_F32 0
#endif
#if ACT_F32
typedef float act_t;
#else
typedef bf16_t act_t;
#endif
#ifndef N_LAUNCH_PER_PHASE
#define N_LAUNCH_PER_PHASE 0
#endif

constexpr int NB = 4, SEQ = 2048, DM = 4096, NTOK = NB * SEQ;
constexpr int CHUNK = 64, LEFT = 8, NREL = 192;
constexpr int HD = 128, HA = 16, HB = 16, QLORA = 1024, KVLORA = 512, QKB = 192;
constexpr int MEMT = 256, MH = 4, NE = 64, EFF = 512;
constexpr int WA = HA * HD;
constexpr int INW = 3 * WA + QLORA + KVLORA + 64;
constexpr int NMEM = NB * MEMT;
constexpr int C_Q0 = 0, C_K0 = WA, C_V0 = 2 * WA, C_CQ = 3 * WA, C_CKV = 3 * WA + QLORA, C_KPE = 3 * WA + QLORA + KVLORA;
constexpr float EPS = 1e-6f;
constexpr int CAP = NTOK;

constexpr size_t MiB = 1u << 20;
constexpr size_t AS = sizeof(act_t);
constexpr size_t al(size_t x) { return (x + 255) / 256 * 256; }
constexpr size_t WS_CTL = 0, CTL_BYTES = 1 * MiB;
constexpr size_t WS_ROWTOK = 1 * MiB, WS_ROWGATE = 3 * MiB, WS_ROWDST = 5 * MiB;
constexpr int PK(int K) { return K; }
constexpr int INWP = 7936;
constexpr size_t WS_WR = 8 * MiB;
constexpr size_t WS_WIN = 12 * MiB;
constexpr size_t WS_WUQ = WS_WIN + al((size_t)INWP * PK(DM) * 2);
constexpr size_t WS_WUKV = WS_WUQ + al((size_t)3072 * PK(QLORA) * 2);
constexpr size_t WS_WO = WS_WUKV + al((size_t)4096 * PK(KVLORA) * 2);
constexpr size_t WS_WXQ = WS_WO + al((size_t)DM * PK(DM) * 2);
constexpr size_t WS_WXKV = WS_WXQ + al((size_t)512 * PK(DM) * 2);
constexpr size_t WS_WXO = WS_WXKV + al((size_t)1024 * PK(DM) * 2);
constexpr size_t WS_WGU = WS_WXO + al((size_t)DM * PK(512) * 2);
constexpr size_t WS_WD = WS_WGU + al((size_t)65 * 1024 * DM);
constexpr size_t WS_T8 = WS_WD + al((size_t)65 * DM * EFF);
constexpr size_t WS_SSP1 = WS_T8 + al((size_t)NTOK * DM);
constexpr size_t WS_SSP2 = WS_SSP1 + (size_t)NTOK * 64 * 4;
constexpr size_t WS_RS2 = WS_SSP2 + (size_t)NTOK * 64 * 4;
constexpr size_t WS_X1 = WS_RS2 + al((size_t)NTOK * 4);
constexpr size_t WS_X2 = WS_X1 + al((size_t)NTOK * DM * 4);
constexpr size_t WS_T = WS_X2 + al((size_t)NTOK * DM * 4);
constexpr int HH_ROWS = NTOK * 8 + NE * 256 + NTOK;
constexpr size_t WS_HH = WS_T + al((size_t)NTOK * DM * AS);
constexpr size_t WS_Y = WS_HH + al((size_t)HH_ROWS * EFF * AS);
constexpr size_t WS_H = WS_Y;
constexpr size_t WS_MEMN = WS_H + al((size_t)NTOK * DM * AS);
constexpr size_t WS_P1 = WS_MEMN + al((size_t)NMEM * DM * AS);
constexpr size_t WS_KVM = WS_P1 + al((size_t)NTOK * INW * AS);
constexpr size_t WS_QB = WS_KVM + al((size_t)NMEM * 1024 * AS);
constexpr size_t WS_KVB = WS_QB + al((size_t)NTOK * 3072 * AS);
constexpr size_t WS_MIXED = WS_KVB + al((size_t)NTOK * 4096 * AS);
constexpr size_t WS_HC = WS_MIXED + al((size_t)NTOK * DM * AS);
constexpr size_t WS_QXP = WS_HC + al((size_t)NTOK * DM * AS);
constexpr size_t WS_QX = WS_QXP + al((size_t)4 * NTOK * 512 * 4);
constexpr size_t WS_OX = WS_QX + al((size_t)NTOK * 512 * AS);
constexpr size_t WS_END0 = WS_OX + al((size_t)NTOK * 512 * AS);
constexpr size_t WS_YEND = WS_Y + al((size_t)NTOK * 8 * DM * 2);
constexpr size_t WS_END = WS_END0 > WS_YEND ? WS_END0 : WS_YEND;
static_assert(WS_END <= 2147483648ull, "workspace map exceeds the guaranteed 2 GiB");
constexpr int CW_BAR = 4096;
constexpr int CW_CNT = 16384;
constexpr int CW_QCONV = 26624, CW_QB = 26688, CW_QA = 26752;
constexpr int CW_SS1 = 32768, CW_SS2 = 40960;
constexpr int CW_TICKET = 24576;

constexpr int LDS_BYTES = 163840;
constexpr int LDS_MISC = LDS_BYTES - 64;

__device__ __forceinline__ unsigned f2bf(float f) { unsigned u = __builtin_bit_cast(unsigned, f); return (u + 0x7fffu + ((u >> 16) & 1u)) >> 16; }
__device__ __forceinline__ float ldf(const float* p) { return *p; }
__device__ __forceinline__ float ldf(const bf16_t* p) { return __uint_as_float(((unsigned)*p) << 16); }
__device__ __forceinline__ void stf(float* p, float v) { *p = v; }
__device__ __forceinline__ void stf(bf16_t* p, float v) { *p = (bf16_t)f2bf(v); }
__device__ __forceinline__ float wave_sum(float v) {
#pragma unroll
    for (int o = 1; o < 64; o <<= 1) v += __shfl_xor(v, o);
    return v;
}

#define XB_TMO      128
#define XB_XCNT(j)  (256  + 64 * (j))
#define XB_XSUB(j)  (1280 + 64 * (j))
#define XB_XGEN(j)  (2304 + 64 * (j))
#define XB_TOP      3328
#define XB_TOPGEN   3392
#define XCD_BAR_WORDS 3456
#define XB_SPIN_CAP (1u << 18)
__device__ __forceinline__ unsigned xb_ld(unsigned* p)              { return __hip_atomic_load(p, __ATOMIC_RELAXED, __HIP_MEMORY_SCOPE_AGENT); }
__device__ __forceinline__ unsigned xb_add(unsigned* p, unsigned v) { return __hip_atomic_fetch_add(p, v, __ATOMIC_RELAXED, __HIP_MEMORY_SCOPE_AGENT); }
__device__ __forceinline__ unsigned xb_xcc_id() { return (unsigned)__builtin_amdgcn_s_getreg((3 << 11) | 20) & 0xFu; }
#define XB_SPIN(cond, bar) do { unsigned _sp = 0; while (cond) { __builtin_amdgcn_s_sleep(1); \
    if ((++_sp & 255u) == 0u) { if (xb_ld(&(bar)[XB_TMO])) break; if (_sp > XB_SPIN_CAP) { atomicAdd(&(bar)[XB_TMO], 1u); break; } } } } while (0)
struct XcdBarrier { unsigned* bar; unsigned x; volatile LAS unsigned* st; };
__device__ __forceinline__ XcdBarrier xcd_barrier_post(unsigned* bar, volatile LAS unsigned* st) {
    XcdBarrier b; b.bar = bar; b.x = xb_xcc_id(); b.st = st;
    if (threadIdx.x == 0) (void)xb_add(&bar[XB_XCNT(b.x)], 1u);
    return b;
}
__device__ __forceinline__ void xcd_barrier_complete(unsigned* bar, unsigned x, unsigned& nloc, unsigned& nx) {
    const unsigned G = gridDim.x * gridDim.y * gridDim.z;
    unsigned sum, cnt, mine, sp = 0u;
    for (;;) {
        sum = 0u; cnt = 0u; mine = 0u;
#pragma unroll
        for (unsigned j = 0; j < 16; ++j) { const unsigned c = xb_ld(&bar[XB_XCNT(j)]); sum += c; cnt += (c > 0u) ? 1u : 0u; mine = (j == x) ? c : mine; }
        if (sum == G) break;
        __builtin_amdgcn_s_sleep(1);
        if ((++sp & 255u) == 0u) { if (xb_ld(&bar[XB_TMO])) break; if (sp > XB_SPIN_CAP) { atomicAdd(&bar[XB_TMO], 1u); break; } }
    }
    nloc = mine > 0u ? mine : 1u; nx = cnt > 0u ? cnt : 1u;
}
__device__ __forceinline__ void xcd_barrier(const XcdBarrier& b) {
    asm volatile("s_waitcnt vmcnt(0)" ::: "memory");
    __syncthreads();
    if (threadIdx.x == 0) {
        unsigned* bar = b.bar;
        __builtin_amdgcn_s_waitcnt(0);
        unsigned nloc = b.st[0], nx = b.st[1];
        if (nloc == 0u) { xcd_barrier_complete(bar, b.x, nloc, nx); b.st[0] = nloc; b.st[1] = nx; }
        const unsigned old = xb_add(&bar[XB_XSUB(b.x)], 1u);
        const unsigned gen = old / nloc;
        if (old + 1u == (gen + 1u) * nloc) {
            __builtin_amdgcn_fence(__ATOMIC_RELEASE, "agent");
            asm volatile("s_waitcnt vmcnt(0)" ::: "memory");
            const unsigned og = xb_add(&bar[XB_TOP], 1u);
            const unsigned tg = og / nx;
            if (og + 1u == (tg + 1u) * nx) xb_add(&bar[XB_TOPGEN], 1u);
            else XB_SPIN(xb_ld(&bar[XB_TOPGEN]) == tg, bar);
            __builtin_amdgcn_fence(__ATOMIC_ACQUIRE, "agent");
            xb_add(&bar[XB_XGEN(b.x)], 1u);
            asm volatile("s_waitcnt vmcnt(0)" ::: "memory");
        } else {
            XB_SPIN(xb_ld(&bar[XB_XGEN(b.x)]) == gen, bar);
            __builtin_amdgcn_fence(__ATOMIC_ACQUIRE, "agent");
            asm volatile("s_waitcnt vmcnt(0)" ::: "memory");
        }
    }
    __syncthreads();
}

struct Params {
    const float* in[31];
    float* out;
    unsigned char* ws;
    int ph_lo, ph_hi, var, pad;
};
enum { I_X = 0, I_MEM, I_POS, I_GMIX, I_WIN, I_GQA, I_GKA, I_RELB, I_GCQ, I_WUQ, I_GCKV, I_WUKV, I_GQB, I_GKB, I_WO, I_GCROSS, I_GMEM, I_WXQ, I_WXKV,
       I_GQX, I_GKX, I_WXO, I_GFFN, I_WROUTER, I_RBIAS, I_WSHG, I_WSHU, I_WSHD, I_WEXG, I_WEXU, I_WEXD };

template <class OT>
__device__ __forceinline__ void rms_row_4096(const float* x, const float* g, OT* o, int lane, float* keep  ) {
    f32x4 v[16]; float s = 0.f;
#pragma unroll
    for (int j = 0; j < 16; ++j) { v[j] = ((const f32x4*)x)[lane + 64 * j]; s += v[j].x * v[j].x + v[j].y * v[j].y + v[j].z * v[j].z + v[j].w * v[j].w; }
    s = wave_sum(s);
    const float r = 1.0f / sqrtf(s * (1.0f / 4096.f) + EPS);
#pragma unroll
    for (int j = 0; j < 16; ++j) v[j] = v[j] * r * __builtin_nontemporal_load((const f32x4*)g + lane + 64 * j);
    asm volatile("s_waitcnt vmcnt(0)" ::: "memory");
#pragma unroll
    for (int j = 0; j < 16; ++j) {
        const f32x4 y = v[j];
        const int c = (lane + 64 * j) * 4;
        stf(o + c, y.x); stf(o + c + 1, y.y); stf(o + c + 2, y.z); stf(o + c + 3, y.w);
        if (keep) { keep[c] = y.x; keep[c + 1] = y.y; keep[c + 2] = y.z; keep[c + 3] = y.w; }
    }
}
template <int N>
__device__ __forceinline__ void rms_inplace(act_t* p, const float* g, int lane) {
    float v[N / 64]; float s = 0.f;
#pragma unroll
    for (int j = 0; j < N / 64; ++j) { v[j] = ldf(p + lane + 64 * j); s += v[j] * v[j]; }
    s = wave_sum(s);
    const float r = 1.0f / sqrtf(s * (1.0f / N) + EPS);
#pragma unroll
    for (int j = 0; j < N / 64; ++j) stf(p + lane + 64 * j, v[j] * r * g[lane + 64 * j]);
}
__device__ __forceinline__ void rms_rope64_inplace(act_t* p, const float* g, int pos, int lane) {
    float v = ldf(p + lane);
    float s = wave_sum(v * v);
    const float r = 1.0f / sqrtf(s * (1.0f / 64.f) + EPS);
    v = v * r * g[lane];
    const int fi = lane & 31;
    const float inv_freq = powf(10000.0f, -(float)(2 * fi) / 64.0f);
    const float ang = (float)pos * inv_freq;
    float sn, cs; sincosf(ang, &sn, &cs);
    const float other = __shfl_xor(v, 32);
    const float y = (lane < 32) ? (v * cs - other * sn) : (v * cs + other * sn);
    stf(p + lane, y);
}

template <class AT, class BCol, class Epi>
__device__ __forceinline__ void ngemm_tile(float* lds, const AT* A, long lda, const int* rowlist, int row0, int nrows, int K, const BCol& bcol, const Epi& epi) {
    const int tid = threadIdx.x, tx = tid & 31, ty = tid >> 5;
    float* As = lds; float* Bs = lds + 16 * 132;
    const int arow = tid >> 2, akq = (tid & 3) * 4;
    int grow; { const int rr = (arow < nrows) ? arow : 0; grow = rowlist ? rowlist[row0 + rr] : (row0 + rr); }
    const AT* Ap = A + (long)grow * lda + akq;
    const int bj = tid & 127, bk = tid >> 7;
    const float* Bp = bcol(bj) + (long)bk * bcol.ldb;
    float acc[8][4];
#pragma unroll
    for (int i = 0; i < 8; ++i)
#pragma unroll
        for (int j = 0; j < 4; ++j) acc[i][j] = 0.f;
    for (int k0 = 0; k0 < K; k0 += 16) {
        float a0 = ldf(Ap + k0), a1 = ldf(Ap + k0 + 1), a2 = ldf(Ap + k0 + 2), a3 = ldf(Ap + k0 + 3);
        float b0 = Bp[(long)(k0) * bcol.ldb], b1 = Bp[(long)(k0 + 4) * bcol.ldb], b2 = Bp[(long)(k0 + 8) * bcol.ldb], b3 = Bp[(long)(k0 + 12) * bcol.ldb];
        __syncthreads();
        As[(akq + 0) * 132 + arow] = a0; As[(akq + 1) * 132 + arow] = a1; As[(akq + 2) * 132 + arow] = a2; As[(akq + 3) * 132 + arow] = a3;
        Bs[(bk + 0) * 132 + bj] = b0; Bs[(bk + 4) * 132 + bj] = b1; Bs[(bk + 8) * 132 + bj] = b2; Bs[(bk + 12) * 132 + bj] = b3;
        __syncthreads();
#pragma unroll
        for (int kk = 0; kk < 16; ++kk) {
            const f32x4 al = *(const f32x4*)(As + kk * 132 + ty * 8), ah = *(const f32x4*)(As + kk * 132 + ty * 8 + 4);
            const f32x4 b = *(const f32x4*)(Bs + kk * 132 + tx * 4);
            const float a[8] = {al.x, al.y, al.z, al.w, ah.x, ah.y, ah.z, ah.w};
#pragma unroll
            for (int i = 0; i < 8; ++i) { acc[i][0] += a[i] * b.x; acc[i][1] += a[i] * b.y; acc[i][2] += a[i] * b.z; acc[i][3] += a[i] * b.w; }
        }
    }
    __syncthreads();
#pragma unroll
    for (int i = 0; i < 8; ++i) { const int r = ty * 8 + i; if (r < nrows) epi(r, tx * 4, acc[i]); }
}
struct BGU { const float* Wg; const float* Wu; int ldb; int ff0; __device__ __forceinline__ const float* operator()(int j) const { const int ff = ff0 + (j >> 2) * 2 + (j & 1); const uintptr_t a = (uintptr_t)Wg, b = (uintptr_t)Wu; return (const float*)((j & 2) ? b : a) + ff; } };
struct BPlain { const float* B; int ldb; int col0, ncols; __device__ __forceinline__ const float* operator()(int j) const { const int c = col0 + j; return B + (c < ncols ? c : 0); } };

template <int DQK, class KeyTile, class Bias>
__device__ __forceinline__ void nattn_unit(float* lds, const act_t* Q, long ldq, const act_t* K1, long ldk1, const act_t* K2, long ldk2, const act_t* V, long ldv,
                                           int ntiles, const KeyTile& keytile, float scale, const Bias& bias, act_t* O, long ldo) {
    constexpr int QS = DQK + 4;
    float* Qs = lds; float* Ks = Qs + 64 * QS; float* Vs = Ks + 64 * QS; float* Ss = Vs + 64 * 132;
    const int tid = threadIdx.x, r = tid >> 3, s = tid & 7;
    __syncthreads();
    for (int idx = tid; idx < 64 * DQK; idx += 512) { const int row = idx / DQK, d = idx % DQK; Qs[row * QS + d] = ldf(Q + (long)row * ldq + d); }
    float m = -INFINITY, l = 0.f; float o[16];
#pragma unroll
    for (int d = 0; d < 16; ++d) o[d] = 0.f;
    for (int t = 0; t < ntiles; ++t) {
        const int k0 = keytile(t);
        __syncthreads();
        for (int idx = tid; idx < 64 * 128; idx += 512) { const int row = idx >> 7, d = idx & 127;
            Ks[row * QS + d] = ldf(K1 + (long)(k0 + row) * ldk1 + d); Vs[row * 132 + d] = ldf(V + (long)(k0 + row) * ldv + d); }
        if (DQK > 128) for (int idx = tid; idx < 64 * (DQK - 128); idx += 512) { const int row = idx / (DQK - 128), d = idx % (DQK - 128);
            Ks[row * QS + 128 + d] = ldf(K2 + (long)(k0 + row) * ldk2 + d); }
        __syncthreads();
#pragma unroll
        for (int jj = 0; jj < 8; ++jj) { const int key = s + 8 * jj; float dot = 0.f;
#pragma unroll 8
            for (int d = 0; d < DQK; d += 4) { const f32x4 q = *(const f32x4*)(Qs + r * QS + d), k = *(const f32x4*)(Ks + key * QS + d); dot += q.x * k.x + q.y * k.y + q.z * k.z + q.w * k.w; }
            Ss[r * 65 + key] = dot * scale + bias(r, t, key); }
        __syncthreads();
        float mt = -INFINITY;
        for (int k = 0; k < 64; ++k) mt = fmaxf(mt, Ss[r * 65 + k]);
        const float mn = fmaxf(m, mt), alpha = expf(m - mn);
        float ladd = 0.f;
#pragma unroll
        for (int d = 0; d < 16; ++d) o[d] *= alpha;
        for (int k = 0; k < 64; ++k) { const float pk = expf(Ss[r * 65 + k] - mn); ladd += pk;
#pragma unroll
            for (int d = 0; d < 16; d += 4) { const f32x4 v = *(const f32x4*)(Vs + k * 132 + s * 16 + d); o[d] += pk * v.x; o[d + 1] += pk * v.y; o[d + 2] += pk * v.z; o[d + 3] += pk * v.w; } }
        m = mn; l = l * alpha + ladd;
    }
    const float il = 1.0f / l;
#pragma unroll
    for (int d = 0; d < 16; ++d) stf(O + (long)r * ldo + s * 16 + d, o[d] * il);
}

struct MoeTab { int* cnt; int* mtp; int* offh; };
__device__ __forceinline__ MoeTab moe_tables(int* tab, const unsigned* gcnt, int tile_m) {
    MoeTab T; T.cnt = tab; T.mtp = tab + 80; T.offh = tab + 160;
    __syncthreads();
    if (threadIdx.x == 0) {
        int pm = 0, po = 0;
        for (int e = 0; e <= NE; ++e) { const int c = (e < NE) ? (int)gcnt[e] : NTOK; T.cnt[e] = c; T.mtp[e] = pm; T.offh[e] = po; pm += (c + tile_m - 1) / tile_m; po += c; }
        T.mtp[NE + 1] = pm;
    }
    __syncthreads();
    return T;
}

namespace fg {
constexpr int BM = 256, BK = 64, HALF = 128, HTB = HALF * BK * 2, STAGE_BYTES = 8 * HTB;
__device__ __forceinline__ int lds_byte(int r, int c) { const int st = (r >> 4) * 2 + (c >> 5), rr = r & 15, cc = c & 31, ob = rr * 64 + cc * 2; return st * 1024 + (ob ^ (((ob >> 9) & 1) << 5)); }
__device__ __forceinline__ void stage_rc(int b, int& R, int& C) { const int st = b / 1024, sb = b % 1024, swz = sb ^ (((sb >> 9) & 1) << 5); R = (st >> 1) * 16 + swz / 64; C = (st & 1) * 32 + (swz % 64) / 2; }
__device__ __forceinline__ int perm32(int rho) { const int n = rho >> 4, i = rho & 15; return 8 * (i >> 2) + 4 * n + (i & 3); }
__device__ __forceinline__ unsigned cvt_pk_bf16(float lo, float hi) { unsigned r; asm volatile("v_cvt_pk_bf16_f32 %0, %1, %2" : "=v"(r) : "v"(lo), "v"(hi)); return r; }

__device__ __forceinline__ unsigned pk4_fp8(float a, float b, float c, float d) { int w = 0; w = __builtin_amdgcn_cvt_pk_fp8_f32(a, b, w, false); w = __builtin_amdgcn_cvt_pk_fp8_f32(c, d, w, true); return (unsigned)w; }
constexpr float H_SCALE = 4.0f, WD_SCALE = 32.0f, WGU_SCALE = 64.0f, T_SCALE = 2.0f, Y_SCALE = 16.0f;
struct Unit { const char* A; const char* B; const int* rows; int nkt, nvalid, pm, pn, e, arow0; };

template <class Epi, class Sched, bool GATHER, bool FP8 = false, bool SP2 = false>
__device__ __forceinline__ void gemm_phase(LAS unsigned char* lds, const Sched& S, const Epi& E, const int lda, const int ldb, const int var_in = 0) {
#ifdef PROBE_PH
    const int var = var_in;
#else
    constexpr int var = 0; (void)var_in;
#endif
    int tid = threadIdx.x; asm volatile("" : "+v"(tid));
    const int wid = __builtin_amdgcn_readfirstlane(tid >> 6), lane = tid & 63, wr = wid >> 2, wc = wid & 3, fr = lane & 15, fq = lane >> 4;
    unsigned voffB[2][2], voffA[2][2];
#pragma unroll
    for (int i = 0; i < 2; ++i) { int sR, sC; stage_rc(tid * 16 + i * 8192, sR, sC);
#pragma unroll
        for (int hb = 0; hb < 2; ++hb) { int Rb;
            if (Epi::PERM == 2) Rb = 64 * (sR >> 5) + 16 * ((sR >> 2) & 3) + 8 * hb + 4 * ((sR >> 4) & 1) + (sR & 3);
            else Rb = 128 * hb + (Epi::PERM == 1 ? ((sR & ~31) + perm32(sR & 31)) : sR);
            voffB[hb][i] = (unsigned)((Rb >> 6) * ldb * 64 + (Rb & 63) * 64 + sC) * 2u; }
#pragma unroll
        for (int h = 0; h < 2; ++h) voffA[h][i] = (unsigned)((sR + HALF * h) * lda + sC) * 2u; }
    const size_t kstep = (size_t)(BK * 2), kstepB = 8192;
    const unsigned ldsw = (unsigned)wid * 1024u;
    const int aoff = FP8 ? lds_byte(wr * 64 + fr, fq * 16) : lds_byte(wr * 64 + fr, fq * 8), boff = FP8 ? lds_byte(wc * 32 + fr, fq * 16) : lds_byte(wc * 32 + fr, fq * 8);
#define FG_SA(b, h) (((b) * 2 + (h)) * HTB)
#define FG_SB(b, h) ((4 + (b) * 2 + (h)) * HTB)
#define FG_STAGE2(bufoff, gbase, v0, v1) do { \
        __builtin_amdgcn_global_load_lds((const unsigned*)((const char*)(gbase) + (v0)), (LAS unsigned*)(lds + (bufoff) + ldsw), 16, 0, 0); \
        __builtin_amdgcn_global_load_lds((const unsigned*)((const char*)(gbase) + (v1)), (LAS unsigned*)(lds + (bufoff) + ldsw + 8192), 16, 0, 0); } while (0)
#define FG_STAGEB(bufoff, gbase, hb) FG_STAGE2(bufoff, gbase, voffB[hb][0], voffB[hb][1])
#define FG_STAGEA(bufoff, gbase, h) FG_STAGE2(bufoff, gbase, voffA[h][0], voffA[h][1])
#define FG_LD8(base_) __builtin_shufflevector(*(const LAS v4i_t*)(base_), *(const LAS v4i_t*)((base_) + 16), 0, 1, 2, 3, 4, 5, 6, 7)
#define FG_LDA(dst, b, h) do { if (FP8) { _Pragma("unroll") for (int m = 0; m < 4; ++m) dst##8[m] = FG_LD8(lds + FG_SA(b, h) + aoff + m * 2048); } \
      else { _Pragma("unroll") for (int m = 0; m < 4; ++m) _Pragma("unroll") for (int k = 0; k < 2; ++k) dst[m][k] = *(const LAS bf16x8*)(lds + FG_SA(b, h) + aoff + m * 2048 + k * 1024); } } while (0)
#define FG_LDB(dst, b, h) do { if (FP8) { _Pragma("unroll") for (int n = 0; n < 2; ++n) dst##8[n] = FG_LD8(lds + FG_SB(b, h) + boff + n * 2048); } \
      else { _Pragma("unroll") for (int n = 0; n < 2; ++n) _Pragma("unroll") for (int k = 0; k < 2; ++k) dst[n][k] = *(const LAS bf16x8*)(lds + FG_SB(b, h) + boff + n * 2048 + k * 1024); } } while (0)
#define FG_MMA(ai, bj, At, Bt) do { __builtin_amdgcn_s_setprio(1); if (FP8) { _Pragma("unroll") for (int m = 0; m < 4; ++m) _Pragma("unroll") for (int n = 0; n < 2; ++n) \
        asm volatile("v_mfma_scale_f32_16x16x128_f8f6f4 %0, %1, %2, %0, %3, %3 op_sel_hi:[0,0,0]" : "+v"(acc[ai][bj][m][n]) : "v"(Bt##8[n]), "v"(At##8[m]), "v"(sc127)); } \
      else { _Pragma("unroll") for (int m = 0; m < 4; ++m) _Pragma("unroll") for (int n = 0; n < 2; ++n) _Pragma("unroll") for (int k = 0; k < 2; ++k) \
        acc[ai][bj][m][n] = __builtin_amdgcn_mfma_f32_16x16x32_bf16(Bt[n][k], At[m][k], acc[ai][bj][m][n], 0, 0, 0); } __builtin_amdgcn_s_setprio(0); } while (0)
#define FG_WAIT_V(n) asm volatile("s_waitcnt vmcnt(" #n ")" ::: "memory")
#define FG_WAIT_L(n) asm volatile("s_waitcnt lgkmcnt(" #n ")" ::: "memory")
#define FG_BAR __builtin_amdgcn_s_barrier()
#define FG_SCHED __builtin_amdgcn_sched_barrier(0)
#define FG_GATHER(dst, u) do { if (GATHER) { int tz = threadIdx.x; asm volatile("" : "+v"(tz)); _Pragma("unroll") for (int i = 0; i < 2; ++i) { int sR, sC; stage_rc(tz * 16 + i * 8192, sR, sC); \
        _Pragma("unroll") for (int h = 0; h < 2; ++h) { int rr = sR + HALF * h; rr = rr < (u).nvalid ? rr : 0; const int tok = (u).rows ? (u).rows[rr] : ((u).arow0 + rr); dst[h][i] = (unsigned)(tok * lda + sC) * 2u; } } } } while (0)
    Unit cur, nxt; int ui = 0;
    if (!S.next(0, cur)) return;
    f32x4 acc[2][2][4][2];
#pragma unroll
    for (int a = 0; a < 2; ++a)
#pragma unroll
        for (int b = 0; b < 2; ++b)
#pragma unroll
            for (int m = 0; m < 4; ++m)
#pragma unroll
                for (int n = 0; n < 2; ++n) acc[a][b][m][n] = (f32x4){0.f, 0.f, 0.f, 0.f};
    const int sc127 = 127;
    bf16x8 At[4][2], B0[2][2], B1[2][2]; v8i_t At8[4], B08[2], B18[2];
    const char* cA = cur.A; const char* cB = cur.B;
    typename Epi::Pre pre; E.prefetch(pre, cur, wr, fr);
    FG_GATHER(voffA, cur);
    if (SP2) {
    FG_STAGEB(FG_SB(0, 0), cB, 0); FG_STAGEB(FG_SB(0, 1), cB, 1); FG_STAGEA(FG_SA(0, 0), cA, 0); FG_STAGEA(FG_SA(0, 1), cA, 1);
    if (wr == 1) FG_BAR;
    FG_WAIT_V(2); FG_BAR;
    FG_STAGEB(FG_SB(1, 0), cB + kstepB, 0); FG_STAGEA(FG_SA(1, 0), cA + kstep, 0); FG_STAGEB(FG_SB(1, 1), cB + kstepB, 1);
    FG_WAIT_V(6); FG_BAR;
    } else {
    FG_STAGEB(FG_SB(0, 0), cB, 0); FG_STAGEA(FG_SA(0, 0), cA, 0); FG_STAGEB(FG_SB(0, 1), cB, 1); FG_STAGEA(FG_SA(0, 1), cA, 1);
    if (wr == 1) FG_BAR;
    FG_WAIT_V(4); FG_BAR;
    FG_STAGEB(FG_SB(1, 0), cB + kstepB, 0); FG_STAGEA(FG_SA(1, 0), cA + kstep, 0); FG_STAGEB(FG_SB(1, 1), cB + kstepB, 1);
    FG_WAIT_V(6); FG_BAR;
    }
    for (;;) {
        const bool has_next = S.next(ui + 1, nxt);
        const char* nA = has_next ? nxt.A : cA; const char* nB = has_next ? nxt.B : cB;
        const int nt = cur.nkt;
#pragma unroll 1
        for (int t = 0; t < nt; t += 2) {
            const bool last = (t == nt - 2);
            const char* a1 = cA + (size_t)(t + 1) * kstep;
            const char* a2 = last ? nA : cA + (size_t)(t + 2) * kstep; const char* b2 = last ? nB : cB + (size_t)(t + 2) * kstepB;
            const char* a3 = a2 + kstep; const char* b3 = b2 + kstepB;
            if (SP2) {
            FG_LDB(B0, 0, 0); FG_LDB(B1, 0, 1); FG_SCHED; FG_LDA(At, 0, 0); FG_STAGEA(FG_SA(1, 1), a1, 1);
            if (GATHER && last && has_next) { FG_GATHER(voffA, nxt); }
            FG_WAIT_V(8); FG_WAIT_L(0); FG_BAR; FG_MMA(0, 0, At, B0); FG_MMA(0, 1, At, B1); FG_BAR; FG_SCHED;
            FG_LDA(At, 0, 1); FG_STAGEB(FG_SB(0, 0), b2, 0); FG_STAGEB(FG_SB(0, 1), b2, 1); FG_STAGEA(FG_SA(0, 0), a2, 0);
            FG_WAIT_V(8); FG_WAIT_L(0); FG_BAR; FG_MMA(1, 0, At, B0); FG_MMA(1, 1, At, B1); FG_BAR; FG_SCHED;
            FG_LDB(B0, 1, 0); FG_LDB(B1, 1, 1); FG_SCHED; FG_LDA(At, 1, 0); FG_STAGEA(FG_SA(0, 1), a2, 1);
            FG_WAIT_V(8); FG_WAIT_L(0); FG_BAR; FG_MMA(0, 0, At, B0); FG_MMA(0, 1, At, B1); FG_BAR; FG_SCHED;
            FG_LDA(At, 1, 1); FG_STAGEB(FG_SB(1, 0), b3, 0); FG_STAGEB(FG_SB(1, 1), b3, 1); FG_STAGEA(FG_SA(1, 0), a3, 0);
            FG_WAIT_V(8); FG_WAIT_L(0); FG_BAR; FG_MMA(1, 0, At, B0); FG_MMA(1, 1, At, B1); FG_BAR; FG_SCHED;
            } else {
            FG_LDB(B0, 0, 0); FG_SCHED; FG_LDA(At, 0, 0); FG_STAGEA(FG_SA(1, 1), a1, 1);
            if (GATHER && last && has_next) { FG_GATHER(voffA, nxt); }
            FG_WAIT_L(8); FG_BAR; FG_WAIT_L(0); if (var < 4) FG_MMA(0, 0, At, B0); FG_BAR; FG_SCHED;
            FG_LDB(B1, 0, 1); FG_STAGEB(FG_SB(0, 0), b2, 0);
            FG_BAR; FG_WAIT_L(0); if (var < 3) FG_MMA(0, 1, At, B1); FG_BAR;
            FG_LDA(At, 0, 1); FG_STAGEA(FG_SA(0, 0), a2, 0);
            FG_BAR; FG_WAIT_L(0); if (var < 4) FG_MMA(1, 0, At, B0); FG_BAR; FG_SCHED;
            FG_STAGEB(FG_SB(0, 1), b2, 1);
            FG_WAIT_V(6); FG_BAR; if (var < 3) FG_MMA(1, 1, At, B1); FG_BAR;
            FG_LDB(B0, 1, 0); FG_SCHED; FG_LDA(At, 1, 0); FG_STAGEA(FG_SA(0, 1), a2, 1);
            FG_WAIT_L(8); FG_BAR; FG_WAIT_L(0); if (var < 4) FG_MMA(0, 0, At, B0); FG_BAR; FG_SCHED;
            FG_LDB(B1, 1, 1); FG_STAGEB(FG_SB(1, 0), b3, 0);
            FG_BAR; FG_WAIT_L(0); if (var < 3) FG_MMA(0, 1, At, B1); FG_BAR;
            FG_LDA(At, 1, 1); FG_STAGEA(FG_SA(1, 0), a3, 0);
            FG_BAR; FG_WAIT_L(0); if (var < 4) FG_MMA(1, 0, At, B0); FG_BAR; FG_SCHED;
            FG_STAGEB(FG_SB(1, 1), b3, 1);
            FG_WAIT_V(6); FG_BAR; if (var < 3) FG_MMA(1, 1, At, B1); FG_BAR;
                    }
}
        if (SP2) { if (wr == 0) FG_BAR; }
        { int tz = threadIdx.x; asm volatile("" : "+v"(tz));
          const int wz = __builtin_amdgcn_readfirstlane(tz >> 6), lz = tz & 63; if (var != 2 && var != 9) E(acc, cur, wz >> 2, wz & 3, lz & 15, lz >> 4, pre); }
        if (!has_next) break;
#pragma unroll
        for (int a = 0; a < 2; ++a)
#pragma unroll
            for (int b = 0; b < 2; ++b)
#pragma unroll
                for (int m = 0; m < 4; ++m)
#pragma unroll
                    for (int n = 0; n < 2; ++n) acc[a][b][m][n] = (f32x4){0.f, 0.f, 0.f, 0.f};
        cur = nxt; cA = nA; cB = nB; ++ui;
        { int tz = threadIdx.x; asm volatile("" : "+v"(tz)); E.prefetch(pre, cur, __builtin_amdgcn_readfirstlane(tz >> 6) >> 2, tz & 15); }
        if (SP2) { if (wr == 1) FG_BAR; }
    }
    FG_WAIT_V(0);
    if (!SP2) { if (wr == 0) FG_BAR; }
    FG_BAR;
#undef FG_SA
#undef FG_SB
#undef FG_STAGE2
#undef FG_STAGEB
#undef FG_STAGEA
#undef FG_STAGEAX
#undef FG_LDA
#undef FG_LDB
#undef FG_MMA
#undef FG_LD8
#undef FG_WAIT_V
#undef FG_WAIT_L
#undef FG_BAR
#undef FG_SCHED
#undef FG_GATHER
}

struct DenseSched {
    const char* A; const char* B; int lda, ldb, nM, nN, nS, nkt, G, c, first;
    __device__ __forceinline__ bool next(int i, Unit& u) const {
        const int total = nM * nN * nS; const int per = (total + 7) / 8;
        int L;
        if (first == 1) {
            const int x = c & 7, r = c >> 3; if (r >= 16) { if (i >= 3) return false; L = x * 64 + (r - 16) * 3 + i; } else { if (i >= 1) return false; L = x * 64 + 48 + r; }
        } else {
        const int j = i * G + c; const int x = j & 7, q = j >> 3;
        if (q >= per) return false; L = x * per + q; if (L >= total) return false; }
        const int ks = L % nS, t2 = L / nS;
        const int nig = 8 * nN, gid = t2 / nig, fm = gid * 8, gsz = (nM - fm) < 8 ? (nM - fm) : 8;
        const int pm = fm + (t2 % nig) % gsz, pn = (t2 % nig) / gsz;
        u.A = A + ((size_t)pm * BM * lda + (size_t)ks * nkt * BK) * 2; u.B = B + ((size_t)pn * BM * ldb + (size_t)ks * nkt * 4096) * 2;
        if (first == 2) { u.A = A; u.B = B; }
        u.rows = nullptr; u.nkt = nkt; u.nvalid = BM; u.pm = pm; u.pn = pn; u.e = ks; u.arow0 = pm * BM; return true;
    }
};
struct NoPre {};
struct EpiBf16 {
    static constexpr int PERM = 1; typedef NoPre Pre; __device__ __forceinline__ void prefetch(Pre&, const Unit&, int, int) const {}
    bf16_t* O; int ldc, ncols; float scale;
    __device__ __forceinline__ void operator()(const f32x4 (&acc)[2][2][4][2], const Unit& u, int wr, int wc, int fr, int fq, const Pre& pre) const {
        const int row0 = u.pm * BM + wr * 64 + fr, col0 = u.pn * BM + wc * 32 + 8 * fq;
#pragma unroll
        for (int ai = 0; ai < 2; ++ai)
#pragma unroll
            for (int m = 0; m < 4; ++m) { bf16_t* rowp = O + (size_t)(row0 + ai * HALF + m * 16) * ldc + col0;
#pragma unroll
                for (int bj = 0; bj < 2; ++bj) { const f32x4 v0 = acc[ai][bj][m][0] * scale, v1 = acc[ai][bj][m][1] * scale;
                    u32x4 w; w.x = cvt_pk_bf16(v0[0], v0[1]); w.y = cvt_pk_bf16(v0[2], v0[3]); w.z = cvt_pk_bf16(v1[0], v1[1]); w.w = cvt_pk_bf16(v1[2], v1[3]);
                    if (col0 + bj * HALF + 8 <= ncols) *(u32x4*)(rowp + bj * HALF) = w; } }
    }
};
struct EpiBf16N {
    static constexpr int PERM = 1; typedef NoPre Pre; __device__ __forceinline__ void prefetch(Pre&, const Unit&, int, int) const {}
    bf16_t* O; int ldc, ncols; float scale;
    const float* gA; int pnA_end; const float* gB; int pnB_end; int half0_only; LAS float* part;
    __device__ __forceinline__ void operator()(const f32x4 (&acc)[2][2][4][2], const Unit& u, int wr, int wc, int fr, int fq, const Pre& pre) const {
        const int rt0 = wr * 64 + fr, row0 = u.pm * BM + rt0, col0 = u.pn * BM + wc * 32 + 8 * fq;
        const bool do_norm = u.pn < pnB_end;
        if (do_norm) {
#pragma unroll
            for (int ai = 0; ai < 2; ++ai)
#pragma unroll
                for (int m = 0; m < 4; ++m)
#pragma unroll
                    for (int bj = 0; bj < 2; ++bj) { if (half0_only && bj == 1) continue;
                        const f32x4 v0 = acc[ai][bj][m][0] * scale, v1 = acc[ai][bj][m][1] * scale;
                        float ss = (v0.x * v0.x + v0.y * v0.y) + (v0.z * v0.z + v0.w * v0.w) + (v1.x * v1.x + v1.y * v1.y) + (v1.z * v1.z + v1.w * v1.w);
                        ss += __shfl_xor(ss, 16); ss += __shfl_xor(ss, 32);
                        if (fq == 0) part[((rt0 + ai * HALF + m * 16) * 2 + bj) * 4 + wc] = ss; }
            asm volatile("s_waitcnt lgkmcnt(0)" ::: "memory"); __builtin_amdgcn_s_barrier(); asm volatile("" ::: "memory");
        }
        const float* g = (u.pn < pnA_end) ? gA : gB;
        f32x4 g0 = (f32x4){1.f, 1.f, 1.f, 1.f}, g1 = g0;
        if (do_norm) { g0 = *(const f32x4*)(g + wc * 32 + 8 * fq); g1 = *(const f32x4*)(g + wc * 32 + 8 * fq + 4); }
#pragma unroll
        for (int ai = 0; ai < 2; ++ai)
#pragma unroll
            for (int m = 0; m < 4; ++m) { const int rt = rt0 + ai * HALF + m * 16; bf16_t* rowp = O + (size_t)(row0 + ai * HALF + m * 16) * ldc + col0;
#pragma unroll
                for (int bj = 0; bj < 2; ++bj) { f32x4 v0 = acc[ai][bj][m][0] * scale, v1 = acc[ai][bj][m][1] * scale;
                    if (do_norm && !(half0_only && bj == 1)) { const f32x4 p4 = *(const LAS f32x4*)(part + (rt * 2 + bj) * 4);
                        const float r = 1.0f / sqrtf(((p4.x + p4.y) + (p4.z + p4.w)) * (1.0f / 128.f) + 1e-6f); v0 = v0 * r * g0; v1 = v1 * r * g1; }
                    u32x4 w; w.x = cvt_pk_bf16(v0[0], v0[1]); w.y = cvt_pk_bf16(v0[2], v0[3]); w.z = cvt_pk_bf16(v1[0], v1[1]); w.w = cvt_pk_bf16(v1[2], v1[3]);
                    if (col0 + bj * HALF + 8 <= ncols) *(u32x4*)(rowp + bj * HALF) = w; } }
    }
};
template <bool HAS_RES> struct EpiF32Res {
    static constexpr int PERM = 0; typedef NoPre Pre; __device__ __forceinline__ void prefetch(Pre&, const Unit&, int, int) const {}
    float* __restrict__ C; const float* __restrict__ res; int ldc; size_t slab; float scale;
    __device__ __forceinline__ void operator()(const f32x4 (&acc)[2][2][4][2], const Unit& u, int wr, int wc, int fr, int fq, const Pre& pre) const {
        const int row0 = u.pm * BM + wr * 64 + fr, col0 = u.pn * BM + wc * 32 + 4 * fq;
        float* __restrict__ Cb = C + (size_t)u.e * slab;
#pragma unroll
        for (int ai = 0; ai < 2; ++ai) {
            f32x4 r[4][2][2];
            if (HAS_RES) {
#pragma unroll
                for (int m = 0; m < 4; ++m) { const size_t o = (size_t)(row0 + ai * HALF + m * 16) * ldc + col0;
#pragma unroll
                    for (int bj = 0; bj < 2; ++bj)
#pragma unroll
                        for (int n = 0; n < 2; ++n) r[m][bj][n] = __builtin_nontemporal_load((const f32x4*)(res + o + bj * HALF + n * 16)); }
            }
#pragma unroll
            for (int m = 0; m < 4; ++m) { const size_t o = (size_t)(row0 + ai * HALF + m * 16) * ldc + col0;
#pragma unroll
                for (int bj = 0; bj < 2; ++bj)
#pragma unroll
                    for (int n = 0; n < 2; ++n) { f32x4 v = acc[ai][bj][m][n] * scale; if (HAS_RES) v = v + r[m][bj][n]; *(f32x4*)(Cb + o + bj * HALF + n * 16) = v; } }
        }
    }
};
struct MoeTabs { const LAS int* cnt; const LAS int* mtp; };
template <int PHASE  >
struct MoeSched {
    MoeTabs T; const char* A; const char* B; const int* rowtok; int G, c;
    __device__ __forceinline__ bool next(int i, Unit& u) const {
        constexpr int NT = (PHASE == 1) ? 4 : 16;
        const int nm = T.mtp[(PHASE == 1) ? 65 : 64], total = nm * NT, per = (total + 7) / 8;
        const int j = i * G + c, x = j & 7, q = j >> 3;
        if (q >= per) return false; const int L = x * per + q; if (L >= total) return false;
        int mti, pn;
        if (PHASE == 1) { mti = L / NT; pn = L % NT; }
        else { mti = L / NT; pn = 0; }
        int e = 0;
#pragma unroll 1
        for (int s2 = 32; s2 >= 1; s2 >>= 1) { if (e + s2 <= 64 && T.mtp[e + s2] <= mti) e += s2; }
        while (T.mtp[e + 1] <= mti) ++e;
        e = __builtin_amdgcn_readfirstlane(e);
        int mt = mti - T.mtp[e];
        if (PHASE == 2) {
            const int nme = T.mtp[e + 1] - T.mtp[e], r = L - T.mtp[e] * NT, ph = r / (nme * 8), r2 = r % (nme * 8);
            mt = r2 >> 3; pn = ph * 8 + (r2 & 7); mti = T.mtp[e] + mt; }
        int nv = T.cnt[e] - mt * 256; nv = nv < 256 ? nv : 256;
        u.nvalid = nv; u.pm = mti; u.pn = pn; u.e = e;
        if (PHASE == 1) { u.A = A; u.B = B + ((size_t)e * 1024 + (size_t)pn * 256) * DM; u.rows = (e < NE) ? rowtok + e * CAP + mt * 256 : nullptr; u.arow0 = mt * 256; u.nkt = DM / 128; }
        else { u.A = A + (size_t)mti * 256 * EFF; u.B = B + ((size_t)e * DM + (size_t)pn * 256) * EFF; u.rows = nullptr; u.arow0 = mt * 256; u.nkt = EFF / 128; }
        return true;
    }
};
struct EpiSwiglu {
    static constexpr int PERM = 1;
    struct Pre { float ssv[2][4]; };
    bf16_t* H; const float* ss;
    __device__ __forceinline__ void prefetch(Pre& pre, const Unit& u, int wr, int fr) const {
        const int r0 = wr * 64 + fr;
#pragma unroll
        for (int ai = 0; ai < 2; ++ai)
#pragma unroll
            for (int m = 0; m < 4; ++m) { int rr = r0 + ai * HALF + m * 16; rr = rr < u.nvalid ? rr : 0; const int tok = u.rows ? u.rows[rr] : (u.arow0 + rr); pre.ssv[ai][m] = ss[tok]; } }
    __device__ __forceinline__ void operator()(const f32x4 (&acc)[2][2][4][2], const Unit& u, int wr, int wc, int fr, int fq, const Pre& pre) const {
        const int r0 = wr * 64 + fr, col0 = u.pn * 128 + wc * 32 + 8 * fq;
#pragma unroll
        for (int ai = 0; ai < 2; ++ai)
#pragma unroll
            for (int m = 0; m < 4; ++m) { const int r = r0 + ai * HALF + m * 16;
                const float rs = pre.ssv[ai][m] * (1.0f / (T_SCALE * WGU_SCALE));
                float h[8];
#pragma unroll
                for (int n = 0; n < 2; ++n)
#pragma unroll
                    for (int j = 0; j < 4; ++j) { const float g = acc[ai][0][m][n][j] * rs, up = acc[ai][1][m][n][j] * rs; h[n * 4 + j] = g * __builtin_amdgcn_rcpf(1.0f + __expf(-g)) * up; }
                u32x2 w; w.x = pk4_fp8(h[0] * H_SCALE, h[1] * H_SCALE, h[2] * H_SCALE, h[3] * H_SCALE); w.y = pk4_fp8(h[4] * H_SCALE, h[5] * H_SCALE, h[6] * H_SCALE, h[7] * H_SCALE);
                if (r < u.nvalid) *(u32x2*)((unsigned char*)H + ((size_t)u.pm * 256 + r) * EFF + col0) = w; }
    }
};
struct EpiScatter {
    static constexpr int PERM = 2;
    struct Pre { int dst[2][4]; float gt[2][4]; };
    unsigned char* Y; const int* rowdst; const float* rowgate; const LAS int* mtp;
    __device__ __forceinline__ void prefetch(Pre& pre, const Unit& u, int wr, int fr) const {
        const int r0 = wr * 64 + fr, lbase = u.e * CAP + (u.pm - mtp[u.e]) * 256;
#pragma unroll
        for (int ai = 0; ai < 2; ++ai)
#pragma unroll
            for (int m = 0; m < 4; ++m) { const int r = r0 + ai * HALF + m * 16; const bool ok = r < u.nvalid; pre.dst[ai][m] = ok ? rowdst[lbase + r] : -1; pre.gt[ai][m] = ok ? rowgate[lbase + r] : 0.f; } }
    __device__ __forceinline__ void operator()(const f32x4 (&acc)[2][2][4][2], const Unit& u, int wr, int wc, int fr, int fq, const Pre& pre) const {
        const int col0 = u.pn * BM + wc * 64 + 16 * fq;
#pragma unroll
        for (int ai = 0; ai < 2; ++ai)
#pragma unroll
            for (int m = 0; m < 4; ++m) { if (pre.dst[ai][m] >= 0) { const float g = pre.gt[ai][m] * (Y_SCALE / (H_SCALE * WD_SCALE));
                const f32x4 v0 = acc[ai][0][m][0] * g, v1 = acc[ai][0][m][1] * g, v2 = acc[ai][1][m][0] * g, v3 = acc[ai][1][m][1] * g;
                u32x4 w; w.x = pk4_fp8(v0[0], v0[1], v0[2], v0[3]); w.y = pk4_fp8(v1[0], v1[1], v1[2], v1[3]); w.z = pk4_fp8(v2[0], v2[1], v2[2], v2[3]); w.w = pk4_fp8(v3[0], v3[1], v3[2], v3[3]);
                *(u32x4*)(Y + (size_t)pre.dst[ai][m] * DM + col0) = w; } }
    }
};
struct EpiShared {
    static constexpr int PERM = 2; typedef NoPre Pre; __device__ __forceinline__ void prefetch(Pre&, const Unit&, int, int) const {}
    unsigned char* Y9;
    __device__ __forceinline__ void operator()(const f32x4 (&acc)[2][2][4][2], const Unit& u, int wr, int wc, int fr, int fq, const Pre& pre) const {
        const int col0 = u.pn * BM + wc * 64 + 16 * fq; const float g = Y_SCALE / (H_SCALE * WD_SCALE);
#pragma unroll
        for (int ai = 0; ai < 2; ++ai)
#pragma unroll
            for (int m = 0; m < 4; ++m) { const int row = u.pm * BM + ai * HALF + wr * 64 + m * 16 + fr;
                const f32x4 v0 = acc[ai][0][m][0] * g, v1 = acc[ai][0][m][1] * g, v2 = acc[ai][1][m][0] * g, v3 = acc[ai][1][m][1] * g;
                u32x4 w; w.x = pk4_fp8(v0[0], v0[1], v0[2], v0[3]); w.y = pk4_fp8(v1[0], v1[1], v1[2], v1[3]); w.z = pk4_fp8(v2[0], v2[1], v2[2], v2[3]); w.w = pk4_fp8(v3[0], v3[1], v3[2], v3[3]);
                *(u32x4*)(Y9 + (size_t)row * DM + col0) = w; }
    }
};
struct EpiResStat {
    static constexpr int PERM = 0; typedef NoPre Pre; __device__ __forceinline__ void prefetch(Pre&, const Unit&, int, int) const {}
    float* __restrict__ C; const float* __restrict__ res; bf16_t* __restrict__ Xb; const float* __restrict__ g; float* ss; int ldc; float scale;
    __device__ __forceinline__ void operator()(const f32x4 (&acc)[2][2][4][2], const Unit& u, int wr, int wc, int fr, int fq, const Pre& pre) const {
        const int row0 = u.pm * BM + wr * 64 + fr, col0 = u.pn * BM + wc * 32 + 4 * fq;
        f32x4 gv[2][2];
#pragma unroll
        for (int bj = 0; bj < 2; ++bj)
#pragma unroll
            for (int n = 0; n < 2; ++n) gv[bj][n] = *(const f32x4*)(g + col0 + bj * HALF + n * 16);
#pragma unroll
        for (int ah = 0; ah < 4; ++ah) { const int ai = ah >> 1, mb = (ah & 1) * 2;
            f32x4 r[4][2][2];
#pragma unroll
            for (int m = mb; m < mb + 2; ++m) { const size_t o = (size_t)(row0 + ai * HALF + m * 16) * ldc + col0;
#pragma unroll
                for (int bj = 0; bj < 2; ++bj)
#pragma unroll
                    for (int n = 0; n < 2; ++n) r[m][bj][n] = __builtin_nontemporal_load((const f32x4*)(res + o + bj * HALF + n * 16)); }
#pragma unroll
            for (int m = mb; m < mb + 2; ++m) { const int row = row0 + ai * HALF + m * 16; const size_t o = (size_t)row * ldc + col0; float sq = 0.f;
#pragma unroll
                for (int bj = 0; bj < 2; ++bj)
#pragma unroll
                    for (int n = 0; n < 2; ++n) { const f32x4 v = acc[ai][bj][m][n] * scale + r[m][bj][n]; *(f32x4*)(C + o + bj * HALF + n * 16) = v;
                        sq += (v.x * v.x + v.y * v.y) + (v.z * v.z + v.w * v.w);
                        const f32x4 w = v * gv[bj][n]; u32x2 pk; pk.x = cvt_pk_bf16(w.x, w.y); pk.y = cvt_pk_bf16(w.z, w.w); *(u32x2*)(Xb + o + bj * HALF + n * 16) = pk; }
                sq += __shfl_xor(sq, 16); sq += __shfl_xor(sq, 32);
                if (fq == 0) ss[(size_t)row * 64 + u.pn * 4 + wc] = sq; }
        }
    }
};
struct EpiX2 {
    static constexpr int PERM = 1; typedef NoPre Pre; __device__ __forceinline__ void prefetch(Pre&, const Unit&, int, int) const {}
    float* __restrict__ C; const float* __restrict__ res; bf16_t* __restrict__ Th; bf16_t* __restrict__ Tl; unsigned char* __restrict__ T8; const float* __restrict__ g; float* ss; int ldc;
    __device__ __forceinline__ void operator()(const f32x4 (&acc)[2][2][4][2], const Unit& u, int wr, int wc, int fr, int fq, const Pre& pre) const {
        const int row0 = u.pm * BM + wr * 64 + fr, col0 = u.pn * BM + wc * 32 + 8 * fq;
        f32x4 gv[2][2];
#pragma unroll
        for (int bj = 0; bj < 2; ++bj)
#pragma unroll
            for (int n = 0; n < 2; ++n) gv[bj][n] = *(const f32x4*)(g + col0 + bj * HALF + n * 4);
#pragma unroll
        for (int ah = 0; ah < 4; ++ah) { const int ai = ah >> 1, mb = (ah & 1) * 2;
            f32x4 r[4][2][2];
#pragma unroll
            for (int m = mb; m < mb + 2; ++m) { const size_t o = (size_t)(row0 + ai * HALF + m * 16) * ldc + col0;
#pragma unroll
                for (int bj = 0; bj < 2; ++bj)
#pragma unroll
                    for (int n = 0; n < 2; ++n) r[m][bj][n] = __builtin_nontemporal_load((const f32x4*)(res + o + bj * HALF + n * 4)); }
#pragma unroll
            for (int m = mb; m < mb + 2; ++m) { const int row = row0 + ai * HALF + m * 16; const size_t o = (size_t)row * ldc + col0; float sq = 0.f;
#pragma unroll
                for (int bj = 0; bj < 2; ++bj) {
                    const f32x4 v0 = acc[ai][bj][m][0] + r[m][bj][0], v1 = acc[ai][bj][m][1] + r[m][bj][1];
                    *(f32x4*)(C + o + bj * HALF) = v0; *(f32x4*)(C + o + bj * HALF + 4) = v1;
                    sq += (v0.x * v0.x + v0.y * v0.y) + (v0.z * v0.z + v0.w * v0.w) + (v1.x * v1.x + v1.y * v1.y) + (v1.z * v1.z + v1.w * v1.w);
                    const f32x4 w0 = v0 * gv[bj][0], w1 = v1 * gv[bj][1];
                    u32x4 h; h.x = cvt_pk_bf16(w0.x, w0.y); h.y = cvt_pk_bf16(w0.z, w0.w); h.z = cvt_pk_bf16(w1.x, w1.y); h.w = cvt_pk_bf16(w1.z, w1.w);
                    u32x4 l; l.x = cvt_pk_bf16(w0.x - __uint_as_float(h.x << 16), w0.y - __uint_as_float(h.x & 0xffff0000u)); l.y = cvt_pk_bf16(w0.z - __uint_as_float(h.y << 16), w0.w - __uint_as_float(h.y & 0xffff0000u));
                    l.z = cvt_pk_bf16(w1.x - __uint_as_float(h.z << 16), w1.y - __uint_as_float(h.z & 0xffff0000u)); l.w = cvt_pk_bf16(w1.z - __uint_as_float(h.w << 16), w1.w - __uint_as_float(h.w & 0xffff0000u));
                    u32x2 q8; q8.x = pk4_fp8(w0.x * T_SCALE, w0.y * T_SCALE, w0.z * T_SCALE, w0.w * T_SCALE); q8.y = pk4_fp8(w1.x * T_SCALE, w1.y * T_SCALE, w1.z * T_SCALE, w1.w * T_SCALE);
                    *(u32x4*)(Th + o + bj * HALF) = h; *(u32x4*)(Tl + o + bj * HALF) = l; *(u32x2*)(T8 + o + bj * HALF) = q8; }
                sq += __shfl_xor(sq, 16); sq += __shfl_xor(sq, 32);
                if (fq == 0) ss[(size_t)row * 64 + u.pn * 4 + wc] = sq; }
        }
    }
};
}

namespace fa {
typedef short s16x4 __attribute__((ext_vector_type(4)));
typedef float f32x16 __attribute__((ext_vector_type(16)));
constexpr int SHM_V = 16384, SHM_K = 16384, SHM_K2 = 8192;
constexpr int OFF_V = 0, OFF_K = 2 * SHM_V, OFF_K2 = OFF_K + 2 * SHM_K, OFF_WS = OFF_K2 + 2 * SHM_K2, OFF_TBL = OFF_WS + 8 * 64 * 4, OFF_QPE = OFF_TBL + 1024, LDS_ATTN = OFF_QPE + 8 * 4096;
#define KSWZ(row, colB) ((row) * 256 + ((colB) ^ (((row) & 7) << 4)))
#define KSWZ2(row, colB) ((row) * 128 + ((colB) ^ (((row) & 7) << 4)))
#define SBAR() __builtin_amdgcn_sched_barrier(0)
__device__ __forceinline__ int crow(int r, int hi) { return (r & 3) + 8 * (r >> 2) + 4 * hi; }
__device__ __forceinline__ unsigned cvtpk(float lo, float hi) { unsigned r; asm volatile("v_cvt_pk_bf16_f32 %0, %1, %2" : "=v"(r) : "v"(lo), "v"(hi)); return r; }
constexpr float MIX_SCALE = 64.0f;
__device__ __forceinline__ unsigned fg_pk4_fp8(float a, float b, float c, float d) { int w = 0; w = __builtin_amdgcn_cvt_pk_fp8_f32(a, b, w, false); w = __builtin_amdgcn_cvt_pk_fp8_f32(c, d, w, true); return (unsigned)w; }
template <int MODE> struct Cf { static constexpr float SCALE = (MODE == 1) ? 0.07216878364870323f : 0.08838834764831845f; static constexpr float C = SCALE * 1.4426950408889634f; static constexpr float THRS = 8.0f / SCALE; };

template <int MODE>
__device__ __forceinline__ void partialSM(f32x16& p0, f32x16& p1, float& m_reg, float& mn, float& alpha) {
  constexpr float C = Cf<MODE>::C;
  float pmax = p0[0];
#pragma unroll
  for (int r = 1; r < 16; ++r) pmax = fmaxf(pmax, p0[r]);
#pragma unroll
  for (int r = 0; r < 16; ++r) pmax = fmaxf(pmax, p1[r]);
  { auto rr = __builtin_amdgcn_permlane32_swap(__float_as_uint(pmax), __float_as_uint(pmax), false, false);
    pmax = fmaxf(__uint_as_float(rr[0]), __uint_as_float(rr[1])); }
  if (__builtin_expect(__all(pmax - m_reg <= Cf<MODE>::THRS), 1)) { mn = m_reg; alpha = 1.f; }
  else { mn = fmaxf(m_reg, pmax); alpha = __builtin_amdgcn_exp2f((m_reg - mn) * C); m_reg = mn; }
  const float mnC = -mn * C;
#pragma unroll
  for (int r = 0; r < 16; ++r) p0[r] = fmaf(p0[r], C, mnC);
#pragma unroll
  for (int r = 0; r < 16; ++r) p1[r] = fmaf(p1[r], C, mnC);
#pragma unroll
  for (int r = 0; r < 16; ++r) p0[r] = __builtin_amdgcn_exp2f(p0[r]);
}
__device__ __forceinline__ void finishSM(f32x16& p0, f32x16& p1, float alpha, float& l_reg, bf16x8& pa0, bf16x8& pa1, bf16x8& pa2, bf16x8& pa3) {
#pragma unroll
  for (int r = 0; r < 16; ++r) p1[r] = __builtin_amdgcn_exp2f(p1[r]);
  float ps = 0;
#pragma unroll
  for (int r = 0; r < 16; ++r) ps += p0[r];
#pragma unroll
  for (int r = 0; r < 16; ++r) ps += p1[r];
  { auto rr = __builtin_amdgcn_permlane32_swap(__float_as_uint(ps), __float_as_uint(ps), false, false);
    ps = __uint_as_float(rr[0]) + __uint_as_float(rr[1]); }
  l_reg = l_reg * alpha + ps;
#define PK4(P, BASE, OUT) do { unsigned a0 = cvtpk(P[BASE + 0], P[BASE + 1]), a1 = cvtpk(P[BASE + 2], P[BASE + 3]);   \
    unsigned b0 = cvtpk(P[BASE + 4], P[BASE + 5]), b1 = cvtpk(P[BASE + 6], P[BASE + 7]);                              \
    auto r0 = __builtin_amdgcn_permlane32_swap(a0, b0, false, false); auto r1 = __builtin_amdgcn_permlane32_swap(a1, b1, false, false); \
    u32x4 w = {r0[0], r1[0], r0[1], r1[1]}; OUT = *reinterpret_cast<bf16x8*>(&w); } while (0)
  PK4(p0, 0, pa0); PK4(p0, 8, pa1); PK4(p1, 0, pa2); PK4(p1, 8, pa3);
#undef PK4
}
template <int MODE>
__device__ __forceinline__ void qkt(f32x16& p0, f32x16& p1, const LAS char* Ks, const LAS char* K2s, const bf16x8* qr, int r32, int hi, const LAS char* qpe) {
  p0 = f32x16{}; p1 = f32x16{};
#pragma unroll
  for (int d0 = 0; d0 < 8; ++d0) { const int cb = (d0 * 16 + hi * 8) * 2;
    const bf16x8 b0 = *reinterpret_cast<const LAS bf16x8*>(Ks + KSWZ(r32, cb));
    const bf16x8 b1 = *reinterpret_cast<const LAS bf16x8*>(Ks + KSWZ(32 + r32, cb));
    p0 = __builtin_amdgcn_mfma_f32_32x32x16_bf16(b0, qr[d0], p0, 0, 0, 0);
    p1 = __builtin_amdgcn_mfma_f32_32x32x16_bf16(b1, qr[d0], p1, 0, 0, 0); }
  if (MODE == 1) {
#pragma unroll
    for (int d0 = 0; d0 < 4; ++d0) { const int cb = (d0 * 16 + hi * 8) * 2;
      const bf16x8 b0 = *reinterpret_cast<const LAS bf16x8*>(K2s + KSWZ2(r32, cb));
      const bf16x8 b1 = *reinterpret_cast<const LAS bf16x8*>(K2s + KSWZ2(32 + r32, cb));
      const bf16x8 qp = *reinterpret_cast<const LAS bf16x8*>(qpe + d0 * 1024);
      p0 = __builtin_amdgcn_mfma_f32_32x32x16_bf16(b0, qp, p0, 0, 0, 0);
      p1 = __builtin_amdgcn_mfma_f32_32x32x16_bf16(b1, qp, p1, 0, 0, 0); }
  }
}
__device__ __forceinline__ int v_st(int k, int c) { const int kk = (k & ~0xC) | ((k & 4) << 1) | ((k & 8) >> 1); return ((kk >> 3) * 4 + (c >> 5)) * 512 + ((kk & 7) * 32 + (c & 31)) * 2; }
__device__ __forceinline__ int v_rd_base(int lane) { return ((lane & 3) << 3) | (((lane >> 2) & 3) << 6) | (((lane >> 4) & 1) << 5) | (((lane >> 5) & 1) << 8); }
constexpr int v_rd_off(int d0, int ks, int half) { return d0 * 512 + ks * 4096 + half * 2048; }
template <int OFF> __device__ __forceinline__ s16x4 tr_read(int vb) { s16x4 r; asm volatile("ds_read_b64_tr_b16 %0, %1 offset:%2" : "=&v"(r) : "v"(vb), "i"(OFF) : "memory"); return r; }
template <int D0> __device__ __forceinline__ void pv_one(f32x16& od, int vb, bf16x8 pa0, bf16x8 pa1, bf16x8 pa2, bf16x8 pa3) {
  const s16x4 l0 = tr_read<v_rd_off(D0, 0, 0)>(vb), h0 = tr_read<v_rd_off(D0, 0, 1)>(vb), l1 = tr_read<v_rd_off(D0, 1, 0)>(vb), h1 = tr_read<v_rd_off(D0, 1, 1)>(vb);
  const s16x4 l2 = tr_read<v_rd_off(D0, 2, 0)>(vb), h2 = tr_read<v_rd_off(D0, 2, 1)>(vb), l3 = tr_read<v_rd_off(D0, 3, 0)>(vb), h3 = tr_read<v_rd_off(D0, 3, 1)>(vb);
  asm volatile("s_waitcnt lgkmcnt(0)" ::: "memory"); SBAR();
#define PK(L, H) (bf16x8){L[0], L[1], L[2], L[3], H[0], H[1], H[2], H[3]}
  od = __builtin_amdgcn_mfma_f32_32x32x16_bf16(pa0, PK(l0, h0), od, 0, 0, 0);
  od = __builtin_amdgcn_mfma_f32_32x32x16_bf16(pa1, PK(l1, h1), od, 0, 0, 0);
  od = __builtin_amdgcn_mfma_f32_32x32x16_bf16(pa2, PK(l2, h2), od, 0, 0, 0);
  od = __builtin_amdgcn_mfma_f32_32x32x16_bf16(pa3, PK(l3, h3), od, 0, 0, 0);
#undef PK
}
__device__ __forceinline__ void pv_d0(f32x16* o, int vb, bf16x8 pa0, bf16x8 pa1, bf16x8 pa2, bf16x8 pa3) {
  pv_one<0>(o[0], vb, pa0, pa1, pa2, pa3); pv_one<1>(o[1], vb, pa0, pa1, pa2, pa3); pv_one<2>(o[2], vb, pa0, pa1, pa2, pa3); pv_one<3>(o[3], vb, pa0, pa1, pa2, pa3);
}
struct Args { const bf16_t* Q; const bf16_t* K1; const bf16_t* K2; const bf16_t* V; bf16_t* O; int kt0, NT, qch0; };
template <int MODE> struct St {
    static constexpr int LDQ = (MODE == 0) ? INW : (MODE == 1 ? 3072 : 512), LDK1 = (MODE == 0) ? INW : (MODE == 1 ? 4096 : 1024), LDK2 = INW, LDV = LDK1, LDO = (MODE == 2) ? 512 : DM; };
template <int MODE>
__device__ __forceinline__ void mask_bias(f32x16& p0, f32x16& p1, int qch, int kch, int qpos, int hi, const LAS float* tbl) {
  const bool valid = (MODE == 2) || ((kch <= qch) && (MODE == 1 || kch >= qch - 8));
  if (!valid) {
#pragma unroll
    for (int r = 0; r < 16; ++r) { p0[r] = -INFINITY; p1[r] = -INFINITY; }
  } else if (MODE == 0) {
    if (qch - kch >= 3) { const float b = tbl[191];
#pragma unroll
      for (int r = 0; r < 16; ++r) { p0[r] += b; p1[r] += b; }
    } else { const int base = qpos - kch * 64 + 63 - 4 * hi;
#pragma unroll
      for (int g = 0; g < 4; ++g) {
#pragma unroll
        for (int r = 4 * g; r < 4 * g + 4; ++r) { int d0 = base - ((r & 3) + 8 * (r >> 2)), d1 = d0 - 32;
          d0 = d0 < 0 ? 0 : (d0 > 191 ? 191 : d0); d1 = d1 < 0 ? 0 : (d1 > 191 ? 191 : d1);
          p0[r] += tbl[d0]; p1[r] += tbl[d1]; }
        SBAR();
      }
    }
  }
}
template <int MODE>
__device__ __forceinline__ void attn_body(const Args& a, LAS char* lds) {
  constexpr int NQ = 8;
  int tid = threadIdx.x; asm volatile("" : "+v"(tid));
  const int wid = tid >> 6, lane = tid & 63, r32 = lane & 31, hi = lane >> 5;
  LAS char* V_lds = lds + OFF_V; LAS char* K_lds = lds + OFF_K; LAS char* K2_lds = lds + OFF_K2;
  LAS float* ws = (LAS float*)(lds + OFF_WS) + wid * 64; LAS float* li_l = ws; LAS float* al_l = ws + 32;
  const LAS float* tbl = (const LAS float*)(lds + OFF_TBL);
  float m_reg = -1e30f, l_reg = 0; f32x16 o[4] = {}; bf16x8 qr[NQ];
  const bf16_t* Qw = a.Q + (wid * 32 + r32) * St<MODE>::LDQ + hi * 8;
#pragma unroll
  for (int d0 = 0; d0 < NQ; ++d0) qr[d0] = *reinterpret_cast<const bf16x8*>(Qw + d0 * 16);
  const LAS char* qpe = lds + OFF_QPE + wid * 4096 + lane * 16;
  if (MODE == 1) {
#pragma unroll
    for (int d0 = 0; d0 < 4; ++d0) *(LAS bf16x8*)(lds + OFF_QPE + wid * 4096 + lane * 16 + d0 * 1024) = *reinterpret_cast<const bf16x8*>(Qw + 128 + d0 * 16);
  }
  const int sr = tid >> 4, sc = (tid & 15) * 8, vst0 = v_st(sr, sc), vst1 = v_st(32 + sr, sc);
  const int s2r = tid >> 3, s2c = (tid & 7) * 8;
  const int vb0 = (int)(uintptr_t)V_lds + v_rd_base(lane);
  const int qch = a.qch0 + (wid >> 1), qpos = a.qch0 * 64 + wid * 32 + r32;
  bf16x8 vs0, vs1, ks0, ks1, k2s;
  const unsigned ovk = (unsigned)(sr * St<MODE>::LDK1 + sc) * 2u, ok2 = (unsigned)(s2r * St<MODE>::LDK2 + s2c) * 2u;
#define SLOAD(j) do { const size_t k0_ = (size_t)(a.kt0 + (j)) * 64; \
    const char* vt_ = (const char*)(a.V + k0_ * St<MODE>::LDV); const char* kt_ = (const char*)(a.K1 + k0_ * St<MODE>::LDK1); \
    vs0 = *reinterpret_cast<const bf16x8*>(vt_ + ovk); vs1 = *reinterpret_cast<const bf16x8*>(vt_ + 64 * St<MODE>::LDV + ovk); \
    ks0 = *reinterpret_cast<const bf16x8*>(kt_ + ovk); ks1 = *reinterpret_cast<const bf16x8*>(kt_ + 64 * St<MODE>::LDK1 + ovk); \
    if (MODE == 1) k2s = *reinterpret_cast<const bf16x8*>((const char*)(a.K2 + k0_ * St<MODE>::LDK2) + ok2); } while (0)
#define SWRITE(b) do { *(LAS bf16x8*)(V_lds + (b) * SHM_V + vst0) = vs0; *(LAS bf16x8*)(V_lds + (b) * SHM_V + vst1) = vs1; const int kc = sc * 2; \
    *(LAS bf16x8*)(K_lds + (b) * SHM_K + KSWZ(sr, kc)) = ks0; *(LAS bf16x8*)(K_lds + (b) * SHM_K + KSWZ(32 + sr, kc)) = ks1; \
    if (MODE == 1) *(LAS bf16x8*)(K2_lds + (b) * SHM_K2 + KSWZ2(s2r, s2c * 2)) = k2s; } while (0)
#define SWAIT() asm volatile("s_waitcnt vmcnt(0)" ::: "memory")
#define RESC(al) do { if (__any((al) < 1.f)) { if (hi == 0) al_l[r32] = (al); asm volatile("s_waitcnt lgkmcnt(0)" ::: "memory"); \
    _Pragma("unroll") for (int d = 0; d < 4; ++d) _Pragma("unroll") for (int r = 0; r < 16; ++r) o[d][r] *= al_l[crow(r, hi)]; } } while (0)
  f32x16 pA0, pA1, pB0, pB1; float mnA, mnB, alA, alB; bf16x8 pa0, pa1, pa2, pa3; const int NT = a.NT;
  SLOAD(0); SWAIT(); SWRITE(0); __syncthreads();
  qkt<MODE>(pA0, pA1, K_lds, K2_lds, qr, r32, hi, qpe); mask_bias<MODE>(pA0, pA1, qch, a.kt0, qpos, hi, tbl); partialSM<MODE>(pA0, pA1, m_reg, mnA, alA);
  SLOAD(1);
  SWAIT(); SWRITE(1); __syncthreads();
  for (int j = 1; j + 1 < NT; j += 2) {
    SBAR(); qkt<MODE>(pB0, pB1, K_lds + SHM_K, K2_lds + SHM_K2, qr, r32, hi, qpe); mask_bias<MODE>(pB0, pB1, qch, a.kt0 + j, qpos, hi, tbl);
    finishSM(pA0, pA1, alA, l_reg, pa0, pa1, pa2, pa3); SBAR();
    SLOAD(j + 1); SBAR();
    pv_d0(o, vb0, pa0, pa1, pa2, pa3); partialSM<MODE>(pB0, pB1, m_reg, mnB, alB);
    __syncthreads(); SWAIT(); SWRITE(0);
    RESC(alB); __syncthreads();
    SBAR(); qkt<MODE>(pA0, pA1, K_lds, K2_lds, qr, r32, hi, qpe); mask_bias<MODE>(pA0, pA1, qch, a.kt0 + j + 1, qpos, hi, tbl);
    finishSM(pB0, pB1, alB, l_reg, pa0, pa1, pa2, pa3); SBAR();
    SLOAD(j + 2); SBAR();
    pv_d0(o, vb0 + SHM_V, pa0, pa1, pa2, pa3); partialSM<MODE>(pA0, pA1, m_reg, mnA, alA);
    __syncthreads(); SWAIT(); SWRITE(1);
    RESC(alA); __syncthreads();
  }
  SBAR(); qkt<MODE>(pB0, pB1, K_lds + SHM_K, K2_lds + SHM_K2, qr, r32, hi, qpe); mask_bias<MODE>(pB0, pB1, qch, a.kt0 + NT - 1, qpos, hi, tbl);
  finishSM(pA0, pA1, alA, l_reg, pa0, pa1, pa2, pa3); SBAR();
  pv_d0(o, vb0, pa0, pa1, pa2, pa3); partialSM<MODE>(pB0, pB1, m_reg, mnB, alB);
  __syncthreads(); RESC(alB);
  finishSM(pB0, pB1, alB, l_reg, pa0, pa1, pa2, pa3); SBAR();
  pv_d0(o, vb0 + SHM_V, pa0, pa1, pa2, pa3);
  if (hi == 0) li_l[r32] = l_reg; asm volatile("s_waitcnt lgkmcnt(0)" ::: "memory");
  if (MODE != 2) {
    unsigned char* Ow8 = (unsigned char*)a.O + (size_t)(wid * 32) * DM;
    const int qi = lane & 3;
#pragma unroll
    for (int rg = 0; rg < 4; ++rg) {
      float rl[4];
#pragma unroll
      for (int j = 0; j < 4; ++j) rl[j] = __builtin_amdgcn_rcpf(li_l[crow(4 * rg + j, hi)]) * MIX_SCALE;
#pragma unroll
      for (int d0 = 0; d0 < 4; ++d0) { float v[4];
#pragma unroll
        for (int j = 0; j < 4; ++j) v[j] = o[d0][4 * rg + j] * rl[j];
        { const float s0 = (qi & 1) ? v[0] : v[1], s1 = (qi & 1) ? v[2] : v[3]; const float t0 = __shfl_xor(s0, 1), t1 = __shfl_xor(s1, 1);
          if (qi & 1) { v[0] = t0; v[2] = t1; } else { v[1] = t0; v[3] = t1; } }
        { const float s0 = (qi & 2) ? v[0] : v[2], s1 = (qi & 2) ? v[1] : v[3]; const float t0 = __shfl_xor(s0, 2), t1 = __shfl_xor(s1, 2);
          if (qi & 2) { v[0] = t0; v[1] = t1; } else { v[2] = t0; v[3] = t1; } }
        const int orow = 8 * rg + 4 * hi + qi;
        *(unsigned*)(Ow8 + (size_t)orow * DM + d0 * 32 + (r32 & ~3)) = fg_pk4_fp8(v[0], v[1], v[2], v[3]); } }
  } else {
  bf16_t* Ow = a.O + (wid * 32) * St<MODE>::LDO;
  const int odd = lane & 1;
#pragma unroll
  for (int r = 0; r < 16; r += 2) { const float ra = __builtin_amdgcn_rcpf(li_l[crow(r, hi)]), rb = __builtin_amdgcn_rcpf(li_l[crow(r + 1, hi)]);
#pragma unroll
    for (int d0 = 0; d0 < 4; ++d0) { const float vA = o[d0][r] * ra, vB = o[d0][r + 1] * rb;
      const float pA = __shfl_xor(vA, 1), pB = __shfl_xor(vB, 1);
      const unsigned w = odd ? cvtpk(pB, vB) : cvtpk(vA, pA);
      const int orow = odd ? crow(r + 1, hi) : crow(r, hi);
      *(unsigned*)(Ow + orow * St<MODE>::LDO + d0 * 32 + (r32 & ~1)) = w; } }
  }
  __syncthreads();
#undef SLOAD
#undef SWRITE
#undef SWAIT
#undef RESC
}
#undef KSWZ
#undef KSWZ2
#undef SBAR
template <int MODE> __device__ __forceinline__ void attn_call(const bf16_t* Q, const bf16_t* K1, const bf16_t* K2, const bf16_t* V, bf16_t* O, int kt0, int NT, int qch0, LAS char* lds) {
  Args a{Q, K1, K2, V, O, kt0, NT, qch0}; attn_body<MODE>(a, lds);
}
}

#ifndef TVAR
#define TVAR 0
#endif
template <int VAR = 0>
__device__ __forceinline__ void transpose_item(const float* W, int K, int N, bf16_t* WT, int k0, int n0, int drow0, LAS float* scr, int lane) {
    float v[64];
    const float* src = W + (size_t)k0 * N + n0 + lane;
#pragma unroll
    for (int i = 0; i < 64; ++i) v[i] = __builtin_nontemporal_load(src + (size_t)i * N);
    if (VAR == 1) {
#pragma unroll
        for (int i = 0; i < 64; ++i) asm volatile("" :: "v"(v[i]));
        return; }
#pragma unroll
    for (int i = 0; i < 64; ++i) scr[i * 65 + lane] = v[i];
    asm volatile("s_waitcnt lgkmcnt(0)" ::: "memory");
    if (VAR == 2) { drow0 = 0; k0 = 0; }
    const int c = lane & 7;
#pragma unroll
    for (int j = 0; j < 8; ++j) { const int n = (lane >> 3) + 8 * j; const LAS float* sp = scr + (8 * c) * 65 + n;
        u32x4 o; o.x = fg::cvt_pk_bf16(sp[0 * 65], sp[1 * 65]); o.y = fg::cvt_pk_bf16(sp[2 * 65], sp[3 * 65]); o.z = fg::cvt_pk_bf16(sp[4 * 65], sp[5 * 65]); o.w = fg::cvt_pk_bf16(sp[6 * 65], sp[7 * 65]);
        *(u32x4*)(WT + ((size_t)(drow0 >> 6) * (K >> 6) + (k0 >> 6)) * 4096 + n * 64 + 8 * c) = o; }
    asm volatile("s_waitcnt lgkmcnt(0)" ::: "memory");
}
__device__ __forceinline__ fg::MoeTabs moe_tables_fast(LAS int* tab, const unsigned* gcnt) {
    fg::MoeTabs T; T.cnt = tab; T.mtp = tab + 80;
    __syncthreads();
    if (threadIdx.x == 0) { int pm = 0;
        for (int e = 0; e <= NE; ++e) { const int c = (e < NE) ? (int)gcnt[64 * e] : NTOK; tab[e] = c; tab[80 + e] = pm; pm += (c + 255) / 256; }
        tab[80 + NE + 1] = pm; }
    __syncthreads();
    return T;
}
__device__ __forceinline__ void transpose_item_fp8(const float* W, int K, int N, unsigned char* WT, int k0, int n0, int drow0, float scale, LAS float* scr, int lane) {
    float v[64];
    const float* src = W + (size_t)k0 * N + n0 + lane;
#pragma unroll
    for (int i = 0; i < 64; ++i) v[i] = __builtin_nontemporal_load(src + (size_t)i * N);
#pragma unroll
    for (int i = 0; i < 64; ++i) scr[i * 65 + lane] = v[i] * scale;
    asm volatile("s_waitcnt lgkmcnt(0)" ::: "memory");
    const int c = lane & 3;
    unsigned char* tile = WT + ((size_t)(drow0 >> 6) * (K >> 7) + (k0 >> 7)) * 8192 + (k0 & 64);
#pragma unroll
    for (int j = 0; j < 4; ++j) { const int n = (lane >> 2) + 16 * j; const LAS float* sp = scr + (16 * c) * 65 + n;
        u32x4 o; o.x = fg::pk4_fp8(sp[0 * 65], sp[1 * 65], sp[2 * 65], sp[3 * 65]); o.y = fg::pk4_fp8(sp[4 * 65], sp[5 * 65], sp[6 * 65], sp[7 * 65]);
        o.z = fg::pk4_fp8(sp[8 * 65], sp[9 * 65], sp[10 * 65], sp[11 * 65]); o.w = fg::pk4_fp8(sp[12 * 65], sp[13 * 65], sp[14 * 65], sp[15 * 65]);
        *(u32x4*)(tile + n * 128 + 16 * c) = o; }
    asm volatile("s_waitcnt lgkmcnt(0)" ::: "memory");
}
__device__ __forceinline__ void transpose_item_hilo(const float* W, int K, bf16_t* WH, bf16_t* WL, int k0, LAS float* scr, int lane) {
    float v[64];
    const float* src = W + (size_t)k0 * 64 + lane;
#pragma unroll
    for (int i = 0; i < 64; ++i) v[i] = src[(size_t)i * 64];
#pragma unroll
    for (int i = 0; i < 64; ++i) scr[i * 65 + lane] = v[i];
    asm volatile("s_waitcnt lgkmcnt(0)" ::: "memory");
    const int c = lane & 7;
#pragma unroll
    for (int j = 0; j < 8; ++j) { const int n = (lane >> 3) + 8 * j; const LAS float* sp = scr + (8 * c) * 65 + n;
        float f[8], l[8];
#pragma unroll
        for (int q = 0; q < 8; ++q) f[q] = sp[q * 65];
        u32x4 o; o.x = fg::cvt_pk_bf16(f[0], f[1]); o.y = fg::cvt_pk_bf16(f[2], f[3]); o.z = fg::cvt_pk_bf16(f[4], f[5]); o.w = fg::cvt_pk_bf16(f[6], f[7]);
        l[0] = f[0] - __uint_as_float(o.x << 16); l[1] = f[1] - __uint_as_float(o.x & 0xffff0000u); l[2] = f[2] - __uint_as_float(o.y << 16); l[3] = f[3] - __uint_as_float(o.y & 0xffff0000u);
        l[4] = f[4] - __uint_as_float(o.z << 16); l[5] = f[5] - __uint_as_float(o.z & 0xffff0000u); l[6] = f[6] - __uint_as_float(o.w << 16); l[7] = f[7] - __uint_as_float(o.w & 0xffff0000u);
        u32x4 ol; ol.x = fg::cvt_pk_bf16(l[0], l[1]); ol.y = fg::cvt_pk_bf16(l[2], l[3]); ol.z = fg::cvt_pk_bf16(l[4], l[5]); ol.w = fg::cvt_pk_bf16(l[6], l[7]);
        const size_t off = (size_t)(k0 >> 6) * 4096 + n * 64 + 8 * c;
        *(u32x4*)(WH + off) = o; *(u32x4*)(WL + off) = ol; }
    asm volatile("s_waitcnt lgkmcnt(0)" ::: "memory");
}
constexpr int N_EXPERT_ITEMS = 65 * 1536;
__device__ __forceinline__ void expert_item(const Params& p, unsigned char* ws, int r0, LAS float* scr, int lane) {
    bf16_t* wguT = (bf16_t*)(ws + WS_WGU); bf16_t* wdT = (bf16_t*)(ws + WS_WD);
    const int e = r0 / 1536, r = r0 % 1536, mat = r >> 9, item = r & 511;
    if (mat < 2) { const float* W = (e < NE) ? p.in[mat ? I_WEXU : I_WEXG] + (size_t)e * DM * EFF : p.in[mat ? I_WSHU : I_WSHG];
        const int kb = (item & 7) + 8 * (item >> 6), nb = (item >> 3) & 7, n0 = nb * 64;
        transpose_item_fp8(W, DM, EFF, (unsigned char*)wguT + (size_t)e * 1024 * DM, kb * 64, n0, (n0 >> 7) * 256 + mat * 128 + (n0 & 127), fg::WGU_SCALE, scr, lane);
    } else { const float* W = (e < NE) ? p.in[I_WEXD] + (size_t)e * EFF * DM : p.in[I_WSHD];
        const int kb = item & 7, nb = item >> 3;
        transpose_item_fp8(W, EFF, DM, (unsigned char*)wdT + (size_t)e * DM * EFF, kb * 64, nb * 64, nb * 64, fg::WD_SCALE, scr, lane); }
}
__device__ __forceinline__ void expert_conv_loop(const Params& p, unsigned char* ws, unsigned* qhead, LAS float* scr, int lane) {
    for (;;) {
        unsigned start = 0; if (lane == 0) start = xb_add(qhead, 8u);
        start = (unsigned)__builtin_amdgcn_readfirstlane((int)start);
        if (start >= (unsigned)N_EXPERT_ITEMS) break;
        for (int q = 0; q < 8; ++q) expert_item(p, ws, (int)start + q, scr, lane);
    }
}
template <int VAR>
__device__ __forceinline__ void p0_items(const Params& p, unsigned char* ws, LAS float* scr, int lane, int gw, int NGW) {
    bf16_t* winT = (bf16_t*)(ws + WS_WIN); bf16_t* wuqT = (bf16_t*)(ws + WS_WUQ); bf16_t* wukvT = (bf16_t*)(ws + WS_WUKV); bf16_t* woT = (bf16_t*)(ws + WS_WO);
    bf16_t* wxqT = (bf16_t*)(ws + WS_WXQ); bf16_t* wxkvT = (bf16_t*)(ws + WS_WXKV); bf16_t* wxoT = (bf16_t*)(ws + WS_WXO); bf16_t* wguT = (bf16_t*)(ws + WS_WGU); bf16_t* wdT = (bf16_t*)(ws + WS_WD);
            constexpr int I0 = (DM / 64) * (INW / 64), I1 = I0 + (DM / 64) * (DM / 64), I2 = I1 + (QLORA / 64) * (3072 / 64), I3 = I2 + (KVLORA / 64) * (4096 / 64),
                          I4 = I3 + (DM / 64) * (512 / 64), I5 = I4 + (DM / 64) * (1024 / 64), I6 = I5 + (512 / 64) * (DM / 64);
            constexpr int IR = I6, ITOT = IR + DM / 64;
            for (int it = gw; it < ITOT; it += NGW) {
                if (it < I0) { const int nb = it % (INW / 64), kb = it / (INW / 64); transpose_item_fp8(p.in[I_WIN], DM, INW, (unsigned char*)winT, kb * 64, nb * 64, nb * 64, 64.0f, scr, lane); }
                else if (it < I1) { const int r = it - I0, nb = r % 64, kb = r / 64; transpose_item_fp8(p.in[I_WO], DM, DM, (unsigned char*)woT, kb * 64, nb * 64, nb * 64, 64.0f, scr, lane); }
                else if (it < I2) { const int r = it - I1, nb = r % 48, kb = r / 48; transpose_item<VAR>(p.in[I_WUQ], QLORA, 3072, wuqT, kb * 64, nb * 64, nb * 64, scr, lane); }
                else if (it < I3) { const int r = it - I2, nb = r % 64, kb = r / 64; transpose_item<VAR>(p.in[I_WUKV], KVLORA, 4096, wukvT, kb * 64, nb * 64, nb * 64, scr, lane); }
                else if (it < I4) { const int r = it - I3, nb = r % 8, kb = r / 8; transpose_item<VAR>(p.in[I_WXQ], DM, 512, wxqT, kb * 64, nb * 64, nb * 64, scr, lane); }
                else if (it < I5) { const int r = it - I4, nb = r % 16, kb = r / 16; transpose_item<VAR>(p.in[I_WXKV], DM, 1024, wxkvT, kb * 64, nb * 64, nb * 64, scr, lane); }
                else if (it < I6) { const int r = it - I5, nb = r % 64, kb = r / 64; transpose_item<VAR>(p.in[I_WXO], 512, DM, wxoT, kb * 64, nb * 64, nb * 64, scr, lane); }
                else if (it >= IR) { transpose_item_hilo(p.in[I_WROUTER], DM, (bf16_t*)(ws + WS_WR), (bf16_t*)(ws + WS_WR + (size_t)(DM / 64) * 8192), (it - IR) * 64, scr, lane); }
            }
}
__device__ __forceinline__ void unpack8(const u32x4 w, float (&f)[8]) {
    f[0] = __uint_as_float(w.x << 16); f[1] = __uint_as_float(w.x & 0xffff0000u); f[2] = __uint_as_float(w.y << 16); f[3] = __uint_as_float(w.y & 0xffff0000u);
    f[4] = __uint_as_float(w.z << 16); f[5] = __uint_as_float(w.z & 0xffff0000u); f[6] = __uint_as_float(w.w << 16); f[7] = __uint_as_float(w.w & 0xffff0000u); }
__device__ __forceinline__ u32x4 pack8(const float (&f)[8]) { u32x4 w; w.x = fg::cvt_pk_bf16(f[0], f[1]); w.y = fg::cvt_pk_bf16(f[2], f[3]); w.z = fg::cvt_pk_bf16(f[4], f[5]); w.w = fg::cvt_pk_bf16(f[6], f[7]); return w; }
__device__ __forceinline__ float sumsq8(const float (&f)[8]) { return (f[0] * f[0] + f[1] * f[1]) + (f[2] * f[2] + f[3] * f[3]) + (f[4] * f[4] + f[5] * f[5]) + (f[6] * f[6] + f[7] * f[7]); }
template <int W> __device__ __forceinline__ float group_sum(float v) {
#pragma unroll
    for (int o = 1; o < W; o <<= 1) v += __shfl_xor(v, o);
    return v;
}
__device__ __forceinline__ void load8f(const float* g, float (&f)[8]) { const f32x4 a = *(const f32x4*)g, b = *(const f32x4*)(g + 4); f[0] = a.x; f[1] = a.y; f[2] = a.z; f[3] = a.w; f[4] = b.x; f[5] = b.y; f[6] = b.z; f[7] = b.w; }
__device__ __forceinline__ void scale8(float (&f)[8], float r, const float (&g)[8]) {
#pragma unroll
    for (int i = 0; i < 8; ++i) f[i] = f[i] * r * g[i]; }
        struct RouterSched { const char* th; const char* tl; const char* wh; const char* wl; int G, c;
            __device__ __forceinline__ bool next(int i, fg::Unit& u) const {
                const int total = (NTOK / 256) * 8, per = (total + 7) / 8; const int j = i * G + c, x = j & 7, q = j >> 3;
                if (q >= per) return false; const int L = x * per + q; if (L >= total) return false;
                const int pm = L / 8, slab = L % 8, term = slab >> 2, kq = slab & 3;
                u.A = (term == 1 ? tl : th) + ((size_t)pm * 256 * DM + (size_t)kq * 1024) * 2; u.B = wh + (size_t)kq * 16 * 8192;
                u.rows = nullptr; u.nkt = 16; u.nvalid = 256; u.pm = pm; u.pn = 0; u.e = slab; u.arow0 = pm * 256; return true; } };
        struct EpiLogits { static constexpr int PERM = 0; typedef fg::NoPre Pre; __device__ __forceinline__ void prefetch(Pre&, const fg::Unit&, int, int) const {} float* C;
            __device__ __forceinline__ void operator()(const f32x4 (&acc)[2][2][4][2], const fg::Unit& u, int wr, int wc, int fr, int fq, const Pre& pre) const {
                { float* Cb = C + (size_t)u.e * NTOK * 128;
#pragma unroll
                    for (int ai = 0; ai < 2; ++ai)
#pragma unroll
                        for (int m = 0; m < 4; ++m)
#pragma unroll
                            for (int n = 0; n < 2; ++n) *(f32x4*)(Cb + (size_t)(u.pm * 256 + ai * 128 + wr * 64 + m * 16 + fr) * 128 + wc * 32 + n * 16 + 4 * fq) = acc[ai][0][m][n]; } } };
constexpr int NPHASE = 18;
template <unsigned PMASK>
__global__ void __launch_bounds__(512, 2) fwd(Params p) {
    extern __shared__ __attribute__((aligned(16))) unsigned char lds_raw[];
    float* ldsf = (float*)lds_raw;
    const int tid = threadIdx.x, lane = tid & 63, wave = tid >> 6;
    const int G = gridDim.x; int bid = blockIdx.x;
    const int gw = bid * 8 + wave, NGW = G * 8;
    unsigned char* ws = p.ws;
    unsigned* ctl = (unsigned*)(ws + WS_CTL);
    volatile LAS unsigned* misc = (volatile LAS unsigned*)((LAS unsigned char*)lds_raw + LDS_MISC);
    if (tid < 16) misc[tid] = 0u;
    __syncthreads();
    XcdBarrier bar = xcd_barrier_post(ctl + CW_BAR, misc);
    const int lo = p.ph_lo, hi = p.ph_hi;
    if (tid == 0) { const unsigned x = xb_xcc_id() & 15u; misc[4] = x; misc[5] = xb_add(ctl + CW_TICKET + 64 * x, 1u); }
#define IN(k) (((PMASK >> (k)) & 1u) && lo <= (k) && (k) < hi)
#ifndef DUP_PHASE
#define DUP_PHASE -1
#endif
#define REP(k) for (int rep_ = 0; rep_ < ((DUP_PHASE == (k)) ? 2 : 1); ++rep_)
#define SEAM(k) do { if (IN(k) && IN((k) + 1)) xcd_barrier(bar); } while (0)

    const float* x = p.in[I_X];
    act_t* hbuf = (act_t*)(ws + WS_H); act_t* memn = (act_t*)(ws + WS_MEMN); act_t* p1 = (act_t*)(ws + WS_P1); act_t* kvm = (act_t*)(ws + WS_KVM);
    act_t* qb = (act_t*)(ws + WS_QB); act_t* kvb = (act_t*)(ws + WS_KVB); act_t* mixed = (act_t*)(ws + WS_MIXED); float* x1 = (float*)(ws + WS_X1);
    act_t* hc = (act_t*)(ws + WS_HC); act_t* qx = (act_t*)(ws + WS_QX); act_t* ox = (act_t*)(ws + WS_OX); float* x2 = (float*)(ws + WS_X2);
    act_t* tb = (act_t*)(ws + WS_T); act_t* hh = (act_t*)(ws + WS_HH);
    LAS unsigned char* lds = (LAS unsigned char*)lds_raw;
    bf16_t* winT = (bf16_t*)(ws + WS_WIN); bf16_t* wuqT = (bf16_t*)(ws + WS_WUQ); bf16_t* wukvT = (bf16_t*)(ws + WS_WUKV); bf16_t* woT = (bf16_t*)(ws + WS_WO);
    bf16_t* wxqT = (bf16_t*)(ws + WS_WXQ); bf16_t* wxkvT = (bf16_t*)(ws + WS_WXKV); bf16_t* wxoT = (bf16_t*)(ws + WS_WXO); bf16_t* wguT = (bf16_t*)(ws + WS_WGU); bf16_t* wdT = (bf16_t*)(ws + WS_WD);
    float* qxp = (float*)(ws + WS_QXP); bf16_t* ybuf = (bf16_t*)(ws + WS_Y);
    int* rowtok = (int*)(ws + WS_ROWTOK); float* rowgate = (float*)(ws + WS_ROWGATE); int* rowdst = (int*)(ws + WS_ROWDST);
    unsigned* gcnt = ctl + CW_CNT;
    const int* positions = (const int*)p.in[I_POS];

    if (IN(0)) REP(0) {
        for (int m = gw; m < NTOK; m += NGW) {
            const float* xr = x + (size_t)m * DM; f32x4 v[16]; float ssq = 0.f;
#pragma unroll
            for (int j = 0; j < 16; ++j) { v[j] = __builtin_nontemporal_load((const f32x4*)xr + lane + 64 * j); ssq += v[j].x * v[j].x + v[j].y * v[j].y + v[j].z * v[j].z + v[j].w * v[j].w; }
            ssq = wave_sum(ssq); const float r = 2.0f / sqrtf(ssq * (1.0f / 4096.f) + EPS);
#pragma unroll
            for (int j = 0; j < 16; ++j) v[j] = v[j] * r * __builtin_nontemporal_load((const f32x4*)p.in[I_GMIX] + lane + 64 * j);
            asm volatile("s_waitcnt vmcnt(0)" ::: "memory");
#pragma unroll
            for (int j = 0; j < 16; ++j) *(unsigned*)((unsigned char*)hbuf + (size_t)m * DM + (lane + 64 * j) * 4) = fg::pk4_fp8(v[j].x, v[j].y, v[j].z, v[j].w);
        }
        for (int m = gw; m < NMEM; m += NGW) rms_row_4096<act_t>(p.in[I_MEM] + (size_t)m * DM, p.in[I_GMEM], memn + (size_t)m * DM, lane, nullptr);
#if FAST_GEMM
        {
            LAS float* scr = (LAS float*)(lds + wave * 16640);
            p0_items<0>(p, ws, scr, lane, gw, NGW);
        }
#endif
    }
    SEAM(0);
    if (IN(0) && IN(1) && G == 256) {
        if (tid == 0) { bool even = true;
            for (int j2 = 0; j2 < 8; ++j2) even = even && (xb_ld(ctl + CW_TICKET + 64 * j2) == 32u);
            misc[6] = (even && misc[4] < 8u && misc[5] < 32u) ? (misc[4] + 8u * misc[5]) : (unsigned)blockIdx.x; }
        __syncthreads();
        bid = __builtin_amdgcn_readfirstlane((int)misc[6]);
    }
    if (IN(1)) REP(1) {
#if FAST_GEMM
        { fg::DenseSched S{(const char*)hbuf, (const char*)winT, DM / 2, DM / 2, NTOK / 256, INWP / 256, 1, DM / 128, G, bid, (p.var == 10) ? 2 : 0};
          fg::EpiBf16N E{p1, INW, INW, 1.0f / (2.0f * 64.0f), p.in[I_GQA], 8, p.in[I_GKA], 16, 0, (LAS float*)(lds + 131072 + 2048)};
          fg::gemm_phase<fg::EpiBf16N, fg::DenseSched, false, true, true>(lds, S, E, DM / 2, DM / 2, p.var); }
        { fg::DenseSched S{(const char*)memn, (const char*)wxkvT, DM, PK(DM), NMEM / 256, 1024 / 256, 1, DM / 64, G, (bid + G - 224) % G, 0};
          fg::EpiBf16 E{kvm, 1024, 1024, 1.0f};
          fg::gemm_phase<fg::EpiBf16, fg::DenseSched, false, false, true>(lds, S, E, DM, PK(DM)); }
#else
        constexpr int NT1 = (INW + 127) / 128, U1 = (NTOK / 128) * NT1, U2 = (NMEM / 128) * (1024 / 128);
        for (int u = bid; u < U1 + U2; u += G) {
            if (u < U1) { const int mt = u / NT1, nt = u % NT1;
                BPlain bc{p.in[I_WIN], INW, nt * 128, INW};
                auto epi = [&](int r, int c, const float (&v)[4]) { const int col = nt * 128 + c; if (col < INW) { act_t* o = p1 + (size_t)(mt * 128 + r) * INW + col; stf(o, v[0]); stf(o + 1, v[1]); stf(o + 2, v[2]); stf(o + 3, v[3]); } };
                ngemm_tile<act_t>(ldsf, hbuf, DM, nullptr, mt * 128, 128, DM, bc, epi);
            } else { const int v2 = u - U1, mt = v2 / 8, nt = v2 % 8;
                BPlain bc{p.in[I_WXKV], 1024, nt * 128, 1024};
                auto epi = [&](int r, int c, const float (&v)[4]) { act_t* o = kvm + (size_t)(mt * 128 + r) * 1024 + nt * 128 + c; stf(o, v[0]); stf(o + 1, v[1]); stf(o + 2, v[2]); stf(o + 3, v[3]); };
                ngemm_tile<act_t>(ldsf, memn, DM, nullptr, mt * 128, 128, DM, bc, epi);
            }
        }
    #endif
    }
    SEAM(1);
    if (IN(2)) {
#if FAST_GEMM
        {
            float gcq0[8], gcq1[8], gckv[8];
            load8f(p.in[I_GCQ] + lane * 8, gcq0); load8f(p.in[I_GCQ] + 512 + lane * 8, gcq1); load8f(p.in[I_GCKV] + lane * 8, gckv);
            for (int m = gw; m < NTOK; m += NGW) {
                act_t* row = p1 + (size_t)m * INW;
                u32x4 cq[2], ckv;
                cq[0] = *(const u32x4*)(row + C_CQ + lane * 8); cq[1] = *(const u32x4*)(row + C_CQ + 512 + lane * 8); ckv = *(const u32x4*)(row + C_CKV + lane * 8);
                const int pos = positions[m];
                asm volatile("s_waitcnt vmcnt(0)" ::: "memory");
                { float f0[8], f1[8]; unpack8(cq[0], f0); unpack8(cq[1], f1); const float ss = wave_sum(sumsq8(f0) + sumsq8(f1)); const float r = 1.0f / sqrtf(ss * (1.0f / 1024.f) + EPS);
                  scale8(f0, r, gcq0); scale8(f1, r, gcq1); cq[0] = pack8(f0); cq[1] = pack8(f1); }
                { float f[8]; unpack8(ckv, f); const float ss = wave_sum(sumsq8(f)); const float r = 1.0f / sqrtf(ss * (1.0f / 512.f) + EPS); scale8(f, r, gckv); ckv = pack8(f); }
                *(u32x4*)(row + C_CQ + lane * 8) = cq[0]; *(u32x4*)(row + C_CQ + 512 + lane * 8) = cq[1]; *(u32x4*)(row + C_CKV + lane * 8) = ckv;
                rms_rope64_inplace(row + C_KPE, p.in[I_GKB] + 128, pos, lane);
            }
            float gkx[8]; load8f(p.in[I_GKX] + (lane & 15) * 8, gkx);
            for (int m = gw; m < NMEM; m += NGW) { act_t* row = kvm + (size_t)m * 1024;
                u32x4 w = *(const u32x4*)(row + lane * 8); float f[8]; unpack8(w, f); const float ss = group_sum<16>(sumsq8(f)); const float r = 1.0f / sqrtf(ss * (1.0f / 128.f) + EPS);
                scale8(f, r, gkx); *(u32x4*)(row + lane * 8) = pack8(f); }
        }
#else
        for (int m = gw; m < NTOK; m += NGW) {
            act_t* row = p1 + (size_t)m * INW;
            for (int h = 0; h < HA; ++h) { rms_inplace<128>(row + C_Q0 + h * HD, p.in[I_GQA], lane); rms_inplace<128>(row + C_K0 + h * HD, p.in[I_GKA], lane); }
            rms_inplace<QLORA>(row + C_CQ, p.in[I_GCQ], lane);
            rms_inplace<KVLORA>(row + C_CKV, p.in[I_GCKV], lane);
            rms_rope64_inplace(row + C_KPE, p.in[I_GKB] + 128, positions[m], lane);
        }
        for (int m = gw; m < NMEM; m += NGW) for (int h = 0; h < MH; ++h) rms_inplace<128>(kvm + (size_t)m * 1024 + h * 128, p.in[I_GKX], lane);
#endif
    }
    SEAM(2);
    if (IN(3)) REP(3) {
#if FAST_GEMM
        { fg::DenseSched S{(const char*)(p1 + C_CQ), (const char*)wuqT, INW, PK(QLORA), NTOK / 256, 3072 / 256, 1, QLORA / 64, G, bid, 0};
          fg::EpiBf16 E{qb, 3072, 3072, 1.0f};
          fg::gemm_phase<fg::EpiBf16, fg::DenseSched, false, false, true>(lds, S, E, INW, PK(QLORA)); }
        { fg::DenseSched S{(const char*)(p1 + C_CKV), (const char*)wukvT, INW, PK(KVLORA), NTOK / 256, 4096 / 256, 1, KVLORA / 64, G, bid, (G == 256) ? 1 : 0};
          fg::EpiBf16N E{kvb, 4096, 4096, 1.0f, p.in[I_GKB], 16, p.in[I_GKB], 16, 1, (LAS float*)(lds + 131072 + 2048)};
          fg::gemm_phase<fg::EpiBf16N, fg::DenseSched, false, false, true>(lds, S, E, INW, PK(KVLORA)); }
#else
        constexpr int UA = (NTOK / 128) * (3072 / 128), UB = (NTOK / 128) * (4096 / 128);
        for (int u = bid; u < UA + UB; u += G) {
            if (u < UA) { const int mt = u / 24, nt = u % 24;
                BPlain bc{p.in[I_WUQ], 3072, nt * 128, 3072};
                auto epi = [&](int r, int c, const float (&v)[4]) { act_t* o = qb + (size_t)(mt * 128 + r) * 3072 + nt * 128 + c; stf(o, v[0]); stf(o + 1, v[1]); stf(o + 2, v[2]); stf(o + 3, v[3]); };
                ngemm_tile<act_t>(ldsf, p1 + C_CQ, INW, nullptr, mt * 128, 128, QLORA, bc, epi);
            } else { const int v2 = u - UA, mt = v2 / 32, nt = v2 % 32;
                BPlain bc{p.in[I_WUKV], 4096, nt * 128, 4096};
                auto epi = [&](int r, int c, const float (&v)[4]) { act_t* o = kvb + (size_t)(mt * 128 + r) * 4096 + nt * 128 + c; stf(o, v[0]); stf(o + 1, v[1]); stf(o + 2, v[2]); stf(o + 3, v[3]); };
                ngemm_tile<act_t>(ldsf, p1 + C_CKV, INW, nullptr, mt * 128, 128, KVLORA, bc, epi);
            }
        }
    #endif
    }
    SEAM(3);
    if (IN(4)) {
#if FAST_GEMM
        {
            float gqn[8], gqp[8];
            load8f(p.in[I_GQB] + (lane & 15) * 8, gqn); load8f(p.in[I_GQB] + 128 + (lane & 7) * 8, gqp);
            for (int m = gw; m < NTOK; m += NGW) {
                act_t* qrow = qb + (size_t)m * 3072;
                u32x4 qn[4], qp[2];
#pragma unroll
                for (int j = 0; j < 4; ++j) qn[j] = *(const u32x4*)(qrow + (j * 4 + (lane >> 4)) * QKB + (lane & 15) * 8);
#pragma unroll
                for (int j = 0; j < 2; ++j) qp[j] = *(const u32x4*)(qrow + (j * 8 + (lane >> 3)) * QKB + 128 + (lane & 7) * 8);
                float cs[8], sn[8];
                { const int fi = lane & 31; const float inv_freq = powf(10000.0f, -(float)(2 * fi) / 64.0f); const float ang = (float)positions[m] * inv_freq; float s1, c1; sincosf(ang, &s1, &c1);
#pragma unroll
                  for (int i = 0; i < 8; ++i) { const int src = ((lane & 3) * 8 + i); cs[i] = __shfl(c1, src); sn[i] = __shfl(s1, src); } }
                asm volatile("s_waitcnt vmcnt(0)" ::: "memory");
#pragma unroll
                for (int j = 0; j < 4; ++j) { float f[8]; unpack8(qn[j], f); const float ss = group_sum<16>(sumsq8(f)); const float r = 1.0f / sqrtf(ss * (1.0f / 128.f) + EPS); scale8(f, r, gqn); qn[j] = pack8(f); }
#pragma unroll
                for (int j = 0; j < 2; ++j) { float f[8]; unpack8(qp[j], f); const float ss = group_sum<8>(sumsq8(f)); const float r = 1.0f / sqrtf(ss * (1.0f / 64.f) + EPS); scale8(f, r, gqp);
                    const bool lowhalf = ((lane & 7) < 4);
#pragma unroll
                    for (int i = 0; i < 8; ++i) { const float other = __shfl_xor(f[i], 4); f[i] = lowhalf ? (f[i] * cs[i] - other * sn[i]) : (f[i] * cs[i] + other * sn[i]); }
                    qp[j] = pack8(f); }
#pragma unroll
                for (int j = 0; j < 4; ++j) *(u32x4*)(qrow + (j * 4 + (lane >> 4)) * QKB + (lane & 15) * 8) = qn[j];
#pragma unroll
                for (int j = 0; j < 2; ++j) *(u32x4*)(qrow + (j * 8 + (lane >> 3)) * QKB + 128 + (lane & 7) * 8) = qp[j];
            }
        }
#else
        for (int m = gw; m < NTOK; m += NGW) {
            const int pos = positions[m];
            for (int h = 0; h < HB; ++h) {
                rms_inplace<128>(qb + (size_t)m * 3072 + h * QKB, p.in[I_GQB], lane);
                rms_rope64_inplace(qb + (size_t)m * 3072 + h * QKB + 128, p.in[I_GQB] + 128, pos, lane);
                rms_inplace<128>(kvb + (size_t)m * 4096 + h * 256, p.in[I_GKB], lane);
            }
        }
#endif
    }
    SEAM(4);
    if (IN(5)) {
#if FAST_ATTN
        {
            constexpr int NA_BLK = 176;
            LAS char* al = (LAS char*)lds;
            LAS float* scr = (LAS float*)(lds + wave * 16640);
            if (bid >= NA_BLK) { expert_conv_loop(p, ws, ctl + CW_QCONV, scr, lane); }
            for (;;) {
                __syncthreads(); if (tid == 0) misc[7] = xb_add(ctl + CW_QB, 1u); __syncthreads();
                const int q = (int)misc[7]; if (q >= 512) break;
                const int grp = q >> 8, idx = q & 255, pair = idx >> 2, qbk = (grp == 0 ? 7 : 3) - (idx & 3), b = pair >> 4, h = pair & 15;
                const int c0 = qbk * 4; const size_t tok0 = (size_t)b * SEQ + (size_t)qbk * 256;
                const act_t* kb = kvb + (size_t)b * SEQ * 4096;
                fa::attn_call<1>(qb + tok0 * 3072 + h * QKB, kb + h * 256, p1 + (size_t)b * SEQ * INW + C_KPE, kb + h * 256 + 128, (bf16_t*)((unsigned char*)mixed + tok0 * DM + WA + h * HD), 0, c0 + 4, c0, al);
            }
            for (;;) {
                __syncthreads(); if (tid == 0) misc[7] = xb_add(ctl + CW_QA, 1u); __syncthreads();
                const int q = (int)misc[7]; if (q >= 512) break;
                const int grp = q >> 8, idx = q & 255, pair = idx >> 2, qbk = (grp == 0 ? 7 : 3) - (idx & 3), b = pair >> 4, h = pair & 15;
                { LAS float* tbl = (LAS float*)(al + fa::OFF_TBL); if (tid < NREL) tbl[tid] = p.in[I_RELB][h * NREL + tid] * 11.313708498984761f; }
                const int c0 = qbk * 4; const size_t tok0 = (size_t)b * SEQ + (size_t)qbk * 256;
                const int kt0 = (c0 - LEFT) > 0 ? (c0 - LEFT) : 0;
                const act_t* base = p1 + (size_t)b * SEQ * INW;
                fa::attn_call<0>(p1 + tok0 * INW + C_Q0 + h * HD, base + C_K0 + h * HD, nullptr, base + C_V0 + h * HD, (bf16_t*)((unsigned char*)mixed + tok0 * DM + h * HD), kt0, c0 + 4 - kt0, c0, al);
            }
            __syncthreads();
            expert_conv_loop(p, ws, ctl + CW_QCONV, scr, lane);
        }
#else
        for (int u = bid; u < 4096; u += G) {
            const int c = 31 - (u >> 7), rem = u & 127, type = rem >> 6, b = (rem >> 4) & 3, h = rem & 15;
            const size_t tok0 = (size_t)b * SEQ + (size_t)c * CHUNK;
            if (type == 0) {
                const int t0 = (c - LEFT) > 0 ? (c - LEFT) : 0, nt = c - t0 + 1;
                const float* rb = p.in[I_RELB] + h * NREL;
                auto keytile = [&](int t) { return (t0 + t) * CHUNK; };
                auto bias = [&](int r, int t, int key) { int dist = (c * CHUNK + r) - ((t0 + t) * CHUNK + key); dist = dist < -(CHUNK - 1) ? -(CHUNK - 1) : (dist > 128 ? 128 : dist); return rb[dist + CHUNK - 1]; };
                const act_t* base = p1 + (size_t)b * SEQ * INW;
                nattn_unit<128>(ldsf, p1 + tok0 * INW + C_Q0 + h * HD, INW, base + C_K0 + h * HD, INW, nullptr, 0, base + C_V0 + h * HD, INW,
                                nt, keytile, 0.08838834764831845f, bias, mixed + tok0 * DM + h * HD, DM);
            } else {
                auto keytile = [&](int t) { return t * CHUNK; };
                auto bias = [&](int, int, int) { return 0.f; };
                const act_t* kb = kvb + (size_t)b * SEQ * 4096;
                nattn_unit<192>(ldsf, qb + tok0 * 3072 + h * QKB, 3072, kb + h * 256, 4096, p1 + (size_t)b * SEQ * INW + C_KPE, INW, kb + h * 256 + 128, 4096,
                                c + 1, keytile, 0.07216878364870323f, bias, mixed + tok0 * DM + WA + h * HD, DM);
            }
        }
    #endif
    }
    SEAM(5);
    if (IN(6)) REP(6) {
#if FAST_GEMM
        { fg::DenseSched S{(const char*)mixed, (const char*)woT, DM / 2, DM / 2, NTOK / 256, DM / 256, 1, DM / 128, G, bid, 0};
          fg::EpiResStat E{x1, x, hc, p.in[I_GCROSS], (float*)(ws + WS_SSP1), DM, 1.0f / (fa::MIX_SCALE * 64.0f)};
          fg::gemm_phase<fg::EpiResStat, fg::DenseSched, false, true, true>(lds, S, E, DM / 2, DM / 2); }
#else
        for (int u = bid; u < (NTOK / 128) * (DM / 128); u += G) { const int mt = u / 32, nt = u % 32;
            BPlain bc{p.in[I_WO], DM, nt * 128, DM};
            auto epi = [&](int r, int c, const float (&v)[4]) { const size_t o = (size_t)(mt * 128 + r) * DM + nt * 128 + c;
                const f32x4 xv = *(const f32x4*)(x + o); *(f32x4*)(x1 + o) = (f32x4){xv.x + v[0], xv.y + v[1], xv.z + v[2], xv.w + v[3]}; };
            ngemm_tile<act_t>(ldsf, mixed, DM, nullptr, mt * 128, 128, DM, bc, epi);
        }
    #endif
    }
    SEAM(6);
    if (IN(8)) REP(8) {
#if FAST_GEMM
        { fg::DenseSched S{(const char*)hc, (const char*)wxqT, DM, PK(DM), NTOK / 256, 512 / 256, 4, DM / 64 / 4, G, bid, 0};
          fg::EpiF32Res<false> E{qxp, nullptr, 512, (size_t)NTOK * 512, 1.0f};
          fg::gemm_phase<fg::EpiF32Res<false>, fg::DenseSched, false, false, true>(lds, S, E, DM, PK(DM)); }
#else
        for (int u = bid; u < (NTOK / 128) * 4; u += G) { const int mt = u / 4, nt = u % 4;
            BPlain bc{p.in[I_WXQ], 512, nt * 128, 512};
            auto epi = [&](int r, int c, const float (&v)[4]) { act_t* o = qx + (size_t)(mt * 128 + r) * 512 + nt * 128 + c; stf(o, v[0]); stf(o + 1, v[1]); stf(o + 2, v[2]); stf(o + 3, v[3]); };
            ngemm_tile<act_t>(ldsf, hc, DM, nullptr, mt * 128, 128, DM, bc, epi);
        }
    #endif
    }
    SEAM(8);
    if (IN(9)) {
#if FAST_GEMM
        { float gqx[8]; load8f(p.in[I_GQX] + (lane & 15) * 8, gqx);
          for (int m = gw; m < NTOK; m += NGW) {
            f32x4 a[4][2];
#pragma unroll
            for (int sl = 0; sl < 4; ++sl) { const float* src = qxp + (size_t)sl * NTOK * 512 + (size_t)m * 512 + lane * 8; a[sl][0] = *(const f32x4*)src; a[sl][1] = *(const f32x4*)(src + 4); }
            const float rs1 = 1.0f / sqrtf(wave_sum(((const float*)(ws + WS_SSP1))[(size_t)m * 64 + lane]) * (1.0f / 4096.f) + EPS);
            const f32x4 lo = ((a[0][0] + a[1][0]) + (a[2][0] + a[3][0])) * rs1, hi4 = ((a[0][1] + a[1][1]) + (a[2][1] + a[3][1])) * rs1;
            float f[8] = {lo.x, lo.y, lo.z, lo.w, hi4.x, hi4.y, hi4.z, hi4.w};
            const float ss = group_sum<16>(sumsq8(f)); const float r = 1.0f / sqrtf(ss * (1.0f / 128.f) + EPS); scale8(f, r, gqx);
            *(u32x4*)(qx + (size_t)m * 512 + lane * 8) = pack8(f); } }
#else
        for (int m = gw; m < NTOK; m += NGW) for (int h = 0; h < MH; ++h) rms_inplace<128>(qx + (size_t)m * 512 + h * 128, p.in[I_GQX], lane);
#endif
    }
    SEAM(9);
    if (IN(10)) REP(10) {
#if FAST_ATTN
        for (int u = bid; u < NB * MH * (SEQ / 256); u += G) { const int qbk = u & 7, h = (u >> 3) & 3, b = u >> 5;
            const size_t tok0 = (size_t)b * SEQ + (size_t)qbk * 256;
            const act_t* kb = kvm + (size_t)b * MEMT * 1024;
            fa::attn_call<2>(qx + tok0 * 512 + h * 128, kb + h * 128, nullptr, kb + 512 + h * 128, ox + tok0 * 512 + h * 128, 0, 4, 0, (LAS char*)lds);
        }
#else
        for (int u = bid; u < NB * MH * (SEQ / 64); u += G) { const int c = u & 31, h = (u >> 5) & 3, b = u >> 7;
            const size_t tok0 = (size_t)b * SEQ + (size_t)c * 64;
            auto keytile = [&](int t) { return t * 64; };
            auto bias = [&](int, int, int) { return 0.f; };
            const act_t* kb = kvm + (size_t)b * MEMT * 1024;
            nattn_unit<128>(ldsf, qx + tok0 * 512 + h * 128, 512, kb + h * 128, 1024, nullptr, 0, kb + 512 + h * 128, 1024, 4, keytile, 0.08838834764831845f, bias, ox + tok0 * 512 + h * 128, 512);
        }
    #endif
    }
    SEAM(10);
    if (IN(11)) REP(11) {
#if FAST_GEMM
        { fg::DenseSched S{(const char*)ox, (const char*)wxoT, 512, PK(512), NTOK / 256, DM / 256, 1, 512 / 64, G, bid, 0};
          fg::EpiX2 E{x2, x1, tb, (bf16_t*)hh, ws + WS_T8, p.in[I_GFFN], (float*)(ws + WS_SSP2), DM};
          fg::gemm_phase<fg::EpiX2, fg::DenseSched, false, false, true>(lds, S, E, 512, PK(512)); }
#else
        for (int u = bid; u < (NTOK / 128) * (DM / 128); u += G) { const int mt = u / 32, nt = u % 32;
            BPlain bc{p.in[I_WXO], DM, nt * 128, DM};
            auto epi = [&](int r, int c, const float (&v)[4]) { const size_t o = (size_t)(mt * 128 + r) * DM + nt * 128 + c;
                const f32x4 xv = *(const f32x4*)(x1 + o); const f32x4 y = (f32x4){xv.x + v[0], xv.y + v[1], xv.z + v[2], xv.w + v[3]}; *(f32x4*)(x2 + o) = y; *(f32x4*)(p.out + o) = y; };
            ngemm_tile<act_t>(ldsf, ox, 512, nullptr, mt * 128, 128, 512, bc, epi);
        }
    #endif
    }
    SEAM(11);
    if (IN(13)) {
        RouterSched S{(const char*)tb, (const char*)hh, (const char*)(ws + WS_WR), nullptr, G, bid};
        EpiLogits E{(float*)(ws + WS_Y)};
        fg::gemm_phase<EpiLogits, RouterSched, false, false, true>(lds, S, E, DM, DM);
    }
    SEAM(13);
    if (IN(14)) {
        const float* lgp = (const float*)(ws + WS_Y);
        const float rb = p.in[I_RBIAS][lane];
        const int g = lane >> 3;
        float lgA[16];
#pragma unroll
        for (int sl = 0; sl < 16; ++sl) lgA[sl] = (gw < NTOK) ? lgp[((size_t)(sl >> 1) * NTOK + gw) * 128 + (sl & 1) * 64 + lane] : 0.f;
        int pm_ = -1, psel = 0, prank = 0; float pgate = 0.f; unsigned ppos = 0u;
        for (int m = gw; m < NTOK; m += NGW) {
            float lgB[16]; const int mn = m + NGW;
#pragma unroll
            for (int sl = 0; sl < 16; ++sl) lgB[sl] = (mn < NTOK) ? lgp[((size_t)(sl >> 1) * NTOK + mn) * 128 + (sl & 1) * 64 + lane] : 0.f;
            const float rs2 = 1.0f / sqrtf(wave_sum(((const float*)(ws + WS_SSP2))[(size_t)m * 64 + lane]) * (1.0f / 4096.f) + EPS);
            if (lane == 0) ((float*)(ws + WS_RS2))[m] = rs2;
            const float logit = ((((lgA[0] + lgA[1]) + (lgA[2] + lgA[3])) + ((lgA[4] + lgA[5]) + (lgA[6] + lgA[7]))) + (((lgA[8] + lgA[9]) + (lgA[10] + lgA[11])) + ((lgA[12] + lgA[13]) + (lgA[14] + lgA[15])))) * rs2;
            const float score = 1.0f / (1.0f + expf(-logit));
            const float choice = score + rb;
            float gm1 = fmaxf(choice, __shfl_xor(choice, 1)); gm1 = fmaxf(gm1, __shfl_xor(gm1, 2)); gm1 = fmaxf(gm1, __shfl_xor(gm1, 4));
            const unsigned long long eq = __ballot(choice == gm1);
            const unsigned gbits = (unsigned)(eq >> (8 * g)) & 0xffu;
            const bool is_first = (lane & 7) == (__builtin_ctz(gbits | 0x100u));
            float v2 = is_first ? -INFINITY : choice;
            v2 = fmaxf(v2, __shfl_xor(v2, 1)); v2 = fmaxf(v2, __shfl_xor(v2, 2)); v2 = fmaxf(v2, __shfl_xor(v2, 4));
            const float gscore = gm1 + v2;
            int grank = 0;
#pragma unroll
            for (int j2 = 0; j2 < 8; ++j2) { const float gj = __int_as_float(__builtin_amdgcn_readlane(__float_as_int(gscore), 8 * j2)); grank += ((gj > gscore) || (gj == gscore && j2 < g)) ? 1 : 0; }
            const bool gsel = grank < 4;
            const float mv = gsel ? choice : -INFINITY;
            int rank = 0;
#pragma unroll
            for (int i2 = 0; i2 < 64; ++i2) { const float vi = __int_as_float(__builtin_amdgcn_readlane(__float_as_int(mv), i2)); rank += ((vi > mv) || (vi == mv && i2 < lane)) ? 1 : 0; }
            const bool sel = gsel && rank < 8;
            const float wsum = wave_sum(sel ? score : 0.f);
            if (pm_ >= 0 && psel) { rowtok[lane * CAP + ppos] = pm_; rowgate[lane * CAP + ppos] = pgate; rowdst[lane * CAP + ppos] = pm_ * 8 + prank; }
            ppos = 0u; if (sel) ppos = atomicAdd(&gcnt[64 * lane], 1u);
            pm_ = m; psel = sel ? 1 : 0; prank = rank; pgate = score * 2.5f / (wsum + 1e-20f);
#pragma unroll
            for (int sl = 0; sl < 16; ++sl) lgA[sl] = lgB[sl];
        }
        if (pm_ >= 0 && psel) { rowtok[lane * CAP + ppos] = pm_; rowgate[lane * CAP + ppos] = pgate; rowdst[lane * CAP + ppos] = pm_ * 8 + prank; }
    }
    SEAM(14);
    if (IN(15)) REP(15) {
#if FAST_MOE
        { const fg::MoeTabs T = moe_tables_fast((LAS int*)(lds + 131072), gcnt);
          fg::MoeSched<1> S{T, (const char*)(ws + WS_T8), (const char*)wguT, rowtok, G, bid};
          fg::EpiSwiglu E{hh, (const float*)(ws + WS_RS2)};
          fg::gemm_phase<fg::EpiSwiglu, fg::MoeSched<1>, true, true, true>(lds, S, E, DM / 2, DM / 2, p.var); }
#else
        int* tab = (int*)(ldsf + 2 * 16 * 132);
        const MoeTab T = moe_tables(tab, gcnt, 128);
        const int nunits = T.mtp[NE + 1] * 8;
        for (int u = bid; u < nunits; u += G) {
            const int mti = u >> 3, nt = u & 7; int e = 0; while (T.mtp[e + 1] <= mti) ++e;
            const int mt = mti - T.mtp[e], nrows = (T.cnt[e] - mt * 128) < 128 ? (T.cnt[e] - mt * 128) : 128;
            const float* Wg = (e < NE) ? p.in[I_WEXG] + (size_t)e * DM * EFF : p.in[I_WSHG];
            const float* Wu = (e < NE) ? p.in[I_WEXU] + (size_t)e * DM * EFF : p.in[I_WSHU];
            BGU bc{Wg, Wu, EFF, nt * 64};
            const size_t hrow0 = (size_t)T.offh[e] + (size_t)mt * 128;
            auto epi = [&](int r, int c, const float (&v)[4]) { act_t* o = hh + (hrow0 + r) * EFF + nt * 64 + (c >> 2) * 2;
                stf(o, v[0] / (1.0f + expf(-v[0])) * v[2]); stf(o + 1, v[1] / (1.0f + expf(-v[1])) * v[3]); };
            ngemm_tile<act_t>(ldsf, tb, DM, (e < NE) ? rowtok + e * CAP : nullptr, mt * 128, nrows, DM, bc, epi);
        }
    #endif
    }
    SEAM(15);
    if (IN(16)) REP(16) {
#if FAST_MOE
        { const fg::MoeTabs T = moe_tables_fast((LAS int*)(lds + 131072), gcnt);
          { fg::MoeSched<2> S{T, (const char*)hh, (const char*)wdT, rowtok, G, bid};
            fg::EpiScatter E{(unsigned char*)ybuf, rowdst, rowgate, T.mtp};
            fg::gemm_phase<fg::EpiScatter, fg::MoeSched<2>, false, true, true>(lds, S, E, EFF / 2, EFF / 2, p.var); }
          { fg::DenseSched S{(const char*)hh + (size_t)T.mtp[64] * 256 * EFF, (const char*)wdT + (size_t)64 * DM * EFF, EFF / 2, EFF / 2, NTOK / 256, DM / 256, 1, EFF / 128, G, bid, 0};
            fg::EpiShared E{(unsigned char*)ybuf + (size_t)NTOK * 8 * DM};
            fg::gemm_phase<fg::EpiShared, fg::DenseSched, false, true, true>(lds, S, E, EFF / 2, EFF / 2); } }
#else
        int* tab = (int*)(ldsf + 2 * 16 * 132);
        const MoeTab T = moe_tables(tab, gcnt, 128);
        const int nunits = T.mtp[NE + 1] * 32;
        for (int u = bid; u < nunits; u += G) {
            const int mti = u >> 5, nt = u & 31; int e = 0; while (T.mtp[e + 1] <= mti) ++e;
            const int mt = mti - T.mtp[e], nrows = (T.cnt[e] - mt * 128) < 128 ? (T.cnt[e] - mt * 128) : 128;
            const float* Wd = (e < NE) ? p.in[I_WEXD] + (size_t)e * EFF * DM : p.in[I_WSHD];
            BPlain bc{Wd, DM, nt * 128, DM};
            const int hrow0 = T.offh[e] + mt * 128;
            auto epi = [&](int r, int c, const float (&v)[4]) {
                int tok; float g; if (e < NE) { tok = rowtok[e * CAP + mt * 128 + r]; g = rowgate[e * CAP + mt * 128 + r]; } else { tok = mt * 128 + r; g = 1.0f; }
                float* o = p.out + (size_t)tok * DM + nt * 128 + c;
                atomicAdd(o, v[0] * g); atomicAdd(o + 1, v[1] * g); atomicAdd(o + 2, v[2] * g); atomicAdd(o + 3, v[3] * g); };
            ngemm_tile<act_t>(ldsf, hh, EFF, nullptr, hrow0, nrows, EFF, bc, epi);
        }
    #endif
    }
    SEAM(16);
    if (IN(17)) REP(17) {
#if FAST_MOE
        for (int m = gw; m < NTOK; m += NGW) {
            const unsigned char* y8 = (const unsigned char*)ybuf + (size_t)m * 8 * DM;
#pragma unroll 2
            for (int j = 0; j < 4; ++j) { const int c0 = lane * 16 + 1024 * j;
                const float* sp = x2 + (size_t)m * DM + c0; float* op = p.out + (size_t)m * DM + c0;
                f32x4 sv[4];
#pragma unroll
                for (int q = 0; q < 4; ++q) sv[q] = __builtin_nontemporal_load((const f32x4*)(sp + 4 * q));
                u32x4 y[9];
#pragma unroll
                for (int k = 0; k < 8; ++k) y[k] = __builtin_nontemporal_load((const u32x4*)(y8 + (size_t)k * DM + c0));
                y[8] = __builtin_nontemporal_load((const u32x4*)((const unsigned char*)ybuf + (size_t)NTOK * 8 * DM + (size_t)m * DM + c0));
                float a[16];
#pragma unroll
                for (int q = 0; q < 16; ++q) a[q] = 0.f;
#pragma unroll
                for (int k = 0; k < 9; ++k) {
#pragma unroll
                    for (int q = 0; q < 4; ++q) { const int w = (int)y[k][q]; const auto lo = __builtin_amdgcn_cvt_pk_f32_fp8(w, false); const auto hi2 = __builtin_amdgcn_cvt_pk_f32_fp8(w, true);
                        a[4 * q] += lo[0]; a[4 * q + 1] += lo[1]; a[4 * q + 2] += hi2[0]; a[4 * q + 3] += hi2[1]; } }
#pragma unroll
                for (int q = 0; q < 4; ++q) { f32x4 o; o.x = sv[q].x + a[4 * q] * (1.0f / fg::Y_SCALE); o.y = sv[q].y + a[4 * q + 1] * (1.0f / fg::Y_SCALE); o.z = sv[q].z + a[4 * q + 2] * (1.0f / fg::Y_SCALE); o.w = sv[q].w + a[4 * q + 3] * (1.0f / fg::Y_SCALE);
                    *(f32x4*)(op + 4 * q) = o; } }
        }
#endif
    }
#undef IN
#undef SEAM
}

#if TVAR
__global__ void __launch_bounds__(512, 2) probe_k(Params p) {
    extern __shared__ __attribute__((aligned(16))) unsigned char lds_raw[];
    const int tid = threadIdx.x, lane = tid & 63, wave = tid >> 6;
    p0_items<TVAR>(p, p.ws, (LAS float*)((LAS unsigned char*)lds_raw + wave * 16640), lane, blockIdx.x * 8 + wave, gridDim.x * 8);
}
#endif
typedef void (*kern_t)(Params);
template <int PH> struct KTab { static void fill(kern_t* t) { t[PH] = fwd<(1u << PH)>; KTab<PH - 1>::fill(t); } };
template <> struct KTab<-1> { static void fill(kern_t*) {} };
extern "C" void kernel_launch(void* const* d_in, const int* in_sizes, int n_in, void* d_out, int out_size, void* d_ws, size_t ws_size, hipStream_t stream) {
    static int grid = 0;
    static kern_t ktab[NPHASE + 1];
    if (grid == 0) {
        if (n_in != 31 || out_size != NTOK * DM || ws_size < WS_END) { fprintf(stderr, "kernel_launch: bad shapes n_in %d out %d ws %zu (need %zu)\n", n_in, out_size, ws_size, (size_t)WS_END); grid = -1; return; }
        int dev = 0, cus = 0;
        if (hipGetDevice(&dev) != hipSuccess || hipDeviceGetAttribute(&cus, hipDeviceAttributeMultiprocessorCount, dev) != hipSuccess) { grid = -1; return; }
#if N_LAUNCH_PER_PHASE
        KTab<NPHASE - 1>::fill(ktab);
#else
        ktab[NPHASE] = fwd<0xFFFFFFFFu>;
#endif
#if N_LAUNCH_PER_PHASE
        for (int i = 0; i < NPHASE; ++i)
#else
        for (int i = NPHASE; i <= NPHASE; ++i)
#endif
            if (hipFuncSetAttribute((const void*)ktab[i], hipFuncAttributeMaxDynamicSharedMemorySize, LDS_BYTES) != hipSuccess) { fprintf(stderr, "kernel_launch: hipFuncSetAttribute failed\n"); grid = -1; return; }
        (void)hipGetLastError();
        grid = cus;
    }
    if (grid < 0) return;
    (void)hipMemsetAsync((char*)d_ws + WS_CTL, 0, CTL_BYTES, stream);
    Params p{};
    for (int i = 0; i < 31; ++i) p.in[i] = (const float*)d_in[i];
    p.out = (float*)d_out; p.ws = (unsigned char*)d_ws;
#if TVAR
    { static int once = 0; if (!once) { (void)hipFuncSetAttribute((const void*)probe_k, hipFuncAttributeMaxDynamicSharedMemorySize, LDS_BYTES); once = 1; } p.ph_lo = 0; p.ph_hi = 0; hipLaunchKernelGGL(probe_k, dim3(grid), dim3(512), LDS_BYTES, stream, p); }
#endif
#if N_LAUNCH_PER_PHASE
    for (int ph = 0; ph < NPHASE; ++ph) { p.ph_lo = ph; p.ph_hi = ph + 1; hipLaunchKernelGGL(ktab[ph], dim3(grid), dim3(512), LDS_BYTES, stream, p); }
#else
    p.ph_lo = 0; p.ph_hi = NPHASE; hipLaunchKernelGGL(ktab[NPHASE], dim3(grid), dim3(512), LDS_BYTES, stream, p);
#endif
#ifdef PROBE_PH
#ifndef PROBE_VAR
#define PROBE_VAR 0
#endif
    (void)hipMemsetAsync((char*)d_ws + WS_CTL + (size_t)CW_QCONV * 4, 0, 1024, stream);
    (void)hipMemsetAsync((char*)d_ws + WS_CTL + (size_t)CW_QCONV * 4, 0, 1024, stream);
    p.ph_lo = PROBE_PH; p.ph_hi = PROBE_PH + 1; p.var = PROBE_VAR; hipLaunchKernelGGL(ktab[NPHASE], dim3(grid), dim3(512), LDS_BYTES, stream, p);
#endif
    const hipError_t le = hipPeekAtLastError();
    if (le != hipSuccess) fprintf(stderr, "kernel_launch: launch failed: %s\n", hipGetErrorName(le));
}
```

```cpp
#include <hip/hip_runtime.h>
#include <cstdio>
#include <cstdint>

#define LAS __attribute__((address_space(3)))
typedef unsigned short bf16_t;
typedef float f32x4 __attribute__((ext_vector_type(4)));
typedef short bf16x8 __attribute__((ext_vector_type(8)));
typedef unsigned u32x4 __attribute__((ext_vector_type(4)));
typedef unsigned u32x2 __attribute__((ext_vector_type(2)));
typedef int v4i_t __attribute__((ext_vector_type(4)));
typedef int v8i_t __attribute__((ext_vector_type(8)));
#ifndef FAST_GEMM
#define FAST_GEMM 1
#endif
#ifndef FAST_MOE
#define FAST_MOE 1
#endif
#ifndef FAST_ATTN
#define FAST_ATTN 1
#endif

#ifndef ACT_F32
#define ACT_F32 0
#endif
#if ACT_F32
typedef float act_t;
#else
typedef bf16_t act_t;
#endif
#ifndef N_LAUNCH_PER_PHASE
#define N_LAUNCH_PER_PHASE 0
#endif

constexpr int NB = 4, SEQ = 2048, DM = 4096, NTOK = NB * SEQ;
constexpr int CHUNK = 64, LEFT = 8, NREL = 192;
constexpr int HD = 128, HA = 16, HB = 16, QLORA = 1024, KVLORA = 512, QKB = 192;
constexpr int MEMT = 256, MH = 4, NE = 64, EFF = 512;
constexpr int WA = HA * HD;
constexpr int INW = 3 * WA + QLORA + KVLORA + 64;
constexpr int NMEM = NB * MEMT;
constexpr int C_Q0 = 0, C_K0 = WA, C_V0 = 2 * WA, C_CQ = 3 * WA, C_CKV = 3 * WA + QLORA, C_KPE = 3 * WA + QLORA + KVLORA;
constexpr float EPS = 1e-6f;
constexpr int CAP = NTOK;

constexpr size_t MiB = 1u << 20;
constexpr size_t AS = sizeof(act_t);
constexpr size_t al(size_t x) { return (x + 255) / 256 * 256; }
constexpr size_t WS_CTL = 0, CTL_BYTES = 1 * MiB;
constexpr size_t WS_ROWTOK = 1 * MiB, WS_ROWGATE = 3 * MiB, WS_ROWDST = 5 * MiB;
constexpr int PK(int K) { return K; }
constexpr int INWP = 7936;
constexpr size_t WS_WR = 8 * MiB;
constexpr size_t WS_WIN = 12 * MiB;
constexpr size_t WS_WUQ = WS_WIN + al((size_t)INWP * PK(DM) * 2);
constexpr size_t WS_WUKV = WS_WUQ + al((size_t)3072 * PK(QLORA) * 2);
constexpr size_t WS_WO = WS_WUKV + al((size_t)4096 * PK(KVLORA) * 2);
constexpr size_t WS_WXQ = WS_WO + al((size_t)DM * PK(DM) * 2);
constexpr size_t WS_WXKV = WS_WXQ + al((size_t)512 * PK(DM) * 2);
constexpr size_t WS_WXO = WS_WXKV + al((size_t)1024 * PK(DM) * 2);
constexpr size_t WS_WGU = WS_WXO + al((size_t)DM * PK(512) * 2);
constexpr size_t WS_WD = WS_WGU + al((size_t)65 * 1024 * DM);
constexpr size_t WS_T8 = WS_WD + al((size_t)65 * DM * EFF);
constexpr size_t WS_SSP1 = WS_T8 + al((size_t)NTOK * DM);
constexpr size_t WS_SSP2 = WS_SSP1 + (size_t)NTOK * 64 * 4;
constexpr size_t WS_RS2 = WS_SSP2 + (size_t)NTOK * 64 * 4;
constexpr size_t WS_X1 = WS_RS2 + al((size_t)NTOK * 4);
constexpr size_t WS_X2 = WS_X1 + al((size_t)NTOK * DM * 4);
constexpr size_t WS_T = WS_X2 + al((size_t)NTOK * DM * 4);
constexpr int HH_ROWS = NTOK * 8 + NE * 256 + NTOK;
constexpr size_t WS_HH = WS_T + al((size_t)NTOK * DM * AS);
constexpr size_t WS_Y = WS_HH + al((size_t)HH_ROWS * EFF * AS);
constexpr size_t WS_H = WS_Y;
constexpr size_t WS_MEMN = WS_H + al((size_t)NTOK * DM * AS);
constexpr size_t WS_P1 = WS_MEMN + al((size_t)NMEM * DM * AS);
constexpr size_t WS_KVM = WS_P1 + al((size_t)NTOK * INW * AS);
constexpr size_t WS_QB = WS_KVM + al((size_t)NMEM * 1024 * AS);
constexpr size_t WS_KVB = WS_QB + al((size_t)NTOK * 3072 * AS);
constexpr size_t WS_MIXED = WS_KVB + al((size_t)NTOK * 4096 * AS);
constexpr size_t WS_HC = WS_MIXED + al((size_t)NTOK * DM * AS);
constexpr size_t WS_QXP = WS_HC + al((size_t)NTOK * DM * AS);
constexpr size_t WS_QX = WS_QXP + al((size_t)4 * NTOK * 512 * 4);
constexpr size_t WS_OX = WS_QX + al((size_t)NTOK * 512 * AS);
constexpr size_t WS_END0 = WS_OX + al((size_t)NTOK * 512 * AS);
constexpr size_t WS_YEND = WS_Y + al((size_t)NTOK * 8 * DM * 2);
constexpr size_t WS_END = WS_END0 > WS_YEND ? WS_END0 : WS_YEND;
static_assert(WS_END <= 2147483648ull, "workspace map exceeds the guaranteed 2 GiB");
constexpr int CW_BAR = 4096;
constexpr int CW_CNT = 16384;
constexpr int CW_QCONV = 26624, CW_QB = 26688, CW_QA = 26752;
constexpr int CW_SS1 = 32768, CW_SS2 = 40960;
constexpr int CW_TICKET = 24576;

constexpr int LDS_BYTES = 163840;
constexpr int LDS_MISC = LDS_BYTES - 64;

__device__ __forceinline__ unsigned f2bf(float f) { unsigned u = __builtin_bit_cast(unsigned, f); return (u + 0x7fffu + ((u >> 16) & 1u)) >> 16; }
__device__ __forceinline__ float ldf(const float* p) { return *p; }
__device__ __forceinline__ float ldf(const bf16_t* p) { return __uint_as_float(((unsigned)*p) << 16); }
__device__ __forceinline__ void stf(float* p, float v) { *p = v; }
__device__ __forceinline__ void stf(bf16_t* p, float v) { *p = (bf16_t)f2bf(v); }
__device__ __forceinline__ float wave_sum(float v) {
#pragma unroll
    for (int o = 1; o < 64; o <<= 1) v += __shfl_xor(v, o);
    return v;
}

#define XB_TMO      128
#define XB_XCNT(j)  (256  + 64 * (j))
#define XB_XSUB(j)  (1280 + 64 * (j))
#define XB_XGEN(j)  (2304 + 64 * (j))
#define XB_TOP      3328
#define XB_TOPGEN   3392
#define XCD_BAR_WORDS 3456
#define XB_SPIN_CAP (1u << 18)
__device__ __forceinline__ unsigned xb_ld(unsigned* p)              { return __hip_atomic_load(p, __ATOMIC_RELAXED, __HIP_MEMORY_SCOPE_AGENT); }
__device__ __forceinline__ unsigned xb_add(unsigned* p, unsigned v) { return __hip_atomic_fetch_add(p, v, __ATOMIC_RELAXED, __HIP_MEMORY_SCOPE_AGENT); }
__device__ __forceinline__ unsigned xb_xcc_id() { return (unsigned)__builtin_amdgcn_s_getreg((3 << 11) | 20) & 0xFu; }
#define XB_SPIN(cond, bar) do { unsigned _sp = 0; while (cond) { __builtin_amdgcn_s_sleep(1); \
    if ((++_sp & 255u) == 0u) { if (xb_ld(&(bar)[XB_TMO])) break; if (_sp > XB_SPIN_CAP) { atomicAdd(&(bar)[XB_TMO], 1u); break; } } } } while (0)
struct XcdBarrier { unsigned* bar; unsigned x; volatile LAS unsigned* st; };
__device__ __forceinline__ XcdBarrier xcd_barrier_post(unsigned* bar, volatile LAS unsigned* st) {
    XcdBarrier b; b.bar = bar; b.x = xb_xcc_id(); b.st = st;
    if (threadIdx.x == 0) (void)xb_add(&bar[XB_XCNT(b.x)], 1u);
    return b;
}
__device__ __forceinline__ void xcd_barrier_complete(unsigned* bar, unsigned x, unsigned& nloc, unsigned& nx) {
    const unsigned G = gridDim.x * gridDim.y * gridDim.z;
    unsigned sum, cnt, mine, sp = 0u;
    for (;;) {
        sum = 0u; cnt = 0u; mine = 0u;
#pragma unroll
        for (unsigned j = 0; j < 16; ++j) { const unsigned c = xb_ld(&bar[XB_XCNT(j)]); sum += c; cnt += (c > 0u) ? 1u : 0u; mine = (j == x) ? c : mine; }
        if (sum == G) break;
        __builtin_amdgcn_s_sleep(1);
        if ((++sp & 255u) == 0u) { if (xb_ld(&bar[XB_TMO])) break; if (sp > XB_SPIN_CAP) { atomicAdd(&bar[XB_TMO], 1u); break; } }
    }
    nloc = mine > 0u ? mine : 1u; nx = cnt > 0u ? cnt : 1u;
}
__device__ __forceinline__ void xcd_barrier(const XcdBarrier& b) {
    asm volatile("s_waitcnt vmcnt(0)" ::: "memory");
    __syncthreads();
    if (threadIdx.x == 0) {
        unsigned* bar = b.bar;
        __builtin_amdgcn_s_waitcnt(0);
        unsigned nloc = b.st[0], nx = b.st[1];
        if (nloc == 0u) { xcd_barrier_complete(bar, b.x, nloc, nx); b.st[0] = nloc; b.st[1] = nx; }
        const unsigned old = xb_add(&bar[XB_XSUB(b.x)], 1u);
        const unsigned gen = old / nloc;
        if (old + 1u == (gen + 1u) * nloc) {
            __builtin_amdgcn_fence(__ATOMIC_RELEASE, "agent");
            asm volatile("s_waitcnt vmcnt(0)" ::: "memory");
            const unsigned og = xb_add(&bar[XB_TOP], 1u);
            const unsigned tg = og / nx;
            if (og + 1u == (tg + 1u) * nx) xb_add(&bar[XB_TOPGEN], 1u);
            else XB_SPIN(xb_ld(&bar[XB_TOPGEN]) == tg, bar);
            __builtin_amdgcn_fence(__ATOMIC_ACQUIRE, "agent");
            xb_add(&bar[XB_XGEN(b.x)], 1u);
            asm volatile("s_waitcnt vmcnt(0)" ::: "memory");
        } else {
            XB_SPIN(xb_ld(&bar[XB_XGEN(b.x)]) == gen, bar);
            __builtin_amdgcn_fence(__ATOMIC_ACQUIRE, "agent");
            asm volatile("s_waitcnt vmcnt(0)" ::: "memory");
        }
    }
    __syncthreads();
}

struct Params {
    const float* in[31];
    float* out;
    unsigned char* ws;
    int ph_lo, ph_hi, var, pad;
};
enum { I_X = 0, I_MEM, I_POS, I_GMIX, I_WIN, I_GQA, I_GKA, I_RELB, I_GCQ, I_WUQ, I_GCKV, I_WUKV, I_GQB, I_GKB, I_WO, I_GCROSS, I_GMEM, I_WXQ, I_WXKV,
       I_GQX, I_GKX, I_WXO, I_GFFN, I_WROUTER, I_RBIAS, I_WSHG, I_WSHU, I_WSHD, I_WEXG, I_WEXU, I_WEXD };

template <class OT>
__device__ __forceinline__ void rms_row_4096(const float* x, const float* g, OT* o, int lane, float* keep  ) {
    f32x4 v[16]; float s = 0.f;
#pragma unroll
    for (int j = 0; j < 16; ++j) { v[j] = ((const f32x4*)x)[lane + 64 * j]; s += v[j].x * v[j].x + v[j].y * v[j].y + v[j].z * v[j].z + v[j].w * v[j].w; }
    s = wave_sum(s);
    const float r = 1.0f / sqrtf(s * (1.0f / 4096.f) + EPS);
#pragma unroll
    for (int j = 0; j < 16; ++j) v[j] = v[j] * r * __builtin_nontemporal_load((const f32x4*)g + lane + 64 * j);
    asm volatile("s_waitcnt vmcnt(0)" ::: "memory");
#pragma unroll
    for (int j = 0; j < 16; ++j) {
        const f32x4 y = v[j];
        const int c = (lane + 64 * j) * 4;
        stf(o + c, y.x); stf(o + c + 1, y.y); stf(o + c + 2, y.z); stf(o + c + 3, y.w);
        if (keep) { keep[c] = y.x; keep[c + 1] = y.y; keep[c + 2] = y.z; keep[c + 3] = y.w; }
    }
}
template <int N>
__device__ __forceinline__ void rms_inplace(act_t* p, const float* g, int lane) {
    float v[N / 64]; float s = 0.f;
#pragma unroll
    for (int j = 0; j < N / 64; ++j) { v[j] = ldf(p + lane + 64 * j); s += v[j] * v[j]; }
    s = wave_sum(s);
    const float r = 1.0f / sqrtf(s * (1.0f / N) + EPS);
#pragma unroll
    for (int j = 0; j < N / 64; ++j) stf(p + lane + 64 * j, v[j] * r * g[lane + 64 * j]);
}
__device__ __forceinline__ void rms_rope64_inplace(act_t* p, const float* g, int pos, int lane) {
    float v = ldf(p + lane);
    float s = wave_sum(v * v);
    const float r = 1.0f / sqrtf(s * (1.0f / 64.f) + EPS);
    v = v * r * g[lane];
    const int fi = lane & 31;
    const float inv_freq = powf(10000.0f, -(float)(2 * fi) / 64.0f);
    const float ang = (float)pos * inv_freq;
    float sn, cs; sincosf(ang, &sn, &cs);
    const float other = __shfl_xor(v, 32);
    const float y = (lane < 32) ? (v * cs - other * sn) : (v * cs + other * sn);
    stf(p + lane, y);
}

template <class AT, class BCol, class Epi>
__device__ __forceinline__ void ngemm_tile(float* lds, const AT* A, long lda, const int* rowlist, int row0, int nrows, int K, const BCol& bcol, const Epi& epi) {
    const int tid = threadIdx.x, tx = tid & 31, ty = tid >> 5;
    float* As = lds; float* Bs = lds + 16 * 132;
    const int arow = tid >> 2, akq = (tid & 3) * 4;
    int grow; { const int rr = (arow < nrows) ? arow : 0; grow = rowlist ? rowlist[row0 + rr] : (row0 + rr); }
    const AT* Ap = A + (long)grow * lda + akq;
    const int bj = tid & 127, bk = tid >> 7;
    const float* Bp = bcol(bj) + (long)bk * bcol.ldb;
    float acc[8][4];
#pragma unroll
    for (int i = 0; i < 8; ++i)
#pragma unroll
        for (int j = 0; j < 4; ++j) acc[i][j] = 0.f;
    for (int k0 = 0; k0 < K; k0 += 16) {
        float a0 = ldf(Ap + k0), a1 = ldf(Ap + k0 + 1), a2 = ldf(Ap + k0 + 2), a3 = ldf(Ap + k0 + 3);
        float b0 = Bp[(long)(k0) * bcol.ldb], b1 = Bp[(long)(k0 + 4) * bcol.ldb], b2 = Bp[(long)(k0 + 8) * bcol.ldb], b3 = Bp[(long)(k0 + 12) * bcol.ldb];
        __syncthreads();
        As[(akq + 0) * 132 + arow] = a0; As[(akq + 1) * 132 + arow] = a1; As[(akq + 2) * 132 + arow] = a2; As[(akq + 3) * 132 + arow] = a3;
        Bs[(bk + 0) * 132 + bj] = b0; Bs[(bk + 4) * 132 + bj] = b1; Bs[(bk + 8) * 132 + bj] = b2; Bs[(bk + 12) * 132 + bj] = b3;
        __syncthreads();
#pragma unroll
        for (int kk = 0; kk < 16; ++kk) {
            const f32x4 al = *(const f32x4*)(As + kk * 132 + ty * 8), ah = *(const f32x4*)(As + kk * 132 + ty * 8 + 4);
            const f32x4 b = *(const f32x4*)(Bs + kk * 132 + tx * 4);
            const float a[8] = {al.x, al.y, al.z, al.w, ah.x, ah.y, ah.z, ah.w};
#pragma unroll
            for (int i = 0; i < 8; ++i) { acc[i][0] += a[i] * b.x; acc[i][1] += a[i] * b.y; acc[i][2] += a[i] * b.z; acc[i][3] += a[i] * b.w; }
        }
    }
    __syncthreads();
#pragma unroll
    for (int i = 0; i < 8; ++i) { const int r = ty * 8 + i; if (r < nrows) epi(r, tx * 4, acc[i]); }
}
struct BGU { const float* Wg; const float* Wu; int ldb; int ff0; __device__ __forceinline__ const float* operator()(int j) const { const int ff = ff0 + (j >> 2) * 2 + (j & 1); const uintptr_t a = (uintptr_t)Wg, b = (uintptr_t)Wu; return (const float*)((j & 2) ? b : a) + ff; } };
struct BPlain { const float* B; int ldb; int col0, ncols; __device__ __forceinline__ const float* operator()(int j) const { const int c = col0 + j; return B + (c < ncols ? c : 0); } };

template <int DQK, class KeyTile, class Bias>
__device__ __forceinline__ void nattn_unit(float* lds, const act_t* Q, long ldq, const act_t* K1, long ldk1, const act_t* K2, long ldk2, const act_t* V, long ldv,
                                           int ntiles, const KeyTile& keytile, float scale, const Bias& bias, act_t* O, long ldo) {
    constexpr int QS = DQK + 4;
    float* Qs = lds; float* Ks = Qs + 64 * QS; float* Vs = Ks + 64 * QS; float* Ss = Vs + 64 * 132;
    const int tid = threadIdx.x, r = tid >> 3, s = tid & 7;
    __syncthreads();
    for (int idx = tid; idx < 64 * DQK; idx += 512) { const int row = idx / DQK, d = idx % DQK; Qs[row * QS + d] = ldf(Q + (long)row * ldq + d); }
    float m = -INFINITY, l = 0.f; float o[16];
#pragma unroll
    for (int d = 0; d < 16; ++d) o[d] = 0.f;
    for (int t = 0; t < ntiles; ++t) {
        const int k0 = keytile(t);
        __syncthreads();
        for (int idx = tid; idx < 64 * 128; idx += 512) { const int row = idx >> 7, d = idx & 127;
            Ks[row * QS + d] = ldf(K1 + (long)(k0 + row) * ldk1 + d); Vs[row * 132 + d] = ldf(V + (long)(k0 + row) * ldv + d); }
        if (DQK > 128) for (int idx = tid; idx < 64 * (DQK - 128); idx += 512) { const int row = idx / (DQK - 128), d = idx % (DQK - 128);
            Ks[row * QS + 128 + d] = ldf(K2 + (long)(k0 + row) * ldk2 + d); }
        __syncthreads();
#pragma unroll
        for (int jj = 0; jj < 8; ++jj) { const int key = s + 8 * jj; float dot = 0.f;
#pragma unroll 8
            for (int d = 0; d < DQK; d += 4) { const f32x4 q = *(const f32x4*)(Qs + r * QS + d), k = *(const f32x4*)(Ks + key * QS + d); dot += q.x * k.x + q.y * k.y + q.z * k.z + q.w * k.w; }
            Ss[r * 65 + key] = dot * scale + bias(r, t, key); }
        __syncthreads();
        float mt = -INFINITY;
        for (int k = 0; k < 64; ++k) mt = fmaxf(mt, Ss[r * 65 + k]);
        const float mn = fmaxf(m, mt), alpha = expf(m - mn);
        float ladd = 0.f;
#pragma unroll
        for (int d = 0; d < 16; ++d) o[d] *= alpha;
        for (int k = 0; k < 64; ++k) { const float pk = expf(Ss[r * 65 + k] - mn); ladd += pk;
#pragma unroll
            for (int d = 0; d < 16; d += 4) { const f32x4 v = *(const f32x4*)(Vs + k * 132 + s * 16 + d); o[d] += pk * v.x; o[d + 1] += pk * v.y; o[d + 2] += pk * v.z; o[d + 3] += pk * v.w; } }
        m = mn; l = l * alpha + ladd;
    }
    const float il = 1.0f / l;
#pragma unroll
    for (int d = 0; d < 16; ++d) stf(O + (long)r * ldo + s * 16 + d, o[d] * il);
}

struct MoeTab { int* cnt; int* mtp; int* offh; };
__device__ __forceinline__ MoeTab moe_tables(int* tab, const unsigned* gcnt, int tile_m) {
    MoeTab T; T.cnt = tab; T.mtp = tab + 80; T.offh = tab + 160;
    __syncthreads();
    if (threadIdx.x == 0) {
        int pm = 0, po = 0;
        for (int e = 0; e <= NE; ++e) { const int c = (e < NE) ? (int)gcnt[e] : NTOK; T.cnt[e] = c; T.mtp[e] = pm; T.offh[e] = po; pm += (c + tile_m - 1) / tile_m; po += c; }
        T.mtp[NE + 1] = pm;
    }
    __syncthreads();
    return T;
}

namespace fg {
constexpr int BM = 256, BK = 64, HALF = 128, HTB = HALF * BK * 2, STAGE_BYTES = 8 * HTB;
__device__ __forceinline__ int lds_byte(int r, int c) { const int st = (r >> 4) * 2 + (c >> 5), rr = r & 15, cc = c & 31, ob = rr * 64 + cc * 2; return st * 1024 + (ob ^ (((ob >> 9) & 1) << 5)); }
__device__ __forceinline__ void stage_rc(int b, int& R, int& C) { const int st = b / 1024, sb = b % 1024, swz = sb ^ (((sb >> 9) & 1) << 5); R = (st >> 1) * 16 + swz / 64; C = (st & 1) * 32 + (swz % 64) / 2; }
__device__ __forceinline__ int perm32(int rho) { const int n = rho >> 4, i = rho & 15; return 8 * (i >> 2) + 4 * n + (i & 3); }
__device__ __forceinline__ unsigned cvt_pk_bf16(float lo, float hi) { unsigned r; asm volatile("v_cvt_pk_bf16_f32 %0, %1, %2" : "=v"(r) : "v"(lo), "v"(hi)); return r; }

__device__ __forceinline__ unsigned pk4_fp8(float a, float b, float c, float d) { int w = 0; w = __builtin_amdgcn_cvt_pk_fp8_f32(a, b, w, false); w = __builtin_amdgcn_cvt_pk_fp8_f32(c, d, w, true); return (unsigned)w; }
constexpr float H_SCALE = 4.0f, WD_SCALE = 32.0f, WGU_SCALE = 64.0f, T_SCALE = 2.0f, Y_SCALE = 16.0f;
struct Unit { const char* A; const char* B; const int* rows; int nkt, nvalid, pm, pn, e, arow0; };

template <class Epi, class Sched, bool GATHER, bool FP8 = false, bool SP2 = false>
__device__ __forceinline__ void gemm_phase(LAS unsigned char* lds, const Sched& S, const Epi& E, const int lda, const int ldb, const int var_in = 0) {
#ifdef PROBE_PH
    const int var = var_in;
#else
    constexpr int var = 0; (void)var_in;
#endif
    int tid = threadIdx.x; asm volatile("" : "+v"(tid));
    const int wid = __builtin_amdgcn_readfirstlane(tid >> 6), lane = tid & 63, wr = wid >> 2, wc = wid & 3, fr = lane & 15, fq = lane >> 4;
    unsigned voffB[2][2], voffA[2][2];
#pragma unroll
    for (int i = 0; i < 2; ++i) { int sR, sC; stage_rc(tid * 16 + i * 8192, sR, sC);
#pragma unroll
        for (int hb = 0; hb < 2; ++hb) { int Rb;
            if (Epi::PERM == 2) Rb = 64 * (sR >> 5) + 16 * ((sR >> 2) & 3) + 8 * hb + 4 * ((sR >> 4) & 1) + (sR & 3);
            else Rb = 128 * hb + (Epi::PERM == 1 ? ((sR & ~31) + perm32(sR & 31)) : sR);
            voffB[hb][i] = (unsigned)((Rb >> 6) * ldb * 64 + (Rb & 63) * 64 + sC) * 2u; }
#pragma unroll
        for (int h = 0; h < 2; ++h) voffA[h][i] = (unsigned)((sR + HALF * h) * lda + sC) * 2u; }
    const size_t kstep = (size_t)(BK * 2), kstepB = 8192;
    const unsigned ldsw = (unsigned)wid * 1024u;
    const int aoff = FP8 ? lds_byte(wr * 64 + fr, fq * 16) : lds_byte(wr * 64 + fr, fq * 8), boff = FP8 ? lds_byte(wc * 32 + fr, fq * 16) : lds_byte(wc * 32 + fr, fq * 8);
#define FG_SA(b, h) (((b) * 2 + (h)) * HTB)
#define FG_SB(b, h) ((4 + (b) * 2 + (h)) * HTB)
#define FG_STAGE2(bufoff, gbase, v0, v1) do { \
        __builtin_amdgcn_global_load_lds((const unsigned*)((const char*)(gbase) + (v0)), (LAS unsigned*)(lds + (bufoff) + ldsw), 16, 0, 0); \
        __builtin_amdgcn_global_load_lds((const unsigned*)((const char*)(gbase) + (v1)), (LAS unsigned*)(lds + (bufoff) + ldsw + 8192), 16, 0, 0); } while (0)
#define FG_STAGEB(bufoff, gbase, hb) FG_STAGE2(bufoff, gbase, voffB[hb][0], voffB[hb][1])
#define FG_STAGEA(bufoff, gbase, h) FG_STAGE2(bufoff, gbase, voffA[h][0], voffA[h][1])
#define FG_LD8(base_) __builtin_shufflevector(*(const LAS v4i_t*)(base_), *(const LAS v4i_t*)((base_) + 16), 0, 1, 2, 3, 4, 5, 6, 7)
#define FG_LDA(dst, b, h) do { if (FP8) { _Pragma("unroll") for (int m = 0; m < 4; ++m) dst##8[m] = FG_LD8(lds + FG_SA(b, h) + aoff + m * 2048); } \
      else { _Pragma("unroll") for (int m = 0; m < 4; ++m) _Pragma("unroll") for (int k = 0; k < 2; ++k) dst[m][k] = *(const LAS bf16x8*)(lds + FG_SA(b, h) + aoff + m * 2048 + k * 1024); } } while (0)
#define FG_LDB(dst, b, h) do { if (FP8) { _Pragma("unroll") for (int n = 0; n < 2; ++n) dst##8[n] = FG_LD8(lds + FG_SB(b, h) + boff + n * 2048); } \
      else { _Pragma("unroll") for (int n = 0; n < 2; ++n) _Pragma("unroll") for (int k = 0; k < 2; ++k) dst[n][k] = *(const LAS bf16x8*)(lds + FG_SB(b, h) + boff + n * 2048 + k * 1024); } } while (0)
#define FG_MMA(ai, bj, At, Bt) do { __builtin_amdgcn_s_setprio(1); if (FP8) { _Pragma("unroll") for (int m = 0; m < 4; ++m) _Pragma("unroll") for (int n = 0; n < 2; ++n) \
        asm volatile("v_mfma_scale_f32_16x16x128_f8f6f4 %0, %1, %2, %0, %3, %3 op_sel_hi:[0,0,0]" : "+v"(acc[ai][bj][m][n]) : "v"(Bt##8[n]), "v"(At##8[m]), "v"(sc127)); } \
      else { _Pragma("unroll") for (int m = 0; m < 4; ++m) _Pragma("unroll") for (int n = 0; n < 2; ++n) _Pragma("unroll") for (int k = 0; k < 2; ++k) \
        acc[ai][bj][m][n] = __builtin_amdgcn_mfma_f32_16x16x32_bf16(Bt[n][k], At[m][k], acc[ai][bj][m][n], 0, 0, 0); } __builtin_amdgcn_s_setprio(0); } while (0)
#define FG_WAIT_V(n) asm volatile("s_waitcnt vmcnt(" #n ")" ::: "memory")
#define FG_WAIT_L(n) asm volatile("s_waitcnt lgkmcnt(" #n ")" ::: "memory")
#define FG_BAR __builtin_amdgcn_s_barrier()
#define FG_SCHED __builtin_amdgcn_sched_barrier(0)
#define FG_GATHER(dst, u) do { if (GATHER) { int tz = threadIdx.x; asm volatile("" : "+v"(tz)); _Pragma("unroll") for (int i = 0; i < 2; ++i) { int sR, sC; stage_rc(tz * 16 + i * 8192, sR, sC); \
        _Pragma("unroll") for (int h = 0; h < 2; ++h) { int rr = sR + HALF * h; rr = rr < (u).nvalid ? rr : 0; const int tok = (u).rows ? (u).rows[rr] : ((u).arow0 + rr); dst[h][i] = (unsigned)(tok * lda + sC) * 2u; } } } } while (0)
    Unit cur, nxt; int ui = 0;
    if (!S.next(0, cur)) return;
    f32x4 acc[2][2][4][2];
#pragma unroll
    for (int a = 0; a < 2; ++a)
#pragma unroll
        for (int b = 0; b < 2; ++b)
#pragma unroll
            for (int m = 0; m < 4; ++m)
#pragma unroll
                for (int n = 0; n < 2; ++n) acc[a][b][m][n] = (f32x4){0.f, 0.f, 0.f, 0.f};
    const int sc127 = 127;
    bf16x8 At[4][2], B0[2][2], B1[2][2]; v8i_t At8[4], B08[2], B18[2];
    const char* cA = cur.A; const char* cB = cur.B;
    typename Epi::Pre pre; E.prefetch(pre, cur, wr, fr);
    FG_GATHER(voffA, cur);
    if (SP2) {
    FG_STAGEB(FG_SB(0, 0), cB, 0); FG_STAGEB(FG_SB(0, 1), cB, 1); FG_STAGEA(FG_SA(0, 0), cA, 0); FG_STAGEA(FG_SA(0, 1), cA, 1);
    if (wr == 1) FG_BAR;
    FG_WAIT_V(2); FG_BAR;
    FG_STAGEB(FG_SB(1, 0), cB + kstepB, 0); FG_STAGEA(FG_SA(1, 0), cA + kstep, 0); FG_STAGEB(FG_SB(1, 1), cB + kstepB, 1);
    FG_WAIT_V(6); FG_BAR;
    } else {
    FG_STAGEB(FG_SB(0, 0), cB, 0); FG_STAGEA(FG_SA(0, 0), cA, 0); FG_STAGEB(FG_SB(0, 1), cB, 1); FG_STAGEA(FG_SA(0, 1), cA, 1);
    if (wr == 1) FG_BAR;
    FG_WAIT_V(4); FG_BAR;
    FG_STAGEB(FG_SB(1, 0), cB + kstepB, 0); FG_STAGEA(FG_SA(1, 0), cA + kstep, 0); FG_STAGEB(FG_SB(1, 1), cB + kstepB, 1);
    FG_WAIT_V(6); FG_BAR;
    }
    for (;;) {
        const bool has_next = S.next(ui + 1, nxt);
        const char* nA = has_next ? nxt.A : cA; const char* nB = has_next ? nxt.B : cB;
        const int nt = cur.nkt;
#pragma unroll 1
        for (int t = 0; t < nt; t += 2) {
            const bool last = (t == nt - 2);
            const char* a1 = cA + (size_t)(t + 1) * kstep;
            const char* a2 = last ? nA : cA + (size_t)(t + 2) * kstep; const char* b2 = last ? nB : cB + (size_t)(t + 2) * kstepB;
            const char* a3 = a2 + kstep; const char* b3 = b2 + kstepB;
            if (SP2) {
            FG_LDB(B0, 0, 0); FG_LDB(B1, 0, 1); FG_SCHED; FG_LDA(At, 0, 0); FG_STAGEA(FG_SA(1, 1), a1, 1);
            if (GATHER && last && has_next) { FG_GATHER(voffA, nxt); }
            FG_WAIT_V(8); FG_WAIT_L(0); FG_BAR; FG_MMA(0, 0, At, B0); FG_MMA(0, 1, At, B1); FG_BAR; FG_SCHED;
            FG_LDA(At, 0, 1); FG_STAGEB(FG_SB(0, 0), b2, 0); FG_STAGEB(FG_SB(0, 1), b2, 1); FG_STAGEA(FG_SA(0, 0), a2, 0);
            FG_WAIT_V(8); FG_WAIT_L(0); FG_BAR; FG_MMA(1, 0, At, B0); FG_MMA(1, 1, At, B1); FG_BAR; FG_SCHED;
            FG_LDB(B0, 1, 0); FG_LDB(B1, 1, 1); FG_SCHED; FG_LDA(At, 1, 0); FG_STAGEA(FG_SA(0, 1), a2, 1);
            FG_WAIT_V(8); FG_WAIT_L(0); FG_BAR; FG_MMA(0, 0, At, B0); FG_MMA(0, 1, At, B1); FG_BAR; FG_SCHED;
            FG_LDA(At, 1, 1); FG_STAGEB(FG_SB(1, 0), b3, 0); FG_STAGEB(FG_SB(1, 1), b3, 1); FG_STAGEA(FG_SA(1, 0), a3, 0);
            FG_WAIT_V(8); FG_WAIT_L(0); FG_BAR; FG_MMA(1, 0, At, B0); FG_MMA(1, 1, At, B1); FG_BAR; FG_SCHED;
            } else {
            FG_LDB(B0, 0, 0); FG_SCHED; FG_LDA(At, 0, 0); FG_STAGEA(FG_SA(1, 1), a1, 1);
            if (GATHER && last && has_next) { FG_GATHER(voffA, nxt); }
            FG_WAIT_L(8); FG_BAR; FG_WAIT_L(0); if (var < 4) FG_MMA(0, 0, At, B0); FG_BAR; FG_SCHED;
            FG_LDB(B1, 0, 1); FG_STAGEB(FG_SB(0, 0), b2, 0);
            FG_BAR; FG_WAIT_L(0); if (var < 3) FG_MMA(0, 1, At, B1); FG_BAR;
            FG_LDA(At, 0, 1); FG_STAGEA(FG_SA(0, 0), a2, 0);
            FG_BAR; FG_WAIT_L(0); if (var < 4) FG_MMA(1, 0, At, B0); FG_BAR; FG_SCHED;
            FG_STAGEB(FG_SB(0, 1), b2, 1);
            FG_WAIT_V(6); FG_BAR; if (var < 3) FG_MMA(1, 1, At, B1); FG_BAR;
            FG_LDB(B0, 1, 0); FG_SCHED; FG_LDA(At, 1, 0); FG_STAGEA(FG_SA(0, 1), a2, 1);
            FG_WAIT_L(8); FG_BAR; FG_WAIT_L(0); if (var < 4) FG_MMA(0, 0, At, B0); FG_BAR; FG_SCHED;
            FG_LDB(B1, 1, 1); FG_STAGEB(FG_SB(1, 0), b3, 0);
            FG_BAR; FG_WAIT_L(0); if (var < 3) FG_MMA(0, 1, At, B1); FG_BAR;
            FG_LDA(At, 1, 1); FG_STAGEA(FG_SA(1, 0), a3, 0);
            FG_BAR; FG_WAIT_L(0); if (var < 4) FG_MMA(1, 0, At, B0); FG_BAR; FG_SCHED;
            FG_STAGEB(FG_SB(1, 1), b3, 1);
            FG_WAIT_V(6); FG_BAR; if (var < 3) FG_MMA(1, 1, At, B1); FG_BAR;
                    }
}
        if (SP2) { if (wr == 0) FG_BAR; }
        { int tz = threadIdx.x; asm volatile("" : "+v"(tz));
          const int wz = __builtin_amdgcn_readfirstlane(tz >> 6), lz = tz & 63; if (var != 2 && var != 9) E(acc, cur, wz >> 2, wz & 3, lz & 15, lz >> 4, pre); }
        if (!has_next) break;
#pragma unroll
        for (int a = 0; a < 2; ++a)
#pragma unroll
            for (int b = 0; b < 2; ++b)
#pragma unroll
                for (int m = 0; m < 4; ++m)
#pragma unroll
                    for (int n = 0; n < 2; ++n) acc[a][b][m][n] = (f32x4){0.f, 0.f, 0.f, 0.f};
        cur = nxt; cA = nA; cB = nB; ++ui;
        { int tz = threadIdx.x; asm volatile("" : "+v"(tz)); E.prefetch(pre, cur, __builtin_amdgcn_readfirstlane(tz >> 6) >> 2, tz & 15); }
        if (SP2) { if (wr == 1) FG_BAR; }
    }
    FG_WAIT_V(0);
    if (!SP2) { if (wr == 0) FG_BAR; }
    FG_BAR;
#undef FG_SA
#undef FG_SB
#undef FG_STAGE2
#undef FG_STAGEB
#undef FG_STAGEA
#undef FG_STAGEAX
#undef FG_LDA
#undef FG_LDB
#undef FG_MMA
#undef FG_LD8
#undef FG_WAIT_V
#undef FG_WAIT_L
#undef FG_BAR
#undef FG_SCHED
#undef FG_GATHER
}

struct DenseSched {
    const char* A; const char* B; int lda, ldb, nM, nN, nS, nkt, G, c, first;
    __device__ __forceinline__ bool next(int i, Unit& u) const {
        const int total = nM * nN * nS; const int per = (total + 7) / 8;
        int L;
        if (first == 1) {
            const int x = c & 7, r = c >> 3; if (r >= 16) { if (i >= 3) return false; L = x * 64 + (r - 16) * 3 + i; } else { if (i >= 1) return false; L = x * 64 + 48 + r; }
        } else {
        const int j = i * G + c; const int x = j & 7, q = j >> 3;
        if (q >= per) return false; L = x * per + q; if (L >= total) return false; }
        const int ks = L % nS, t2 = L / nS;
        const int nig = 8 * nN, gid = t2 / nig, fm = gid * 8, gsz = (nM - fm) < 8 ? (nM - fm) : 8;
        const int pm = fm + (t2 % nig) % gsz, pn = (t2 % nig) / gsz;
        u.A = A + ((size_t)pm * BM * lda + (size_t)ks * nkt * BK) * 2; u.B = B + ((size_t)pn * BM * ldb + (size_t)ks * nkt * 4096) * 2;
        if (first == 2) { u.A = A; u.B = B; }
        u.rows = nullptr; u.nkt = nkt; u.nvalid = BM; u.pm = pm; u.pn = pn; u.e = ks; u.arow0 = pm * BM; return true;
    }
};
struct NoPre {};
struct EpiBf16 {
    static constexpr int PERM = 1; typedef NoPre Pre; __device__ __forceinline__ void prefetch(Pre&, const Unit&, int, int) const {}
    bf16_t* O; int ldc, ncols; float scale;
    __device__ __forceinline__ void operator()(const f32x4 (&acc)[2][2][4][2], const Unit& u, int wr, int wc, int fr, int fq, const Pre& pre) const {
        const int row0 = u.pm * BM + wr * 64 + fr, col0 = u.pn * BM + wc * 32 + 8 * fq;
#pragma unroll
        for (int ai = 0; ai < 2; ++ai)
#pragma unroll
            for (int m = 0; m < 4; ++m) { bf16_t* rowp = O + (size_t)(row0 + ai * HALF + m * 16) * ldc + col0;
#pragma unroll
                for (int bj = 0; bj < 2; ++bj) { const f32x4 v0 = acc[ai][bj][m][0] * scale, v1 = acc[ai][bj][m][1] * scale;
                    u32x4 w; w.x = cvt_pk_bf16(v0[0], v0[1]); w.y = cvt_pk_bf16(v0[2], v0[3]); w.z = cvt_pk_bf16(v1[0], v1[1]); w.w = cvt_pk_bf16(v1[2], v1[3]);
                    if (col0 + bj * HALF + 8 <= ncols) *(u32x4*)(rowp + bj * HALF) = w; } }
    }
};
struct EpiBf16N {
    static constexpr int PERM = 1; typedef NoPre Pre; __device__ __forceinline__ void prefetch(Pre&, const Unit&, int, int) const {}
    bf16_t* O; int ldc, ncols; float scale;
    const float* gA; int pnA_end; const float* gB; int pnB_end; int half0_only; LAS float* part;
    __device__ __forceinline__ void operator()(const f32x4 (&acc)[2][2][4][2], const Unit& u, int wr, int wc, int fr, int fq, const Pre& pre) const {
        const int rt0 = wr * 64 + fr, row0 = u.pm * BM + rt0, col0 = u.pn * BM + wc * 32 + 8 * fq;
        const bool do_norm = u.pn < pnB_end;
        if (do_norm) {
#pragma unroll
            for (int ai = 0; ai < 2; ++ai)
#pragma unroll
                for (int m = 0; m < 4; ++m)
#pragma unroll
                    for (int bj = 0; bj < 2; ++bj) { if (half0_only && bj == 1) continue;
                        const f32x4 v0 = acc[ai][bj][m][0] * scale, v1 = acc[ai][bj][m][1] * scale;
                        float ss = (v0.x * v0.x + v0.y * v0.y) + (v0.z * v0.z + v0.w * v0.w) + (v1.x * v1.x + v1.y * v1.y) + (v1.z * v1.z + v1.w * v1.w);
                        ss += __shfl_xor(ss, 16); ss += __shfl_xor(ss, 32);
                        if (fq == 0) part[((rt0 + ai * HALF + m * 16) * 2 + bj) * 4 + wc] = ss; }
            asm volatile("s_waitcnt lgkmcnt(0)" ::: "memory"); __builtin_amdgcn_s_barrier(); asm volatile("" ::: "memory");
        }
        const float* g = (u.pn < pnA_end) ? gA : gB;
        f32x4 g0 = (f32x4){1.f, 1.f, 1.f, 1.f}, g1 = g0;
        if (do_norm) { g0 = *(const f32x4*)(g + wc * 32 + 8 * fq); g1 = *(const f32x4*)(g + wc * 32 + 8 * fq + 4); }
#pragma unroll
        for (int ai = 0; ai < 2; ++ai)
#pragma unroll
            for (int m = 0; m < 4; ++m) { const int rt = rt0 + ai * HALF + m * 16; bf16_t* rowp = O + (size_t)(row0 + ai * HALF + m * 16) * ldc + col0;
#pragma unroll
                for (int bj = 0; bj < 2; ++bj) { f32x4 v0 = acc[ai][bj][m][0] * scale, v1 = acc[ai][bj][m][1] * scale;
                    if (do_norm && !(half0_only && bj == 1)) { const f32x4 p4 = *(const LAS f32x4*)(part + (rt * 2 + bj) * 4);
                        const float r = 1.0f / sqrtf(((p4.x + p4.y) + (p4.z + p4.w)) * (1.0f / 128.f) + 1e-6f); v0 = v0 * r * g0; v1 = v1 * r * g1; }
                    u32x4 w; w.x = cvt_pk_bf16(v0[0], v0[1]); w.y = cvt_pk_bf16(v0[2], v0[3]); w.z = cvt_pk_bf16(v1[0], v1[1]); w.w = cvt_pk_bf16(v1[2], v1[3]);
                    if (col0 + bj * HALF + 8 <= ncols) *(u32x4*)(rowp + bj * HALF) = w; } }
    }
};
template <bool HAS_RES> struct EpiF32Res {
    static constexpr int PERM = 0; typedef NoPre Pre; __device__ __forceinline__ void prefetch(Pre&, const Unit&, int, int) const {}
    float* __restrict__ C; const float* __restrict__ res; int ldc; size_t slab; float scale;
    __device__ __forceinline__ void operator()(const f32x4 (&acc)[2][2][4][2], const Unit& u, int wr, int wc, int fr, int fq, const Pre& pre) const {
        const int row0 = u.pm * BM + wr * 64 + fr, col0 = u.pn * BM + wc * 32 + 4 * fq;
        float* __restrict__ Cb = C + (size_t)u.e * slab;
#pragma unroll
        for (int ai = 0; ai < 2; ++ai) {
            f32x4 r[4][2][2];
            if (HAS_RES) {
#pragma unroll
                for (int m = 0; m < 4; ++m) { const size_t o = (size_t)(row0 + ai * HALF + m * 16) * ldc + col0;
#pragma unroll
                    for (int bj = 0; bj < 2; ++bj)
#pragma unroll
                        for (int n = 0; n < 2; ++n) r[m][bj][n] = __builtin_nontemporal_load((const f32x4*)(res + o + bj * HALF + n * 16)); }
            }
#pragma unroll
            for (int m = 0; m < 4; ++m) { const size_t o = (size_t)(row0 + ai * HALF + m * 16) * ldc + col0;
#pragma unroll
                for (int bj = 0; bj < 2; ++bj)
#pragma unroll
                    for (int n = 0; n < 2; ++n) { f32x4 v = acc[ai][bj][m][n] * scale; if (HAS_RES) v = v + r[m][bj][n]; *(f32x4*)(Cb + o + bj * HALF + n * 16) = v; } }
        }
    }
};
struct MoeTabs { const LAS int* cnt; const LAS int* mtp; };
template <int PHASE  >
struct MoeSched {
    MoeTabs T; const char* A; const char* B; const int* rowtok; int G, c;
    __device__ __forceinline__ bool next(int i, Unit& u) const {
        constexpr int NT = (PHASE == 1) ? 4 : 16;
        const int nm = T.mtp[(PHASE == 1) ? 65 : 64], total = nm * NT, per = (total + 7) / 8;
        const int j = i * G + c, x = j & 7, q = j >> 3;
        if (q >= per) return false; const int L = x * per + q; if (L >= total) return false;
        int mti, pn;
        if (PHASE == 1) { mti = L / NT; pn = L % NT; }
        else { mti = L / NT; pn = 0; }
        int e = 0;
#pragma unroll 1
        for (int s2 = 32; s2 >= 1; s2 >>= 1) { if (e + s2 <= 64 && T.mtp[e + s2] <= mti) e += s2; }
        while (T.mtp[e + 1] <= mti) ++e;
        e = __builtin_amdgcn_readfirstlane(e);
        int mt = mti - T.mtp[e];
        if (PHASE == 2) {
            const int nme = T.mtp[e + 1] - T.mtp[e], r = L - T.mtp[e] * NT, ph = r / (nme * 8), r2 = r % (nme * 8);
            mt = r2 >> 3; pn = ph * 8 + (r2 & 7); mti = T.mtp[e] + mt; }
        int nv = T.cnt[e] - mt * 256; nv = nv < 256 ? nv : 256;
        u.nvalid = nv; u.pm = mti; u.pn = pn; u.e = e;
        if (PHASE == 1) { u.A = A; u.B = B + ((size_t)e * 1024 + (size_t)pn * 256) * DM; u.rows = (e < NE) ? rowtok + e * CAP + mt * 256 : nullptr; u.arow0 = mt * 256; u.nkt = DM / 128; }
        else { u.A = A + (size_t)mti * 256 * EFF; u.B = B + ((size_t)e * DM + (size_t)pn * 256) * EFF; u.rows = nullptr; u.arow0 = mt * 256; u.nkt = EFF / 128; }
        return true;
    }
};
struct EpiSwiglu {
    static constexpr int PERM = 1;
    struct Pre { float ssv[2][4]; };
    bf16_t* H; const float* ss;
    __device__ __forceinline__ void prefetch(Pre& pre, const Unit& u, int wr, int fr) const {
        const int r0 = wr * 64 + fr;
#pragma unroll
        for (int ai = 0; ai < 2; ++ai)
#pragma unroll
            for (int m = 0; m < 4; ++m) { int rr = r0 + ai * HALF + m * 16; rr = rr < u.nvalid ? rr : 0; const int tok = u.rows ? u.rows[rr] : (u.arow0 + rr); pre.ssv[ai][m] = ss[tok]; } }
    __device__ __forceinline__ void operator()(const f32x4 (&acc)[2][2][4][2], const Unit& u, int wr, int wc, int fr, int fq, const Pre& pre) const {
        const int r0 = wr * 64 + fr, col0 = u.pn * 128 + wc * 32 + 8 * fq;
#pragma unroll
        for (int ai = 0; ai < 2; ++ai)
#pragma unroll
            for (int m = 0; m < 4; ++m) { const int r = r0 + ai * HALF + m * 16;
                const float rs = pre.ssv[ai][m] * (1.0f / (T_SCALE * WGU_SCALE));
                float h[8];
#pragma unroll
                for (int n = 0; n < 2; ++n)
#pragma unroll
                    for (int j = 0; j < 4; ++j) { const float g = acc[ai][0][m][n][j] * rs, up = acc[ai][1][m][n][j] * rs; h[n * 4 + j] = g * __builtin_amdgcn_rcpf(1.0f + __expf(-g)) * up; }
                u32x2 w; w.x = pk4_fp8(h[0] * H_SCALE, h[1] * H_SCALE, h[2] * H_SCALE, h[3] * H_SCALE); w.y = pk4_fp8(h[4] * H_SCALE, h[5] * H_SCALE, h[6] * H_SCALE, h[7] * H_SCALE);
                if (r < u.nvalid) *(u32x2*)((unsigned char*)H + ((size_t)u.pm * 256 + r) * EFF + col0) = w; }
    }
};
struct EpiScatter {
    static constexpr int PERM = 2;
    struct Pre { int dst[2][4]; float gt[2][4]; };
    unsigned char* Y; const int* rowdst; const float* rowgate; const LAS int* mtp;
    __device__ __forceinline__ void prefetch(Pre& pre, const Unit& u, int wr, int fr) const {
        const int r0 = wr * 64 + fr, lbase = u.e * CAP + (u.pm - mtp[u.e]) * 256;
#pragma unroll
        for (int ai = 0; ai < 2; ++ai)
#pragma unroll
            for (int m = 0; m < 4; ++m) { const int r = r0 + ai * HALF + m * 16; const bool ok = r < u.nvalid; pre.dst[ai][m] = ok ? rowdst[lbase + r] : -1; pre.gt[ai][m] = ok ? rowgate[lbase + r] : 0.f; } }
    __device__ __forceinline__ void operator()(const f32x4 (&acc)[2][2][4][2], const Unit& u, int wr, int wc, int fr, int fq, const Pre& pre) const {
        const int col0 = u.pn * BM + wc * 64 + 16 * fq;
#pragma unroll
        for (int ai = 0; ai < 2; ++ai)
#pragma unroll
            for (int m = 0; m < 4; ++m) { if (pre.dst[ai][m] >= 0) { const float g = pre.gt[ai][m] * (Y_SCALE / (H_SCALE * WD_SCALE));
                const f32x4 v0 = acc[ai][0][m][0] * g, v1 = acc[ai][0][m][1] * g, v2 = acc[ai][1][m][0] * g, v3 = acc[ai][1][m][1] * g;
                u32x4 w; w.x = pk4_fp8(v0[0], v0[1], v0[2], v0[3]); w.y = pk4_fp8(v1[0], v1[1], v1[2], v1[3]); w.z = pk4_fp8(v2[0], v2[1], v2[2], v2[3]); w.w = pk4_fp8(v3[0], v3[1], v3[2], v3[3]);
                *(u32x4*)(Y + (size_t)pre.dst[ai][m] * DM + col0) = w; } }
    }
};
struct EpiShared {
    static constexpr int PERM = 2; typedef NoPre Pre; __device__ __forceinline__ void prefetch(Pre&, const Unit&, int, int) const {}
    unsigned char* Y9;
    __device__ __forceinline__ void operator()(const f32x4 (&acc)[2][2][4][2], const Unit& u, int wr, int wc, int fr, int fq, const Pre& pre) const {
        const int col0 = u.pn * BM + wc * 64 + 16 * fq; const float g = Y_SCALE / (H_SCALE * WD_SCALE);
#pragma unroll
        for (int ai = 0; ai < 2; ++ai)
#pragma unroll
            for (int m = 0; m < 4; ++m) { const int row = u.pm * BM + ai * HALF + wr * 64 + m * 16 + fr;
                const f32x4 v0 = acc[ai][0][m][0] * g, v1 = acc[ai][0][m][1] * g, v2 = acc[ai][1][m][0] * g, v3 = acc[ai][1][m][1] * g;
                u32x4 w; w.x = pk4_fp8(v0[0], v0[1], v0[2], v0[3]); w.y = pk4_fp8(v1[0], v1[1], v1[2], v1[3]); w.z = pk4_fp8(v2[0], v2[1], v2[2], v2[3]); w.w = pk4_fp8(v3[0], v3[1], v3[2], v3[3]);
                *(u32x4*)(Y9 + (size_t)row * DM + col0) = w; }
    }
};
struct EpiResStat {
    static constexpr int PERM = 0; typedef NoPre Pre; __device__ __forceinline__ void prefetch(Pre&, const Unit&, int, int) const {}
    const float* __restrict__ res; bf16_t* __restrict__ Xb; float* ss; int ldc; float scale;
    __device__ __forceinline__ void operator()(const f32x4 (&acc)[2][2][4][2], const Unit& u, int wr, int wc, int fr, int fq, const Pre& pre) const {
        const int row0 = u.pm * BM + wr * 64 + fr, col0 = u.pn * BM + wc * 32 + 4 * fq;
#pragma unroll
        for (int ah = 0; ah < 4; ++ah) { const int ai = ah >> 1, mb = (ah & 1) * 2;
            f32x4 r[4][2][2];
#pragma unroll
            for (int m = mb; m < mb + 2; ++m) { const size_t o = (size_t)(row0 + ai * HALF + m * 16) * ldc + col0;
#pragma unroll
                for (int bj = 0; bj < 2; ++bj)
#pragma unroll
                    for (int n = 0; n < 2; ++n) r[m][bj][n] = __builtin_nontemporal_load((const f32x4*)(res + o + bj * HALF + n * 16)); }
#pragma unroll
            for (int m = mb; m < mb + 2; ++m) { const int row = row0 + ai * HALF + m * 16; const size_t o = (size_t)row * ldc + col0; float sq = 0.f;
#pragma unroll
                for (int bj = 0; bj < 2; ++bj)
#pragma unroll
                    for (int n = 0; n < 2; ++n) { const f32x4 v = acc[ai][bj][m][n] * scale + r[m][bj][n];
                        sq += (v.x * v.x + v.y * v.y) + (v.z * v.z + v.w * v.w);
                        u32x2 pk; pk.x = cvt_pk_bf16(v.x, v.y); pk.y = cvt_pk_bf16(v.z, v.w); *(u32x2*)(Xb + o + bj * HALF + n * 16) = pk; }
                sq += __shfl_xor(sq, 16); sq += __shfl_xor(sq, 32);
                if (fq == 0) ss[(size_t)row * 64 + u.pn * 4 + wc] = sq; }
        }
    }
};
struct EpiX2 {
    static constexpr int PERM = 1; typedef NoPre Pre; __device__ __forceinline__ void prefetch(Pre&, const Unit&, int, int) const {}
    const bf16_t* __restrict__ res; bf16_t* __restrict__ Th; bf16_t* __restrict__ Tl; unsigned char* __restrict__ T8; float* ss; int ldc;
    __device__ __forceinline__ void operator()(const f32x4 (&acc)[2][2][4][2], const Unit& u, int wr, int wc, int fr, int fq, const Pre& pre) const {
        const int row0 = u.pm * BM + wr * 64 + fr, col0 = u.pn * BM + wc * 32 + 8 * fq;
#pragma unroll
        for (int ah = 0; ah < 2; ++ah) { const int ai = ah;
            u32x4 r[4][2];
#pragma unroll
            for (int m = 0; m < 4; ++m) { const size_t o = (size_t)(row0 + ai * HALF + m * 16) * ldc + col0;
#pragma unroll
                for (int bj = 0; bj < 2; ++bj) r[m][bj] = __builtin_nontemporal_load((const u32x4*)(res + o + bj * HALF)); }
#pragma unroll
            for (int m = 0; m < 4; ++m) { const int row = row0 + ai * HALF + m * 16; const size_t o = (size_t)row * ldc + col0; float sq = 0.f;
#pragma unroll
                for (int bj = 0; bj < 2; ++bj) { const u32x4 rr = r[m][bj];
                    const f32x4 r0 = (f32x4){__uint_as_float(rr.x << 16), __uint_as_float(rr.x & 0xffff0000u), __uint_as_float(rr.y << 16), __uint_as_float(rr.y & 0xffff0000u)};
                    const f32x4 r1 = (f32x4){__uint_as_float(rr.z << 16), __uint_as_float(rr.z & 0xffff0000u), __uint_as_float(rr.w << 16), __uint_as_float(rr.w & 0xffff0000u)};
                    const f32x4 w0 = acc[ai][bj][m][0] + r0, w1 = acc[ai][bj][m][1] + r1;
                    sq += (w0.x * w0.x + w0.y * w0.y) + (w0.z * w0.z + w0.w * w0.w) + (w1.x * w1.x + w1.y * w1.y) + (w1.z * w1.z + w1.w * w1.w);
                    u32x4 h; h.x = cvt_pk_bf16(w0.x, w0.y); h.y = cvt_pk_bf16(w0.z, w0.w); h.z = cvt_pk_bf16(w1.x, w1.y); h.w = cvt_pk_bf16(w1.z, w1.w);
                    u32x4 l; l.x = cvt_pk_bf16(w0.x - __uint_as_float(h.x << 16), w0.y - __uint_as_float(h.x & 0xffff0000u)); l.y = cvt_pk_bf16(w0.z - __uint_as_float(h.y << 16), w0.w - __uint_as_float(h.y & 0xffff0000u));
                    l.z = cvt_pk_bf16(w1.x - __uint_as_float(h.z << 16), w1.y - __uint_as_float(h.z & 0xffff0000u)); l.w = cvt_pk_bf16(w1.z - __uint_as_float(h.w << 16), w1.w - __uint_as_float(h.w & 0xffff0000u));
                    u32x2 q8; q8.x = pk4_fp8(w0.x * T_SCALE, w0.y * T_SCALE, w0.z * T_SCALE, w0.w * T_SCALE); q8.y = pk4_fp8(w1.x * T_SCALE, w1.y * T_SCALE, w1.z * T_SCALE, w1.w * T_SCALE);
                    *(u32x4*)(Th + o + bj * HALF) = h; *(u32x4*)(Tl + o + bj * HALF) = l; *(u32x2*)(T8 + o + bj * HALF) = q8; }
                sq += __shfl_xor(sq, 16); sq += __shfl_xor(sq, 32);
                if (fq == 0) ss[(size_t)row * 64 + u.pn * 4 + wc] = sq; }
        }
    }
};
}

namespace fa {
typedef short s16x4 __attribute__((ext_vector_type(4)));
typedef float f32x16 __attribute__((ext_vector_type(16)));
constexpr int SHM_V = 16384, SHM_K = 16384, SHM_K2 = 8192;
constexpr int OFF_V = 0, OFF_K = 2 * SHM_V, OFF_K2 = OFF_K + 2 * SHM_K, OFF_WS = OFF_K2 + 2 * SHM_K2, OFF_TBL = OFF_WS + 8 * 64 * 4, OFF_QPE = OFF_TBL + 1024, LDS_ATTN = OFF_QPE + 8 * 4096;
#define KSWZ(row, colB) ((row) * 256 + ((colB) ^ (((row) & 7) << 4)))
#define KSWZ2(row, colB) ((row) * 128 + ((colB) ^ (((row) & 7) << 4)))
#define SBAR() __builtin_amdgcn_sched_barrier(0)
__device__ __forceinline__ int crow(int r, int hi) { return (r & 3) + 8 * (r >> 2) + 4 * hi; }
__device__ __forceinline__ unsigned cvtpk(float lo, float hi) { unsigned r; asm volatile("v_cvt_pk_bf16_f32 %0, %1, %2" : "=v"(r) : "v"(lo), "v"(hi)); return r; }
constexpr float MIX_SCALE = 64.0f;
__device__ __forceinline__ unsigned fg_pk4_fp8(float a, float b, float c, float d) { int w = 0; w = __builtin_amdgcn_cvt_pk_fp8_f32(a, b, w, false); w = __builtin_amdgcn_cvt_pk_fp8_f32(c, d, w, true); return (unsigned)w; }
template <int MODE> struct Cf { static constexpr float SCALE = (MODE == 1) ? 0.07216878364870323f : 0.08838834764831845f; static constexpr float C = SCALE * 1.4426950408889634f; static constexpr float THRS = 8.0f / SCALE; };

template <int MODE>
__device__ __forceinline__ void partialSM(f32x16& p0, f32x16& p1, float& m_reg, float& mn, float& alpha) {
  constexpr float C = Cf<MODE>::C;
  float pmax = p0[0];
#pragma unroll
  for (int r = 1; r < 16; ++r) pmax = fmaxf(pmax, p0[r]);
#pragma unroll
  for (int r = 0; r < 16; ++r) pmax = fmaxf(pmax, p1[r]);
  { auto rr = __builtin_amdgcn_permlane32_swap(__float_as_uint(pmax), __float_as_uint(pmax), false, false);
    pmax = fmaxf(__uint_as_float(rr[0]), __uint_as_float(rr[1])); }
  if (__builtin_expect(__all(pmax - m_reg <= Cf<MODE>::THRS), 1)) { mn = m_reg; alpha = 1.f; }
  else { mn = fmaxf(m_reg, pmax); alpha = __builtin_amdgcn_exp2f((m_reg - mn) * C); m_reg = mn; }
  const float mnC = -mn * C;
#pragma unroll
  for (int r = 0; r < 16; ++r) p0[r] = fmaf(p0[r], C, mnC);
#pragma unroll
  for (int r = 0; r < 16; ++r) p1[r] = fmaf(p1[r], C, mnC);
#pragma unroll
  for (int r = 0; r < 16; ++r) p0[r] = __builtin_amdgcn_exp2f(p0[r]);
}
__device__ __forceinline__ void finishSM(f32x16& p0, f32x16& p1, float alpha, float& l_reg, bf16x8& pa0, bf16x8& pa1, bf16x8& pa2, bf16x8& pa3) {
#pragma unroll
  for (int r = 0; r < 16; ++r) p1[r] = __builtin_amdgcn_exp2f(p1[r]);
  float ps = 0;
#pragma unroll
  for (int r = 0; r < 16; ++r) ps += p0[r];
#pragma unroll
  for (int r = 0; r < 16; ++r) ps += p1[r];
  { auto rr = __builtin_amdgcn_permlane32_swap(__float_as_uint(ps), __float_as_uint(ps), false, false);
    ps = __uint_as_float(rr[0]) + __uint_as_float(rr[1]); }
  l_reg = l_reg * alpha + ps;
#define PK4(P, BASE, OUT) do { unsigned a0 = cvtpk(P[BASE + 0], P[BASE + 1]), a1 = cvtpk(P[BASE + 2], P[BASE + 3]);   \
    unsigned b0 = cvtpk(P[BASE + 4], P[BASE + 5]), b1 = cvtpk(P[BASE + 6], P[BASE + 7]);                              \
    auto r0 = __builtin_amdgcn_permlane32_swap(a0, b0, false, false); auto r1 = __builtin_amdgcn_permlane32_swap(a1, b1, false, false); \
    u32x4 w = {r0[0], r1[0], r0[1], r1[1]}; OUT = *reinterpret_cast<bf16x8*>(&w); } while (0)
  PK4(p0, 0, pa0); PK4(p0, 8, pa1); PK4(p1, 0, pa2); PK4(p1, 8, pa3);
#undef PK4
}
template <int MODE>
__device__ __forceinline__ void qkt(f32x16& p0, f32x16& p1, const LAS char* Ks, const LAS char* K2s, const bf16x8* qr, int r32, int hi, const LAS char* qpe) {
  p0 = f32x16{}; p1 = f32x16{};
#pragma unroll
  for (int d0 = 0; d0 < 8; ++d0) { const int cb = (d0 * 16 + hi * 8) * 2;
    const bf16x8 b0 = *reinterpret_cast<const LAS bf16x8*>(Ks + KSWZ(r32, cb));
    const bf16x8 b1 = *reinterpret_cast<const LAS bf16x8*>(Ks + KSWZ(32 + r32, cb));
    p0 = __builtin_amdgcn_mfma_f32_32x32x16_bf16(b0, qr[d0], p0, 0, 0, 0);
    p1 = __builtin_amdgcn_mfma_f32_32x32x16_bf16(b1, qr[d0], p1, 0, 0, 0); }
  if (MODE == 1) {
#pragma unroll
    for (int d0 = 0; d0 < 4; ++d0) { const int cb = (d0 * 16 + hi * 8) * 2;
      const bf16x8 b0 = *reinterpret_cast<const LAS bf16x8*>(K2s + KSWZ2(r32, cb));
      const bf16x8 b1 = *reinterpret_cast<const LAS bf16x8*>(K2s + KSWZ2(32 + r32, cb));
      const bf16x8 qp = *reinterpret_cast<const LAS bf16x8*>(qpe + d0 * 1024);
      p0 = __builtin_amdgcn_mfma_f32_32x32x16_bf16(b0, qp, p0, 0, 0, 0);
      p1 = __builtin_amdgcn_mfma_f32_32x32x16_bf16(b1, qp, p1, 0, 0, 0); }
  }
}
__device__ __forceinline__ int v_st(int k, int c) { const int kk = (k & ~0xC) | ((k & 4) << 1) | ((k & 8) >> 1); return ((kk >> 3) * 4 + (c >> 5)) * 512 + ((kk & 7) * 32 + (c & 31)) * 2; }
__device__ __forceinline__ int v_rd_base(int lane) { return ((lane & 3) << 3) | (((lane >> 2) & 3) << 6) | (((lane >> 4) & 1) << 5) | (((lane >> 5) & 1) << 8); }
constexpr int v_rd_off(int d0, int ks, int half) { return d0 * 512 + ks * 4096 + half * 2048; }
template <int OFF> __device__ __forceinline__ s16x4 tr_read(int vb) { s16x4 r; asm volatile("ds_read_b64_tr_b16 %0, %1 offset:%2" : "=&v"(r) : "v"(vb), "i"(OFF) : "memory"); return r; }
template <int D0> __device__ __forceinline__ void pv_one(f32x16& od, int vb, bf16x8 pa0, bf16x8 pa1, bf16x8 pa2, bf16x8 pa3) {
  const s16x4 l0 = tr_read<v_rd_off(D0, 0, 0)>(vb), h0 = tr_read<v_rd_off(D0, 0, 1)>(vb), l1 = tr_read<v_rd_off(D0, 1, 0)>(vb), h1 = tr_read<v_rd_off(D0, 1, 1)>(vb);
  const s16x4 l2 = tr_read<v_rd_off(D0, 2, 0)>(vb), h2 = tr_read<v_rd_off(D0, 2, 1)>(vb), l3 = tr_read<v_rd_off(D0, 3, 0)>(vb), h3 = tr_read<v_rd_off(D0, 3, 1)>(vb);
  asm volatile("s_waitcnt lgkmcnt(0)" ::: "memory"); SBAR();
#define PK(L, H) (bf16x8){L[0], L[1], L[2], L[3], H[0], H[1], H[2], H[3]}
  od = __builtin_amdgcn_mfma_f32_32x32x16_bf16(pa0, PK(l0, h0), od, 0, 0, 0);
  od = __builtin_amdgcn_mfma_f32_32x32x16_bf16(pa1, PK(l1, h1), od, 0, 0, 0);
  od = __builtin_amdgcn_mfma_f32_32x32x16_bf16(pa2, PK(l2, h2), od, 0, 0, 0);
  od = __builtin_amdgcn_mfma_f32_32x32x16_bf16(pa3, PK(l3, h3), od, 0, 0, 0);
#undef PK
}
__device__ __forceinline__ void pv_d0(f32x16* o, int vb, bf16x8 pa0, bf16x8 pa1, bf16x8 pa2, bf16x8 pa3) {
  pv_one<0>(o[0], vb, pa0, pa1, pa2, pa3); pv_one<1>(o[1], vb, pa0, pa1, pa2, pa3); pv_one<2>(o[2], vb, pa0, pa1, pa2, pa3); pv_one<3>(o[3], vb, pa0, pa1, pa2, pa3);
}
struct Args { const bf16_t* Q; const bf16_t* K1; const bf16_t* K2; const bf16_t* V; bf16_t* O; int kt0, NT, qch0; };
template <int MODE> struct St {
    static constexpr int LDQ = (MODE == 0) ? INW : (MODE == 1 ? 3072 : 512), LDK1 = (MODE == 0) ? INW : (MODE == 1 ? 4096 : 1024), LDK2 = INW, LDV = LDK1, LDO = (MODE == 2) ? 512 : DM; };
template <int MODE>
__device__ __forceinline__ void mask_bias(f32x16& p0, f32x16& p1, int qch, int kch, int qpos, int hi, const LAS float* tbl) {
  const bool valid = (MODE == 2) || ((kch <= qch) && (MODE == 1 || kch >= qch - 8));
  if (!valid) {
#pragma unroll
    for (int r = 0; r < 16; ++r) { p0[r] = -INFINITY; p1[r] = -INFINITY; }
  } else if (MODE == 0) {
    if (qch - kch >= 3) { const float b = tbl[191];
#pragma unroll
      for (int r = 0; r < 16; ++r) { p0[r] += b; p1[r] += b; }
    } else { const int base = qpos - kch * 64 + 63 - 4 * hi;
#pragma unroll
      for (int g = 0; g < 4; ++g) {
#pragma unroll
        for (int r = 4 * g; r < 4 * g + 4; ++r) { int d0 = base - ((r & 3) + 8 * (r >> 2)), d1 = d0 - 32;
          d0 = d0 < 0 ? 0 : (d0 > 191 ? 191 : d0); d1 = d1 < 0 ? 0 : (d1 > 191 ? 191 : d1);
          p0[r] += tbl[d0]; p1[r] += tbl[d1]; }
        SBAR();
      }
    }
  }
}
template <int MODE>
__device__ __forceinline__ void attn_body(const Args& a, LAS char* lds) {
  constexpr int NQ = 8;
  int tid = threadIdx.x; asm volatile("" : "+v"(tid));
  const int wid = tid >> 6, lane = tid & 63, r32 = lane & 31, hi = lane >> 5;
  LAS char* V_lds = lds + OFF_V; LAS char* K_lds = lds + OFF_K; LAS char* K2_lds = lds + OFF_K2;
  LAS float* ws = (LAS float*)(lds + OFF_WS) + wid * 64; LAS float* li_l = ws; LAS float* al_l = ws + 32;
  const LAS float* tbl = (const LAS float*)(lds + OFF_TBL);
  float m_reg = -1e30f, l_reg = 0; f32x16 o[4] = {}; bf16x8 qr[NQ];
  const bf16_t* Qw = a.Q + (wid * 32 + r32) * St<MODE>::LDQ + hi * 8;
#pragma unroll
  for (int d0 = 0; d0 < NQ; ++d0) qr[d0] = *reinterpret_cast<const bf16x8*>(Qw + d0 * 16);
  const LAS char* qpe = lds + OFF_QPE + wid * 4096 + lane * 16;
  if (MODE == 1) {
#pragma unroll
    for (int d0 = 0; d0 < 4; ++d0) *(LAS bf16x8*)(lds + OFF_QPE + wid * 4096 + lane * 16 + d0 * 1024) = *reinterpret_cast<const bf16x8*>(Qw + 128 + d0 * 16);
  }
  const int sr = tid >> 4, sc = (tid & 15) * 8, vst0 = v_st(sr, sc), vst1 = v_st(32 + sr, sc);
  const int s2r = tid >> 3, s2c = (tid & 7) * 8;
  const int vb0 = (int)(uintptr_t)V_lds + v_rd_base(lane);
  const int qch = a.qch0 + (wid >> 1), qpos = a.qch0 * 64 + wid * 32 + r32;
  bf16x8 vs0, vs1, ks0, ks1, k2s;
  const unsigned ovk = (unsigned)(sr * St<MODE>::LDK1 + sc) * 2u, ok2 = (unsigned)(s2r * St<MODE>::LDK2 + s2c) * 2u;
#define SLOAD(j) do { const size_t k0_ = (size_t)(a.kt0 + (j)) * 64; \
    const char* vt_ = (const char*)(a.V + k0_ * St<MODE>::LDV); const char* kt_ = (const char*)(a.K1 + k0_ * St<MODE>::LDK1); \
    vs0 = *reinterpret_cast<const bf16x8*>(vt_ + ovk); vs1 = *reinterpret_cast<const bf16x8*>(vt_ + 64 * St<MODE>::LDV + ovk); \
    ks0 = *reinterpret_cast<const bf16x8*>(kt_ + ovk); ks1 = *reinterpret_cast<const bf16x8*>(kt_ + 64 * St<MODE>::LDK1 + ovk); \
    if (MODE == 1) k2s = *reinterpret_cast<const bf16x8*>((const char*)(a.K2 + k0_ * St<MODE>::LDK2) + ok2); } while (0)
#define SWRITE(b) do { *(LAS bf16x8*)(V_lds + (b) * SHM_V + vst0) = vs0; *(LAS bf16x8*)(V_lds + (b) * SHM_V + vst1) = vs1; const int kc = sc * 2; \
    *(LAS bf16x8*)(K_lds + (b) * SHM_K + KSWZ(sr, kc)) = ks0; *(LAS bf16x8*)(K_lds + (b) * SHM_K + KSWZ(32 + sr, kc)) = ks1; \
    if (MODE == 1) *(LAS bf16x8*)(K2_lds + (b) * SHM_K2 + KSWZ2(s2r, s2c * 2)) = k2s; } while (0)
#define SWAIT() asm volatile("s_waitcnt vmcnt(0)" ::: "memory")
#define RESC(al) do { if (__any((al) < 1.f)) { if (hi == 0) al_l[r32] = (al); asm volatile("s_waitcnt lgkmcnt(0)" ::: "memory"); \
    _Pragma("unroll") for (int d = 0; d < 4; ++d) _Pragma("unroll") for (int r = 0; r < 16; ++r) o[d][r] *= al_l[crow(r, hi)]; } } while (0)
  f32x16 pA0, pA1, pB0, pB1; float mnA, mnB, alA, alB; bf16x8 pa0, pa1, pa2, pa3; const int NT = a.NT;
  SLOAD(0); SWAIT(); SWRITE(0); __syncthreads();
  qkt<MODE>(pA0, pA1, K_lds, K2_lds, qr, r32, hi, qpe); mask_bias<MODE>(pA0, pA1, qch, a.kt0, qpos, hi, tbl); partialSM<MODE>(pA0, pA1, m_reg, mnA, alA);
  SLOAD(1);
  SWAIT(); SWRITE(1); __syncthreads();
  for (int j = 1; j + 1 < NT; j += 2) {
    SBAR(); qkt<MODE>(pB0, pB1, K_lds + SHM_K, K2_lds + SHM_K2, qr, r32, hi, qpe); mask_bias<MODE>(pB0, pB1, qch, a.kt0 + j, qpos, hi, tbl);
    finishSM(pA0, pA1, alA, l_reg, pa0, pa1, pa2, pa3); SBAR();
    SLOAD(j + 1); SBAR();
    pv_d0(o, vb0, pa0, pa1, pa2, pa3); partialSM<MODE>(pB0, pB1, m_reg, mnB, alB);
    __syncthreads(); SWAIT(); SWRITE(0);
    RESC(alB); __syncthreads();
    SBAR(); qkt<MODE>(pA0, pA1, K_lds, K2_lds, qr, r32, hi, qpe); mask_bias<MODE>(pA0, pA1, qch, a.kt0 + j + 1, qpos, hi, tbl);
    finishSM(pB0, pB1, alB, l_reg, pa0, pa1, pa2, pa3); SBAR();
    SLOAD(j + 2); SBAR();
    pv_d0(o, vb0 + SHM_V, pa0, pa1, pa2, pa3); partialSM<MODE>(pA0, pA1, m_reg, mnA, alA);
    __syncthreads(); SWAIT(); SWRITE(1);
    RESC(alA); __syncthreads();
  }
  SBAR(); qkt<MODE>(pB0, pB1, K_lds + SHM_K, K2_lds + SHM_K2, qr, r32, hi, qpe); mask_bias<MODE>(pB0, pB1, qch, a.kt0 + NT - 1, qpos, hi, tbl);
  finishSM(pA0, pA1, alA, l_reg, pa0, pa1, pa2, pa3); SBAR();
  pv_d0(o, vb0, pa0, pa1, pa2, pa3); partialSM<MODE>(pB0, pB1, m_reg, mnB, alB);
  __syncthreads(); RESC(alB);
  finishSM(pB0, pB1, alB, l_reg, pa0, pa1, pa2, pa3); SBAR();
  pv_d0(o, vb0 + SHM_V, pa0, pa1, pa2, pa3);
  if (hi == 0) li_l[r32] = l_reg; asm volatile("s_waitcnt lgkmcnt(0)" ::: "memory");
  if (MODE != 2) {
    unsigned char* Ow8 = (unsigned char*)a.O + (size_t)(wid * 32) * DM;
    const int qi = lane & 3;
#pragma unroll
    for (int rg = 0; rg < 4; ++rg) {
      float rl[4];
#pragma unroll
      for (int j = 0; j < 4; ++j) rl[j] = __builtin_amdgcn_rcpf(li_l[crow(4 * rg + j, hi)]) * MIX_SCALE;
#pragma unroll
      for (int d0 = 0; d0 < 4; ++d0) { float v[4];
#pragma unroll
        for (int j = 0; j < 4; ++j) v[j] = o[d0][4 * rg + j] * rl[j];
        { const float s0 = (qi & 1) ? v[0] : v[1], s1 = (qi & 1) ? v[2] : v[3]; const float t0 = __shfl_xor(s0, 1), t1 = __shfl_xor(s1, 1);
          if (qi & 1) { v[0] = t0; v[2] = t1; } else { v[1] = t0; v[3] = t1; } }
        { const float s0 = (qi & 2) ? v[0] : v[2], s1 = (qi & 2) ? v[1] : v[3]; const float t0 = __shfl_xor(s0, 2), t1 = __shfl_xor(s1, 2);
          if (qi & 2) { v[0] = t0; v[1] = t1; } else { v[2] = t0; v[3] = t1; } }
        const int orow = 8 * rg + 4 * hi + qi;
        *(unsigned*)(Ow8 + (size_t)orow * DM + d0 * 32 + (r32 & ~3)) = fg_pk4_fp8(v[0], v[1], v[2], v[3]); } }
  } else {
  bf16_t* Ow = a.O + (wid * 32) * St<MODE>::LDO;
  const int odd = lane & 1;
#pragma unroll
  for (int r = 0; r < 16; r += 2) { const float ra = __builtin_amdgcn_rcpf(li_l[crow(r, hi)]), rb = __builtin_amdgcn_rcpf(li_l[crow(r + 1, hi)]);
#pragma unroll
    for (int d0 = 0; d0 < 4; ++d0) { const float vA = o[d0][r] * ra, vB = o[d0][r + 1] * rb;
      const float pA = __shfl_xor(vA, 1), pB = __shfl_xor(vB, 1);
      const unsigned w = odd ? cvtpk(pB, vB) : cvtpk(vA, pA);
      const int orow = odd ? crow(r + 1, hi) : crow(r, hi);
      *(unsigned*)(Ow + orow * St<MODE>::LDO + d0 * 32 + (r32 & ~1)) = w; } }
  }
  __syncthreads();
#undef SLOAD
#undef SWRITE
#undef SWAIT
#undef RESC
}
#undef KSWZ
#undef KSWZ2
#undef SBAR
template <int MODE> __device__ __forceinline__ void attn_call(const bf16_t* Q, const bf16_t* K1, const bf16_t* K2, const bf16_t* V, bf16_t* O, int kt0, int NT, int qch0, LAS char* lds) {
  Args a{Q, K1, K2, V, O, kt0, NT, qch0}; attn_body<MODE>(a, lds);
}
}

#ifndef TVAR
#define TVAR 0
#endif
template <int VAR = 0, bool GK = false>
__device__ __forceinline__ void transpose_item(const float* W, int K, int N, bf16_t* WT, int k0, int n0, int drow0, LAS float* scr, int lane, const float* gk = nullptr) {
    float v[64];
    const float* src = W + (size_t)k0 * N + n0 + lane;
#pragma unroll
    for (int i = 0; i < 64; ++i) v[i] = __builtin_nontemporal_load(src + (size_t)i * N);
    if (VAR == 1) {
#pragma unroll
        for (int i = 0; i < 64; ++i) asm volatile("" :: "v"(v[i]));
        return; }
#pragma unroll
    for (int i = 0; i < 64; ++i) scr[i * 65 + lane] = GK ? v[i] * gk[k0 + i] : v[i];
    asm volatile("s_waitcnt lgkmcnt(0)" ::: "memory");
    if (VAR == 2) { drow0 = 0; k0 = 0; }
    const int c = lane & 7;
#pragma unroll
    for (int j = 0; j < 8; ++j) { const int n = (lane >> 3) + 8 * j; const LAS float* sp = scr + (8 * c) * 65 + n;
        u32x4 o; o.x = fg::cvt_pk_bf16(sp[0 * 65], sp[1 * 65]); o.y = fg::cvt_pk_bf16(sp[2 * 65], sp[3 * 65]); o.z = fg::cvt_pk_bf16(sp[4 * 65], sp[5 * 65]); o.w = fg::cvt_pk_bf16(sp[6 * 65], sp[7 * 65]);
        *(u32x4*)(WT + ((size_t)(drow0 >> 6) * (K >> 6) + (k0 >> 6)) * 4096 + n * 64 + 8 * c) = o; }
    asm volatile("s_waitcnt lgkmcnt(0)" ::: "memory");
}
__device__ __forceinline__ fg::MoeTabs moe_tables_fast(LAS int* tab, const unsigned* gcnt) {
    fg::MoeTabs T; T.cnt = tab; T.mtp = tab + 80;
    __syncthreads();
    if (threadIdx.x == 0) { int pm = 0;
        for (int e = 0; e <= NE; ++e) { const int c = (e < NE) ? (int)gcnt[64 * e] : NTOK; tab[e] = c; tab[80 + e] = pm; pm += (c + 255) / 256; }
        tab[80 + NE + 1] = pm; }
    __syncthreads();
    return T;
}
template <bool GK = false>
__device__ __forceinline__ void transpose_item_fp8(const float* W, int K, int N, unsigned char* WT, int k0, int n0, int drow0, float scale, LAS float* scr, int lane, const float* gk = nullptr) {
    float v[64];
    const float* src = W + (size_t)k0 * N + n0 + lane;
#pragma unroll
    for (int i = 0; i < 64; ++i) v[i] = __builtin_nontemporal_load(src + (size_t)i * N);
#pragma unroll
    for (int i = 0; i < 64; ++i) scr[i * 65 + lane] = GK ? v[i] * (scale * gk[k0 + i]) : v[i] * scale;
    asm volatile("s_waitcnt lgkmcnt(0)" ::: "memory");
    const int c = lane & 3;
    unsigned char* tile = WT + ((size_t)(drow0 >> 6) * (K >> 7) + (k0 >> 7)) * 8192 + (k0 & 64);
#pragma unroll
    for (int j = 0; j < 4; ++j) { const int n = (lane >> 2) + 16 * j; const LAS float* sp = scr + (16 * c) * 65 + n;
        u32x4 o; o.x = fg::pk4_fp8(sp[0 * 65], sp[1 * 65], sp[2 * 65], sp[3 * 65]); o.y = fg::pk4_fp8(sp[4 * 65], sp[5 * 65], sp[6 * 65], sp[7 * 65]);
        o.z = fg::pk4_fp8(sp[8 * 65], sp[9 * 65], sp[10 * 65], sp[11 * 65]); o.w = fg::pk4_fp8(sp[12 * 65], sp[13 * 65], sp[14 * 65], sp[15 * 65]);
        *(u32x4*)(tile + n * 128 + 16 * c) = o; }
    asm volatile("s_waitcnt lgkmcnt(0)" ::: "memory");
}
__device__ __forceinline__ void transpose_item_hilo(const float* W, int K, bf16_t* WH, bf16_t* WL, int k0, LAS float* scr, int lane, const float* gk) {
    float v[64];
    const float* src = W + (size_t)k0 * 64 + lane;
#pragma unroll
    for (int i = 0; i < 64; ++i) v[i] = src[(size_t)i * 64];
#pragma unroll
    for (int i = 0; i < 64; ++i) scr[i * 65 + lane] = v[i] * gk[k0 + i];
    asm volatile("s_waitcnt lgkmcnt(0)" ::: "memory");
    const int c = lane & 7;
#pragma unroll
    for (int j = 0; j < 8; ++j) { const int n = (lane >> 3) + 8 * j; const LAS float* sp = scr + (8 * c) * 65 + n;
        float f[8], l[8];
#pragma unroll
        for (int q = 0; q < 8; ++q) f[q] = sp[q * 65];
        u32x4 o; o.x = fg::cvt_pk_bf16(f[0], f[1]); o.y = fg::cvt_pk_bf16(f[2], f[3]); o.z = fg::cvt_pk_bf16(f[4], f[5]); o.w = fg::cvt_pk_bf16(f[6], f[7]);
        l[0] = f[0] - __uint_as_float(o.x << 16); l[1] = f[1] - __uint_as_float(o.x & 0xffff0000u); l[2] = f[2] - __uint_as_float(o.y << 16); l[3] = f[3] - __uint_as_float(o.y & 0xffff0000u);
        l[4] = f[4] - __uint_as_float(o.z << 16); l[5] = f[5] - __uint_as_float(o.z & 0xffff0000u); l[6] = f[6] - __uint_as_float(o.w << 16); l[7] = f[7] - __uint_as_float(o.w & 0xffff0000u);
        u32x4 ol; ol.x = fg::cvt_pk_bf16(l[0], l[1]); ol.y = fg::cvt_pk_bf16(l[2], l[3]); ol.z = fg::cvt_pk_bf16(l[4], l[5]); ol.w = fg::cvt_pk_bf16(l[6], l[7]);
        const size_t off = (size_t)(k0 >> 6) * 4096 + n * 64 + 8 * c;
        *(u32x4*)(WH + off) = o; *(u32x4*)(WL + off) = ol; }
    asm volatile("s_waitcnt lgkmcnt(0)" ::: "memory");
}
constexpr int N_EXPERT_ITEMS = 65 * 1536;
__device__ __forceinline__ void expert_item(const Params& p, unsigned char* ws, int r0, LAS float* scr, int lane) {
    bf16_t* wguT = (bf16_t*)(ws + WS_WGU); bf16_t* wdT = (bf16_t*)(ws + WS_WD);
    const int e = r0 / 1536, r = r0 % 1536, mat = r >> 9, item = r & 511;
    if (mat < 2) { const float* W = (e < NE) ? p.in[mat ? I_WEXU : I_WEXG] + (size_t)e * DM * EFF : p.in[mat ? I_WSHU : I_WSHG];
        const int kb = (item & 7) + 8 * (item >> 6), nb = (item >> 3) & 7, n0 = nb * 64;
        transpose_item_fp8<true>(W, DM, EFF, (unsigned char*)wguT + (size_t)e * 1024 * DM, kb * 64, n0, (n0 >> 7) * 256 + mat * 128 + (n0 & 127), fg::WGU_SCALE, scr, lane, p.in[I_GFFN]);
    } else { const float* W = (e < NE) ? p.in[I_WEXD] + (size_t)e * EFF * DM : p.in[I_WSHD];
        const int kb = item & 7, nb = item >> 3;
        transpose_item_fp8(W, EFF, DM, (unsigned char*)wdT + (size_t)e * DM * EFF, kb * 64, nb * 64, nb * 64, fg::WD_SCALE, scr, lane); }
}
__device__ __forceinline__ void expert_conv_loop(const Params& p, unsigned char* ws, unsigned* qhead, LAS float* scr, int lane) {
    for (;;) {
        unsigned start = 0; if (lane == 0) start = xb_add(qhead, 8u);
        start = (unsigned)__builtin_amdgcn_readfirstlane((int)start);
        if (start >= (unsigned)N_EXPERT_ITEMS) break;
        for (int q = 0; q < 8; ++q) expert_item(p, ws, (int)start + q, scr, lane);
    }
}
template <int VAR>
__device__ __forceinline__ void p0_items(const Params& p, unsigned char* ws, LAS float* scr, int lane, int gw, int NGW) {
    bf16_t* winT = (bf16_t*)(ws + WS_WIN); bf16_t* wuqT = (bf16_t*)(ws + WS_WUQ); bf16_t* wukvT = (bf16_t*)(ws + WS_WUKV); bf16_t* woT = (bf16_t*)(ws + WS_WO);
    bf16_t* wxqT = (bf16_t*)(ws + WS_WXQ); bf16_t* wxkvT = (bf16_t*)(ws + WS_WXKV); bf16_t* wxoT = (bf16_t*)(ws + WS_WXO); bf16_t* wguT = (bf16_t*)(ws + WS_WGU); bf16_t* wdT = (bf16_t*)(ws + WS_WD);
            constexpr int I0 = (DM / 64) * (INW / 64), I1 = I0 + (DM / 64) * (DM / 64), I2 = I1 + (QLORA / 64) * (3072 / 64), I3 = I2 + (KVLORA / 64) * (4096 / 64),
                          I4 = I3 + (DM / 64) * (512 / 64), I5 = I4 + (DM / 64) * (1024 / 64), I6 = I5 + (512 / 64) * (DM / 64);
            constexpr int IR = I6, ITOT = IR + DM / 64;
            for (int it = gw; it < ITOT; it += NGW) {
                if (it < I0) { const int nb = it % (INW / 64), kb = it / (INW / 64); transpose_item_fp8(p.in[I_WIN], DM, INW, (unsigned char*)winT, kb * 64, nb * 64, nb * 64, 64.0f, scr, lane); }
                else if (it < I1) { const int r = it - I0, nb = r % 64, kb = r / 64; transpose_item_fp8(p.in[I_WO], DM, DM, (unsigned char*)woT, kb * 64, nb * 64, nb * 64, 64.0f, scr, lane); }
                else if (it < I2) { const int r = it - I1, nb = r % 48, kb = r / 48; transpose_item<VAR>(p.in[I_WUQ], QLORA, 3072, wuqT, kb * 64, nb * 64, nb * 64, scr, lane); }
                else if (it < I3) { const int r = it - I2, nb = r % 64, kb = r / 64; transpose_item<VAR>(p.in[I_WUKV], KVLORA, 4096, wukvT, kb * 64, nb * 64, nb * 64, scr, lane); }
                else if (it < I4) { const int r = it - I3, nb = r % 8, kb = r / 8; transpose_item<VAR, true>(p.in[I_WXQ], DM, 512, wxqT, kb * 64, nb * 64, nb * 64, scr, lane, p.in[I_GCROSS]); }
                else if (it < I5) { const int r = it - I4, nb = r % 16, kb = r / 16; transpose_item<VAR>(p.in[I_WXKV], DM, 1024, wxkvT, kb * 64, nb * 64, nb * 64, scr, lane); }
                else if (it < I6) { const int r = it - I5, nb = r % 64, kb = r / 64; transpose_item<VAR>(p.in[I_WXO], 512, DM, wxoT, kb * 64, nb * 64, nb * 64, scr, lane); }
                else if (it >= IR) { transpose_item_hilo(p.in[I_WROUTER], DM, (bf16_t*)(ws + WS_WR), (bf16_t*)(ws + WS_WR + (size_t)(DM / 64) * 8192), (it - IR) * 64, scr, lane, p.in[I_GFFN]); }
            }
}
__device__ __forceinline__ void unpack8(const u32x4 w, float (&f)[8]) {
    f[0] = __uint_as_float(w.x << 16); f[1] = __uint_as_float(w.x & 0xffff0000u); f[2] = __uint_as_float(w.y << 16); f[3] = __uint_as_float(w.y & 0xffff0000u);
    f[4] = __uint_as_float(w.z << 16); f[5] = __uint_as_float(w.z & 0xffff0000u); f[6] = __uint_as_float(w.w << 16); f[7] = __uint_as_float(w.w & 0xffff0000u); }
__device__ __forceinline__ u32x4 pack8(const float (&f)[8]) { u32x4 w; w.x = fg::cvt_pk_bf16(f[0], f[1]); w.y = fg::cvt_pk_bf16(f[2], f[3]); w.z = fg::cvt_pk_bf16(f[4], f[5]); w.w = fg::cvt_pk_bf16(f[6], f[7]); return w; }
__device__ __forceinline__ float sumsq8(const float (&f)[8]) { return (f[0] * f[0] + f[1] * f[1]) + (f[2] * f[2] + f[3] * f[3]) + (f[4] * f[4] + f[5] * f[5]) + (f[6] * f[6] + f[7] * f[7]); }
template <int W> __device__ __forceinline__ float group_sum(float v) {
#pragma unroll
    for (int o = 1; o < W; o <<= 1) v += __shfl_xor(v, o);
    return v;
}
__device__ __forceinline__ void load8f(const float* g, float (&f)[8]) { const f32x4 a = *(const f32x4*)g, b = *(const f32x4*)(g + 4); f[0] = a.x; f[1] = a.y; f[2] = a.z; f[3] = a.w; f[4] = b.x; f[5] = b.y; f[6] = b.z; f[7] = b.w; }
__device__ __forceinline__ void scale8(float (&f)[8], float r, const float (&g)[8]) {
#pragma unroll
    for (int i = 0; i < 8; ++i) f[i] = f[i] * r * g[i]; }
        struct RouterSched { const char* th; const char* tl; const char* wh; const char* wl; int G, c;
            __device__ __forceinline__ bool next(int i, fg::Unit& u) const {
                const int total = (NTOK / 256) * 8, per = (total + 7) / 8; const int j = i * G + c, x = j & 7, q = j >> 3;
                if (q >= per) return false; const int L = x * per + q; if (L >= total) return false;
                const int pm = L / 8, slab = L % 8, term = slab >> 2, kq = slab & 3;
                u.A = (term == 1 ? tl : th) + ((size_t)pm * 256 * DM + (size_t)kq * 1024) * 2; u.B = wh + (size_t)kq * 16 * 8192;
                u.rows = nullptr; u.nkt = 16; u.nvalid = 256; u.pm = pm; u.pn = 0; u.e = slab; u.arow0 = pm * 256; return true; } };
        struct EpiLogits { static constexpr int PERM = 0; typedef fg::NoPre Pre; __device__ __forceinline__ void prefetch(Pre&, const fg::Unit&, int, int) const {} float* C;
            __device__ __forceinline__ void operator()(const f32x4 (&acc)[2][2][4][2], const fg::Unit& u, int wr, int wc, int fr, int fq, const Pre& pre) const {
                { float* Cb = C + (size_t)u.e * NTOK * 128;
#pragma unroll
                    for (int ai = 0; ai < 2; ++ai)
#pragma unroll
                        for (int m = 0; m < 4; ++m)
#pragma unroll
                            for (int n = 0; n < 2; ++n) *(f32x4*)(Cb + (size_t)(u.pm * 256 + ai * 128 + wr * 64 + m * 16 + fr) * 128 + wc * 32 + n * 16 + 4 * fq) = acc[ai][0][m][n]; } } };
constexpr int NPHASE = 18;
template <unsigned PMASK>
__global__ void __launch_bounds__(512, 2) fwd(Params p) {
    extern __shared__ __attribute__((aligned(16))) unsigned char lds_raw[];
    float* ldsf = (float*)lds_raw;
    const int tid = threadIdx.x, lane = tid & 63, wave = tid >> 6;
    const int G = gridDim.x; int bid = blockIdx.x;
    const int gw = bid * 8 + wave, NGW = G * 8;
    unsigned char* ws = p.ws;
    unsigned* ctl = (unsigned*)(ws + WS_CTL);
    volatile LAS unsigned* misc = (volatile LAS unsigned*)((LAS unsigned char*)lds_raw + LDS_MISC);
    if (tid < 16) misc[tid] = 0u;
    __syncthreads();
    XcdBarrier bar = xcd_barrier_post(ctl + CW_BAR, misc);
    const int lo = p.ph_lo, hi = p.ph_hi;
    if (tid == 0) { const unsigned x = xb_xcc_id() & 15u; misc[4] = x; misc[5] = xb_add(ctl + CW_TICKET + 64 * x, 1u); }
#define IN(k) (((PMASK >> (k)) & 1u) && lo <= (k) && (k) < hi)
#ifndef DUP_PHASE
#define DUP_PHASE -1
#endif
#define REP(k) for (int rep_ = 0; rep_ < ((DUP_PHASE == (k)) ? 2 : 1); ++rep_)
#define SEAM(k) do { if (IN(k) && IN((k) + 1)) xcd_barrier(bar); } while (0)

    const float* x = p.in[I_X];
    act_t* hbuf = (act_t*)(ws + WS_H); act_t* memn = (act_t*)(ws + WS_MEMN); act_t* p1 = (act_t*)(ws + WS_P1); act_t* kvm = (act_t*)(ws + WS_KVM);
    act_t* qb = (act_t*)(ws + WS_QB); act_t* kvb = (act_t*)(ws + WS_KVB); act_t* mixed = (act_t*)(ws + WS_MIXED); float* x1 = (float*)(ws + WS_X1);
    act_t* hc = (act_t*)(ws + WS_HC); act_t* qx = (act_t*)(ws + WS_QX); act_t* ox = (act_t*)(ws + WS_OX); float* x2 = (float*)(ws + WS_X2);
    act_t* tb = (act_t*)(ws + WS_T); act_t* hh = (act_t*)(ws + WS_HH);
    LAS unsigned char* lds = (LAS unsigned char*)lds_raw;
    bf16_t* winT = (bf16_t*)(ws + WS_WIN); bf16_t* wuqT = (bf16_t*)(ws + WS_WUQ); bf16_t* wukvT = (bf16_t*)(ws + WS_WUKV); bf16_t* woT = (bf16_t*)(ws + WS_WO);
    bf16_t* wxqT = (bf16_t*)(ws + WS_WXQ); bf16_t* wxkvT = (bf16_t*)(ws + WS_WXKV); bf16_t* wxoT = (bf16_t*)(ws + WS_WXO); bf16_t* wguT = (bf16_t*)(ws + WS_WGU); bf16_t* wdT = (bf16_t*)(ws + WS_WD);
    float* qxp = (float*)(ws + WS_QXP); bf16_t* ybuf = (bf16_t*)(ws + WS_Y);
    int* rowtok = (int*)(ws + WS_ROWTOK); float* rowgate = (float*)(ws + WS_ROWGATE); int* rowdst = (int*)(ws + WS_ROWDST);
    unsigned* gcnt = ctl + CW_CNT;
    const int* positions = (const int*)p.in[I_POS];

    if (IN(0)) REP(0) {
        for (int m = gw; m < NTOK; m += NGW) {
            const float* xr = x + (size_t)m * DM; f32x4 v[16]; float ssq = 0.f;
#pragma unroll
            for (int j = 0; j < 16; ++j) { v[j] = __builtin_nontemporal_load((const f32x4*)xr + lane + 64 * j); ssq += v[j].x * v[j].x + v[j].y * v[j].y + v[j].z * v[j].z + v[j].w * v[j].w; }
            ssq = wave_sum(ssq); const float r = 2.0f / sqrtf(ssq * (1.0f / 4096.f) + EPS);
#pragma unroll
            for (int j = 0; j < 16; ++j) v[j] = v[j] * r * __builtin_nontemporal_load((const f32x4*)p.in[I_GMIX] + lane + 64 * j);
            asm volatile("s_waitcnt vmcnt(0)" ::: "memory");
#pragma unroll
            for (int j = 0; j < 16; ++j) *(unsigned*)((unsigned char*)hbuf + (size_t)m * DM + (lane + 64 * j) * 4) = fg::pk4_fp8(v[j].x, v[j].y, v[j].z, v[j].w);
        }
        for (int m = gw; m < NMEM; m += NGW) rms_row_4096<act_t>(p.in[I_MEM] + (size_t)m * DM, p.in[I_GMEM], memn + (size_t)m * DM, lane, nullptr);
#if FAST_GEMM
        {
            LAS float* scr = (LAS float*)(lds + wave * 16640);
            p0_items<0>(p, ws, scr, lane, gw, NGW);
        }
#endif
    }
    SEAM(0);
    if (IN(0) && IN(1) && G == 256) {
        if (tid == 0) { bool even = true;
            for (int j2 = 0; j2 < 8; ++j2) even = even && (xb_ld(ctl + CW_TICKET + 64 * j2) == 32u);
            misc[6] = (even && misc[4] < 8u && misc[5] < 32u) ? (misc[4] + 8u * misc[5]) : (unsigned)blockIdx.x; }
        __syncthreads();
        bid = __builtin_amdgcn_readfirstlane((int)misc[6]);
    }
    if (IN(1)) REP(1) {
#if FAST_GEMM
        { fg::DenseSched S{(const char*)hbuf, (const char*)winT, DM / 2, DM / 2, NTOK / 256, INWP / 256, 1, DM / 128, G, bid, (p.var == 10) ? 2 : 0};
          fg::EpiBf16N E{p1, INW, INW, 1.0f / (2.0f * 64.0f), p.in[I_GQA], 8, p.in[I_GKA], 16, 0, (LAS float*)(lds + 131072 + 2048)};
          fg::gemm_phase<fg::EpiBf16N, fg::DenseSched, false, true, true>(lds, S, E, DM / 2, DM / 2, p.var); }
        { fg::DenseSched S{(const char*)memn, (const char*)wxkvT, DM, PK(DM), NMEM / 256, 1024 / 256, 1, DM / 64, G, (bid + G - 224) % G, 0};
          fg::EpiBf16 E{kvm, 1024, 1024, 1.0f};
          fg::gemm_phase<fg::EpiBf16, fg::DenseSched, false, false, true>(lds, S, E, DM, PK(DM)); }
#else
        constexpr int NT1 = (INW + 127) / 128, U1 = (NTOK / 128) * NT1, U2 = (NMEM / 128) * (1024 / 128);
        for (int u = bid; u < U1 + U2; u += G) {
            if (u < U1) { const int mt = u / NT1, nt = u % NT1;
                BPlain bc{p.in[I_WIN], INW, nt * 128, INW};
                auto epi = [&](int r, int c, const float (&v)[4]) { const int col = nt * 128 + c; if (col < INW) { act_t* o = p1 + (size_t)(mt * 128 + r) * INW + col; stf(o, v[0]); stf(o + 1, v[1]); stf(o + 2, v[2]); stf(o + 3, v[3]); } };
                ngemm_tile<act_t>(ldsf, hbuf, DM, nullptr, mt * 128, 128, DM, bc, epi);
            } else { const int v2 = u - U1, mt = v2 / 8, nt = v2 % 8;
                BPlain bc{p.in[I_WXKV], 1024, nt * 128, 1024};
                auto epi = [&](int r, int c, const float (&v)[4]) { act_t* o = kvm + (size_t)(mt * 128 + r) * 1024 + nt * 128 + c; stf(o, v[0]); stf(o + 1, v[1]); stf(o + 2, v[2]); stf(o + 3, v[3]); };
                ngemm_tile<act_t>(ldsf, memn, DM, nullptr, mt * 128, 128, DM, bc, epi);
            }
        }
    #endif
    }
    SEAM(1);
    if (IN(2)) {
#if FAST_GEMM
        {
            float gcq0[8], gcq1[8], gckv[8];
            load8f(p.in[I_GCQ] + lane * 8, gcq0); load8f(p.in[I_GCQ] + 512 + lane * 8, gcq1); load8f(p.in[I_GCKV] + lane * 8, gckv);
            for (int m = gw; m < NTOK; m += NGW) {
                act_t* row = p1 + (size_t)m * INW;
                u32x4 cq[2], ckv;
                cq[0] = *(const u32x4*)(row + C_CQ + lane * 8); cq[1] = *(const u32x4*)(row + C_CQ + 512 + lane * 8); ckv = *(const u32x4*)(row + C_CKV + lane * 8);
                const int pos = positions[m];
                asm volatile("s_waitcnt vmcnt(0)" ::: "memory");
                { float f0[8], f1[8]; unpack8(cq[0], f0); unpack8(cq[1], f1); const float ss = wave_sum(sumsq8(f0) + sumsq8(f1)); const float r = 1.0f / sqrtf(ss * (1.0f / 1024.f) + EPS);
                  scale8(f0, r, gcq0); scale8(f1, r, gcq1); cq[0] = pack8(f0); cq[1] = pack8(f1); }
                { float f[8]; unpack8(ckv, f); const float ss = wave_sum(sumsq8(f)); const float r = 1.0f / sqrtf(ss * (1.0f / 512.f) + EPS); scale8(f, r, gckv); ckv = pack8(f); }
                *(u32x4*)(row + C_CQ + lane * 8) = cq[0]; *(u32x4*)(row + C_CQ + 512 + lane * 8) = cq[1]; *(u32x4*)(row + C_CKV + lane * 8) = ckv;
                rms_rope64_inplace(row + C_KPE, p.in[I_GKB] + 128, pos, lane);
            }
            float gkx[8]; load8f(p.in[I_GKX] + (lane & 15) * 8, gkx);
            for (int m = gw; m < NMEM; m += NGW) { act_t* row = kvm + (size_t)m * 1024;
                u32x4 w = *(const u32x4*)(row + lane * 8); float f[8]; unpack8(w, f); const float ss = group_sum<16>(sumsq8(f)); const float r = 1.0f / sqrtf(ss * (1.0f / 128.f) + EPS);
                scale8(f, r, gkx); *(u32x4*)(row + lane * 8) = pack8(f); }
        }
#else
        for (int m = gw; m < NTOK; m += NGW) {
            act_t* row = p1 + (size_t)m * INW;
            for (int h = 0; h < HA; ++h) { rms_inplace<128>(row + C_Q0 + h * HD, p.in[I_GQA], lane); rms_inplace<128>(row + C_K0 + h * HD, p.in[I_GKA], lane); }
            rms_inplace<QLORA>(row + C_CQ, p.in[I_GCQ], lane);
            rms_inplace<KVLORA>(row + C_CKV, p.in[I_GCKV], lane);
            rms_rope64_inplace(row + C_KPE, p.in[I_GKB] + 128, positions[m], lane);
        }
        for (int m = gw; m < NMEM; m += NGW) for (int h = 0; h < MH; ++h) rms_inplace<128>(kvm + (size_t)m * 1024 + h * 128, p.in[I_GKX], lane);
#endif
    }
    SEAM(2);
    if (IN(3)) REP(3) {
#if FAST_GEMM
        { fg::DenseSched S{(const char*)(p1 + C_CQ), (const char*)wuqT, INW, PK(QLORA), NTOK / 256, 3072 / 256, 1, QLORA / 64, G, bid, 0};
          fg::EpiBf16 E{qb, 3072, 3072, 1.0f};
          fg::gemm_phase<fg::EpiBf16, fg::DenseSched, false, false, true>(lds, S, E, INW, PK(QLORA)); }
        { fg::DenseSched S{(const char*)(p1 + C_CKV), (const char*)wukvT, INW, PK(KVLORA), NTOK / 256, 4096 / 256, 1, KVLORA / 64, G, bid, (G == 256) ? 1 : 0};
          fg::EpiBf16N E{kvb, 4096, 4096, 1.0f, p.in[I_GKB], 16, p.in[I_GKB], 16, 1, (LAS float*)(lds + 131072 + 2048)};
          fg::gemm_phase<fg::EpiBf16N, fg::DenseSched, false, false, true>(lds, S, E, INW, PK(KVLORA)); }
#else
        constexpr int UA = (NTOK / 128) * (3072 / 128), UB = (NTOK / 128) * (4096 / 128);
        for (int u = bid; u < UA + UB; u += G) {
            if (u < UA) { const int mt = u / 24, nt = u % 24;
                BPlain bc{p.in[I_WUQ], 3072, nt * 128, 3072};
                auto epi = [&](int r, int c, const float (&v)[4]) { act_t* o = qb + (size_t)(mt * 128 + r) * 3072 + nt * 128 + c; stf(o, v[0]); stf(o + 1, v[1]); stf(o + 2, v[2]); stf(o + 3, v[3]); };
                ngemm_tile<act_t>(ldsf, p1 + C_CQ, INW, nullptr, mt * 128, 128, QLORA, bc, epi);
            } else { const int v2 = u - UA, mt = v2 / 32, nt = v2 % 32;
                BPlain bc{p.in[I_WUKV], 4096, nt * 128, 4096};
                auto epi = [&](int r, int c, const float (&v)[4]) { act_t* o = kvb + (size_t)(mt * 128 + r) * 4096 + nt * 128 + c; stf(o, v[0]); stf(o + 1, v[1]); stf(o + 2, v[2]); stf(o + 3, v[3]); };
                ngemm_tile<act_t>(ldsf, p1 + C_CKV, INW, nullptr, mt * 128, 128, KVLORA, bc, epi);
            }
        }
    #endif
    }
    SEAM(3);
    if (IN(4)) {
#if FAST_GEMM
        {
            float gqn[8], gqp[8];
            load8f(p.in[I_GQB] + (lane & 15) * 8, gqn); load8f(p.in[I_GQB] + 128 + (lane & 7) * 8, gqp);
            for (int m = gw; m < NTOK; m += NGW) {
                act_t* qrow = qb + (size_t)m * 3072;
                u32x4 qn[4], qp[2];
#pragma unroll
                for (int j = 0; j < 4; ++j) qn[j] = *(const u32x4*)(qrow + (j * 4 + (lane >> 4)) * QKB + (lane & 15) * 8);
#pragma unroll
                for (int j = 0; j < 2; ++j) qp[j] = *(const u32x4*)(qrow + (j * 8 + (lane >> 3)) * QKB + 128 + (lane & 7) * 8);
                float cs[8], sn[8];
                { const int fi = lane & 31; const float inv_freq = powf(10000.0f, -(float)(2 * fi) / 64.0f); const float ang = (float)positions[m] * inv_freq; float s1, c1; sincosf(ang, &s1, &c1);
#pragma unroll
                  for (int i = 0; i < 8; ++i) { const int src = ((lane & 3) * 8 + i); cs[i] = __shfl(c1, src); sn[i] = __shfl(s1, src); } }
                asm volatile("s_waitcnt vmcnt(0)" ::: "memory");
#pragma unroll
                for (int j = 0; j < 4; ++j) { float f[8]; unpack8(qn[j], f); const float ss = group_sum<16>(sumsq8(f)); const float r = 1.0f / sqrtf(ss * (1.0f / 128.f) + EPS); scale8(f, r, gqn); qn[j] = pack8(f); }
#pragma unroll
                for (int j = 0; j < 2; ++j) { float f[8]; unpack8(qp[j], f); const float ss = group_sum<8>(sumsq8(f)); const float r = 1.0f / sqrtf(ss * (1.0f / 64.f) + EPS); scale8(f, r, gqp);
                    const bool lowhalf = ((lane & 7) < 4);
#pragma unroll
                    for (int i = 0; i < 8; ++i) { const float other = __shfl_xor(f[i], 4); f[i] = lowhalf ? (f[i] * cs[i] - other * sn[i]) : (f[i] * cs[i] + other * sn[i]); }
                    qp[j] = pack8(f); }
#pragma unroll
                for (int j = 0; j < 4; ++j) *(u32x4*)(qrow + (j * 4 + (lane >> 4)) * QKB + (lane & 15) * 8) = qn[j];
#pragma unroll
                for (int j = 0; j < 2; ++j) *(u32x4*)(qrow + (j * 8 + (lane >> 3)) * QKB + 128 + (lane & 7) * 8) = qp[j];
            }
        }
#else
        for (int m = gw; m < NTOK; m += NGW) {
            const int pos = positions[m];
            for (int h = 0; h < HB; ++h) {
                rms_inplace<128>(qb + (size_t)m * 3072 + h * QKB, p.in[I_GQB], lane);
                rms_rope64_inplace(qb + (size_t)m * 3072 + h * QKB + 128, p.in[I_GQB] + 128, pos, lane);
                rms_inplace<128>(kvb + (size_t)m * 4096 + h * 256, p.in[I_GKB], lane);
            }
        }
#endif
    }
    SEAM(4);
    if (IN(5)) {
#if FAST_ATTN
        {
            constexpr int NA_BLK = 176;
            LAS char* al = (LAS char*)lds;
            LAS float* scr = (LAS float*)(lds + wave * 16640);
            if (bid >= NA_BLK) { expert_conv_loop(p, ws, ctl + CW_QCONV, scr, lane); }
            for (;;) {
                __syncthreads(); if (tid == 0) misc[7] = xb_add(ctl + CW_QB, 1u); __syncthreads();
                const int q = (int)misc[7]; if (q >= 512) break;
                const int grp = q >> 8, idx = q & 255, pair = idx >> 2, qbk = (grp == 0 ? 7 : 3) - (idx & 3), b = pair >> 4, h = pair & 15;
                const int c0 = qbk * 4; const size_t tok0 = (size_t)b * SEQ + (size_t)qbk * 256;
                const act_t* kb = kvb + (size_t)b * SEQ * 4096;
                fa::attn_call<1>(qb + tok0 * 3072 + h * QKB, kb + h * 256, p1 + (size_t)b * SEQ * INW + C_KPE, kb + h * 256 + 128, (bf16_t*)((unsigned char*)mixed + tok0 * DM + WA + h * HD), 0, c0 + 4, c0, al);
            }
            for (;;) {
                __syncthreads(); if (tid == 0) misc[7] = xb_add(ctl + CW_QA, 1u); __syncthreads();
                const int q = (int)misc[7]; if (q >= 512) break;
                const int grp = q >> 8, idx = q & 255, pair = idx >> 2, qbk = (grp == 0 ? 7 : 3) - (idx & 3), b = pair >> 4, h = pair & 15;
                { LAS float* tbl = (LAS float*)(al + fa::OFF_TBL); if (tid < NREL) tbl[tid] = p.in[I_RELB][h * NREL + tid] * 11.313708498984761f; }
                const int c0 = qbk * 4; const size_t tok0 = (size_t)b * SEQ + (size_t)qbk * 256;
                const int kt0 = (c0 - LEFT) > 0 ? (c0 - LEFT) : 0;
                const act_t* base = p1 + (size_t)b * SEQ * INW;
                fa::attn_call<0>(p1 + tok0 * INW + C_Q0 + h * HD, base + C_K0 + h * HD, nullptr, base + C_V0 + h * HD, (bf16_t*)((unsigned char*)mixed + tok0 * DM + h * HD), kt0, c0 + 4 - kt0, c0, al);
            }
            __syncthreads();
            expert_conv_loop(p, ws, ctl + CW_QCONV, scr, lane);
        }
#else
        for (int u = bid; u < 4096; u += G) {
            const int c = 31 - (u >> 7), rem = u & 127, type = rem >> 6, b = (rem >> 4) & 3, h = rem & 15;
            const size_t tok0 = (size_t)b * SEQ + (size_t)c * CHUNK;
            if (type == 0) {
                const int t0 = (c - LEFT) > 0 ? (c - LEFT) : 0, nt = c - t0 + 1;
                const float* rb = p.in[I_RELB] + h * NREL;
                auto keytile = [&](int t) { return (t0 + t) * CHUNK; };
                auto bias = [&](int r, int t, int key) { int dist = (c * CHUNK + r) - ((t0 + t) * CHUNK + key); dist = dist < -(CHUNK - 1) ? -(CHUNK - 1) : (dist > 128 ? 128 : dist); return rb[dist + CHUNK - 1]; };
                const act_t* base = p1 + (size_t)b * SEQ * INW;
                nattn_unit<128>(ldsf, p1 + tok0 * INW + C_Q0 + h * HD, INW, base + C_K0 + h * HD, INW, nullptr, 0, base + C_V0 + h * HD, INW,
                                nt, keytile, 0.08838834764831845f, bias, mixed + tok0 * DM + h * HD, DM);
            } else {
                auto keytile = [&](int t) { return t * CHUNK; };
                auto bias = [&](int, int, int) { return 0.f; };
                const act_t* kb = kvb + (size_t)b * SEQ * 4096;
                nattn_unit<192>(ldsf, qb + tok0 * 3072 + h * QKB, 3072, kb + h * 256, 4096, p1 + (size_t)b * SEQ * INW + C_KPE, INW, kb + h * 256 + 128, 4096,
                                c + 1, keytile, 0.07216878364870323f, bias, mixed + tok0 * DM + WA + h * HD, DM);
            }
        }
    #endif
    }
    SEAM(5);
    if (IN(6)) REP(6) {
#if FAST_GEMM
        { fg::DenseSched S{(const char*)mixed, (const char*)woT, DM / 2, DM / 2, NTOK / 256, DM / 256, 1, DM / 128, G, bid, 0};
          fg::EpiResStat E{x, hc, (float*)(ws + WS_SSP1), DM, 1.0f / (fa::MIX_SCALE * 64.0f)};
          fg::gemm_phase<fg::EpiResStat, fg::DenseSched, false, true, true>(lds, S, E, DM / 2, DM / 2); }
#else
        for (int u = bid; u < (NTOK / 128) * (DM / 128); u += G) { const int mt = u / 32, nt = u % 32;
            BPlain bc{p.in[I_WO], DM, nt * 128, DM};
            auto epi = [&](int r, int c, const float (&v)[4]) { const size_t o = (size_t)(mt * 128 + r) * DM + nt * 128 + c;
                const f32x4 xv = *(const f32x4*)(x + o); *(f32x4*)(x1 + o) = (f32x4){xv.x + v[0], xv.y + v[1], xv.z + v[2], xv.w + v[3]}; };
            ngemm_tile<act_t>(ldsf, mixed, DM, nullptr, mt * 128, 128, DM, bc, epi);
        }
    #endif
    }
    SEAM(6);
    if (IN(8)) REP(8) {
#if FAST_GEMM
        { fg::DenseSched S{(const char*)hc, (const char*)wxqT, DM, PK(DM), NTOK / 256, 512 / 256, 4, DM / 64 / 4, G, bid, 0};
          fg::EpiF32Res<false> E{qxp, nullptr, 512, (size_t)NTOK * 512, 1.0f};
          fg::gemm_phase<fg::EpiF32Res<false>, fg::DenseSched, false, false, true>(lds, S, E, DM, PK(DM)); }
#else
        for (int u = bid; u < (NTOK / 128) * 4; u += G) { const int mt = u / 4, nt = u % 4;
            BPlain bc{p.in[I_WXQ], 512, nt * 128, 512};
            auto epi = [&](int r, int c, const float (&v)[4]) { act_t* o = qx + (size_t)(mt * 128 + r) * 512 + nt * 128 + c; stf(o, v[0]); stf(o + 1, v[1]); stf(o + 2, v[2]); stf(o + 3, v[3]); };
            ngemm_tile<act_t>(ldsf, hc, DM, nullptr, mt * 128, 128, DM, bc, epi);
        }
    #endif
    }
    SEAM(8);
    if (IN(9)) {
#if FAST_GEMM
        { float gqx[8]; load8f(p.in[I_GQX] + (lane & 15) * 8, gqx);
          for (int m = gw; m < NTOK; m += NGW) {
            f32x4 a[4][2];
#pragma unroll
            for (int sl = 0; sl < 4; ++sl) { const float* src = qxp + (size_t)sl * NTOK * 512 + (size_t)m * 512 + lane * 8; a[sl][0] = *(const f32x4*)src; a[sl][1] = *(const f32x4*)(src + 4); }
            const float rs1 = 1.0f / sqrtf(wave_sum(((const float*)(ws + WS_SSP1))[(size_t)m * 64 + lane]) * (1.0f / 4096.f) + EPS);
            const f32x4 lo = ((a[0][0] + a[1][0]) + (a[2][0] + a[3][0])) * rs1, hi4 = ((a[0][1] + a[1][1]) + (a[2][1] + a[3][1])) * rs1;
            float f[8] = {lo.x, lo.y, lo.z, lo.w, hi4.x, hi4.y, hi4.z, hi4.w};
            const float ss = group_sum<16>(sumsq8(f)); const float r = 1.0f / sqrtf(ss * (1.0f / 128.f) + EPS); scale8(f, r, gqx);
            *(u32x4*)(qx + (size_t)m * 512 + lane * 8) = pack8(f); } }
#else
        for (int m = gw; m < NTOK; m += NGW) for (int h = 0; h < MH; ++h) rms_inplace<128>(qx + (size_t)m * 512 + h * 128, p.in[I_GQX], lane);
#endif
    }
    SEAM(9);
    if (IN(10)) REP(10) {
#if FAST_ATTN
        for (int u = bid; u < NB * MH * (SEQ / 256); u += G) { const int qbk = u & 7, h = (u >> 3) & 3, b = u >> 5;
            const size_t tok0 = (size_t)b * SEQ + (size_t)qbk * 256;
            const act_t* kb = kvm + (size_t)b * MEMT * 1024;
            fa::attn_call<2>(qx + tok0 * 512 + h * 128, kb + h * 128, nullptr, kb + 512 + h * 128, ox + tok0 * 512 + h * 128, 0, 4, 0, (LAS char*)lds);
        }
#else
        for (int u = bid; u < NB * MH * (SEQ / 64); u += G) { const int c = u & 31, h = (u >> 5) & 3, b = u >> 7;
            const size_t tok0 = (size_t)b * SEQ + (size_t)c * 64;
            auto keytile = [&](int t) { return t * 64; };
            auto bias = [&](int, int, int) { return 0.f; };
            const act_t* kb = kvm + (size_t)b * MEMT * 1024;
            nattn_unit<128>(ldsf, qx + tok0 * 512 + h * 128, 512, kb + h * 128, 1024, nullptr, 0, kb + 512 + h * 128, 1024, 4, keytile, 0.08838834764831845f, bias, ox + tok0 * 512 + h * 128, 512);
        }
    #endif
    }
    SEAM(10);
    if (IN(11)) REP(11) {
#if FAST_GEMM
        { fg::DenseSched S{(const char*)ox, (const char*)wxoT, 512, PK(512), NTOK / 256, DM / 256, 1, 512 / 64, G, bid, 0};
          fg::EpiX2 E{hc, tb, (bf16_t*)hh, ws + WS_T8, (float*)(ws + WS_SSP2), DM};
          fg::gemm_phase<fg::EpiX2, fg::DenseSched, false, false, true>(lds, S, E, 512, PK(512)); }
#else
        for (int u = bid; u < (NTOK / 128) * (DM / 128); u += G) { const int mt = u / 32, nt = u % 32;
            BPlain bc{p.in[I_WXO], DM, nt * 128, DM};
            auto epi = [&](int r, int c, const float (&v)[4]) { const size_t o = (size_t)(mt * 128 + r) * DM + nt * 128 + c;
                const f32x4 xv = *(const f32x4*)(x1 + o); const f32x4 y = (f32x4){xv.x + v[0], xv.y + v[1], xv.z + v[2], xv.w + v[3]}; *(f32x4*)(x2 + o) = y; *(f32x4*)(p.out + o) = y; };
            ngemm_tile<act_t>(ldsf, ox, 512, nullptr, mt * 128, 128, 512, bc, epi);
        }
    #endif
    }
    SEAM(11);
    if (IN(13)) {
        RouterSched S{(const char*)tb, (const char*)hh, (const char*)(ws + WS_WR), nullptr, G, bid};
        EpiLogits E{(float*)(ws + WS_Y)};
        fg::gemm_phase<EpiLogits, RouterSched, false, false, true>(lds, S, E, DM, DM);
    }
    SEAM(13);
    if (IN(14)) {
        const float* lgp = (const float*)(ws + WS_Y);
        const float rb = p.in[I_RBIAS][lane];
        const int g = lane >> 3;
        float lgA[16];
#pragma unroll
        for (int sl = 0; sl < 16; ++sl) lgA[sl] = (gw < NTOK) ? lgp[((size_t)(sl >> 1) * NTOK + gw) * 128 + (sl & 1) * 64 + lane] : 0.f;
        int pm_ = -1, psel = 0, prank = 0; float pgate = 0.f; unsigned ppos = 0u;
        for (int m = gw; m < NTOK; m += NGW) {
            float lgB[16]; const int mn = m + NGW;
#pragma unroll
            for (int sl = 0; sl < 16; ++sl) lgB[sl] = (mn < NTOK) ? lgp[((size_t)(sl >> 1) * NTOK + mn) * 128 + (sl & 1) * 64 + lane] : 0.f;
            const float rs2 = 1.0f / sqrtf(wave_sum(((const float*)(ws + WS_SSP2))[(size_t)m * 64 + lane]) * (1.0f / 4096.f) + EPS);
            if (lane == 0) ((float*)(ws + WS_RS2))[m] = rs2;
            const float logit = ((((lgA[0] + lgA[1]) + (lgA[2] + lgA[3])) + ((lgA[4] + lgA[5]) + (lgA[6] + lgA[7]))) + (((lgA[8] + lgA[9]) + (lgA[10] + lgA[11])) + ((lgA[12] + lgA[13]) + (lgA[14] + lgA[15])))) * rs2;
            const float score = 1.0f / (1.0f + expf(-logit));
            const float choice = score + rb;
            float gm1 = fmaxf(choice, __shfl_xor(choice, 1)); gm1 = fmaxf(gm1, __shfl_xor(gm1, 2)); gm1 = fmaxf(gm1, __shfl_xor(gm1, 4));
            const unsigned long long eq = __ballot(choice == gm1);
            const unsigned gbits = (unsigned)(eq >> (8 * g)) & 0xffu;
            const bool is_first = (lane & 7) == (__builtin_ctz(gbits | 0x100u));
            float v2 = is_first ? -INFINITY : choice;
            v2 = fmaxf(v2, __shfl_xor(v2, 1)); v2 = fmaxf(v2, __shfl_xor(v2, 2)); v2 = fmaxf(v2, __shfl_xor(v2, 4));
            const float gscore = gm1 + v2;
            int grank = 0;
#pragma unroll
            for (int j2 = 0; j2 < 8; ++j2) { const float gj = __int_as_float(__builtin_amdgcn_readlane(__float_as_int(gscore), 8 * j2)); grank += ((gj > gscore) || (gj == gscore && j2 < g)) ? 1 : 0; }
            const bool gsel = grank < 4;
            const float mv = gsel ? choice : -INFINITY;
            int rank = 0;
#pragma unroll
            for (int i2 = 0; i2 < 64; ++i2) { const float vi = __int_as_float(__builtin_amdgcn_readlane(__float_as_int(mv), i2)); rank += ((vi > mv) || (vi == mv && i2 < lane)) ? 1 : 0; }
            const bool sel = gsel && rank < 8;
            const float wsum = wave_sum(sel ? score : 0.f);
            if (pm_ >= 0 && psel) { rowtok[lane * CAP + ppos] = pm_; rowgate[lane * CAP + ppos] = pgate; rowdst[lane * CAP + ppos] = pm_ * 8 + prank; }
            ppos = 0u; if (sel) ppos = atomicAdd(&gcnt[64 * lane], 1u);
            pm_ = m; psel = sel ? 1 : 0; prank = rank; pgate = score * 2.5f / (wsum + 1e-20f);
#pragma unroll
            for (int sl = 0; sl < 16; ++sl) lgA[sl] = lgB[sl];
        }
        if (pm_ >= 0 && psel) { rowtok[lane * CAP + ppos] = pm_; rowgate[lane * CAP + ppos] = pgate; rowdst[lane * CAP + ppos] = pm_ * 8 + prank; }
    }
    SEAM(14);
    if (IN(15)) REP(15) {
#if FAST_MOE
        { const fg::MoeTabs T = moe_tables_fast((LAS int*)(lds + 131072), gcnt);
          fg::MoeSched<1> S{T, (const char*)(ws + WS_T8), (const char*)wguT, rowtok, G, bid};
          fg::EpiSwiglu E{hh, (const float*)(ws + WS_RS2)};
          fg::gemm_phase<fg::EpiSwiglu, fg::MoeSched<1>, true, true, true>(lds, S, E, DM / 2, DM / 2, p.var); }
#else
        int* tab = (int*)(ldsf + 2 * 16 * 132);
        const MoeTab T = moe_tables(tab, gcnt, 128);
        const int nunits = T.mtp[NE + 1] * 8;
        for (int u = bid; u < nunits; u += G) {
            const int mti = u >> 3, nt = u & 7; int e = 0; while (T.mtp[e + 1] <= mti) ++e;
            const int mt = mti - T.mtp[e], nrows = (T.cnt[e] - mt * 128) < 128 ? (T.cnt[e] - mt * 128) : 128;
            const float* Wg = (e < NE) ? p.in[I_WEXG] + (size_t)e * DM * EFF : p.in[I_WSHG];
            const float* Wu = (e < NE) ? p.in[I_WEXU] + (size_t)e * DM * EFF : p.in[I_WSHU];
            BGU bc{Wg, Wu, EFF, nt * 64};
            const size_t hrow0 = (size_t)T.offh[e] + (size_t)mt * 128;
            auto epi = [&](int r, int c, const float (&v)[4]) { act_t* o = hh + (hrow0 + r) * EFF + nt * 64 + (c >> 2) * 2;
                stf(o, v[0] / (1.0f + expf(-v[0])) * v[2]); stf(o + 1, v[1] / (1.0f + expf(-v[1])) * v[3]); };
            ngemm_tile<act_t>(ldsf, tb, DM, (e < NE) ? rowtok + e * CAP : nullptr, mt * 128, nrows, DM, bc, epi);
        }
    #endif
    }
    SEAM(15);
    if (IN(16)) REP(16) {
#if FAST_MOE
        { const fg::MoeTabs T = moe_tables_fast((LAS int*)(lds + 131072), gcnt);
          { fg::MoeSched<2> S{T, (const char*)hh, (const char*)wdT, rowtok, G, bid};
            fg::EpiScatter E{(unsigned char*)ybuf, rowdst, rowgate, T.mtp};
            fg::gemm_phase<fg::EpiScatter, fg::MoeSched<2>, false, true, true>(lds, S, E, EFF / 2, EFF / 2, p.var); }
          { fg::DenseSched S{(const char*)hh + (size_t)T.mtp[64] * 256 * EFF, (const char*)wdT + (size_t)64 * DM * EFF, EFF / 2, EFF / 2, NTOK / 256, DM / 256, 1, EFF / 128, G, bid, 0};
            fg::EpiShared E{(unsigned char*)ybuf + (size_t)NTOK * 8 * DM};
            fg::gemm_phase<fg::EpiShared, fg::DenseSched, false, true, true>(lds, S, E, EFF / 2, EFF / 2); } }
#else
        int* tab = (int*)(ldsf + 2 * 16 * 132);
        const MoeTab T = moe_tables(tab, gcnt, 128);
        const int nunits = T.mtp[NE + 1] * 32;
        for (int u = bid; u < nunits; u += G) {
            const int mti = u >> 5, nt = u & 31; int e = 0; while (T.mtp[e + 1] <= mti) ++e;
            const int mt = mti - T.mtp[e], nrows = (T.cnt[e] - mt * 128) < 128 ? (T.cnt[e] - mt * 128) : 128;
            const float* Wd = (e < NE) ? p.in[I_WEXD] + (size_t)e * EFF * DM : p.in[I_WSHD];
            BPlain bc{Wd, DM, nt * 128, DM};
            const int hrow0 = T.offh[e] + mt * 128;
            auto epi = [&](int r, int c, const float (&v)[4]) {
                int tok; float g; if (e < NE) { tok = rowtok[e * CAP + mt * 128 + r]; g = rowgate[e * CAP + mt * 128 + r]; } else { tok = mt * 128 + r; g = 1.0f; }
                float* o = p.out + (size_t)tok * DM + nt * 128 + c;
                atomicAdd(o, v[0] * g); atomicAdd(o + 1, v[1] * g); atomicAdd(o + 2, v[2] * g); atomicAdd(o + 3, v[3] * g); };
            ngemm_tile<act_t>(ldsf, hh, EFF, nullptr, hrow0, nrows, EFF, bc, epi);
        }
    #endif
    }
    SEAM(16);
    if (IN(17)) REP(17) {
#if FAST_MOE
        for (int m = gw; m < NTOK; m += NGW) {
            const unsigned char* y8 = (const unsigned char*)ybuf + (size_t)m * 8 * DM;
#pragma unroll 2
            for (int j = 0; j < 4; ++j) { const int c0 = lane * 16 + 1024 * j;
                const bf16_t* sp = tb + (size_t)m * DM + c0; float* op = p.out + (size_t)m * DM + c0;
                f32x4 sv[4];
#pragma unroll
                for (int q = 0; q < 2; ++q) { const u32x4 t = __builtin_nontemporal_load((const u32x4*)(sp + 8 * q));
                    sv[2 * q] = (f32x4){__uint_as_float(t.x << 16), __uint_as_float(t.x & 0xffff0000u), __uint_as_float(t.y << 16), __uint_as_float(t.y & 0xffff0000u)};
                    sv[2 * q + 1] = (f32x4){__uint_as_float(t.z << 16), __uint_as_float(t.z & 0xffff0000u), __uint_as_float(t.w << 16), __uint_as_float(t.w & 0xffff0000u)}; }
                u32x4 y[9];
#pragma unroll
                for (int k = 0; k < 8; ++k) y[k] = __builtin_nontemporal_load((const u32x4*)(y8 + (size_t)k * DM + c0));
                y[8] = __builtin_nontemporal_load((const u32x4*)((const unsigned char*)ybuf + (size_t)NTOK * 8 * DM + (size_t)m * DM + c0));
                float a[16];
#pragma unroll
                for (int q = 0; q < 16; ++q) a[q] = 0.f;
#pragma unroll
                for (int k = 0; k < 9; ++k) {
#pragma unroll
                    for (int q = 0; q < 4; ++q) { const int w = (int)y[k][q]; const auto lo = __builtin_amdgcn_cvt_pk_f32_fp8(w, false); const auto hi2 = __builtin_amdgcn_cvt_pk_f32_fp8(w, true);
                        a[4 * q] += lo[0]; a[4 * q + 1] += lo[1]; a[4 * q + 2] += hi2[0]; a[4 * q + 3] += hi2[1]; } }
#pragma unroll
                for (int q = 0; q < 4; ++q) { f32x4 o; o.x = sv[q].x + a[4 * q] * (1.0f / fg::Y_SCALE); o.y = sv[q].y + a[4 * q + 1] * (1.0f / fg::Y_SCALE); o.z = sv[q].z + a[4 * q + 2] * (1.0f / fg::Y_SCALE); o.w = sv[q].w + a[4 * q + 3] * (1.0f / fg::Y_SCALE);
                    *(f32x4*)(op + 4 * q) = o; } }
        }
#endif
    }
#undef IN
#undef SEAM
}

#if TVAR
__global__ void __launch_bounds__(512, 2) probe_k(Params p) {
    extern __shared__ __attribute__((aligned(16))) unsigned char lds_raw[];
    const int tid = threadIdx.x, lane = tid & 63, wave = tid >> 6;
    p0_items<TVAR>(p, p.ws, (LAS float*)((LAS unsigned char*)lds_raw + wave * 16640), lane, blockIdx.x * 8 + wave, gridDim.x * 8);
}
#endif
typedef void (*kern_t)(Params);
template <int PH> struct KTab { static void fill(kern_t* t) { t[PH] = fwd<(1u << PH)>; KTab<PH - 1>::fill(t); } };
template <> struct KTab<-1> { static void fill(kern_t*) {} };
extern "C" void kernel_launch(void* const* d_in, const int* in_sizes, int n_in, void* d_out, int out_size, void* d_ws, size_t ws_size, hipStream_t stream) {
    static int grid = 0;
    static kern_t ktab[NPHASE + 1];
    if (grid == 0) {
        if (n_in != 31 || out_size != NTOK * DM || ws_size < WS_END) { fprintf(stderr, "kernel_launch: bad shapes n_in %d out %d ws %zu (need %zu)\n", n_in, out_size, ws_size, (size_t)WS_END); grid = -1; return; }
        int dev = 0, cus = 0;
        if (hipGetDevice(&dev) != hipSuccess || hipDeviceGetAttribute(&cus, hipDeviceAttributeMultiprocessorCount, dev) != hipSuccess) { grid = -1; return; }
#if N_LAUNCH_PER_PHASE
        KTab<NPHASE - 1>::fill(ktab);
#else
        ktab[NPHASE] = fwd<0xFFFFFFFFu>;
#endif
#if N_LAUNCH_PER_PHASE
        for (int i = 0; i < NPHASE; ++i)
#else
        for (int i = NPHASE; i <= NPHASE; ++i)
#endif
            if (hipFuncSetAttribute((const void*)ktab[i], hipFuncAttributeMaxDynamicSharedMemorySize, LDS_BYTES) != hipSuccess) { fprintf(stderr, "kernel_launch: hipFuncSetAttribute failed\n"); grid = -1; return; }
        (void)hipGetLastError();
        grid = cus;
    }
    if (grid < 0) return;
    (void)hipMemsetAsync((char*)d_ws + WS_CTL, 0, CTL_BYTES, stream);
    Params p{};
    for (int i = 0; i < 31; ++i) p.in[i] = (const float*)d_in[i];
    p.out = (float*)d_out; p.ws = (unsigned char*)d_ws;
#if TVAR
    { static int once = 0; if (!once) { (void)hipFuncSetAttribute((const void*)probe_k, hipFuncAttributeMaxDynamicSharedMemorySize, LDS_BYTES); once = 1; } p.ph_lo = 0; p.ph_hi = 0; hipLaunchKernelGGL(probe_k, dim3(grid), dim3(512), LDS_BYTES, stream, p); }
#endif
#if N_LAUNCH_PER_PHASE
    for (int ph = 0; ph < NPHASE; ++ph) { p.ph_lo = ph; p.ph_hi = ph + 1; hipLaunchKernelGGL(ktab[ph], dim3(grid), dim3(512), LDS_BYTES, stream, p); }
#else
    p.ph_lo = 0; p.ph_hi = NPHASE; hipLaunchKernelGGL(ktab[NPHASE], dim3(grid), dim3(512), LDS_BYTES, stream, p);
#endif
#ifdef PROBE_PH
#ifndef PROBE_VAR
#define PROBE_VAR 0
#endif
    (void)hipMemsetAsync((char*)d_ws + WS_CTL + (size_t)CW_QCONV * 4, 0, 1024, stream);
    (void)hipMemsetAsync((char*)d_ws + WS_CTL + (size_t)CW_QCONV * 4, 0, 1024, stream);
    p.ph_lo = PROBE_PH; p.ph_hi = PROBE_PH + 1; p.var = PROBE_VAR; hipLaunchKernelGGL(ktab[NPHASE], dim3(grid), dim3(512), LDS_BYTES, stream, p);
#endif
    const hipError_t le = hipPeekAtLastError();
    if (le != hipSuccess) fprintf(stderr, "kernel_launch: launch failed: %s\n", hipGetErrorName(le));
}
```

```cpp
#include <hip/hip_runtime.h>
#include <cstdio>
#include <cstdint>

#define LAS __attribute__((address_space(3)))
typedef unsigned short bf16_t;
typedef float f32x4 __attribute__((ext_vector_type(4)));
typedef short bf16x8 __attribute__((ext_vector_type(8)));
typedef unsigned u32x4 __attribute__((ext_vector_type(4)));
typedef unsigned u32x2 __attribute__((ext_vector_type(2)));
typedef int v4i_t __attribute__((ext_vector_type(4)));
typedef int v8i_t __attribute__((ext_vector_type(8)));
#ifndef FAST_GEMM
#define FAST_GEMM 1
#endif
#ifndef FAST_MOE
#define FAST_MOE 1
#endif
#ifndef FAST_ATTN
#define FAST_ATTN 1
#endif

#ifndef ACT_F32
#define ACT_F32 0
#endif
#if ACT_F32
typedef float act_t;
#else
typedef bf16_t act_t;
#endif
#ifndef N_LAUNCH_PER_PHASE
#define N_LAUNCH_PER_PHASE 0
#endif

constexpr int NB = 4, SEQ = 2048, DM = 4096, NTOK = NB * SEQ;
constexpr int CHUNK = 64, LEFT = 8, NREL = 192;
constexpr int HD = 128, HA = 16, HB = 16, QLORA = 1024, KVLORA = 512, QKB = 192;
constexpr int MEMT = 256, MH = 4, NE = 64, EFF = 512;
constexpr int WA = HA * HD;
constexpr int INW = 3 * WA + QLORA + KVLORA + 64;
constexpr int NMEM = NB * MEMT;
constexpr int C_Q0 = 0, C_K0 = WA, C_V0 = 2 * WA, C_CQ = 3 * WA, C_CKV = 3 * WA + QLORA, C_KPE = 3 * WA + QLORA + KVLORA;
constexpr float EPS = 1e-6f;
constexpr int CAP = NTOK;

constexpr size_t MiB = 1u << 20;
constexpr size_t AS = sizeof(act_t);
constexpr size_t al(size_t x) { return (x + 255) / 256 * 256; }
constexpr size_t WS_CTL = 0, CTL_BYTES = 1 * MiB;
constexpr size_t WS_ROWTOK = 1 * MiB, WS_ROWGATE = 3 * MiB, WS_ROWDST = 5 * MiB;
constexpr int PK(int K) { return K; }
constexpr int INWP = 7936;
constexpr size_t WS_WR = 8 * MiB;
constexpr size_t WS_WIN = 12 * MiB;
constexpr size_t WS_WUQ = WS_WIN + al((size_t)INWP * PK(DM) * 2);
constexpr size_t WS_WUKV = WS_WUQ + al((size_t)3072 * PK(QLORA) * 2);
constexpr size_t WS_WO = WS_WUKV + al((size_t)4096 * PK(KVLORA) * 2);
constexpr size_t WS_WXQ = WS_WO + al((size_t)DM * PK(DM) * 2);
constexpr size_t WS_WXKV = WS_WXQ + al((size_t)512 * PK(DM) * 2);
constexpr size_t WS_WXO = WS_WXKV + al((size_t)1024 * PK(DM) * 2);
constexpr size_t WS_WGU = WS_WXO + al((size_t)DM * PK(512) * 2);
constexpr size_t WS_WD = WS_WGU + al((size_t)65 * 1024 * DM);
constexpr size_t WS_T8 = WS_WD + al((size_t)65 * DM * EFF);
constexpr size_t WS_SSP1 = WS_T8 + al((size_t)NTOK * DM);
constexpr size_t WS_SSP2 = WS_SSP1 + (size_t)NTOK * 64 * 4;
constexpr size_t WS_RS2 = WS_SSP2 + (size_t)NTOK * 64 * 4;
constexpr size_t WS_X1 = WS_RS2 + al((size_t)NTOK * 4);
constexpr size_t WS_X2 = WS_X1 + al((size_t)NTOK * DM * 4);
constexpr size_t WS_T = WS_X2 + al((size_t)NTOK * DM * 4);
constexpr int HH_ROWS = NTOK * 8 + NE * 256 + NTOK;
constexpr size_t WS_HH = WS_T + al((size_t)NTOK * DM * AS);
constexpr size_t WS_Y = WS_HH + al((size_t)HH_ROWS * EFF * AS);
constexpr size_t WS_H = WS_Y;
constexpr size_t WS_MEMN = WS_H + al((size_t)NTOK * DM * AS);
constexpr size_t WS_P1 = WS_MEMN + al((size_t)NMEM * DM * AS);
constexpr size_t WS_KVM = WS_P1 + al((size_t)NTOK * INW * AS);
constexpr size_t WS_QB = WS_KVM + al((size_t)NMEM * 1024 * AS);
constexpr size_t WS_KVB = WS_QB + al((size_t)NTOK * 3072 * AS);
constexpr size_t WS_MIXED = WS_KVB + al((size_t)NTOK * 4096 * AS);
constexpr size_t WS_HC = WS_MIXED + al((size_t)NTOK * DM * AS);
constexpr size_t WS_QXP = WS_HC + al((size_t)NTOK * DM * AS);
constexpr size_t WS_QX = WS_QXP + al((size_t)4 * NTOK * 512 * 4);
constexpr size_t WS_OX = WS_QX + al((size_t)NTOK * 512 * AS);
constexpr size_t WS_END0 = WS_OX + al((size_t)NTOK * 512 * AS);
constexpr size_t WS_YEND = WS_Y + al((size_t)NTOK * 8 * DM * 2);
constexpr size_t WS_END = WS_END0 > WS_YEND ? WS_END0 : WS_YEND;
static_assert(WS_END <= 2147483648ull, "workspace map exceeds the guaranteed 2 GiB");
constexpr int CW_BAR = 4096;
constexpr int CW_CNT = 16384;
constexpr int CW_QCONV = 26624, CW_QB = 26688, CW_QA = 26752;
constexpr int CW_SS1 = 32768, CW_SS2 = 40960;
constexpr int CW_TICKET = 24576;

constexpr int LDS_BYTES = 163840;
constexpr int LDS_MISC = LDS_BYTES - 64;

__device__ __forceinline__ unsigned f2bf(float f) { unsigned u = __builtin_bit_cast(unsigned, f); return (u + 0x7fffu + ((u >> 16) & 1u)) >> 16; }
__device__ __forceinline__ float ldf(const float* p) { return *p; }
__device__ __forceinline__ float ldf(const bf16_t* p) { return __uint_as_float(((unsigned)*p) << 16); }
__device__ __forceinline__ void stf(float* p, float v) { *p = v; }
__device__ __forceinline__ void stf(bf16_t* p, float v) { *p = (bf16_t)f2bf(v); }
__device__ __forceinline__ float wave_sum(float v) {
#pragma unroll
    for (int o = 1; o < 64; o <<= 1) v += __shfl_xor(v, o);
    return v;
}

#define XB_TMO      128
#define XB_XCNT(j)  (256  + 64 * (j))
#define XB_XSUB(j)  (1280 + 64 * (j))
#define XB_XGEN(j)  (2304 + 64 * (j))
#define XB_TOP      3328
#define XB_TOPGEN   3392
#define XCD_BAR_WORDS 3456
#define XB_SPIN_CAP (1u << 18)
__device__ __forceinline__ unsigned xb_ld(unsigned* p)              { return __hip_atomic_load(p, __ATOMIC_RELAXED, __HIP_MEMORY_SCOPE_AGENT); }
__device__ __forceinline__ unsigned xb_add(unsigned* p, unsigned v) { return __hip_atomic_fetch_add(p, v, __ATOMIC_RELAXED, __HIP_MEMORY_SCOPE_AGENT); }
__device__ __forceinline__ unsigned xb_xcc_id() { return (unsigned)__builtin_amdgcn_s_getreg((3 << 11) | 20) & 0xFu; }
#define XB_SPIN(cond, bar) do { unsigned _sp = 0; while (cond) { __builtin_amdgcn_s_sleep(1); \
    if ((++_sp & 255u) == 0u) { if (xb_ld(&(bar)[XB_TMO])) break; if (_sp > XB_SPIN_CAP) { atomicAdd(&(bar)[XB_TMO], 1u); break; } } } } while (0)
struct XcdBarrier { unsigned* bar; unsigned x; volatile LAS unsigned* st; };
__device__ __forceinline__ XcdBarrier xcd_barrier_post(unsigned* bar, volatile LAS unsigned* st) {
    XcdBarrier b; b.bar = bar; b.x = xb_xcc_id(); b.st = st;
    if (threadIdx.x == 0) (void)xb_add(&bar[XB_XCNT(b.x)], 1u);
    return b;
}
__device__ __forceinline__ void xcd_barrier_complete(unsigned* bar, unsigned x, unsigned& nloc, unsigned& nx) {
    const unsigned G = gridDim.x * gridDim.y * gridDim.z;
    unsigned sum, cnt, mine, sp = 0u;
    for (;;) {
        sum = 0u; cnt = 0u; mine = 0u;
#pragma unroll
        for (unsigned j = 0; j < 16; ++j) { const unsigned c = xb_ld(&bar[XB_XCNT(j)]); sum += c; cnt += (c > 0u) ? 1u : 0u; mine = (j == x) ? c : mine; }
        if (sum == G) break;
        __builtin_amdgcn_s_sleep(1);
        if ((++sp & 255u) == 0u) { if (xb_ld(&bar[XB_TMO])) break; if (sp > XB_SPIN_CAP) { atomicAdd(&bar[XB_TMO], 1u); break; } }
    }
    nloc = mine > 0u ? mine : 1u; nx = cnt > 0u ? cnt : 1u;
}
__device__ __forceinline__ void xcd_barrier(const XcdBarrier& b) {
    asm volatile("s_waitcnt vmcnt(0)" ::: "memory");
    __syncthreads();
    if (threadIdx.x == 0) {
        unsigned* bar = b.bar;
        __builtin_amdgcn_s_waitcnt(0);
        unsigned nloc = b.st[0], nx = b.st[1];
        if (nloc == 0u) { xcd_barrier_complete(bar, b.x, nloc, nx); b.st[0] = nloc; b.st[1] = nx; }
        const unsigned old = xb_add(&bar[XB_XSUB(b.x)], 1u);
        const unsigned gen = old / nloc;
        if (old + 1u == (gen + 1u) * nloc) {
            __builtin_amdgcn_fence(__ATOMIC_RELEASE, "agent");
            asm volatile("s_waitcnt vmcnt(0)" ::: "memory");
            const unsigned og = xb_add(&bar[XB_TOP], 1u);
            const unsigned tg = og / nx;
            if (og + 1u == (tg + 1u) * nx) xb_add(&bar[XB_TOPGEN], 1u);
            else XB_SPIN(xb_ld(&bar[XB_TOPGEN]) == tg, bar);
            __builtin_amdgcn_fence(__ATOMIC_ACQUIRE, "agent");
            xb_add(&bar[XB_XGEN(b.x)], 1u);
            asm volatile("s_waitcnt vmcnt(0)" ::: "memory");
        } else {
            XB_SPIN(xb_ld(&bar[XB_XGEN(b.x)]) == gen, bar);
            __builtin_amdgcn_fence(__ATOMIC_ACQUIRE, "agent");
            asm volatile("s_waitcnt vmcnt(0)" ::: "memory");
        }
    }
    __syncthreads();
}

struct Params {
    const float* in[31];
    float* out;
    unsigned char* ws;
    int ph_lo, ph_hi, var, pad;
};
enum { I_X = 0, I_MEM, I_POS, I_GMIX, I_WIN, I_GQA, I_GKA, I_RELB, I_GCQ, I_WUQ, I_GCKV, I_WUKV, I_GQB, I_GKB, I_WO, I_GCROSS, I_GMEM, I_WXQ, I_WXKV,
       I_GQX, I_GKX, I_WXO, I_GFFN, I_WROUTER, I_RBIAS, I_WSHG, I_WSHU, I_WSHD, I_WEXG, I_WEXU, I_WEXD };

template <class OT>
__device__ __forceinline__ void rms_row_4096(const float* x, const float* g, OT* o, int lane, float* keep  ) {
    f32x4 v[16]; float s = 0.f;
#pragma unroll
    for (int j = 0; j < 16; ++j) { v[j] = ((const f32x4*)x)[lane + 64 * j]; s += v[j].x * v[j].x + v[j].y * v[j].y + v[j].z * v[j].z + v[j].w * v[j].w; }
    s = wave_sum(s);
    const float r = 1.0f / sqrtf(s * (1.0f / 4096.f) + EPS);
#pragma unroll
    for (int j = 0; j < 16; ++j) v[j] = v[j] * r * __builtin_nontemporal_load((const f32x4*)g + lane + 64 * j);
    asm volatile("s_waitcnt vmcnt(0)" ::: "memory");
#pragma unroll
    for (int j = 0; j < 16; ++j) {
        const f32x4 y = v[j];
        const int c = (lane + 64 * j) * 4;
        stf(o + c, y.x); stf(o + c + 1, y.y); stf(o + c + 2, y.z); stf(o + c + 3, y.w);
        if (keep) { keep[c] = y.x; keep[c + 1] = y.y; keep[c + 2] = y.z; keep[c + 3] = y.w; }
    }
}
template <int N>
__device__ __forceinline__ void rms_inplace(act_t* p, const float* g, int lane) {
    float v[N / 64]; float s = 0.f;
#pragma unroll
    for (int j = 0; j < N / 64; ++j) { v[j] = ldf(p + lane + 64 * j); s += v[j] * v[j]; }
    s = wave_sum(s);
    const float r = 1.0f / sqrtf(s * (1.0f / N) + EPS);
#pragma unroll
    for (int j = 0; j < N / 64; ++j) stf(p + lane + 64 * j, v[j] * r * g[lane + 64 * j]);
}
__device__ __forceinline__ void rms_rope64_inplace(act_t* p, const float* g, int pos, int lane) {
    float v = ldf(p + lane);
    float s = wave_sum(v * v);
    const float r = 1.0f / sqrtf(s * (1.0f / 64.f) + EPS);
    v = v * r * g[lane];
    const int fi = lane & 31;
    const float inv_freq = powf(10000.0f, -(float)(2 * fi) / 64.0f);
    const float ang = (float)pos * inv_freq;
    float sn, cs; sincosf(ang, &sn, &cs);
    const float other = __shfl_xor(v, 32);
    const float y = (lane < 32) ? (v * cs - other * sn) : (v * cs + other * sn);
    stf(p + lane, y);
}

template <class AT, class BCol, class Epi>
__device__ __forceinline__ void ngemm_tile(float* lds, const AT* A, long lda, const int* rowlist, int row0, int nrows, int K, const BCol& bcol, const Epi& epi) {
    const int tid = threadIdx.x, tx = tid & 31, ty = tid >> 5;
    float* As = lds; float* Bs = lds + 16 * 132;
    const int arow = tid >> 2, akq = (tid & 3) * 4;
    int grow; { const int rr = (arow < nrows) ? arow : 0; grow = rowlist ? rowlist[row0 + rr] : (row0 + rr); }
    const AT* Ap = A + (long)grow * lda + akq;
    const int bj = tid & 127, bk = tid >> 7;
    const float* Bp = bcol(bj) + (long)bk * bcol.ldb;
    float acc[8][4];
#pragma unroll
    for (int i = 0; i < 8; ++i)
#pragma unroll
        for (int j = 0; j < 4; ++j) acc[i][j] = 0.f;
    for (int k0 = 0; k0 < K; k0 += 16) {
        float a0 = ldf(Ap + k0), a1 = ldf(Ap + k0 + 1), a2 = ldf(Ap + k0 + 2), a3 = ldf(Ap + k0 + 3);
        float b0 = Bp[(long)(k0) * bcol.ldb], b1 = Bp[(long)(k0 + 4) * bcol.ldb], b2 = Bp[(long)(k0 + 8) * bcol.ldb], b3 = Bp[(long)(k0 + 12) * bcol.ldb];
        __syncthreads();
        As[(akq + 0) * 132 + arow] = a0; As[(akq + 1) * 132 + arow] = a1; As[(akq + 2) * 132 + arow] = a2; As[(akq + 3) * 132 + arow] = a3;
        Bs[(bk + 0) * 132 + bj] = b0; Bs[(bk + 4) * 132 + bj] = b1; Bs[(bk + 8) * 132 + bj] = b2; Bs[(bk + 12) * 132 + bj] = b3;
        __syncthreads();
#pragma unroll
        for (int kk = 0; kk < 16; ++kk) {
            const f32x4 al = *(const f32x4*)(As + kk * 132 + ty * 8), ah = *(const f32x4*)(As + kk * 132 + ty * 8 + 4);
            const f32x4 b = *(const f32x4*)(Bs + kk * 132 + tx * 4);
            const float a[8] = {al.x, al.y, al.z, al.w, ah.x, ah.y, ah.z, ah.w};
#pragma unroll
            for (int i = 0; i < 8; ++i) { acc[i][0] += a[i] * b.x; acc[i][1] += a[i] * b.y; acc[i][2] += a[i] * b.z; acc[i][3] += a[i] * b.w; }
        }
    }
    __syncthreads();
#pragma unroll
    for (int i = 0; i < 8; ++i) { const int r = ty * 8 + i; if (r < nrows) epi(r, tx * 4, acc[i]); }
}
struct BGU { const float* Wg; const float* Wu; int ldb; int ff0; __device__ __forceinline__ const float* operator()(int j) const { const int ff = ff0 + (j >> 2) * 2 + (j & 1); const uintptr_t a = (uintptr_t)Wg, b = (uintptr_t)Wu; return (const float*)((j & 2) ? b : a) + ff; } };
struct BPlain { const float* B; int ldb; int col0, ncols; __device__ __forceinline__ const float* operator()(int j) const { const int c = col0 + j; return B + (c < ncols ? c : 0); } };

template <int DQK, class KeyTile, class Bias>
__device__ __forceinline__ void nattn_unit(float* lds, const act_t* Q, long ldq, const act_t* K1, long ldk1, const act_t* K2, long ldk2, const act_t* V, long ldv,
                                           int ntiles, const KeyTile& keytile, float scale, const Bias& bias, act_t* O, long ldo) {
    constexpr int QS = DQK + 4;
    float* Qs = lds; float* Ks = Qs + 64 * QS; float* Vs = Ks + 64 * QS; float* Ss = Vs + 64 * 132;
    const int tid = threadIdx.x, r = tid >> 3, s = tid & 7;
    __syncthreads();
    for (int idx = tid; idx < 64 * DQK; idx += 512) { const int row = idx / DQK, d = idx % DQK; Qs[row * QS + d] = ldf(Q + (long)row * ldq + d); }
    float m = -INFINITY, l = 0.f; float o[16];
#pragma unroll
    for (int d = 0; d < 16; ++d) o[d] = 0.f;
    for (int t = 0; t < ntiles; ++t) {
        const int k0 = keytile(t);
        __syncthreads();
        for (int idx = tid; idx < 64 * 128; idx += 512) { const int row = idx >> 7, d = idx & 127;
            Ks[row * QS + d] = ldf(K1 + (long)(k0 + row) * ldk1 + d); Vs[row * 132 + d] = ldf(V + (long)(k0 + row) * ldv + d); }
        if (DQK > 128) for (int idx = tid; idx < 64 * (DQK - 128); idx += 512) { const int row = idx / (DQK - 128), d = idx % (DQK - 128);
            Ks[row * QS + 128 + d] = ldf(K2 + (long)(k0 + row) * ldk2 + d); }
        __syncthreads();
#pragma unroll
        for (int jj = 0; jj < 8; ++jj) { const int key = s + 8 * jj; float dot = 0.f;
#pragma unroll 8
            for (int d = 0; d < DQK; d += 4) { const f32x4 q = *(const f32x4*)(Qs + r * QS + d), k = *(const f32x4*)(Ks + key * QS + d); dot += q.x * k.x + q.y * k.y + q.z * k.z + q.w * k.w; }
            Ss[r * 65 + key] = dot * scale + bias(r, t, key); }
        __syncthreads();
        float mt = -INFINITY;
        for (int k = 0; k < 64; ++k) mt = fmaxf(mt, Ss[r * 65 + k]);
        const float mn = fmaxf(m, mt), alpha = expf(m - mn);
        float ladd = 0.f;
#pragma unroll
        for (int d = 0; d < 16; ++d) o[d] *= alpha;
        for (int k = 0; k < 64; ++k) { const float pk = expf(Ss[r * 65 + k] - mn); ladd += pk;
#pragma unroll
            for (int d = 0; d < 16; d += 4) { const f32x4 v = *(const f32x4*)(Vs + k * 132 + s * 16 + d); o[d] += pk * v.x; o[d + 1] += pk * v.y; o[d + 2] += pk * v.z; o[d + 3] += pk * v.w; } }
        m = mn; l = l * alpha + ladd;
    }
    const float il = 1.0f / l;
#pragma unroll
    for (int d = 0; d < 16; ++d) stf(O + (long)r * ldo + s * 16 + d, o[d] * il);
}

struct MoeTab { int* cnt; int* mtp; int* offh; };
__device__ __forceinline__ MoeTab moe_tables(int* tab, const unsigned* gcnt, int tile_m) {
    MoeTab T; T.cnt = tab; T.mtp = tab + 80; T.offh = tab + 160;
    __syncthreads();
    if (threadIdx.x == 0) {
        int pm = 0, po = 0;
        for (int e = 0; e <= NE; ++e) { const int c = (e < NE) ? (int)gcnt[e] : NTOK; T.cnt[e] = c; T.mtp[e] = pm; T.offh[e] = po; pm += (c + tile_m - 1) / tile_m; po += c; }
        T.mtp[NE + 1] = pm;
    }
    __syncthreads();
    return T;
}

namespace fg {
constexpr int BM = 256, BK = 64, HALF = 128, HTB = HALF * BK * 2, STAGE_BYTES = 8 * HTB;
__device__ __forceinline__ int lds_byte(int r, int c) { const int st = (r >> 4) * 2 + (c >> 5), rr = r & 15, cc = c & 31, ob = rr * 64 + cc * 2; return st * 1024 + (ob ^ (((ob >> 9) & 1) << 5)); }
__device__ __forceinline__ void stage_rc(int b, int& R, int& C) { const int st = b / 1024, sb = b % 1024, swz = sb ^ (((sb >> 9) & 1) << 5); R = (st >> 1) * 16 + swz / 64; C = (st & 1) * 32 + (swz % 64) / 2; }
__device__ __forceinline__ int perm32(int rho) { const int n = rho >> 4, i = rho & 15; return 8 * (i >> 2) + 4 * n + (i & 3); }
__device__ __forceinline__ unsigned cvt_pk_bf16(float lo, float hi) { unsigned r; asm volatile("v_cvt_pk_bf16_f32 %0, %1, %2" : "=v"(r) : "v"(lo), "v"(hi)); return r; }

__device__ __forceinline__ unsigned pk4_fp8(float a, float b, float c, float d) { int w = 0; w = __builtin_amdgcn_cvt_pk_fp8_f32(a, b, w, false); w = __builtin_amdgcn_cvt_pk_fp8_f32(c, d, w, true); return (unsigned)w; }
constexpr float H_SCALE = 4.0f, WD_SCALE = 32.0f, WGU_SCALE = 64.0f, T_SCALE = 2.0f, Y_SCALE = 16.0f;
struct Unit { const char* A; const char* B; const int* rows; int nkt, nvalid, pm, pn, e, arow0; };

template <class Epi, class Sched, bool GATHER, bool FP8 = false, bool SP2 = false>
__device__ __forceinline__ void gemm_phase(LAS unsigned char* lds, const Sched& S, const Epi& E, const int lda, const int ldb, const int var_in = 0) {
#ifdef PROBE_PH
    const int var = var_in;
#else
    constexpr int var = 0; (void)var_in;
#endif
    int tid = threadIdx.x; asm volatile("" : "+v"(tid));
    const int wid = __builtin_amdgcn_readfirstlane(tid >> 6), lane = tid & 63, wr = wid >> 2, wc = wid & 3, fr = lane & 15, fq = lane >> 4;
    unsigned voffB[2][2], voffA[2][2];
#pragma unroll
    for (int i = 0; i < 2; ++i) { int sR, sC; stage_rc(tid * 16 + i * 8192, sR, sC);
#pragma unroll
        for (int hb = 0; hb < 2; ++hb) { int Rb;
            if (Epi::PERM == 2) Rb = 64 * (sR >> 5) + 16 * ((sR >> 2) & 3) + 8 * hb + 4 * ((sR >> 4) & 1) + (sR & 3);
            else Rb = 128 * hb + (Epi::PERM == 1 ? ((sR & ~31) + perm32(sR & 31)) : sR);
            voffB[hb][i] = (unsigned)((Rb >> 6) * ldb * 64 + (Rb & 63) * 64 + sC) * 2u; }
#pragma unroll
        for (int h = 0; h < 2; ++h) voffA[h][i] = (unsigned)((sR + HALF * h) * lda + sC) * 2u; }
    const size_t kstep = (size_t)(BK * 2), kstepB = 8192;
    const unsigned ldsw = (unsigned)wid * 1024u;
    const int aoff = FP8 ? lds_byte(wr * 64 + fr, fq * 16) : lds_byte(wr * 64 + fr, fq * 8), boff = FP8 ? lds_byte(wc * 32 + fr, fq * 16) : lds_byte(wc * 32 + fr, fq * 8);
#define FG_SA(b, h) (((b) * 2 + (h)) * HTB)
#define FG_SB(b, h) ((4 + (b) * 2 + (h)) * HTB)
#define FG_STAGE2(bufoff, gbase, v0, v1) do { \
        __builtin_amdgcn_global_load_lds((const unsigned*)((const char*)(gbase) + (v0)), (LAS unsigned*)(lds + (bufoff) + ldsw), 16, 0, 0); \
        __builtin_amdgcn_global_load_lds((const unsigned*)((const char*)(gbase) + (v1)), (LAS unsigned*)(lds + (bufoff) + ldsw + 8192), 16, 0, 0); } while (0)
#define FG_STAGEB(bufoff, gbase, hb) FG_STAGE2(bufoff, gbase, voffB[hb][0], voffB[hb][1])
#define FG_STAGEA(bufoff, gbase, h) FG_STAGE2(bufoff, gbase, voffA[h][0], voffA[h][1])
#define FG_LD8(base_) __builtin_shufflevector(*(const LAS v4i_t*)(base_), *(const LAS v4i_t*)((base_) + 16), 0, 1, 2, 3, 4, 5, 6, 7)
#define FG_LDA(dst, b, h) do { if (FP8) { _Pragma("unroll") for (int m = 0; m < 4; ++m) dst##8[m] = FG_LD8(lds + FG_SA(b, h) + aoff + m * 2048); } \
      else { _Pragma("unroll") for (int m = 0; m < 4; ++m) _Pragma("unroll") for (int k = 0; k < 2; ++k) dst[m][k] = *(const LAS bf16x8*)(lds + FG_SA(b, h) + aoff + m * 2048 + k * 1024); } } while (0)
#define FG_LDB(dst, b, h) do { if (FP8) { _Pragma("unroll") for (int n = 0; n < 2; ++n) dst##8[n] = FG_LD8(lds + FG_SB(b, h) + boff + n * 2048); } \
      else { _Pragma("unroll") for (int n = 0; n < 2; ++n) _Pragma("unroll") for (int k = 0; k < 2; ++k) dst[n][k] = *(const LAS bf16x8*)(lds + FG_SB(b, h) + boff + n * 2048 + k * 1024); } } while (0)
#define FG_MMA(ai, bj, At, Bt) do { __builtin_amdgcn_s_setprio(1); if (FP8) { _Pragma("unroll") for (int m = 0; m < 4; ++m) _Pragma("unroll") for (int n = 0; n < 2; ++n) \
        asm volatile("v_mfma_scale_f32_16x16x128_f8f6f4 %0, %1, %2, %0, %3, %3 op_sel_hi:[0,0,0]" : "+v"(acc[ai][bj][m][n]) : "v"(Bt##8[n]), "v"(At##8[m]), "v"(sc127)); } \
      else { _Pragma("unroll") for (int m = 0; m < 4; ++m) _Pragma("unroll") for (int n = 0; n < 2; ++n) _Pragma("unroll") for (int k = 0; k < 2; ++k) \
        acc[ai][bj][m][n] = __builtin_amdgcn_mfma_f32_16x16x32_bf16(Bt[n][k], At[m][k], acc[ai][bj][m][n], 0, 0, 0); } __builtin_amdgcn_s_setprio(0); } while (0)
#define FG_WAIT_V(n) asm volatile("s_waitcnt vmcnt(" #n ")" ::: "memory")
#define FG_WAIT_L(n) asm volatile("s_waitcnt lgkmcnt(" #n ")" ::: "memory")
#define FG_BAR __builtin_amdgcn_s_barrier()
#define FG_SCHED __builtin_amdgcn_sched_barrier(0)
#define FG_GATHER(dst, u) do { if (GATHER) { int tz = threadIdx.x; asm volatile("" : "+v"(tz)); _Pragma("unroll") for (int i = 0; i < 2; ++i) { int sR, sC; stage_rc(tz * 16 + i * 8192, sR, sC); \
        _Pragma("unroll") for (int h = 0; h < 2; ++h) { int rr = sR + HALF * h; rr = rr < (u).nvalid ? rr : 0; const int tok = (u).rows ? (u).rows[rr] : ((u).arow0 + rr); dst[h][i] = (unsigned)(tok * lda + sC) * 2u; } } } } while (0)
    Unit cur, nxt; int ui = 0;
    if (!S.next(0, cur)) return;
    f32x4 acc[2][2][4][2];
#pragma unroll
    for (int a = 0; a < 2; ++a)
#pragma unroll
        for (int b = 0; b < 2; ++b)
#pragma unroll
            for (int m = 0; m < 4; ++m)
#pragma unroll
                for (int n = 0; n < 2; ++n) acc[a][b][m][n] = (f32x4){0.f, 0.f, 0.f, 0.f};
    const int sc127 = 127;
    bf16x8 At[4][2], B0[2][2], B1[2][2]; v8i_t At8[4], B08[2], B18[2];
    const char* cA = cur.A; const char* cB = cur.B;
    typename Epi::Pre pre; E.prefetch(pre, cur, wr, fr);
    FG_GATHER(voffA, cur);
    if (SP2) {
    FG_STAGEB(FG_SB(0, 0), cB, 0); FG_STAGEB(FG_SB(0, 1), cB, 1); FG_STAGEA(FG_SA(0, 0), cA, 0); FG_STAGEA(FG_SA(0, 1), cA, 1);
    if (wr == 1) FG_BAR;
    FG_WAIT_V(2); FG_BAR;
    FG_STAGEB(FG_SB(1, 0), cB + kstepB, 0); FG_STAGEA(FG_SA(1, 0), cA + kstep, 0); FG_STAGEB(FG_SB(1, 1), cB + kstepB, 1);
    FG_WAIT_V(6); FG_BAR;
    } else {
    FG_STAGEB(FG_SB(0, 0), cB, 0); FG_STAGEA(FG_SA(0, 0), cA, 0); FG_STAGEB(FG_SB(0, 1), cB, 1); FG_STAGEA(FG_SA(0, 1), cA, 1);
    if (wr == 1) FG_BAR;
    FG_WAIT_V(4); FG_BAR;
    FG_STAGEB(FG_SB(1, 0), cB + kstepB, 0); FG_STAGEA(FG_SA(1, 0), cA + kstep, 0); FG_STAGEB(FG_SB(1, 1), cB + kstepB, 1);
    FG_WAIT_V(6); FG_BAR;
    }
    for (;;) {
        const bool has_next = S.next(ui + 1, nxt);
        const char* nA = has_next ? nxt.A : cA; const char* nB = has_next ? nxt.B : cB;
        const int nt = cur.nkt;
#pragma unroll 1
        for (int t = 0; t < nt; t += 2) {
            const bool last = (t == nt - 2);
            const char* a1 = cA + (size_t)(t + 1) * kstep;
            const char* a2 = last ? nA : cA + (size_t)(t + 2) * kstep; const char* b2 = last ? nB : cB + (size_t)(t + 2) * kstepB;
            const char* a3 = a2 + kstep; const char* b3 = b2 + kstepB;
            if (SP2) {
            FG_LDB(B0, 0, 0); FG_LDB(B1, 0, 1); FG_SCHED; FG_LDA(At, 0, 0); FG_STAGEA(FG_SA(1, 1), a1, 1);
            if (GATHER && last && has_next) { FG_GATHER(voffA, nxt); }
            FG_WAIT_V(8); FG_WAIT_L(0); FG_BAR; FG_MMA(0, 0, At, B0); FG_MMA(0, 1, At, B1); FG_BAR; FG_SCHED;
            FG_LDA(At, 0, 1); FG_STAGEB(FG_SB(0, 0), b2, 0); FG_STAGEB(FG_SB(0, 1), b2, 1); FG_STAGEA(FG_SA(0, 0), a2, 0);
            FG_WAIT_V(8); FG_WAIT_L(0); FG_BAR; FG_MMA(1, 0, At, B0); FG_MMA(1, 1, At, B1); FG_BAR; FG_SCHED;
            FG_LDB(B0, 1, 0); FG_LDB(B1, 1, 1); FG_SCHED; FG_LDA(At, 1, 0); FG_STAGEA(FG_SA(0, 1), a2, 1);
            FG_WAIT_V(8); FG_WAIT_L(0); FG_BAR; FG_MMA(0, 0, At, B0); FG_MMA(0, 1, At, B1); FG_BAR; FG_SCHED;
            FG_LDA(At, 1, 1); FG_STAGEB(FG_SB(1, 0), b3, 0); FG_STAGEB(FG_SB(1, 1), b3, 1); FG_STAGEA(FG_SA(1, 0), a3, 0);
            FG_WAIT_V(8); FG_WAIT_L(0); FG_BAR; FG_MMA(1, 0, At, B0); FG_MMA(1, 1, At, B1); FG_BAR; FG_SCHED;
            } else {
            FG_LDB(B0, 0, 0); FG_SCHED; FG_LDA(At, 0, 0); FG_STAGEA(FG_SA(1, 1), a1, 1);
            if (GATHER && last && has_next) { FG_GATHER(voffA, nxt); }
            FG_WAIT_L(8); FG_BAR; FG_WAIT_L(0); if (var < 4) FG_MMA(0, 0, At, B0); FG_BAR; FG_SCHED;
            FG_LDB(B1, 0, 1); FG_STAGEB(FG_SB(0, 0), b2, 0);
            FG_BAR; FG_WAIT_L(0); if (var < 3) FG_MMA(0, 1, At, B1); FG_BAR;
            FG_LDA(At, 0, 1); FG_STAGEA(FG_SA(0, 0), a2, 0);
            FG_BAR; FG_WAIT_L(0); if (var < 4) FG_MMA(1, 0, At, B0); FG_BAR; FG_SCHED;
            FG_STAGEB(FG_SB(0, 1), b2, 1);
            FG_WAIT_V(6); FG_BAR; if (var < 3) FG_MMA(1, 1, At, B1); FG_BAR;
            FG_LDB(B0, 1, 0); FG_SCHED; FG_LDA(At, 1, 0); FG_STAGEA(FG_SA(0, 1), a2, 1);
            FG_WAIT_L(8); FG_BAR; FG_WAIT_L(0); if (var < 4) FG_MMA(0, 0, At, B0); FG_BAR; FG_SCHED;
            FG_LDB(B1, 1, 1); FG_STAGEB(FG_SB(1, 0), b3, 0);
            FG_BAR; FG_WAIT_L(0); if (var < 3) FG_MMA(0, 1, At, B1); FG_BAR;
            FG_LDA(At, 1, 1); FG_STAGEA(FG_SA(1, 0), a3, 0);
            FG_BAR; FG_WAIT_L(0); if (var < 4) FG_MMA(1, 0, At, B0); FG_BAR; FG_SCHED;
            FG_STAGEB(FG_SB(1, 1), b3, 1);
            FG_WAIT_V(6); FG_BAR; if (var < 3) FG_MMA(1, 1, At, B1); FG_BAR;
                    }
}
        if (SP2) { if (wr == 0) FG_BAR; }
        { int tz = threadIdx.x; asm volatile("" : "+v"(tz));
          const int wz = __builtin_amdgcn_readfirstlane(tz >> 6), lz = tz & 63; if (var != 2 && var != 9) E(acc, cur, wz >> 2, wz & 3, lz & 15, lz >> 4, pre); }
        if (!has_next) break;
#pragma unroll
        for (int a = 0; a < 2; ++a)
#pragma unroll
            for (int b = 0; b < 2; ++b)
#pragma unroll
                for (int m = 0; m < 4; ++m)
#pragma unroll
                    for (int n = 0; n < 2; ++n) acc[a][b][m][n] = (f32x4){0.f, 0.f, 0.f, 0.f};
        cur = nxt; cA = nA; cB = nB; ++ui;
        { int tz = threadIdx.x; asm volatile("" : "+v"(tz)); E.prefetch(pre, cur, __builtin_amdgcn_readfirstlane(tz >> 6) >> 2, tz & 15); }
        if (SP2) { if (wr == 1) FG_BAR; }
    }
    FG_WAIT_V(0);
    if (!SP2) { if (wr == 0) FG_BAR; }
    FG_BAR;
#undef FG_SA
#undef FG_SB
#undef FG_STAGE2
#undef FG_STAGEB
#undef FG_STAGEA
#undef FG_STAGEAX
#undef FG_LDA
#undef FG_LDB
#undef FG_MMA
#undef FG_LD8
#undef FG_WAIT_V
#undef FG_WAIT_L
#undef FG_BAR
#undef FG_SCHED
#undef FG_GATHER
}

struct DenseSched {
    const char* A; const char* B; int lda, ldb, nM, nN, nS, nkt, G, c, first;
    __device__ __forceinline__ bool next(int i, Unit& u) const {
        const int total = nM * nN * nS; const int per = (total + 7) / 8;
        int L;
        if (first == 1) {
            const int x = c & 7, r = c >> 3; if (r >= 16) { if (i >= 3) return false; L = x * 64 + (r - 16) * 3 + i; } else { if (i >= 1) return false; L = x * 64 + 48 + r; }
        } else {
        const int j = i * G + c; const int x = j & 7, q = j >> 3;
        if (q >= per) return false; L = x * per + q; if (L >= total) return false; }
        const int ks = L % nS, t2 = L / nS;
        const int nig = 8 * nN, gid = t2 / nig, fm = gid * 8, gsz = (nM - fm) < 8 ? (nM - fm) : 8;
        const int pm = fm + (t2 % nig) % gsz, pn = (t2 % nig) / gsz;
        u.A = A + ((size_t)pm * BM * lda + (size_t)ks * nkt * BK) * 2; u.B = B + ((size_t)pn * BM * ldb + (size_t)ks * nkt * 4096) * 2;
        if (first == 2) { u.A = A; u.B = B; }
        u.rows = nullptr; u.nkt = nkt; u.nvalid = BM; u.pm = pm; u.pn = pn; u.e = ks; u.arow0 = pm * BM; return true;
    }
};
struct NoPre {};
struct EpiBf16 {
    static constexpr int PERM = 1; typedef NoPre Pre; __device__ __forceinline__ void prefetch(Pre&, const Unit&, int, int) const {}
    bf16_t* O; int ldc, ncols; float scale;
    __device__ __forceinline__ void operator()(const f32x4 (&acc)[2][2][4][2], const Unit& u, int wr, int wc, int fr, int fq, const Pre& pre) const {
        const int row0 = u.pm * BM + wr * 64 + fr, col0 = u.pn * BM + wc * 32 + 8 * fq;
#pragma unroll
        for (int ai = 0; ai < 2; ++ai)
#pragma unroll
            for (int m = 0; m < 4; ++m) { bf16_t* rowp = O + (size_t)(row0 + ai * HALF + m * 16) * ldc + col0;
#pragma unroll
                for (int bj = 0; bj < 2; ++bj) { const f32x4 v0 = acc[ai][bj][m][0] * scale, v1 = acc[ai][bj][m][1] * scale;
                    u32x4 w; w.x = cvt_pk_bf16(v0[0], v0[1]); w.y = cvt_pk_bf16(v0[2], v0[3]); w.z = cvt_pk_bf16(v1[0], v1[1]); w.w = cvt_pk_bf16(v1[2], v1[3]);
                    if (col0 + bj * HALF + 8 <= ncols) *(u32x4*)(rowp + bj * HALF) = w; } }
    }
};
struct EpiBf16N {
    static constexpr int PERM = 1; typedef NoPre Pre; __device__ __forceinline__ void prefetch(Pre&, const Unit&, int, int) const {}
    bf16_t* O; int ldc, ncols; float scale;
    const float* gA; int pnA_end; const float* gB; int pnB_end; int half0_only; LAS float* part;
    __device__ __forceinline__ void operator()(const f32x4 (&acc)[2][2][4][2], const Unit& u, int wr, int wc, int fr, int fq, const Pre& pre) const {
        const int rt0 = wr * 64 + fr, row0 = u.pm * BM + rt0, col0 = u.pn * BM + wc * 32 + 8 * fq;
        const bool do_norm = u.pn < pnB_end;
        if (do_norm) {
#pragma unroll
            for (int ai = 0; ai < 2; ++ai)
#pragma unroll
                for (int m = 0; m < 4; ++m)
#pragma unroll
                    for (int bj = 0; bj < 2; ++bj) { if (half0_only && bj == 1) continue;
                        const f32x4 v0 = acc[ai][bj][m][0] * scale, v1 = acc[ai][bj][m][1] * scale;
                        float ss = (v0.x * v0.x + v0.y * v0.y) + (v0.z * v0.z + v0.w * v0.w) + (v1.x * v1.x + v1.y * v1.y) + (v1.z * v1.z + v1.w * v1.w);
                        ss += __shfl_xor(ss, 16); ss += __shfl_xor(ss, 32);
                        if (fq == 0) part[((rt0 + ai * HALF + m * 16) * 2 + bj) * 4 + wc] = ss; }
            asm volatile("s_waitcnt lgkmcnt(0)" ::: "memory"); __builtin_amdgcn_s_barrier(); asm volatile("" ::: "memory");
        }
        const float* g = (u.pn < pnA_end) ? gA : gB;
        f32x4 g0 = (f32x4){1.f, 1.f, 1.f, 1.f}, g1 = g0;
        if (do_norm) { g0 = *(const f32x4*)(g + wc * 32 + 8 * fq); g1 = *(const f32x4*)(g + wc * 32 + 8 * fq + 4); }
#pragma unroll
        for (int ai = 0; ai < 2; ++ai)
#pragma unroll
            for (int m = 0; m < 4; ++m) { const int rt = rt0 + ai * HALF + m * 16; bf16_t* rowp = O + (size_t)(row0 + ai * HALF + m * 16) * ldc + col0;
#pragma unroll
                for (int bj = 0; bj < 2; ++bj) { f32x4 v0 = acc[ai][bj][m][0] * scale, v1 = acc[ai][bj][m][1] * scale;
                    if (do_norm && !(half0_only && bj == 1)) { const f32x4 p4 = *(const LAS f32x4*)(part + (rt * 2 + bj) * 4);
                        const float r = 1.0f / sqrtf(((p4.x + p4.y) + (p4.z + p4.w)) * (1.0f / 128.f) + 1e-6f); v0 = v0 * r * g0; v1 = v1 * r * g1; }
                    u32x4 w; w.x = cvt_pk_bf16(v0[0], v0[1]); w.y = cvt_pk_bf16(v0[2], v0[3]); w.z = cvt_pk_bf16(v1[0], v1[1]); w.w = cvt_pk_bf16(v1[2], v1[3]);
                    if (col0 + bj * HALF + 8 <= ncols) *(u32x4*)(rowp + bj * HALF) = w; } }
    }
};
template <bool HAS_RES> struct EpiF32Res {
    static constexpr int PERM = 0; typedef NoPre Pre; __device__ __forceinline__ void prefetch(Pre&, const Unit&, int, int) const {}
    float* __restrict__ C; const float* __restrict__ res; int ldc; size_t slab; float scale;
    __device__ __forceinline__ void operator()(const f32x4 (&acc)[2][2][4][2], const Unit& u, int wr, int wc, int fr, int fq, const Pre& pre) const {
        const int row0 = u.pm * BM + wr * 64 + fr, col0 = u.pn * BM + wc * 32 + 4 * fq;
        float* __restrict__ Cb = C + (size_t)u.e * slab;
#pragma unroll
        for (int ai = 0; ai < 2; ++ai) {
            f32x4 r[4][2][2];
            if (HAS_RES) {
#pragma unroll
                for (int m = 0; m < 4; ++m) { const size_t o = (size_t)(row0 + ai * HALF + m * 16) * ldc + col0;
#pragma unroll
                    for (int bj = 0; bj < 2; ++bj)
#pragma unroll
                        for (int n = 0; n < 2; ++n) r[m][bj][n] = __builtin_nontemporal_load((const f32x4*)(res + o + bj * HALF + n * 16)); }
            }
#pragma unroll
            for (int m = 0; m < 4; ++m) { const size_t o = (size_t)(row0 + ai * HALF + m * 16) * ldc + col0;
#pragma unroll
                for (int bj = 0; bj < 2; ++bj)
#pragma unroll
                    for (int n = 0; n < 2; ++n) { f32x4 v = acc[ai][bj][m][n] * scale; if (HAS_RES) v = v + r[m][bj][n]; *(f32x4*)(Cb + o + bj * HALF + n * 16) = v; } }
        }
    }
};
struct MoeTabs { const LAS int* cnt; const LAS int* mtp; };
template <int PHASE  >
struct MoeSched {
    MoeTabs T; const char* A; const char* B; const int* rowtok; int G, c;
    __device__ __forceinline__ bool next(int i, Unit& u) const {
        constexpr int NT = (PHASE == 1) ? 4 : 16;
        const int nm = T.mtp[(PHASE == 1) ? 65 : 64], total = nm * NT, per = (total + 7) / 8;
        const int j = i * G + c, x = j & 7, q = j >> 3;
        if (q >= per) return false; const int L = x * per + q; if (L >= total) return false;
        int mti, pn;
        if (PHASE == 1) { mti = L / NT; pn = L % NT; }
        else { mti = L / NT; pn = 0; }
        int e = 0;
#pragma unroll 1
        for (int s2 = 32; s2 >= 1; s2 >>= 1) { if (e + s2 <= 64 && T.mtp[e + s2] <= mti) e += s2; }
        while (T.mtp[e + 1] <= mti) ++e;
        e = __builtin_amdgcn_readfirstlane(e);
        int mt = mti - T.mtp[e];
        if (PHASE == 2) {
            const int nme = T.mtp[e + 1] - T.mtp[e], r = L - T.mtp[e] * NT, ph = r / (nme * 8), r2 = r % (nme * 8);
            mt = r2 >> 3; pn = ph * 8 + (r2 & 7); mti = T.mtp[e] + mt; }
        int nv = T.cnt[e] - mt * 256; nv = nv < 256 ? nv : 256;
        u.nvalid = nv; u.pm = mti; u.pn = pn; u.e = e;
        if (PHASE == 1) { u.A = A; u.B = B + ((size_t)e * 1024 + (size_t)pn * 256) * DM; u.rows = (e < NE) ? rowtok + e * CAP + mt * 256 : nullptr; u.arow0 = mt * 256; u.nkt = DM / 128; }
        else { u.A = A + (size_t)mti * 256 * EFF; u.B = B + ((size_t)e * DM + (size_t)pn * 256) * EFF; u.rows = nullptr; u.arow0 = mt * 256; u.nkt = EFF / 128; }
        return true;
    }
};
struct EpiSwiglu {
    static constexpr int PERM = 1;
    struct Pre { float ssv[2][4]; };
    bf16_t* H; const float* ss;
    __device__ __forceinline__ void prefetch(Pre& pre, const Unit& u, int wr, int fr) const {
        const int r0 = wr * 64 + fr;
#pragma unroll
        for (int ai = 0; ai < 2; ++ai)
#pragma unroll
            for (int m = 0; m < 4; ++m) { int rr = r0 + ai * HALF + m * 16; rr = rr < u.nvalid ? rr : 0; const int tok = u.rows ? u.rows[rr] : (u.arow0 + rr); pre.ssv[ai][m] = ss[tok]; } }
    __device__ __forceinline__ void operator()(const f32x4 (&acc)[2][2][4][2], const Unit& u, int wr, int wc, int fr, int fq, const Pre& pre) const {
        const int r0 = wr * 64 + fr, col0 = u.pn * 128 + wc * 32 + 8 * fq;
#pragma unroll
        for (int ai = 0; ai < 2; ++ai)
#pragma unroll
            for (int m = 0; m < 4; ++m) { const int r = r0 + ai * HALF + m * 16;
                const float rs = pre.ssv[ai][m] * (1.0f / (T_SCALE * WGU_SCALE));
                float h[8];
#pragma unroll
                for (int n = 0; n < 2; ++n)
#pragma unroll
                    for (int j = 0; j < 4; ++j) { const float g = acc[ai][0][m][n][j] * rs, up = acc[ai][1][m][n][j] * rs; h[n * 4 + j] = g * __builtin_amdgcn_rcpf(1.0f + __expf(-g)) * up; }
                u32x2 w; w.x = pk4_fp8(h[0] * H_SCALE, h[1] * H_SCALE, h[2] * H_SCALE, h[3] * H_SCALE); w.y = pk4_fp8(h[4] * H_SCALE, h[5] * H_SCALE, h[6] * H_SCALE, h[7] * H_SCALE);
                if (r < u.nvalid) *(u32x2*)((unsigned char*)H + ((size_t)u.pm * 256 + r) * EFF + col0) = w; }
    }
};
struct EpiScatter {
    static constexpr int PERM = 2;
    struct Pre { int dst[2][4]; float gt[2][4]; };
    unsigned char* Y; const int* rowdst; const float* rowgate; const LAS int* mtp;
    __device__ __forceinline__ void prefetch(Pre& pre, const Unit& u, int wr, int fr) const {
        const int r0 = wr * 64 + fr, lbase = u.e * CAP + (u.pm - mtp[u.e]) * 256;
#pragma unroll
        for (int ai = 0; ai < 2; ++ai)
#pragma unroll
            for (int m = 0; m < 4; ++m) { const int r = r0 + ai * HALF + m * 16; const bool ok = r < u.nvalid; pre.dst[ai][m] = ok ? rowdst[lbase + r] : -1; pre.gt[ai][m] = ok ? rowgate[lbase + r] : 0.f; } }
    __device__ __forceinline__ void operator()(const f32x4 (&acc)[2][2][4][2], const Unit& u, int wr, int wc, int fr, int fq, const Pre& pre) const {
        const int col0 = u.pn * BM + wc * 64 + 16 * fq;
#pragma unroll
        for (int ai = 0; ai < 2; ++ai)
#pragma unroll
            for (int m = 0; m < 4; ++m) { if (pre.dst[ai][m] >= 0) { const float g = pre.gt[ai][m] * (Y_SCALE / (H_SCALE * WD_SCALE));
                const f32x4 v0 = acc[ai][0][m][0] * g, v1 = acc[ai][0][m][1] * g, v2 = acc[ai][1][m][0] * g, v3 = acc[ai][1][m][1] * g;
                u32x4 w; w.x = pk4_fp8(v0[0], v0[1], v0[2], v0[3]); w.y = pk4_fp8(v1[0], v1[1], v1[2], v1[3]); w.z = pk4_fp8(v2[0], v2[1], v2[2], v2[3]); w.w = pk4_fp8(v3[0], v3[1], v3[2], v3[3]);
                *(u32x4*)(Y + (size_t)pre.dst[ai][m] * DM + col0) = w; } }
    }
};
struct EpiShared {
    static constexpr int PERM = 2; typedef NoPre Pre; __device__ __forceinline__ void prefetch(Pre&, const Unit&, int, int) const {}
    unsigned char* Y9;
    __device__ __forceinline__ void operator()(const f32x4 (&acc)[2][2][4][2], const Unit& u, int wr, int wc, int fr, int fq, const Pre& pre) const {
        const int col0 = u.pn * BM + wc * 64 + 16 * fq; const float g = Y_SCALE / (H_SCALE * WD_SCALE);
#pragma unroll
        for (int ai = 0; ai < 2; ++ai)
#pragma unroll
            for (int m = 0; m < 4; ++m) { const int row = u.pm * BM + ai * HALF + wr * 64 + m * 16 + fr;
                const f32x4 v0 = acc[ai][0][m][0] * g, v1 = acc[ai][0][m][1] * g, v2 = acc[ai][1][m][0] * g, v3 = acc[ai][1][m][1] * g;
                u32x4 w; w.x = pk4_fp8(v0[0], v0[1], v0[2], v0[3]); w.y = pk4_fp8(v1[0], v1[1], v1[2], v1[3]); w.z = pk4_fp8(v2[0], v2[1], v2[2], v2[3]); w.w = pk4_fp8(v3[0], v3[1], v3[2], v3[3]);
                *(u32x4*)(Y9 + (size_t)row * DM + col0) = w; }
    }
};
struct EpiResStat {
    static constexpr int PERM = 0; typedef NoPre Pre; __device__ __forceinline__ void prefetch(Pre&, const Unit&, int, int) const {}
    const float* __restrict__ res; bf16_t* __restrict__ Xb; float* ss; int ldc; float scale;
    __device__ __forceinline__ void operator()(const f32x4 (&acc)[2][2][4][2], const Unit& u, int wr, int wc, int fr, int fq, const Pre& pre) const {
        const int row0 = u.pm * BM + wr * 64 + fr, col0 = u.pn * BM + wc * 32 + 4 * fq;
#pragma unroll
        for (int ah = 0; ah < 4; ++ah) { const int ai = ah >> 1, mb = (ah & 1) * 2;
            f32x4 r[4][2][2];
#pragma unroll
            for (int m = mb; m < mb + 2; ++m) { const size_t o = (size_t)(row0 + ai * HALF + m * 16) * ldc + col0;
#pragma unroll
                for (int bj = 0; bj < 2; ++bj)
#pragma unroll
                    for (int n = 0; n < 2; ++n) r[m][bj][n] = __builtin_nontemporal_load((const f32x4*)(res + o + bj * HALF + n * 16)); }
#pragma unroll
            for (int m = mb; m < mb + 2; ++m) { const int row = row0 + ai * HALF + m * 16; const size_t o = (size_t)row * ldc + col0; float sq = 0.f;
#pragma unroll
                for (int bj = 0; bj < 2; ++bj)
#pragma unroll
                    for (int n = 0; n < 2; ++n) { const f32x4 v = acc[ai][bj][m][n] * scale + r[m][bj][n];
                        sq += (v.x * v.x + v.y * v.y) + (v.z * v.z + v.w * v.w);
                        u32x2 pk; pk.x = cvt_pk_bf16(v.x, v.y); pk.y = cvt_pk_bf16(v.z, v.w); *(u32x2*)(Xb + o + bj * HALF + n * 16) = pk; }
                sq += __shfl_xor(sq, 16); sq += __shfl_xor(sq, 32);
                if (fq == 0) ss[(size_t)row * 64 + u.pn * 4 + wc] = sq; }
        }
    }
};
struct EpiX2 {
    static constexpr int PERM = 1; typedef NoPre Pre; __device__ __forceinline__ void prefetch(Pre&, const Unit&, int, int) const {}
    const bf16_t* __restrict__ res; bf16_t* __restrict__ Th; bf16_t* __restrict__ Tl; unsigned char* __restrict__ T8; float* ss; int ldc;
    __device__ __forceinline__ void operator()(const f32x4 (&acc)[2][2][4][2], const Unit& u, int wr, int wc, int fr, int fq, const Pre& pre) const {
        const int row0 = u.pm * BM + wr * 64 + fr, col0 = u.pn * BM + wc * 32 + 8 * fq;
#pragma unroll
        for (int ah = 0; ah < 2; ++ah) { const int ai = ah;
            u32x4 r[4][2];
#pragma unroll
            for (int m = 0; m < 4; ++m) { const size_t o = (size_t)(row0 + ai * HALF + m * 16) * ldc + col0;
#pragma unroll
                for (int bj = 0; bj < 2; ++bj) r[m][bj] = __builtin_nontemporal_load((const u32x4*)(res + o + bj * HALF)); }
#pragma unroll
            for (int m = 0; m < 4; ++m) { const int row = row0 + ai * HALF + m * 16; const size_t o = (size_t)row * ldc + col0; float sq = 0.f;
#pragma unroll
                for (int bj = 0; bj < 2; ++bj) { const u32x4 rr = r[m][bj];
                    const f32x4 r0 = (f32x4){__uint_as_float(rr.x << 16), __uint_as_float(rr.x & 0xffff0000u), __uint_as_float(rr.y << 16), __uint_as_float(rr.y & 0xffff0000u)};
                    const f32x4 r1 = (f32x4){__uint_as_float(rr.z << 16), __uint_as_float(rr.z & 0xffff0000u), __uint_as_float(rr.w << 16), __uint_as_float(rr.w & 0xffff0000u)};
                    const f32x4 w0 = acc[ai][bj][m][0] + r0, w1 = acc[ai][bj][m][1] + r1;
                    sq += (w0.x * w0.x + w0.y * w0.y) + (w0.z * w0.z + w0.w * w0.w) + (w1.x * w1.x + w1.y * w1.y) + (w1.z * w1.z + w1.w * w1.w);
                    u32x4 h; h.x = cvt_pk_bf16(w0.x, w0.y); h.y = cvt_pk_bf16(w0.z, w0.w); h.z = cvt_pk_bf16(w1.x, w1.y); h.w = cvt_pk_bf16(w1.z, w1.w);
                    u32x4 l; l.x = cvt_pk_bf16(w0.x - __uint_as_float(h.x << 16), w0.y - __uint_as_float(h.x & 0xffff0000u)); l.y = cvt_pk_bf16(w0.z - __uint_as_float(h.y << 16), w0.w - __uint_as_float(h.y & 0xffff0000u));
                    l.z = cvt_pk_bf16(w1.x - __uint_as_float(h.z << 16), w1.y - __uint_as_float(h.z & 0xffff0000u)); l.w = cvt_pk_bf16(w1.z - __uint_as_float(h.w << 16), w1.w - __uint_as_float(h.w & 0xffff0000u));
                    u32x2 q8; q8.x = pk4_fp8(w0.x * T_SCALE, w0.y * T_SCALE, w0.z * T_SCALE, w0.w * T_SCALE); q8.y = pk4_fp8(w1.x * T_SCALE, w1.y * T_SCALE, w1.z * T_SCALE, w1.w * T_SCALE);
                    *(u32x4*)(Th + o + bj * HALF) = h; *(u32x4*)(Tl + o + bj * HALF) = l; *(u32x2*)(T8 + o + bj * HALF) = q8; }
                sq += __shfl_xor(sq, 16); sq += __shfl_xor(sq, 32);
                if (fq == 0) ss[(size_t)row * 64 + u.pn * 4 + wc] = sq; }
        }
    }
};
}

namespace fa {
typedef short s16x4 __attribute__((ext_vector_type(4)));
typedef float f32x16 __attribute__((ext_vector_type(16)));
constexpr int SHM_V = 16384, SHM_K = 16384, SHM_K2 = 8192;
constexpr int OFF_V = 0, OFF_K = 2 * SHM_V, OFF_K2 = OFF_K + 2 * SHM_K, OFF_WS = OFF_K2 + 2 * SHM_K2, OFF_TBL = OFF_WS + 8 * 64 * 4, OFF_QPE = OFF_TBL + 1024, LDS_ATTN = OFF_QPE + 8 * 4096;
#define KSWZ(row, colB) ((row) * 256 + ((colB) ^ (((row) & 7) << 4)))
#define KSWZ2(row, colB) ((row) * 128 + ((colB) ^ (((row) & 7) << 4)))
#define SBAR() __builtin_amdgcn_sched_barrier(0)
__device__ __forceinline__ int crow(int r, int hi) { return (r & 3) + 8 * (r >> 2) + 4 * hi; }
__device__ __forceinline__ unsigned cvtpk(float lo, float hi) { unsigned r; asm volatile("v_cvt_pk_bf16_f32 %0, %1, %2" : "=v"(r) : "v"(lo), "v"(hi)); return r; }
constexpr float MIX_SCALE = 64.0f;
__device__ __forceinline__ unsigned fg_pk4_fp8(float a, float b, float c, float d) { int w = 0; w = __builtin_amdgcn_cvt_pk_fp8_f32(a, b, w, false); w = __builtin_amdgcn_cvt_pk_fp8_f32(c, d, w, true); return (unsigned)w; }
template <int MODE> struct Cf { static constexpr float SCALE = (MODE == 1) ? 0.07216878364870323f : 0.08838834764831845f; static constexpr float C = SCALE * 1.4426950408889634f; static constexpr float THRS = 8.0f / SCALE; };

template <int MODE>
__device__ __forceinline__ void partialSM(f32x16& p0, f32x16& p1, float& m_reg, float& mn, float& alpha) {
  constexpr float C = Cf<MODE>::C;
  float pmax = p0[0];
#pragma unroll
  for (int r = 1; r < 16; ++r) pmax = fmaxf(pmax, p0[r]);
#pragma unroll
  for (int r = 0; r < 16; ++r) pmax = fmaxf(pmax, p1[r]);
  { auto rr = __builtin_amdgcn_permlane32_swap(__float_as_uint(pmax), __float_as_uint(pmax), false, false);
    pmax = fmaxf(__uint_as_float(rr[0]), __uint_as_float(rr[1])); }
  if (__builtin_expect(__all(pmax - m_reg <= Cf<MODE>::THRS), 1)) { mn = m_reg; alpha = 1.f; }
  else { mn = fmaxf(m_reg, pmax); alpha = __builtin_amdgcn_exp2f((m_reg - mn) * C); m_reg = mn; }
  const float mnC = -mn * C;
#pragma unroll
  for (int r = 0; r < 16; ++r) p0[r] = fmaf(p0[r], C, mnC);
#pragma unroll
  for (int r = 0; r < 16; ++r) p1[r] = fmaf(p1[r], C, mnC);
#pragma unroll
  for (int r = 0; r < 16; ++r) p0[r] = __builtin_amdgcn_exp2f(p0[r]);
}
__device__ __forceinline__ void finishSM(f32x16& p0, f32x16& p1, float alpha, float& l_reg, bf16x8& pa0, bf16x8& pa1, bf16x8& pa2, bf16x8& pa3) {
#pragma unroll
  for (int r = 0; r < 16; ++r) p1[r] = __builtin_amdgcn_exp2f(p1[r]);
  float ps = 0;
#pragma unroll
  for (int r = 0; r < 16; ++r) ps += p0[r];
#pragma unroll
  for (int r = 0; r < 16; ++r) ps += p1[r];
  { auto rr = __builtin_amdgcn_permlane32_swap(__float_as_uint(ps), __float_as_uint(ps), false, false);
    ps = __uint_as_float(rr[0]) + __uint_as_float(rr[1]); }
  l_reg = l_reg * alpha + ps;
#define PK4(P, BASE, OUT) do { unsigned a0 = cvtpk(P[BASE + 0], P[BASE + 1]), a1 = cvtpk(P[BASE + 2], P[BASE + 3]);   \
    unsigned b0 = cvtpk(P[BASE + 4], P[BASE + 5]), b1 = cvtpk(P[BASE + 6], P[BASE + 7]);                              \
    auto r0 = __builtin_amdgcn_permlane32_swap(a0, b0, false, false); auto r1 = __builtin_amdgcn_permlane32_swap(a1, b1, false, false); \
    u32x4 w = {r0[0], r1[0], r0[1], r1[1]}; OUT = *reinterpret_cast<bf16x8*>(&w); } while (0)
  PK4(p0, 0, pa0); PK4(p0, 8, pa1); PK4(p1, 0, pa2); PK4(p1, 8, pa3);
#undef PK4
}
template <int MODE>
__device__ __forceinline__ void qkt(f32x16& p0, f32x16& p1, const LAS char* Ks, const LAS char* K2s, const bf16x8* qr, int r32, int hi, const LAS char* qpe) {
  p0 = f32x16{}; p1 = f32x16{};
#pragma unroll
  for (int d0 = 0; d0 < 8; ++d0) { const int cb = (d0 * 16 + hi * 8) * 2;
    const bf16x8 b0 = *reinterpret_cast<const LAS bf16x8*>(Ks + KSWZ(r32, cb));
    const bf16x8 b1 = *reinterpret_cast<const LAS bf16x8*>(Ks + KSWZ(32 + r32, cb));
    p0 = __builtin_amdgcn_mfma_f32_32x32x16_bf16(b0, qr[d0], p0, 0, 0, 0);
    p1 = __builtin_amdgcn_mfma_f32_32x32x16_bf16(b1, qr[d0], p1, 0, 0, 0); }
  if (MODE == 1) {
#pragma unroll
    for (int d0 = 0; d0 < 4; ++d0) { const int cb = (d0 * 16 + hi * 8) * 2;
      const bf16x8 b0 = *reinterpret_cast<const LAS bf16x8*>(K2s + KSWZ2(r32, cb));
      const bf16x8 b1 = *reinterpret_cast<const LAS bf16x8*>(K2s + KSWZ2(32 + r32, cb));
      const bf16x8 qp = *reinterpret_cast<const LAS bf16x8*>(qpe + d0 * 1024);
      p0 = __builtin_amdgcn_mfma_f32_32x32x16_bf16(b0, qp, p0, 0, 0, 0);
      p1 = __builtin_amdgcn_mfma_f32_32x32x16_bf16(b1, qp, p1, 0, 0, 0); }
  }
}
__device__ __forceinline__ int v_st(int k, int c) { const int kk = (k & ~0xC) | ((k & 4) << 1) | ((k & 8) >> 1); return ((kk >> 3) * 4 + (c >> 5)) * 512 + ((kk & 7) * 32 + (c & 31)) * 2; }
__device__ __forceinline__ int v_rd_base(int lane) { return ((lane & 3) << 3) | (((lane >> 2) & 3) << 6) | (((lane >> 4) & 1) << 5) | (((lane >> 5) & 1) << 8); }
constexpr int v_rd_off(int d0, int ks, int half) { return d0 * 512 + ks * 4096 + half * 2048; }
template <int OFF> __device__ __forceinline__ s16x4 tr_read(int vb) { s16x4 r; asm volatile("ds_read_b64_tr_b16 %0, %1 offset:%2" : "=&v"(r) : "v"(vb), "i"(OFF) : "memory"); return r; }
template <int D0> __device__ __forceinline__ void pv_one(f32x16& od, int vb, bf16x8 pa0, bf16x8 pa1, bf16x8 pa2, bf16x8 pa3) {
  const s16x4 l0 = tr_read<v_rd_off(D0, 0, 0)>(vb), h0 = tr_read<v_rd_off(D0, 0, 1)>(vb), l1 = tr_read<v_rd_off(D0, 1, 0)>(vb), h1 = tr_read<v_rd_off(D0, 1, 1)>(vb);
  const s16x4 l2 = tr_read<v_rd_off(D0, 2, 0)>(vb), h2 = tr_read<v_rd_off(D0, 2, 1)>(vb), l3 = tr_read<v_rd_off(D0, 3, 0)>(vb), h3 = tr_read<v_rd_off(D0, 3, 1)>(vb);
  asm volatile("s_waitcnt lgkmcnt(0)" ::: "memory"); SBAR();
#define PK(L, H) (bf16x8){L[0], L[1], L[2], L[3], H[0], H[1], H[2], H[3]}
  od = __builtin_amdgcn_mfma_f32_32x32x16_bf16(pa0, PK(l0, h0), od, 0, 0, 0);
  od = __builtin_amdgcn_mfma_f32_32x32x16_bf16(pa1, PK(l1, h1), od, 0, 0, 0);
  od = __builtin_amdgcn_mfma_f32_32x32x16_bf16(pa2, PK(l2, h2), od, 0, 0, 0);
  od = __builtin_amdgcn_mfma_f32_32x32x16_bf16(pa3, PK(l3, h3), od, 0, 0, 0);
#undef PK
}
__device__ __forceinline__ void pv_d0(f32x16* o, int vb, bf16x8 pa0, bf16x8 pa1, bf16x8 pa2, bf16x8 pa3) {
  pv_one<0>(o[0], vb, pa0, pa1, pa2, pa3); pv_one<1>(o[1], vb, pa0, pa1, pa2, pa3); pv_one<2>(o[2], vb, pa0, pa1, pa2, pa3); pv_one<3>(o[3], vb, pa0, pa1, pa2, pa3);
}
struct Args { const bf16_t* Q; const bf16_t* K1; const bf16_t* K2; const bf16_t* V; bf16_t* O; int kt0, NT, qch0; };
template <int MODE> struct St {
    static constexpr int LDQ = (MODE == 0) ? INW : (MODE == 1 ? 3072 : 512), LDK1 = (MODE == 0) ? INW : (MODE == 1 ? 4096 : 1024), LDK2 = INW, LDV = LDK1, LDO = (MODE == 2) ? 512 : DM; };
template <int MODE>
__device__ __forceinline__ void mask_bias(f32x16& p0, f32x16& p1, int qch, int kch, int qpos, int hi, const LAS float* tbl) {
  const bool valid = (MODE == 2) || ((kch <= qch) && (MODE == 1 || kch >= qch - 8));
  if (!valid) {
#pragma unroll
    for (int r = 0; r < 16; ++r) { p0[r] = -INFINITY; p1[r] = -INFINITY; }
  } else if (MODE == 0) {
    if (qch - kch >= 3) { const float b = tbl[191];
#pragma unroll
      for (int r = 0; r < 16; ++r) { p0[r] += b; p1[r] += b; }
    } else { const int base = qpos - kch * 64 + 63 - 4 * hi;
#pragma unroll
      for (int g = 0; g < 4; ++g) {
#pragma unroll
        for (int r = 4 * g; r < 4 * g + 4; ++r) { int d0 = base - ((r & 3) + 8 * (r >> 2)), d1 = d0 - 32;
          d0 = d0 < 0 ? 0 : (d0 > 191 ? 191 : d0); d1 = d1 < 0 ? 0 : (d1 > 191 ? 191 : d1);
          p0[r] += tbl[d0]; p1[r] += tbl[d1]; }
        SBAR();
      }
    }
  }
}
template <int MODE>
__device__ __forceinline__ void attn_body(const Args& a, LAS char* lds) {
  constexpr int NQ = 8;
  int tid = threadIdx.x; asm volatile("" : "+v"(tid));
  const int wid = tid >> 6, lane = tid & 63, r32 = lane & 31, hi = lane >> 5;
  LAS char* V_lds = lds + OFF_V; LAS char* K_lds = lds + OFF_K; LAS char* K2_lds = lds + OFF_K2;
  LAS float* ws = (LAS float*)(lds + OFF_WS) + wid * 64; LAS float* li_l = ws; LAS float* al_l = ws + 32;
  const LAS float* tbl = (const LAS float*)(lds + OFF_TBL);
  float m_reg = -1e30f, l_reg = 0; f32x16 o[4] = {}; bf16x8 qr[NQ];
  const bf16_t* Qw = a.Q + (wid * 32 + r32) * St<MODE>::LDQ + hi * 8;
#pragma unroll
  for (int d0 = 0; d0 < NQ; ++d0) qr[d0] = *reinterpret_cast<const bf16x8*>(Qw + d0 * 16);
  const LAS char* qpe = lds + OFF_QPE + wid * 4096 + lane * 16;
  if (MODE == 1) {
#pragma unroll
    for (int d0 = 0; d0 < 4; ++d0) *(LAS bf16x8*)(lds + OFF_QPE + wid * 4096 + lane * 16 + d0 * 1024) = *reinterpret_cast<const bf16x8*>(Qw + 128 + d0 * 16);
  }
  const int sr = tid >> 4, sc = (tid & 15) * 8, vst0 = v_st(sr, sc), vst1 = v_st(32 + sr, sc);
  const int s2r = tid >> 3, s2c = (tid & 7) * 8;
  const int vb0 = (int)(uintptr_t)V_lds + v_rd_base(lane);
  const int qch = a.qch0 + (wid >> 1), qpos = a.qch0 * 64 + wid * 32 + r32;
  bf16x8 vs0, vs1, ks0, ks1, k2s;
  const unsigned ovk = (unsigned)(sr * St<MODE>::LDK1 + sc) * 2u, ok2 = (unsigned)(s2r * St<MODE>::LDK2 + s2c) * 2u;
#define SLOAD(j) do { const size_t k0_ = (size_t)(a.kt0 + (j)) * 64; \
    const char* vt_ = (const char*)(a.V + k0_ * St<MODE>::LDV); const char* kt_ = (const char*)(a.K1 + k0_ * St<MODE>::LDK1); \
    vs0 = *reinterpret_cast<const bf16x8*>(vt_ + ovk); vs1 = *reinterpret_cast<const bf16x8*>(vt_ + 64 * St<MODE>::LDV + ovk); \
    ks0 = *reinterpret_cast<const bf16x8*>(kt_ + ovk); ks1 = *reinterpret_cast<const bf16x8*>(kt_ + 64 * St<MODE>::LDK1 + ovk); \
    if (MODE == 1) k2s = *reinterpret_cast<const bf16x8*>((const char*)(a.K2 + k0_ * St<MODE>::LDK2) + ok2); } while (0)
#define SWRITE(b) do { *(LAS bf16x8*)(V_lds + (b) * SHM_V + vst0) = vs0; *(LAS bf16x8*)(V_lds + (b) * SHM_V + vst1) = vs1; const int kc = sc * 2; \
    *(LAS bf16x8*)(K_lds + (b) * SHM_K + KSWZ(sr, kc)) = ks0; *(LAS bf16x8*)(K_lds + (b) * SHM_K + KSWZ(32 + sr, kc)) = ks1; \
    if (MODE == 1) *(LAS bf16x8*)(K2_lds + (b) * SHM_K2 + KSWZ2(s2r, s2c * 2)) = k2s; } while (0)
#define SWAIT() asm volatile("s_waitcnt vmcnt(0)" ::: "memory")
#define RESC(al) do { if (__any((al) < 1.f)) { if (hi == 0) al_l[r32] = (al); asm volatile("s_waitcnt lgkmcnt(0)" ::: "memory"); \
    _Pragma("unroll") for (int d = 0; d < 4; ++d) _Pragma("unroll") for (int r = 0; r < 16; ++r) o[d][r] *= al_l[crow(r, hi)]; } } while (0)
  f32x16 pA0, pA1, pB0, pB1; float mnA, mnB, alA, alB; bf16x8 pa0, pa1, pa2, pa3; const int NT = a.NT;
  SLOAD(0); SWAIT(); SWRITE(0); __syncthreads();
  qkt<MODE>(pA0, pA1, K_lds, K2_lds, qr, r32, hi, qpe); mask_bias<MODE>(pA0, pA1, qch, a.kt0, qpos, hi, tbl); partialSM<MODE>(pA0, pA1, m_reg, mnA, alA);
  SLOAD(1);
  SWAIT(); SWRITE(1); __syncthreads();
  for (int j = 1; j + 1 < NT; j += 2) {
    SBAR(); qkt<MODE>(pB0, pB1, K_lds + SHM_K, K2_lds + SHM_K2, qr, r32, hi, qpe); mask_bias<MODE>(pB0, pB1, qch, a.kt0 + j, qpos, hi, tbl);
    finishSM(pA0, pA1, alA, l_reg, pa0, pa1, pa2, pa3); SBAR();
    SLOAD(j + 1); SBAR();
    pv_d0(o, vb0, pa0, pa1, pa2, pa3); partialSM<MODE>(pB0, pB1, m_reg, mnB, alB);
    __syncthreads(); SWAIT(); SWRITE(0);
    RESC(alB); __syncthreads();
    SBAR(); qkt<MODE>(pA0, pA1, K_lds, K2_lds, qr, r32, hi, qpe); mask_bias<MODE>(pA0, pA1, qch, a.kt0 + j + 1, qpos, hi, tbl);
    finishSM(pB0, pB1, alB, l_reg, pa0, pa1, pa2, pa3); SBAR();
    SLOAD(j + 2); SBAR();
    pv_d0(o, vb0 + SHM_V, pa0, pa1, pa2, pa3); partialSM<MODE>(pA0, pA1, m_reg, mnA, alA);
    __syncthreads(); SWAIT(); SWRITE(1);
    RESC(alA); __syncthreads();
  }
  SBAR(); qkt<MODE>(pB0, pB1, K_lds + SHM_K, K2_lds + SHM_K2, qr, r32, hi, qpe); mask_bias<MODE>(pB0, pB1, qch, a.kt0 + NT - 1, qpos, hi, tbl);
  finishSM(pA0, pA1, alA, l_reg, pa0, pa1, pa2, pa3); SBAR();
  pv_d0(o, vb0, pa0, pa1, pa2, pa3); partialSM<MODE>(pB0, pB1, m_reg, mnB, alB);
  __syncthreads(); RESC(alB);
  finishSM(pB0, pB1, alB, l_reg, pa0, pa1, pa2, pa3); SBAR();
  pv_d0(o, vb0 + SHM_V, pa0, pa1, pa2, pa3);
  if (hi == 0) li_l[r32] = l_reg; asm volatile("s_waitcnt lgkmcnt(0)" ::: "memory");
  if (MODE != 2) {
    unsigned char* Ow8 = (unsigned char*)a.O + (size_t)(wid * 32) * DM;
    const int qi = lane & 3;
#pragma unroll
    for (int rg = 0; rg < 4; ++rg) {
      float rl[4];
#pragma unroll
      for (int j = 0; j < 4; ++j) rl[j] = __builtin_amdgcn_rcpf(li_l[crow(4 * rg + j, hi)]) * MIX_SCALE;
#pragma unroll
      for (int d0 = 0; d0 < 4; ++d0) { float v[4];
#pragma unroll
        for (int j = 0; j < 4; ++j) v[j] = o[d0][4 * rg + j] * rl[j];
        { const float s0 = (qi & 1) ? v[0] : v[1], s1 = (qi & 1) ? v[2] : v[3]; const float t0 = __shfl_xor(s0, 1), t1 = __shfl_xor(s1, 1);
          if (qi & 1) { v[0] = t0; v[2] = t1; } else { v[1] = t0; v[3] = t1; } }
        { const float s0 = (qi & 2) ? v[0] : v[2], s1 = (qi & 2) ? v[1] : v[3]; const float t0 = __shfl_xor(s0, 2), t1 = __shfl_xor(s1, 2);
          if (qi & 2) { v[0] = t0; v[1] = t1; } else { v[2] = t0; v[3] = t1; } }
        const int orow = 8 * rg + 4 * hi + qi;
        *(unsigned*)(Ow8 + (size_t)orow * DM + d0 * 32 + (r32 & ~3)) = fg_pk4_fp8(v[0], v[1], v[2], v[3]); } }
  } else {
  bf16_t* Ow = a.O + (wid * 32) * St<MODE>::LDO;
  const int odd = lane & 1;
#pragma unroll
  for (int r = 0; r < 16; r += 2) { const float ra = __builtin_amdgcn_rcpf(li_l[crow(r, hi)]), rb = __builtin_amdgcn_rcpf(li_l[crow(r + 1, hi)]);
#pragma unroll
    for (int d0 = 0; d0 < 4; ++d0) { const float vA = o[d0][r] * ra, vB = o[d0][r + 1] * rb;
      const float pA = __shfl_xor(vA, 1), pB = __shfl_xor(vB, 1);
      const unsigned w = odd ? cvtpk(pB, vB) : cvtpk(vA, pA);
      const int orow = odd ? crow(r + 1, hi) : crow(r, hi);
      *(unsigned*)(Ow + orow * St<MODE>::LDO + d0 * 32 + (r32 & ~1)) = w; } }
  }
  __syncthreads();
#undef SLOAD
#undef SWRITE
#undef SWAIT
#undef RESC
}
#undef KSWZ
#undef KSWZ2
#undef SBAR
template <int MODE> __device__ __forceinline__ void attn_call(const bf16_t* Q, const bf16_t* K1, const bf16_t* K2, const bf16_t* V, bf16_t* O, int kt0, int NT, int qch0, LAS char* lds) {
  Args a{Q, K1, K2, V, O, kt0, NT, qch0}; attn_body<MODE>(a, lds);
}
}

#ifndef TVAR
#define TVAR 0
#endif
template <int VAR = 0, bool GK = false>
__device__ __forceinline__ void transpose_item(const float* W, int K, int N, bf16_t* WT, int k0, int n0, int drow0, LAS float* scr, int lane, const float* gk = nullptr) {
    float v[64];
    const float* src = W + (size_t)k0 * N + n0 + lane;
#pragma unroll
    for (int i = 0; i < 64; ++i) v[i] = __builtin_nontemporal_load(src + (size_t)i * N);
    if (VAR == 1) {
#pragma unroll
        for (int i = 0; i < 64; ++i) asm volatile("" :: "v"(v[i]));
        return; }
#pragma unroll
    for (int i = 0; i < 64; ++i) scr[i * 65 + lane] = GK ? v[i] * gk[k0 + i] : v[i];
    asm volatile("s_waitcnt lgkmcnt(0)" ::: "memory");
    if (VAR == 2) { drow0 = 0; k0 = 0; }
    const int c = lane & 7;
#pragma unroll
    for (int j = 0; j < 8; ++j) { const int n = (lane >> 3) + 8 * j; const LAS float* sp = scr + (8 * c) * 65 + n;
        u32x4 o; o.x = fg::cvt_pk_bf16(sp[0 * 65], sp[1 * 65]); o.y = fg::cvt_pk_bf16(sp[2 * 65], sp[3 * 65]); o.z = fg::cvt_pk_bf16(sp[4 * 65], sp[5 * 65]); o.w = fg::cvt_pk_bf16(sp[6 * 65], sp[7 * 65]);
        *(u32x4*)(WT + ((size_t)(drow0 >> 6) * (K >> 6) + (k0 >> 6)) * 4096 + n * 64 + 8 * c) = o; }
    asm volatile("s_waitcnt lgkmcnt(0)" ::: "memory");
}
__device__ __forceinline__ fg::MoeTabs moe_tables_fast(LAS int* tab, const unsigned* gcnt) {
    fg::MoeTabs T; T.cnt = tab; T.mtp = tab + 80;
    __syncthreads();
    if (threadIdx.x == 0) { int pm = 0;
        for (int e = 0; e <= NE; ++e) { const int c = (e < NE) ? (int)gcnt[64 * e] : NTOK; tab[e] = c; tab[80 + e] = pm; pm += (c + 255) / 256; }
        tab[80 + NE + 1] = pm; }
    __syncthreads();
    return T;
}
template <bool GK = false>
__device__ __forceinline__ void transpose_item_fp8(const float* W, int K, int N, unsigned char* WT, int k0, int n0, int drow0, float scale, LAS float* scr, int lane, const float* gk = nullptr) {
    float v[64];
    const float* src = W + (size_t)k0 * N + n0 + lane;
#pragma unroll
    for (int i = 0; i < 64; ++i) v[i] = __builtin_nontemporal_load(src + (size_t)i * N);
#pragma unroll
    for (int i = 0; i < 64; ++i) scr[i * 65 + lane] = GK ? v[i] * (scale * gk[k0 + i]) : v[i] * scale;
    asm volatile("s_waitcnt lgkmcnt(0)" ::: "memory");
    const int c = lane & 3;
    unsigned char* tile = WT + ((size_t)(drow0 >> 6) * (K >> 7) + (k0 >> 7)) * 8192 + (k0 & 64);
#pragma unroll
    for (int j = 0; j < 4; ++j) { const int n = (lane >> 2) + 16 * j; const LAS float* sp = scr + (16 * c) * 65 + n;
        u32x4 o; o.x = fg::pk4_fp8(sp[0 * 65], sp[1 * 65], sp[2 * 65], sp[3 * 65]); o.y = fg::pk4_fp8(sp[4 * 65], sp[5 * 65], sp[6 * 65], sp[7 * 65]);
        o.z = fg::pk4_fp8(sp[8 * 65], sp[9 * 65], sp[10 * 65], sp[11 * 65]); o.w = fg::pk4_fp8(sp[12 * 65], sp[13 * 65], sp[14 * 65], sp[15 * 65]);
        *(u32x4*)(tile + n * 128 + 16 * c) = o; }
    asm volatile("s_waitcnt lgkmcnt(0)" ::: "memory");
}
__device__ __forceinline__ void transpose_item_hilo(const float* W, int K, bf16_t* WH, bf16_t* WL, int k0, LAS float* scr, int lane, const float* gk) {
    float v[64];
    const float* src = W + (size_t)k0 * 64 + lane;
#pragma unroll
    for (int i = 0; i < 64; ++i) v[i] = src[(size_t)i * 64];
#pragma unroll
    for (int i = 0; i < 64; ++i) scr[i * 65 + lane] = v[i] * gk[k0 + i];
    asm volatile("s_waitcnt lgkmcnt(0)" ::: "memory");
    const int c = lane & 7;
#pragma unroll
    for (int j = 0; j < 8; ++j) { const int n = (lane >> 3) + 8 * j; const LAS float* sp = scr + (8 * c) * 65 + n;
        float f[8], l[8];
#pragma unroll
        for (int q = 0; q < 8; ++q) f[q] = sp[q * 65];
        u32x4 o; o.x = fg::cvt_pk_bf16(f[0], f[1]); o.y = fg::cvt_pk_bf16(f[2], f[3]); o.z = fg::cvt_pk_bf16(f[4], f[5]); o.w = fg::cvt_pk_bf16(f[6], f[7]);
        l[0] = f[0] - __uint_as_float(o.x << 16); l[1] = f[1] - __uint_as_float(o.x & 0xffff0000u); l[2] = f[2] - __uint_as_float(o.y << 16); l[3] = f[3] - __uint_as_float(o.y & 0xffff0000u);
        l[4] = f[4] - __uint_as_float(o.z << 16); l[5] = f[5] - __uint_as_float(o.z & 0xffff0000u); l[6] = f[6] - __uint_as_float(o.w << 16); l[7] = f[7] - __uint_as_float(o.w & 0xffff0000u);
        u32x4 ol; ol.x = fg::cvt_pk_bf16(l[0], l[1]); ol.y = fg::cvt_pk_bf16(l[2], l[3]); ol.z = fg::cvt_pk_bf16(l[4], l[5]); ol.w = fg::cvt_pk_bf16(l[6], l[7]);
        const size_t off = (size_t)(k0 >> 6) * 4096 + n * 64 + 8 * c;
        *(u32x4*)(WH + off) = o; *(u32x4*)(WL + off) = ol; }
    asm volatile("s_waitcnt lgkmcnt(0)" ::: "memory");
}
constexpr int N_EXPERT_ITEMS = 65 * 1536;
__device__ __forceinline__ void expert_item(const Params& p, unsigned char* ws, int r0, LAS float* scr, int lane) {
    bf16_t* wguT = (bf16_t*)(ws + WS_WGU); bf16_t* wdT = (bf16_t*)(ws + WS_WD);
    const int e = r0 / 1536, r = r0 % 1536, mat = r >> 9, item = r & 511;
    if (mat < 2) { const float* W = (e < NE) ? p.in[mat ? I_WEXU : I_WEXG] + (size_t)e * DM * EFF : p.in[mat ? I_WSHU : I_WSHG];
        const int kb = (item & 7) + 8 * (item >> 6), nb = (item >> 3) & 7, n0 = nb * 64;
        transpose_item_fp8<true>(W, DM, EFF, (unsigned char*)wguT + (size_t)e * 1024 * DM, kb * 64, n0, (n0 >> 7) * 256 + mat * 128 + (n0 & 127), fg::WGU_SCALE, scr, lane, p.in[I_GFFN]);
    } else { const float* W = (e < NE) ? p.in[I_WEXD] + (size_t)e * EFF * DM : p.in[I_WSHD];
        const int kb = item & 7, nb = item >> 3;
        transpose_item_fp8(W, EFF, DM, (unsigned char*)wdT + (size_t)e * DM * EFF, kb * 64, nb * 64, nb * 64, fg::WD_SCALE, scr, lane); }
}
__device__ __forceinline__ void expert_conv_loop(const Params& p, unsigned char* ws, unsigned* qhead, LAS float* scr, int lane) {
    for (;;) {
        unsigned start = 0; if (lane == 0) start = xb_add(qhead, 8u);
        start = (unsigned)__builtin_amdgcn_readfirstlane((int)start);
        if (start >= (unsigned)N_EXPERT_ITEMS) break;
        for (int q = 0; q < 8; ++q) expert_item(p, ws, (int)start + q, scr, lane);
    }
}
template <int VAR>
__device__ __forceinline__ void p0_items(const Params& p, unsigned char* ws, LAS float* scr, int lane, int gw, int NGW) {
    bf16_t* winT = (bf16_t*)(ws + WS_WIN); bf16_t* wuqT = (bf16_t*)(ws + WS_WUQ); bf16_t* wukvT = (bf16_t*)(ws + WS_WUKV); bf16_t* woT = (bf16_t*)(ws + WS_WO);
    bf16_t* wxqT = (bf16_t*)(ws + WS_WXQ); bf16_t* wxkvT = (bf16_t*)(ws + WS_WXKV); bf16_t* wxoT = (bf16_t*)(ws + WS_WXO); bf16_t* wguT = (bf16_t*)(ws + WS_WGU); bf16_t* wdT = (bf16_t*)(ws + WS_WD);
            constexpr int I0 = (DM / 64) * (INW / 64), I1 = I0 + (DM / 64) * (DM / 64), I2 = I1 + (QLORA / 64) * (3072 / 64), I3 = I2 + (KVLORA / 64) * (4096 / 64),
                          I4 = I3 + (DM / 64) * (512 / 64), I5 = I4 + (DM / 64) * (1024 / 64), I6 = I5 + (512 / 64) * (DM / 64);
            constexpr int IR = I6, ITOT = IR + DM / 64;
            for (int it = gw; it < ITOT; it += NGW) {
                if (it < I0) { const int nb = it % (INW / 64), kb = it / (INW / 64); transpose_item_fp8(p.in[I_WIN], DM, INW, (unsigned char*)winT, kb * 64, nb * 64, nb * 64, 64.0f, scr, lane); }
                else if (it < I1) { const int r = it - I0, nb = r % 64, kb = r / 64; transpose_item_fp8(p.in[I_WO], DM, DM, (unsigned char*)woT, kb * 64, nb * 64, nb * 64, 64.0f, scr, lane); }
                else if (it < I2) { const int r = it - I1, nb = r % 48, kb = r / 48; transpose_item_fp8(p.in[I_WUQ], QLORA, 3072, (unsigned char*)wuqT, kb * 64, nb * 64, nb * 64, 64.0f, scr, lane); }
                else if (it < I3) { const int r = it - I2, nb = r % 64, kb = r / 64; transpose_item_fp8(p.in[I_WUKV], KVLORA, 4096, (unsigned char*)wukvT, kb * 64, nb * 64, nb * 64, 64.0f, scr, lane); }
                else if (it < I4) { const int r = it - I3, nb = r % 8, kb = r / 8; transpose_item<VAR, true>(p.in[I_WXQ], DM, 512, wxqT, kb * 64, nb * 64, nb * 64, scr, lane, p.in[I_GCROSS]); }
                else if (it < I5) { const int r = it - I4, nb = r % 16, kb = r / 16; transpose_item<VAR>(p.in[I_WXKV], DM, 1024, wxkvT, kb * 64, nb * 64, nb * 64, scr, lane); }
                else if (it < I6) { const int r = it - I5, nb = r % 64, kb = r / 64; transpose_item<VAR>(p.in[I_WXO], 512, DM, wxoT, kb * 64, nb * 64, nb * 64, scr, lane); }
                else if (it >= IR) { transpose_item_hilo(p.in[I_WROUTER], DM, (bf16_t*)(ws + WS_WR), (bf16_t*)(ws + WS_WR + (size_t)(DM / 64) * 8192), (it - IR) * 64, scr, lane, p.in[I_GFFN]); }
            }
}
__device__ __forceinline__ void unpack8(const u32x4 w, float (&f)[8]) {
    f[0] = __uint_as_float(w.x << 16); f[1] = __uint_as_float(w.x & 0xffff0000u); f[2] = __uint_as_float(w.y << 16); f[3] = __uint_as_float(w.y & 0xffff0000u);
    f[4] = __uint_as_float(w.z << 16); f[5] = __uint_as_float(w.z & 0xffff0000u); f[6] = __uint_as_float(w.w << 16); f[7] = __uint_as_float(w.w & 0xffff0000u); }
__device__ __forceinline__ u32x4 pack8(const float (&f)[8]) { u32x4 w; w.x = fg::cvt_pk_bf16(f[0], f[1]); w.y = fg::cvt_pk_bf16(f[2], f[3]); w.z = fg::cvt_pk_bf16(f[4], f[5]); w.w = fg::cvt_pk_bf16(f[6], f[7]); return w; }
__device__ __forceinline__ float sumsq8(const float (&f)[8]) { return (f[0] * f[0] + f[1] * f[1]) + (f[2] * f[2] + f[3] * f[3]) + (f[4] * f[4] + f[5] * f[5]) + (f[6] * f[6] + f[7] * f[7]); }
template <int W> __device__ __forceinline__ float group_sum(float v) {
#pragma unroll
    for (int o = 1; o < W; o <<= 1) v += __shfl_xor(v, o);
    return v;
}
__device__ __forceinline__ void load8f(const float* g, float (&f)[8]) { const f32x4 a = *(const f32x4*)g, b = *(const f32x4*)(g + 4); f[0] = a.x; f[1] = a.y; f[2] = a.z; f[3] = a.w; f[4] = b.x; f[5] = b.y; f[6] = b.z; f[7] = b.w; }
__device__ __forceinline__ void scale8(float (&f)[8], float r, const float (&g)[8]) {
#pragma unroll
    for (int i = 0; i < 8; ++i) f[i] = f[i] * r * g[i]; }
        struct RouterSched { const char* th; const char* tl; const char* wh; const char* wl; int G, c;
            __device__ __forceinline__ bool next(int i, fg::Unit& u) const {
                const int total = (NTOK / 256) * 8, per = (total + 7) / 8; const int j = i * G + c, x = j & 7, q = j >> 3;
                if (q >= per) return false; const int L = x * per + q; if (L >= total) return false;
                const int pm = L / 8, slab = L % 8, term = slab >> 2, kq = slab & 3;
                u.A = (term == 1 ? tl : th) + ((size_t)pm * 256 * DM + (size_t)kq * 1024) * 2; u.B = wh + (size_t)kq * 16 * 8192;
                u.rows = nullptr; u.nkt = 16; u.nvalid = 256; u.pm = pm; u.pn = 0; u.e = slab; u.arow0 = pm * 256; return true; } };
        struct EpiLogits { static constexpr int PERM = 0; typedef fg::NoPre Pre; __device__ __forceinline__ void prefetch(Pre&, const fg::Unit&, int, int) const {} float* C;
            __device__ __forceinline__ void operator()(const f32x4 (&acc)[2][2][4][2], const fg::Unit& u, int wr, int wc, int fr, int fq, const Pre& pre) const {
                { float* Cb = C + (size_t)u.e * NTOK * 128;
#pragma unroll
                    for (int ai = 0; ai < 2; ++ai)
#pragma unroll
                        for (int m = 0; m < 4; ++m)
#pragma unroll
                            for (int n = 0; n < 2; ++n) *(f32x4*)(Cb + (size_t)(u.pm * 256 + ai * 128 + wr * 64 + m * 16 + fr) * 128 + wc * 32 + n * 16 + 4 * fq) = acc[ai][0][m][n]; } } };
constexpr int NPHASE = 18;
template <unsigned PMASK>
__global__ void __launch_bounds__(512, 2) fwd(Params p) {
    extern __shared__ __attribute__((aligned(16))) unsigned char lds_raw[];
    float* ldsf = (float*)lds_raw;
    const int tid = threadIdx.x, lane = tid & 63, wave = tid >> 6;
    const int G = gridDim.x; int bid = blockIdx.x;
    const int gw = bid * 8 + wave, NGW = G * 8;
    unsigned char* ws = p.ws;
    unsigned* ctl = (unsigned*)(ws + WS_CTL);
    volatile LAS unsigned* misc = (volatile LAS unsigned*)((LAS unsigned char*)lds_raw + LDS_MISC);
    if (tid < 16) misc[tid] = 0u;
    __syncthreads();
    XcdBarrier bar = xcd_barrier_post(ctl + CW_BAR, misc);
    const int lo = p.ph_lo, hi = p.ph_hi;
    if (tid == 0) { const unsigned x = xb_xcc_id() & 15u; misc[4] = x; misc[5] = xb_add(ctl + CW_TICKET + 64 * x, 1u); }
#define IN(k) (((PMASK >> (k)) & 1u) && lo <= (k) && (k) < hi)
#ifndef DUP_PHASE
#define DUP_PHASE -1
#endif
#define REP(k) for (int rep_ = 0; rep_ < ((DUP_PHASE == (k)) ? 2 : 1); ++rep_)
#define SEAM(k) do { if (IN(k) && IN((k) + 1)) xcd_barrier(bar); } while (0)

    const float* x = p.in[I_X];
    act_t* hbuf = (act_t*)(ws + WS_H); act_t* memn = (act_t*)(ws + WS_MEMN); act_t* p1 = (act_t*)(ws + WS_P1); act_t* kvm = (act_t*)(ws + WS_KVM);
    act_t* qb = (act_t*)(ws + WS_QB); act_t* kvb = (act_t*)(ws + WS_KVB); act_t* mixed = (act_t*)(ws + WS_MIXED); float* x1 = (float*)(ws + WS_X1);
    act_t* hc = (act_t*)(ws + WS_HC); act_t* qx = (act_t*)(ws + WS_QX); act_t* ox = (act_t*)(ws + WS_OX); float* x2 = (float*)(ws + WS_X2);
    act_t* tb = (act_t*)(ws + WS_T); act_t* hh = (act_t*)(ws + WS_HH);
    unsigned char* cq8 = ws + WS_X1; unsigned char* ckv8 = ws + WS_X1 + (size_t)NTOK * QLORA;
    LAS unsigned char* lds = (LAS unsigned char*)lds_raw;
    bf16_t* winT = (bf16_t*)(ws + WS_WIN); bf16_t* wuqT = (bf16_t*)(ws + WS_WUQ); bf16_t* wukvT = (bf16_t*)(ws + WS_WUKV); bf16_t* woT = (bf16_t*)(ws + WS_WO);
    bf16_t* wxqT = (bf16_t*)(ws + WS_WXQ); bf16_t* wxkvT = (bf16_t*)(ws + WS_WXKV); bf16_t* wxoT = (bf16_t*)(ws + WS_WXO); bf16_t* wguT = (bf16_t*)(ws + WS_WGU); bf16_t* wdT = (bf16_t*)(ws + WS_WD);
    float* qxp = (float*)(ws + WS_QXP); bf16_t* ybuf = (bf16_t*)(ws + WS_Y);
    int* rowtok = (int*)(ws + WS_ROWTOK); float* rowgate = (float*)(ws + WS_ROWGATE); int* rowdst = (int*)(ws + WS_ROWDST);
    unsigned* gcnt = ctl + CW_CNT;
    const int* positions = (const int*)p.in[I_POS];

    if (IN(0)) REP(0) {
        for (int m = gw; m < NTOK; m += NGW) {
            const float* xr = x + (size_t)m * DM; f32x4 v[16]; float ssq = 0.f;
#pragma unroll
            for (int j = 0; j < 16; ++j) { v[j] = __builtin_nontemporal_load((const f32x4*)xr + lane + 64 * j); ssq += v[j].x * v[j].x + v[j].y * v[j].y + v[j].z * v[j].z + v[j].w * v[j].w; }
            ssq = wave_sum(ssq); const float r = 2.0f / sqrtf(ssq * (1.0f / 4096.f) + EPS);
#pragma unroll
            for (int j = 0; j < 16; ++j) v[j] = v[j] * r * __builtin_nontemporal_load((const f32x4*)p.in[I_GMIX] + lane + 64 * j);
            asm volatile("s_waitcnt vmcnt(0)" ::: "memory");
#pragma unroll
            for (int j = 0; j < 16; ++j) *(unsigned*)((unsigned char*)hbuf + (size_t)m * DM + (lane + 64 * j) * 4) = fg::pk4_fp8(v[j].x, v[j].y, v[j].z, v[j].w);
        }
        for (int m = gw; m < NMEM; m += NGW) rms_row_4096<act_t>(p.in[I_MEM] + (size_t)m * DM, p.in[I_GMEM], memn + (size_t)m * DM, lane, nullptr);
#if FAST_GEMM
        {
            LAS float* scr = (LAS float*)(lds + wave * 16640);
            p0_items<0>(p, ws, scr, lane, gw, NGW);
        }
#endif
    }
    SEAM(0);
    if (IN(0) && IN(1) && G == 256) {
        if (tid == 0) { bool even = true;
            for (int j2 = 0; j2 < 8; ++j2) even = even && (xb_ld(ctl + CW_TICKET + 64 * j2) == 32u);
            misc[6] = (even && misc[4] < 8u && misc[5] < 32u) ? (misc[4] + 8u * misc[5]) : (unsigned)blockIdx.x; }
        __syncthreads();
        bid = __builtin_amdgcn_readfirstlane((int)misc[6]);
    }
    if (IN(1)) REP(1) {
#if FAST_GEMM
        { fg::DenseSched S{(const char*)hbuf, (const char*)winT, DM / 2, DM / 2, NTOK / 256, INWP / 256, 1, DM / 128, G, bid, (p.var == 10) ? 2 : 0};
          fg::EpiBf16N E{p1, INW, INW, 1.0f / (2.0f * 64.0f), p.in[I_GQA], 8, p.in[I_GKA], 16, 0, (LAS float*)(lds + 131072 + 2048)};
          fg::gemm_phase<fg::EpiBf16N, fg::DenseSched, false, true, true>(lds, S, E, DM / 2, DM / 2, p.var); }
        { fg::DenseSched S{(const char*)memn, (const char*)wxkvT, DM, PK(DM), NMEM / 256, 1024 / 256, 1, DM / 64, G, (bid + G - 224) % G, 0};
          fg::EpiBf16 E{kvm, 1024, 1024, 1.0f};
          fg::gemm_phase<fg::EpiBf16, fg::DenseSched, false, false, true>(lds, S, E, DM, PK(DM)); }
#else
        constexpr int NT1 = (INW + 127) / 128, U1 = (NTOK / 128) * NT1, U2 = (NMEM / 128) * (1024 / 128);
        for (int u = bid; u < U1 + U2; u += G) {
            if (u < U1) { const int mt = u / NT1, nt = u % NT1;
                BPlain bc{p.in[I_WIN], INW, nt * 128, INW};
                auto epi = [&](int r, int c, const float (&v)[4]) { const int col = nt * 128 + c; if (col < INW) { act_t* o = p1 + (size_t)(mt * 128 + r) * INW + col; stf(o, v[0]); stf(o + 1, v[1]); stf(o + 2, v[2]); stf(o + 3, v[3]); } };
                ngemm_tile<act_t>(ldsf, hbuf, DM, nullptr, mt * 128, 128, DM, bc, epi);
            } else { const int v2 = u - U1, mt = v2 / 8, nt = v2 % 8;
                BPlain bc{p.in[I_WXKV], 1024, nt * 128, 1024};
                auto epi = [&](int r, int c, const float (&v)[4]) { act_t* o = kvm + (size_t)(mt * 128 + r) * 1024 + nt * 128 + c; stf(o, v[0]); stf(o + 1, v[1]); stf(o + 2, v[2]); stf(o + 3, v[3]); };
                ngemm_tile<act_t>(ldsf, memn, DM, nullptr, mt * 128, 128, DM, bc, epi);
            }
        }
    #endif
    }
    SEAM(1);
    if (IN(2)) {
#if FAST_GEMM
        {
            float gcq0[8], gcq1[8], gckv[8];
            load8f(p.in[I_GCQ] + lane * 8, gcq0); load8f(p.in[I_GCQ] + 512 + lane * 8, gcq1); load8f(p.in[I_GCKV] + lane * 8, gckv);
            for (int m = gw; m < NTOK; m += NGW) {
                act_t* row = p1 + (size_t)m * INW;
                u32x4 cq[2], ckv;
                cq[0] = *(const u32x4*)(row + C_CQ + lane * 8); cq[1] = *(const u32x4*)(row + C_CQ + 512 + lane * 8); ckv = *(const u32x4*)(row + C_CKV + lane * 8);
                const int pos = positions[m];
                asm volatile("s_waitcnt vmcnt(0)" ::: "memory");
                { float f0[8], f1[8]; unpack8(cq[0], f0); unpack8(cq[1], f1); const float ss = wave_sum(sumsq8(f0) + sumsq8(f1)); const float r = 1.0f / sqrtf(ss * (1.0f / 1024.f) + EPS);
                  scale8(f0, r * 2.0f, gcq0); scale8(f1, r * 2.0f, gcq1);
                  u32x2 a, b; a.x = fg::pk4_fp8(f0[0], f0[1], f0[2], f0[3]); a.y = fg::pk4_fp8(f0[4], f0[5], f0[6], f0[7]); b.x = fg::pk4_fp8(f1[0], f1[1], f1[2], f1[3]); b.y = fg::pk4_fp8(f1[4], f1[5], f1[6], f1[7]);
                  *(u32x2*)(cq8 + (size_t)m * QLORA + lane * 8) = a; *(u32x2*)(cq8 + (size_t)m * QLORA + 512 + lane * 8) = b; }
                { float f[8]; unpack8(ckv, f); const float ss = wave_sum(sumsq8(f)); const float r = 1.0f / sqrtf(ss * (1.0f / 512.f) + EPS); scale8(f, r * 2.0f, gckv);
                  u32x2 a; a.x = fg::pk4_fp8(f[0], f[1], f[2], f[3]); a.y = fg::pk4_fp8(f[4], f[5], f[6], f[7]); *(u32x2*)(ckv8 + (size_t)m * KVLORA + lane * 8) = a; }
                rms_rope64_inplace(row + C_KPE, p.in[I_GKB] + 128, pos, lane);
            }
            float gkx[8]; load8f(p.in[I_GKX] + (lane & 15) * 8, gkx);
            for (int m = gw; m < NMEM; m += NGW) { act_t* row = kvm + (size_t)m * 1024;
                u32x4 w = *(const u32x4*)(row + lane * 8); float f[8]; unpack8(w, f); const float ss = group_sum<16>(sumsq8(f)); const float r = 1.0f / sqrtf(ss * (1.0f / 128.f) + EPS);
                scale8(f, r, gkx); *(u32x4*)(row + lane * 8) = pack8(f); }
        }
#else
        for (int m = gw; m < NTOK; m += NGW) {
            act_t* row = p1 + (size_t)m * INW;
            for (int h = 0; h < HA; ++h) { rms_inplace<128>(row + C_Q0 + h * HD, p.in[I_GQA], lane); rms_inplace<128>(row + C_K0 + h * HD, p.in[I_GKA], lane); }
            rms_inplace<QLORA>(row + C_CQ, p.in[I_GCQ], lane);
            rms_inplace<KVLORA>(row + C_CKV, p.in[I_GCKV], lane);
            rms_rope64_inplace(row + C_KPE, p.in[I_GKB] + 128, positions[m], lane);
        }
        for (int m = gw; m < NMEM; m += NGW) for (int h = 0; h < MH; ++h) rms_inplace<128>(kvm + (size_t)m * 1024 + h * 128, p.in[I_GKX], lane);
#endif
    }
    SEAM(2);
    if (IN(3)) REP(3) {
#if FAST_GEMM
        { fg::DenseSched S{(const char*)cq8, (const char*)wuqT, QLORA / 2, QLORA / 2, NTOK / 256, 3072 / 256, 1, QLORA / 128, G, bid, 0};
          fg::EpiBf16 E{qb, 3072, 3072, 1.0f / 128.0f};
          fg::gemm_phase<fg::EpiBf16, fg::DenseSched, false, true, true>(lds, S, E, QLORA / 2, QLORA / 2); }
        { fg::DenseSched S{(const char*)ckv8, (const char*)wukvT, KVLORA / 2, KVLORA / 2, NTOK / 256, 4096 / 256, 1, KVLORA / 128, G, bid, (G == 256) ? 1 : 0};
          fg::EpiBf16N E{kvb, 4096, 4096, 1.0f / 128.0f, p.in[I_GKB], 16, p.in[I_GKB], 16, 1, (LAS float*)(lds + 131072 + 2048)};
          fg::gemm_phase<fg::EpiBf16N, fg::DenseSched, false, true, true>(lds, S, E, KVLORA / 2, KVLORA / 2); }
#else
        constexpr int UA = (NTOK / 128) * (3072 / 128), UB = (NTOK / 128) * (4096 / 128);
        for (int u = bid; u < UA + UB; u += G) {
            if (u < UA) { const int mt = u / 24, nt = u % 24;
                BPlain bc{p.in[I_WUQ], 3072, nt * 128, 3072};
                auto epi = [&](int r, int c, const float (&v)[4]) { act_t* o = qb + (size_t)(mt * 128 + r) * 3072 + nt * 128 + c; stf(o, v[0]); stf(o + 1, v[1]); stf(o + 2, v[2]); stf(o + 3, v[3]); };
                ngemm_tile<act_t>(ldsf, p1 + C_CQ, INW, nullptr, mt * 128, 128, QLORA, bc, epi);
            } else { const int v2 = u - UA, mt = v2 / 32, nt = v2 % 32;
                BPlain bc{p.in[I_WUKV], 4096, nt * 128, 4096};
                auto epi = [&](int r, int c, const float (&v)[4]) { act_t* o = kvb + (size_t)(mt * 128 + r) * 4096 + nt * 128 + c; stf(o, v[0]); stf(o + 1, v[1]); stf(o + 2, v[2]); stf(o + 3, v[3]); };
                ngemm_tile<act_t>(ldsf, p1 + C_CKV, INW, nullptr, mt * 128, 128, KVLORA, bc, epi);
            }
        }
    #endif
    }
    SEAM(3);
    if (IN(4)) {
#if FAST_GEMM
        {
            float gqn[8], gqp[8];
            load8f(p.in[I_GQB] + (lane & 15) * 8, gqn); load8f(p.in[I_GQB] + 128 + (lane & 7) * 8, gqp);
            for (int m = gw; m < NTOK; m += NGW) {
                act_t* qrow = qb + (size_t)m * 3072;
                u32x4 qn[4], qp[2];
#pragma unroll
                for (int j = 0; j < 4; ++j) qn[j] = *(const u32x4*)(qrow + (j * 4 + (lane >> 4)) * QKB + (lane & 15) * 8);
#pragma unroll
                for (int j = 0; j < 2; ++j) qp[j] = *(const u32x4*)(qrow + (j * 8 + (lane >> 3)) * QKB + 128 + (lane & 7) * 8);
                float cs[8], sn[8];
                { const int fi = lane & 31; const float inv_freq = powf(10000.0f, -(float)(2 * fi) / 64.0f); const float ang = (float)positions[m] * inv_freq; float s1, c1; sincosf(ang, &s1, &c1);
#pragma unroll
                  for (int i = 0; i < 8; ++i) { const int src = ((lane & 3) * 8 + i); cs[i] = __shfl(c1, src); sn[i] = __shfl(s1, src); } }
                asm volatile("s_waitcnt vmcnt(0)" ::: "memory");
#pragma unroll
                for (int j = 0; j < 4; ++j) { float f[8]; unpack8(qn[j], f); const float ss = group_sum<16>(sumsq8(f)); const float r = 1.0f / sqrtf(ss * (1.0f / 128.f) + EPS); scale8(f, r, gqn); qn[j] = pack8(f); }
#pragma unroll
                for (int j = 0; j < 2; ++j) { float f[8]; unpack8(qp[j], f); const float ss = group_sum<8>(sumsq8(f)); const float r = 1.0f / sqrtf(ss * (1.0f / 64.f) + EPS); scale8(f, r, gqp);
                    const bool lowhalf = ((lane & 7) < 4);
#pragma unroll
                    for (int i = 0; i < 8; ++i) { const float other = __shfl_xor(f[i], 4); f[i] = lowhalf ? (f[i] * cs[i] - other * sn[i]) : (f[i] * cs[i] + other * sn[i]); }
                    qp[j] = pack8(f); }
#pragma unroll
                for (int j = 0; j < 4; ++j) *(u32x4*)(qrow + (j * 4 + (lane >> 4)) * QKB + (lane & 15) * 8) = qn[j];
#pragma unroll
                for (int j = 0; j < 2; ++j) *(u32x4*)(qrow + (j * 8 + (lane >> 3)) * QKB + 128 + (lane & 7) * 8) = qp[j];
            }
        }
#else
        for (int m = gw; m < NTOK; m += NGW) {
            const int pos = positions[m];
            for (int h = 0; h < HB; ++h) {
                rms_inplace<128>(qb + (size_t)m * 3072 + h * QKB, p.in[I_GQB], lane);
                rms_rope64_inplace(qb + (size_t)m * 3072 + h * QKB + 128, p.in[I_GQB] + 128, pos, lane);
                rms_inplace<128>(kvb + (size_t)m * 4096 + h * 256, p.in[I_GKB], lane);
            }
        }
#endif
    }
    SEAM(4);
    if (IN(5)) {
#if FAST_ATTN
        {
            constexpr int NA_BLK = 176;
            LAS char* al = (LAS char*)lds;
            LAS float* scr = (LAS float*)(lds + wave * 16640);
            if (bid >= NA_BLK) { expert_conv_loop(p, ws, ctl + CW_QCONV, scr, lane); }
            for (;;) {
                __syncthreads(); if (tid == 0) misc[7] = xb_add(ctl + CW_QB, 1u); __syncthreads();
                const int q = (int)misc[7]; if (q >= 512) break;
                const int grp = q >> 8, idx = q & 255, pair = idx >> 2, qbk = (grp == 0 ? 7 : 3) - (idx & 3), b = pair >> 4, h = pair & 15;
                const int c0 = qbk * 4; const size_t tok0 = (size_t)b * SEQ + (size_t)qbk * 256;
                const act_t* kb = kvb + (size_t)b * SEQ * 4096;
                fa::attn_call<1>(qb + tok0 * 3072 + h * QKB, kb + h * 256, p1 + (size_t)b * SEQ * INW + C_KPE, kb + h * 256 + 128, (bf16_t*)((unsigned char*)mixed + tok0 * DM + WA + h * HD), 0, c0 + 4, c0, al);
            }
            for (;;) {
                __syncthreads(); if (tid == 0) misc[7] = xb_add(ctl + CW_QA, 1u); __syncthreads();
                const int q = (int)misc[7]; if (q >= 512) break;
                const int grp = q >> 8, idx = q & 255, pair = idx >> 2, qbk = (grp == 0 ? 7 : 3) - (idx & 3), b = pair >> 4, h = pair & 15;
                { LAS float* tbl = (LAS float*)(al + fa::OFF_TBL); if (tid < NREL) tbl[tid] = p.in[I_RELB][h * NREL + tid] * 11.313708498984761f; }
                const int c0 = qbk * 4; const size_t tok0 = (size_t)b * SEQ + (size_t)qbk * 256;
                const int kt0 = (c0 - LEFT) > 0 ? (c0 - LEFT) : 0;
                const act_t* base = p1 + (size_t)b * SEQ * INW;
                fa::attn_call<0>(p1 + tok0 * INW + C_Q0 + h * HD, base + C_K0 + h * HD, nullptr, base + C_V0 + h * HD, (bf16_t*)((unsigned char*)mixed + tok0 * DM + h * HD), kt0, c0 + 4 - kt0, c0, al);
            }
            __syncthreads();
            expert_conv_loop(p, ws, ctl + CW_QCONV, scr, lane);
        }
#else
        for (int u = bid; u < 4096; u += G) {
            const int c = 31 - (u >> 7), rem = u & 127, type = rem >> 6, b = (rem >> 4) & 3, h = rem & 15;
            const size_t tok0 = (size_t)b * SEQ + (size_t)c * CHUNK;
            if (type == 0) {
                const int t0 = (c - LEFT) > 0 ? (c - LEFT) : 0, nt = c - t0 + 1;
                const float* rb = p.in[I_RELB] + h * NREL;
                auto keytile = [&](int t) { return (t0 + t) * CHUNK; };
                auto bias = [&](int r, int t, int key) { int dist = (c * CHUNK + r) - ((t0 + t) * CHUNK + key); dist = dist < -(CHUNK - 1) ? -(CHUNK - 1) : (dist > 128 ? 128 : dist); return rb[dist + CHUNK - 1]; };
                const act_t* base = p1 + (size_t)b * SEQ * INW;
                nattn_unit<128>(ldsf, p1 + tok0 * INW + C_Q0 + h * HD, INW, base + C_K0 + h * HD, INW, nullptr, 0, base + C_V0 + h * HD, INW,
                                nt, keytile, 0.08838834764831845f, bias, mixed + tok0 * DM + h * HD, DM);
            } else {
                auto keytile = [&](int t) { return t * CHUNK; };
                auto bias = [&](int, int, int) { return 0.f; };
                const act_t* kb = kvb + (size_t)b * SEQ * 4096;
                nattn_unit<192>(ldsf, qb + tok0 * 3072 + h * QKB, 3072, kb + h * 256, 4096, p1 + (size_t)b * SEQ * INW + C_KPE, INW, kb + h * 256 + 128, 4096,
                                c + 1, keytile, 0.07216878364870323f, bias, mixed + tok0 * DM + WA + h * HD, DM);
            }
        }
    #endif
    }
    SEAM(5);
    if (IN(6)) REP(6) {
#if FAST_GEMM
        { fg::DenseSched S{(const char*)mixed, (const char*)woT, DM / 2, DM / 2, NTOK / 256, DM / 256, 1, DM / 128, G, bid, 0};
          fg::EpiResStat E{x, hc, (float*)(ws + WS_SSP1), DM, 1.0f / (fa::MIX_SCALE * 64.0f)};
          fg::gemm_phase<fg::EpiResStat, fg::DenseSched, false, true, true>(lds, S, E, DM / 2, DM / 2); }
#else
        for (int u = bid; u < (NTOK / 128) * (DM / 128); u += G) { const int mt = u / 32, nt = u % 32;
            BPlain bc{p.in[I_WO], DM, nt * 128, DM};
            auto epi = [&](int r, int c, const float (&v)[4]) { const size_t o = (size_t)(mt * 128 + r) * DM + nt * 128 + c;
                const f32x4 xv = *(const f32x4*)(x + o); *(f32x4*)(x1 + o) = (f32x4){xv.x + v[0], xv.y + v[1], xv.z + v[2], xv.w + v[3]}; };
            ngemm_tile<act_t>(ldsf, mixed, DM, nullptr, mt * 128, 128, DM, bc, epi);
        }
    #endif
    }
    SEAM(6);
    if (IN(8)) REP(8) {
#if FAST_GEMM
        { fg::DenseSched S{(const char*)hc, (const char*)wxqT, DM, PK(DM), NTOK / 256, 512 / 256, 4, DM / 64 / 4, G, bid, 0};
          fg::EpiF32Res<false> E{qxp, nullptr, 512, (size_t)NTOK * 512, 1.0f};
          fg::gemm_phase<fg::EpiF32Res<false>, fg::DenseSched, false, false, true>(lds, S, E, DM, PK(DM)); }
#else
        for (int u = bid; u < (NTOK / 128) * 4; u += G) { const int mt = u / 4, nt = u % 4;
            BPlain bc{p.in[I_WXQ], 512, nt * 128, 512};
            auto epi = [&](int r, int c, const float (&v)[4]) { act_t* o = qx + (size_t)(mt * 128 + r) * 512 + nt * 128 + c; stf(o, v[0]); stf(o + 1, v[1]); stf(o + 2, v[2]); stf(o + 3, v[3]); };
            ngemm_tile<act_t>(ldsf, hc, DM, nullptr, mt * 128, 128, DM, bc, epi);
        }
    #endif
    }
    SEAM(8);
    if (IN(9)) {
#if FAST_GEMM
        { float gqx[8]; load8f(p.in[I_GQX] + (lane & 15) * 8, gqx);
          for (int m = gw; m < NTOK; m += NGW) {
            f32x4 a[4][2];
#pragma unroll
            for (int sl = 0; sl < 4; ++sl) { const float* src = qxp + (size_t)sl * NTOK * 512 + (size_t)m * 512 + lane * 8; a[sl][0] = *(const f32x4*)src; a[sl][1] = *(const f32x4*)(src + 4); }
            const float rs1 = 1.0f / sqrtf(wave_sum(((const float*)(ws + WS_SSP1))[(size_t)m * 64 + lane]) * (1.0f / 4096.f) + EPS);
            const f32x4 lo = ((a[0][0] + a[1][0]) + (a[2][0] + a[3][0])) * rs1, hi4 = ((a[0][1] + a[1][1]) + (a[2][1] + a[3][1])) * rs1;
            float f[8] = {lo.x, lo.y, lo.z, lo.w, hi4.x, hi4.y, hi4.z, hi4.w};
            const float ss = group_sum<16>(sumsq8(f)); const float r = 1.0f / sqrtf(ss * (1.0f / 128.f) + EPS); scale8(f, r, gqx);
            *(u32x4*)(qx + (size_t)m * 512 + lane * 8) = pack8(f); } }
#else
        for (int m = gw; m < NTOK; m += NGW) for (int h = 0; h < MH; ++h) rms_inplace<128>(qx + (size_t)m * 512 + h * 128, p.in[I_GQX], lane);
#endif
    }
    SEAM(9);
    if (IN(10)) REP(10) {
#if FAST_ATTN
        for (int u = bid; u < NB * MH * (SEQ / 256); u += G) { const int qbk = u & 7, h = (u >> 3) & 3, b = u >> 5;
            const size_t tok0 = (size_t)b * SEQ + (size_t)qbk * 256;
            const act_t* kb = kvm + (size_t)b * MEMT * 1024;
            fa::attn_call<2>(qx + tok0 * 512 + h * 128, kb + h * 128, nullptr, kb + 512 + h * 128, ox + tok0 * 512 + h * 128, 0, 4, 0, (LAS char*)lds);
        }
#else
        for (int u = bid; u < NB * MH * (SEQ / 64); u += G) { const int c = u & 31, h = (u >> 5) & 3, b = u >> 7;
            const size_t tok0 = (size_t)b * SEQ + (size_t)c * 64;
            auto keytile = [&](int t) { return t * 64; };
            auto bias = [&](int, int, int) { return 0.f; };
            const act_t* kb = kvm + (size_t)b * MEMT * 1024;
            nattn_unit<128>(ldsf, qx + tok0 * 512 + h * 128, 512, kb + h * 128, 1024, nullptr, 0, kb + 512 + h * 128, 1024, 4, keytile, 0.08838834764831845f, bias, ox + tok0 * 512 + h * 128, 512);
        }
    #endif
    }
    SEAM(10);
    if (IN(11)) REP(11) {
#if FAST_GEMM
        { fg::DenseSched S{(const char*)ox, (const char*)wxoT, 512, PK(512), NTOK / 256, DM / 256, 1, 512 / 64, G, bid, 0};
          fg::EpiX2 E{hc, tb, (bf16_t*)hh, ws + WS_T8, (float*)(ws + WS_SSP2), DM};
          fg::gemm_phase<fg::EpiX2, fg::DenseSched, false, false, true>(lds, S, E, 512, PK(512)); }
#else
        for (int u = bid; u < (NTOK / 128) * (DM / 128); u += G) { const int mt = u / 32, nt = u % 32;
            BPlain bc{p.in[I_WXO], DM, nt * 128, DM};
            auto epi = [&](int r, int c, const float (&v)[4]) { const size_t o = (size_t)(mt * 128 + r) * DM + nt * 128 + c;
                const f32x4 xv = *(const f32x4*)(x1 + o); const f32x4 y = (f32x4){xv.x + v[0], xv.y + v[1], xv.z + v[2], xv.w + v[3]}; *(f32x4*)(x2 + o) = y; *(f32x4*)(p.out + o) = y; };
            ngemm_tile<act_t>(ldsf, ox, 512, nullptr, mt * 128, 128, 512, bc, epi);
        }
    #endif
    }
    SEAM(11);
    if (IN(13)) {
        RouterSched S{(const char*)tb, (const char*)hh, (const char*)(ws + WS_WR), nullptr, G, bid};
        EpiLogits E{(float*)(ws + WS_Y)};
        fg::gemm_phase<EpiLogits, RouterSched, false, false, true>(lds, S, E, DM, DM);
    }
    SEAM(13);
    if (IN(14)) {
        const float* lgp = (const float*)(ws + WS_Y);
        const float rb = p.in[I_RBIAS][lane];
        const int g = lane >> 3;
        float lgA[16];
#pragma unroll
        for (int sl = 0; sl < 16; ++sl) lgA[sl] = (gw < NTOK) ? lgp[((size_t)(sl >> 1) * NTOK + gw) * 128 + (sl & 1) * 64 + lane] : 0.f;
        int pm_ = -1, psel = 0, prank = 0; float pgate = 0.f; unsigned ppos = 0u;
        for (int m = gw; m < NTOK; m += NGW) {
            float lgB[16]; const int mn = m + NGW;
#pragma unroll
            for (int sl = 0; sl < 16; ++sl) lgB[sl] = (mn < NTOK) ? lgp[((size_t)(sl >> 1) * NTOK + mn) * 128 + (sl & 1) * 64 + lane] : 0.f;
            const float rs2 = 1.0f / sqrtf(wave_sum(((const float*)(ws + WS_SSP2))[(size_t)m * 64 + lane]) * (1.0f / 4096.f) + EPS);
            if (lane == 0) ((float*)(ws + WS_RS2))[m] = rs2;
            const float logit = ((((lgA[0] + lgA[1]) + (lgA[2] + lgA[3])) + ((lgA[4] + lgA[5]) + (lgA[6] + lgA[7]))) + (((lgA[8] + lgA[9]) + (lgA[10] + lgA[11])) + ((lgA[12] + lgA[13]) + (lgA[14] + lgA[15])))) * rs2;
            const float score = 1.0f / (1.0f + expf(-logit));
            const float choice = score + rb;
            float gm1 = fmaxf(choice, __shfl_xor(choice, 1)); gm1 = fmaxf(gm1, __shfl_xor(gm1, 2)); gm1 = fmaxf(gm1, __shfl_xor(gm1, 4));
            const unsigned long long eq = __ballot(choice == gm1);
            const unsigned gbits = (unsigned)(eq >> (8 * g)) & 0xffu;
            const bool is_first = (lane & 7) == (__builtin_ctz(gbits | 0x100u));
            float v2 = is_first ? -INFINITY : choice;
            v2 = fmaxf(v2, __shfl_xor(v2, 1)); v2 = fmaxf(v2, __shfl_xor(v2, 2)); v2 = fmaxf(v2, __shfl_xor(v2, 4));
            const float gscore = gm1 + v2;
            int grank = 0;
#pragma unroll
            for (int j2 = 0; j2 < 8; ++j2) { const float gj = __int_as_float(__builtin_amdgcn_readlane(__float_as_int(gscore), 8 * j2)); grank += ((gj > gscore) || (gj == gscore && j2 < g)) ? 1 : 0; }
            const bool gsel = grank < 4;
            const float mv = gsel ? choice : -INFINITY;
            int rank = 0;
#pragma unroll
            for (int i2 = 0; i2 < 64; ++i2) { const float vi = __int_as_float(__builtin_amdgcn_readlane(__float_as_int(mv), i2)); rank += ((vi > mv) || (vi == mv && i2 < lane)) ? 1 : 0; }
            const bool sel = gsel && rank < 8;
            const float wsum = wave_sum(sel ? score : 0.f);
            if (pm_ >= 0 && psel) { rowtok[lane * CAP + ppos] = pm_; rowgate[lane * CAP + ppos] = pgate; rowdst[lane * CAP + ppos] = pm_ * 8 + prank; }
            ppos = 0u; if (sel) ppos = atomicAdd(&gcnt[64 * lane], 1u);
            pm_ = m; psel = sel ? 1 : 0; prank = rank; pgate = score * 2.5f / (wsum + 1e-20f);
#pragma unroll
            for (int sl = 0; sl < 16; ++sl) lgA[sl] = lgB[sl];
        }
        if (pm_ >= 0 && psel) { rowtok[lane * CAP + ppos] = pm_; rowgate[lane * CAP + ppos] = pgate; rowdst[lane * CAP + ppos] = pm_ * 8 + prank; }
    }
    SEAM(14);
    if (IN(15)) REP(15) {
#if FAST_MOE
        { const fg::MoeTabs T = moe_tables_fast((LAS int*)(lds + 131072), gcnt);
          fg::MoeSched<1> S{T, (const char*)(ws + WS_T8), (const char*)wguT, rowtok, G, bid};
          fg::EpiSwiglu E{hh, (const float*)(ws + WS_RS2)};
          fg::gemm_phase<fg::EpiSwiglu, fg::MoeSched<1>, true, true, true>(lds, S, E, DM / 2, DM / 2, p.var); }
#else
        int* tab = (int*)(ldsf + 2 * 16 * 132);
        const MoeTab T = moe_tables(tab, gcnt, 128);
        const int nunits = T.mtp[NE + 1] * 8;
        for (int u = bid; u < nunits; u += G) {
            const int mti = u >> 3, nt = u & 7; int e = 0; while (T.mtp[e + 1] <= mti) ++e;
            const int mt = mti - T.mtp[e], nrows = (T.cnt[e] - mt * 128) < 128 ? (T.cnt[e] - mt * 128) : 128;
            const float* Wg = (e < NE) ? p.in[I_WEXG] + (size_t)e * DM * EFF : p.in[I_WSHG];
            const float* Wu = (e < NE) ? p.in[I_WEXU] + (size_t)e * DM * EFF : p.in[I_WSHU];
            BGU bc{Wg, Wu, EFF, nt * 64};
            const size_t hrow0 = (size_t)T.offh[e] + (size_t)mt * 128;
            auto epi = [&](int r, int c, const float (&v)[4]) { act_t* o = hh + (hrow0 + r) * EFF + nt * 64 + (c >> 2) * 2;
                stf(o, v[0] / (1.0f + expf(-v[0])) * v[2]); stf(o + 1, v[1] / (1.0f + expf(-v[1])) * v[3]); };
            ngemm_tile<act_t>(ldsf, tb, DM, (e < NE) ? rowtok + e * CAP : nullptr, mt * 128, nrows, DM, bc, epi);
        }
    #endif
    }
    SEAM(15);
    if (IN(16)) REP(16) {
#if FAST_MOE
        { const fg::MoeTabs T = moe_tables_fast((LAS int*)(lds + 131072), gcnt);
          { fg::MoeSched<2> S{T, (const char*)hh, (const char*)wdT, rowtok, G, bid};
            fg::EpiScatter E{(unsigned char*)ybuf, rowdst, rowgate, T.mtp};
            fg::gemm_phase<fg::EpiScatter, fg::MoeSched<2>, false, true, true>(lds, S, E, EFF / 2, EFF / 2, p.var); }
          { fg::DenseSched S{(const char*)hh + (size_t)T.mtp[64] * 256 * EFF, (const char*)wdT + (size_t)64 * DM * EFF, EFF / 2, EFF / 2, NTOK / 256, DM / 256, 1, EFF / 128, G, bid, 0};
            fg::EpiShared E{(unsigned char*)ybuf + (size_t)NTOK * 8 * DM};
            fg::gemm_phase<fg::EpiShared, fg::DenseSched, false, true, true>(lds, S, E, EFF / 2, EFF / 2); } }
#else
        int* tab = (int*)(ldsf + 2 * 16 * 132);
        const MoeTab T = moe_tables(tab, gcnt, 128);
        const int nunits = T.mtp[NE + 1] * 32;
        for (int u = bid; u < nunits; u += G) {
            const int mti = u >> 5, nt = u & 31; int e = 0; while (T.mtp[e + 1] <= mti) ++e;
            const int mt = mti - T.mtp[e], nrows = (T.cnt[e] - mt * 128) < 128 ? (T.cnt[e] - mt * 128) : 128;
            const float* Wd = (e < NE) ? p.in[I_WEXD] + (size_t)e * EFF * DM : p.in[I_WSHD];
            BPlain bc{Wd, DM, nt * 128, DM};
            const int hrow0 = T.offh[e] + mt * 128;
            auto epi = [&](int r, int c, const float (&v)[4]) {
                int tok; float g; if (e < NE) { tok = rowtok[e * CAP + mt * 128 + r]; g = rowgate[e * CAP + mt * 128 + r]; } else { tok = mt * 128 + r; g = 1.0f; }
                float* o = p.out + (size_t)tok * DM + nt * 128 + c;
                atomicAdd(o, v[0] * g); atomicAdd(o + 1, v[1] * g); atomicAdd(o + 2, v[2] * g); atomicAdd(o + 3, v[3] * g); };
            ngemm_tile<act_t>(ldsf, hh, EFF, nullptr, hrow0, nrows, EFF, bc, epi);
        }
    #endif
    }
    SEAM(16);
    if (IN(17)) REP(17) {
#if FAST_MOE
        for (int m = gw; m < NTOK; m += NGW) {
            const unsigned char* y8 = (const unsigned char*)ybuf + (size_t)m * 8 * DM;
#pragma unroll 2
            for (int j = 0; j < 4; ++j) { const int c0 = lane * 16 + 1024 * j;
                const bf16_t* sp = tb + (size_t)m * DM + c0; float* op = p.out + (size_t)m * DM + c0;
                f32x4 sv[4];
#pragma unroll
                for (int q = 0; q < 2; ++q) { const u32x4 t = __builtin_nontemporal_load((const u32x4*)(sp + 8 * q));
                    sv[2 * q] = (f32x4){__uint_as_float(t.x << 16), __uint_as_float(t.x & 0xffff0000u), __uint_as_float(t.y << 16), __uint_as_float(t.y & 0xffff0000u)};
                    sv[2 * q + 1] = (f32x4){__uint_as_float(t.z << 16), __uint_as_float(t.z & 0xffff0000u), __uint_as_float(t.w << 16), __uint_as_float(t.w & 0xffff0000u)}; }
                u32x4 y[9];
#pragma unroll
                for (int k = 0; k < 8; ++k) y[k] = __builtin_nontemporal_load((const u32x4*)(y8 + (size_t)k * DM + c0));
                y[8] = __builtin_nontemporal_load((const u32x4*)((const unsigned char*)ybuf + (size_t)NTOK * 8 * DM + (size_t)m * DM + c0));
                float a[16];
#pragma unroll
                for (int q = 0; q < 16; ++q) a[q] = 0.f;
#pragma unroll
                for (int k = 0; k < 9; ++k) {
#pragma unroll
                    for (int q = 0; q < 4; ++q) { const int w = (int)y[k][q]; const auto lo = __builtin_amdgcn_cvt_pk_f32_fp8(w, false); const auto hi2 = __builtin_amdgcn_cvt_pk_f32_fp8(w, true);
                        a[4 * q] += lo[0]; a[4 * q + 1] += lo[1]; a[4 * q + 2] += hi2[0]; a[4 * q + 3] += hi2[1]; } }
#pragma unroll
                for (int q = 0; q < 4; ++q) { f32x4 o; o.x = sv[q].x + a[4 * q] * (1.0f / fg::Y_SCALE); o.y = sv[q].y + a[4 * q + 1] * (1.0f / fg::Y_SCALE); o.z = sv[q].z + a[4 * q + 2] * (1.0f / fg::Y_SCALE); o.w = sv[q].w + a[4 * q + 3] * (1.0f / fg::Y_SCALE);
                    *(f32x4*)(op + 4 * q) = o; } }
        }
#endif
    }
#undef IN
#undef SEAM
}

#if TVAR
__global__ void __launch_bounds__(512, 2) probe_k(Params p) {
    extern __shared__ __attribute__((aligned(16))) unsigned char lds_raw[];
    const int tid = threadIdx.x, lane = tid & 63, wave = tid >> 6;
    p0_items<TVAR>(p, p.ws, (LAS float*)((LAS unsigned char*)lds_raw + wave * 16640), lane, blockIdx.x * 8 + wave, gridDim.x * 8);
}
#endif
typedef void (*kern_t)(Params);
template <int PH> struct KTab { static void fill(kern_t* t) { t[PH] = fwd<(1u << PH)>; KTab<PH - 1>::fill(t); } };
template <> struct KTab<-1> { static void fill(kern_t*) {} };
extern "C" void kernel_launch(void* const* d_in, const int* in_sizes, int n_in, void* d_out, int out_size, void* d_ws, size_t ws_size, hipStream_t stream) {
    static int grid = 0;
    static kern_t ktab[NPHASE + 1];
    if (grid == 0) {
        if (n_in != 31 || out_size != NTOK * DM || ws_size < WS_END) { fprintf(stderr, "kernel_launch: bad shapes n_in %d out %d ws %zu (need %zu)\n", n_in, out_size, ws_size, (size_t)WS_END); grid = -1; return; }
        int dev = 0, cus = 0;
        if (hipGetDevice(&dev) != hipSuccess || hipDeviceGetAttribute(&cus, hipDeviceAttributeMultiprocessorCount, dev) != hipSuccess) { grid = -1; return; }
#if N_LAUNCH_PER_PHASE
        KTab<NPHASE - 1>::fill(ktab);
#else
        ktab[NPHASE] = fwd<0xFFFFFFFFu>;
#endif
#if N_LAUNCH_PER_PHASE
        for (int i = 0; i < NPHASE; ++i)
#else
        for (int i = NPHASE; i <= NPHASE; ++i)
#endif
            if (hipFuncSetAttribute((const void*)ktab[i], hipFuncAttributeMaxDynamicSharedMemorySize, LDS_BYTES) != hipSuccess) { fprintf(stderr, "kernel_launch: hipFuncSetAttribute failed\n"); grid = -1; return; }
        (void)hipGetLastError();
        grid = cus;
    }
    if (grid < 0) return;
    (void)hipMemsetAsync((char*)d_ws + WS_CTL, 0, CTL_BYTES, stream);
    Params p{};
    for (int i = 0; i < 31; ++i) p.in[i] = (const float*)d_in[i];
    p.out = (float*)d_out; p.ws = (unsigned char*)d_ws;
#if TVAR
    { static int once = 0; if (!once) { (void)hipFuncSetAttribute((const void*)probe_k, hipFuncAttributeMaxDynamicSharedMemorySize, LDS_BYTES); once = 1; } p.ph_lo = 0; p.ph_hi = 0; hipLaunchKernelGGL(probe_k, dim3(grid), dim3(512), LDS_BYTES, stream, p); }
#endif
#if N_LAUNCH_PER_PHASE
    for (int ph = 0; ph < NPHASE; ++ph) { p.ph_lo = ph; p.ph_hi = ph + 1; hipLaunchKernelGGL(ktab[ph], dim3(grid), dim3(512), LDS_BYTES, stream, p); }
#else
    p.ph_lo = 0; p.ph_hi = NPHASE; hipLaunchKernelGGL(ktab[NPHASE], dim3(grid), dim3(512), LDS_BYTES, stream, p);
#endif
#ifdef PROBE_PH
#ifndef PROBE_VAR
#define PROBE_VAR 0
#endif
    (void)hipMemsetAsync((char*)d_ws + WS_CTL + (size_t)CW_QCONV * 4, 0, 1024, stream);
    (void)hipMemsetAsync((char*)d_ws + WS_CTL + (size_t)CW_QCONV * 4, 0, 1024, stream);
    p.ph_lo = PROBE_PH; p.ph_hi = PROBE_PH + 1; p.var = PROBE_VAR; hipLaunchKernelGGL(ktab[NPHASE], dim3(grid), dim3(512), LDS_BYTES, stream, p);
#endif
    const hipError_t le = hipPeekAtLastError();
    if (le != hipSuccess) fprintf(stderr, "kernel_launch: launch failed: %s\n", hipGetErrorName(le));
}
```

```cpp
#include <hip/hip_runtime.h>
#include <cstdio>
#include <cstdint>

#define LAS __attribute__((address_space(3)))
typedef unsigned short bf16_t;
typedef float f32x4 __attribute__((ext_vector_type(4)));
typedef short bf16x8 __attribute__((ext_vector_type(8)));
typedef unsigned u32x4 __attribute__((ext_vector_type(4)));
typedef unsigned u32x2 __attribute__((ext_vector_type(2)));
typedef int v4i_t __attribute__((ext_vector_type(4)));
typedef int v8i_t __attribute__((ext_vector_type(8)));
#ifndef FAST_GEMM
#define FAST_GEMM 1
#endif
#ifndef FAST_MOE
#define FAST_MOE 1
#endif
#ifndef FAST_ATTN
#define FAST_ATTN 1
#endif

#ifndef ACT_F32
#define ACT_F32 0
#endif
#if ACT_F32
typedef float act_t;
#else
typedef bf16_t act_t;
#endif
#ifndef N_LAUNCH_PER_PHASE
#define N_LAUNCH_PER_PHASE 0
#endif

constexpr int NB = 4, SEQ = 2048, DM = 4096, NTOK = NB * SEQ;
constexpr int CHUNK = 64, LEFT = 8, NREL = 192;
constexpr int HD = 128, HA = 16, HB = 16, QLORA = 1024, KVLORA = 512, QKB = 192;
constexpr int MEMT = 256, MH = 4, NE = 64, EFF = 512;
constexpr int WA = HA * HD;
constexpr int INW = 3 * WA + QLORA + KVLORA + 64;
constexpr int NMEM = NB * MEMT;
constexpr int C_Q0 = 0, C_K0 = WA, C_V0 = 2 * WA, C_CQ = 3 * WA, C_CKV = 3 * WA + QLORA, C_KPE = 3 * WA + QLORA + KVLORA;
constexpr float EPS = 1e-6f;
constexpr int CAP = NTOK;

constexpr size_t MiB = 1u << 20;
constexpr size_t AS = sizeof(act_t);
constexpr size_t al(size_t x) { return (x + 255) / 256 * 256; }
constexpr size_t WS_CTL = 0, CTL_BYTES = 1 * MiB;
constexpr size_t WS_ROWTOK = 1 * MiB, WS_ROWGATE = 3 * MiB, WS_ROWDST = 5 * MiB;
constexpr int PK(int K) { return K; }
constexpr int INWP = 7936;
constexpr size_t WS_WR = 8 * MiB;
constexpr size_t WS_WIN = 12 * MiB;
constexpr size_t WS_WUQ = WS_WIN + al((size_t)INWP * PK(DM) * 2);
constexpr size_t WS_WUKV = WS_WUQ + al((size_t)3072 * PK(QLORA) * 2);
constexpr size_t WS_WO = WS_WUKV + al((size_t)4096 * PK(KVLORA) * 2);
constexpr size_t WS_WXQ = WS_WO + al((size_t)DM * PK(DM) * 2);
constexpr size_t WS_WXKV = WS_WXQ + al((size_t)512 * PK(DM) * 2);
constexpr size_t WS_WXO = WS_WXKV + al((size_t)1024 * PK(DM) * 2);
constexpr size_t WS_WGU = WS_WXO + al((size_t)DM * PK(512) * 2);
constexpr size_t WS_WD = WS_WGU + al((size_t)65 * 1024 * DM);
constexpr size_t WS_T8 = WS_WD + al((size_t)65 * DM * EFF);
constexpr size_t WS_SSP1 = WS_T8 + al((size_t)NTOK * DM);
constexpr size_t WS_SSP2 = WS_SSP1 + (size_t)NTOK * 64 * 4;
constexpr size_t WS_RS2 = WS_SSP2 + (size_t)NTOK * 64 * 4;
constexpr size_t WS_X1 = WS_RS2 + al((size_t)NTOK * 4);
constexpr size_t WS_X2 = WS_X1 + al((size_t)NTOK * DM * 4);
constexpr size_t WS_T = WS_X2 + al((size_t)NTOK * DM * 4);
constexpr int HH_ROWS = NTOK * 8 + NE * 256 + NTOK;
constexpr size_t WS_HH = WS_T + al((size_t)NTOK * DM * AS);
constexpr size_t WS_Y = WS_HH + al((size_t)HH_ROWS * EFF * AS);
constexpr size_t WS_H = WS_Y;
constexpr size_t WS_MEMN = WS_H + al((size_t)NTOK * DM * AS);
constexpr size_t WS_P1 = WS_MEMN + al((size_t)NMEM * DM * AS);
constexpr size_t WS_KVM = WS_P1 + al((size_t)NTOK * INW * AS);
constexpr size_t WS_QB = WS_KVM + al((size_t)NMEM * 1024 * AS);
constexpr size_t WS_KVB = WS_QB + al((size_t)NTOK * 3072 * AS);
constexpr size_t WS_MIXED = WS_KVB + al((size_t)NTOK * 4096 * AS);
constexpr size_t WS_HC = WS_MIXED + al((size_t)NTOK * DM * AS);
constexpr size_t WS_QXP = WS_HC + al((size_t)NTOK * DM * AS);
constexpr size_t WS_QX = WS_QXP + al((size_t)4 * NTOK * 512 * 4);
constexpr size_t WS_OX = WS_QX + al((size_t)NTOK * 512 * AS);
constexpr size_t WS_END0 = WS_OX + al((size_t)NTOK * 512 * AS);
constexpr size_t WS_YEND = WS_Y + al((size_t)NTOK * 8 * DM * 2);
constexpr size_t WS_END = WS_END0 > WS_YEND ? WS_END0 : WS_YEND;
static_assert(WS_END <= 2147483648ull, "workspace map exceeds the guaranteed 2 GiB");
constexpr int CW_BAR = 4096;
constexpr int CW_CNT = 16384;
constexpr int CW_QCONV = 26624, CW_QB = 26688, CW_QA = 26752;
constexpr int CW_SS1 = 32768, CW_SS2 = 40960;
constexpr int CW_TICKET = 24576;

constexpr int LDS_BYTES = 163840;
constexpr int LDS_MISC = LDS_BYTES - 64;

__device__ __forceinline__ unsigned f2bf(float f) { unsigned u = __builtin_bit_cast(unsigned, f); return (u + 0x7fffu + ((u >> 16) & 1u)) >> 16; }
__device__ __forceinline__ float ldf(const float* p) { return *p; }
__device__ __forceinline__ float ldf(const bf16_t* p) { return __uint_as_float(((unsigned)*p) << 16); }
__device__ __forceinline__ void stf(float* p, float v) { *p = v; }
__device__ __forceinline__ void stf(bf16_t* p, float v) { *p = (bf16_t)f2bf(v); }
__device__ __forceinline__ float wave_sum(float v) {
#pragma unroll
    for (int o = 1; o < 64; o <<= 1) v += __shfl_xor(v, o);
    return v;
}

#define XB_TMO      128
#define XB_XCNT(j)  (256  + 64 * (j))
#define XB_XSUB(j)  (1280 + 64 * (j))
#define XB_XGEN(j)  (2304 + 64 * (j))
#define XB_TOP      3328
#define XB_TOPGEN   3392
#define XCD_BAR_WORDS 3456
#define XB_SPIN_CAP (1u << 18)
__device__ __forceinline__ unsigned xb_ld(unsigned* p)              { return __hip_atomic_load(p, __ATOMIC_RELAXED, __HIP_MEMORY_SCOPE_AGENT); }
__device__ __forceinline__ unsigned xb_add(unsigned* p, unsigned v) { return __hip_atomic_fetch_add(p, v, __ATOMIC_RELAXED, __HIP_MEMORY_SCOPE_AGENT); }
__device__ __forceinline__ unsigned xb_xcc_id() { return (unsigned)__builtin_amdgcn_s_getreg((3 << 11) | 20) & 0xFu; }
#define XB_SPIN(cond, bar) do { unsigned _sp = 0; while (cond) { __builtin_amdgcn_s_sleep(1); \
    if ((++_sp & 255u) == 0u) { if (xb_ld(&(bar)[XB_TMO])) break; if (_sp > XB_SPIN_CAP) { atomicAdd(&(bar)[XB_TMO], 1u); break; } } } } while (0)
struct XcdBarrier { unsigned* bar; unsigned x; volatile LAS unsigned* st; };
__device__ __forceinline__ XcdBarrier xcd_barrier_post(unsigned* bar, volatile LAS unsigned* st) {
    XcdBarrier b; b.bar = bar; b.x = xb_xcc_id(); b.st = st;
    if (threadIdx.x == 0) (void)xb_add(&bar[XB_XCNT(b.x)], 1u);
    return b;
}
__device__ __forceinline__ void xcd_barrier_complete(unsigned* bar, unsigned x, unsigned& nloc, unsigned& nx) {
    const unsigned G = gridDim.x * gridDim.y * gridDim.z;
    unsigned sum, cnt, mine, sp = 0u;
    for (;;) {
        sum = 0u; cnt = 0u; mine = 0u;
#pragma unroll
        for (unsigned j = 0; j < 16; ++j) { const unsigned c = xb_ld(&bar[XB_XCNT(j)]); sum += c; cnt += (c > 0u) ? 1u : 0u; mine = (j == x) ? c : mine; }
        if (sum == G) break;
        __builtin_amdgcn_s_sleep(1);
        if ((++sp & 255u) == 0u) { if (xb_ld(&bar[XB_TMO])) break; if (sp > XB_SPIN_CAP) { atomicAdd(&bar[XB_TMO], 1u); break; } }
    }
    nloc = mine > 0u ? mine : 1u; nx = cnt > 0u ? cnt : 1u;
}
__device__ __forceinline__ void xcd_barrier(const XcdBarrier& b) {
    asm volatile("s_waitcnt vmcnt(0)" ::: "memory");
    __syncthreads();
    if (threadIdx.x == 0) {
        unsigned* bar = b.bar;
        __builtin_amdgcn_s_waitcnt(0);
        unsigned nloc = b.st[0], nx = b.st[1];
        if (nloc == 0u) { xcd_barrier_complete(bar, b.x, nloc, nx); b.st[0] = nloc; b.st[1] = nx; }
        const unsigned old = xb_add(&bar[XB_XSUB(b.x)], 1u);
        const unsigned gen = old / nloc;
        if (old + 1u == (gen + 1u) * nloc) {
            __builtin_amdgcn_fence(__ATOMIC_RELEASE, "agent");
            asm volatile("s_waitcnt vmcnt(0)" ::: "memory");
            const unsigned og = xb_add(&bar[XB_TOP], 1u);
            const unsigned tg = og / nx;
            if (og + 1u == (tg + 1u) * nx) xb_add(&bar[XB_TOPGEN], 1u);
            else XB_SPIN(xb_ld(&bar[XB_TOPGEN]) == tg, bar);
            __builtin_amdgcn_fence(__ATOMIC_ACQUIRE, "agent");
            xb_add(&bar[XB_XGEN(b.x)], 1u);
            asm volatile("s_waitcnt vmcnt(0)" ::: "memory");
        } else {
            XB_SPIN(xb_ld(&bar[XB_XGEN(b.x)]) == gen, bar);
            __builtin_amdgcn_fence(__ATOMIC_ACQUIRE, "agent");
            asm volatile("s_waitcnt vmcnt(0)" ::: "memory");
        }
    }
    __syncthreads();
}

struct Params {
    const float* in[31];
    float* out;
    unsigned char* ws;
    int ph_lo, ph_hi, var, pad;
};
enum { I_X = 0, I_MEM, I_POS, I_GMIX, I_WIN, I_GQA, I_GKA, I_RELB, I_GCQ, I_WUQ, I_GCKV, I_WUKV, I_GQB, I_GKB, I_WO, I_GCROSS, I_GMEM, I_WXQ, I_WXKV,
       I_GQX, I_GKX, I_WXO, I_GFFN, I_WROUTER, I_RBIAS, I_WSHG, I_WSHU, I_WSHD, I_WEXG, I_WEXU, I_WEXD };

template <class OT>
__device__ __forceinline__ void rms_row_4096(const float* x, const float* g, OT* o, int lane, float* keep  ) {
    f32x4 v[16]; float s = 0.f;
#pragma unroll
    for (int j = 0; j < 16; ++j) { v[j] = ((const f32x4*)x)[lane + 64 * j]; s += v[j].x * v[j].x + v[j].y * v[j].y + v[j].z * v[j].z + v[j].w * v[j].w; }
    s = wave_sum(s);
    const float r = 1.0f / sqrtf(s * (1.0f / 4096.f) + EPS);
#pragma unroll
    for (int j = 0; j < 16; ++j) v[j] = v[j] * r * __builtin_nontemporal_load((const f32x4*)g + lane + 64 * j);
    asm volatile("s_waitcnt vmcnt(0)" ::: "memory");
#pragma unroll
    for (int j = 0; j < 16; ++j) {
        const f32x4 y = v[j];
        const int c = (lane + 64 * j) * 4;
        stf(o + c, y.x); stf(o + c + 1, y.y); stf(o + c + 2, y.z); stf(o + c + 3, y.w);
        if (keep) { keep[c] = y.x; keep[c + 1] = y.y; keep[c + 2] = y.z; keep[c + 3] = y.w; }
    }
}
template <int N>
__device__ __forceinline__ void rms_inplace(act_t* p, const float* g, int lane) {
    float v[N / 64]; float s = 0.f;
#pragma unroll
    for (int j = 0; j < N / 64; ++j) { v[j] = ldf(p + lane + 64 * j); s += v[j] * v[j]; }
    s = wave_sum(s);
    const float r = 1.0f / sqrtf(s * (1.0f / N) + EPS);
#pragma unroll
    for (int j = 0; j < N / 64; ++j) stf(p + lane + 64 * j, v[j] * r * g[lane + 64 * j]);
}
__device__ __forceinline__ void rms_rope64_inplace(act_t* p, const float* g, int pos, int lane) {
    float v = ldf(p + lane);
    float s = wave_sum(v * v);
    const float r = 1.0f / sqrtf(s * (1.0f / 64.f) + EPS);
    v = v * r * g[lane];
    const int fi = lane & 31;
    const float inv_freq = powf(10000.0f, -(float)(2 * fi) / 64.0f);
    const float ang = (float)pos * inv_freq;
    float sn, cs; sincosf(ang, &sn, &cs);
    const float other = __shfl_xor(v, 32);
    const float y = (lane < 32) ? (v * cs - other * sn) : (v * cs + other * sn);
    stf(p + lane, y);
}

template <class AT, class BCol, class Epi>
__device__ __forceinline__ void ngemm_tile(float* lds, const AT* A, long lda, const int* rowlist, int row0, int nrows, int K, const BCol& bcol, const Epi& epi) {
    const int tid = threadIdx.x, tx = tid & 31, ty = tid >> 5;
    float* As = lds; float* Bs = lds + 16 * 132;
    const int arow = tid >> 2, akq = (tid & 3) * 4;
    int grow; { const int rr = (arow < nrows) ? arow : 0; grow = rowlist ? rowlist[row0 + rr] : (row0 + rr); }
    const AT* Ap = A + (long)grow * lda + akq;
    const int bj = tid & 127, bk = tid >> 7;
    const float* Bp = bcol(bj) + (long)bk * bcol.ldb;
    float acc[8][4];
#pragma unroll
    for (int i = 0; i < 8; ++i)
#pragma unroll
        for (int j = 0; j < 4; ++j) acc[i][j] = 0.f;
    for (int k0 = 0; k0 < K; k0 += 16) {
        float a0 = ldf(Ap + k0), a1 = ldf(Ap + k0 + 1), a2 = ldf(Ap + k0 + 2), a3 = ldf(Ap + k0 + 3);
        float b0 = Bp[(long)(k0) * bcol.ldb], b1 = Bp[(long)(k0 + 4) * bcol.ldb], b2 = Bp[(long)(k0 + 8) * bcol.ldb], b3 = Bp[(long)(k0 + 12) * bcol.ldb];
        __syncthreads();
        As[(akq + 0) * 132 + arow] = a0; As[(akq + 1) * 132 + arow] = a1; As[(akq + 2) * 132 + arow] = a2; As[(akq + 3) * 132 + arow] = a3;
        Bs[(bk + 0) * 132 + bj] = b0; Bs[(bk + 4) * 132 + bj] = b1; Bs[(bk + 8) * 132 + bj] = b2; Bs[(bk + 12) * 132 + bj] = b3;
        __syncthreads();
#pragma unroll
        for (int kk = 0; kk < 16; ++kk) {
            const f32x4 al = *(const f32x4*)(As + kk * 132 + ty * 8), ah = *(const f32x4*)(As + kk * 132 + ty * 8 + 4);
            const f32x4 b = *(const f32x4*)(Bs + kk * 132 + tx * 4);
            const float a[8] = {al.x, al.y, al.z, al.w, ah.x, ah.y, ah.z, ah.w};
#pragma unroll
            for (int i = 0; i < 8; ++i) { acc[i][0] += a[i] * b.x; acc[i][1] += a[i] * b.y; acc[i][2] += a[i] * b.z; acc[i][3] += a[i] * b.w; }
        }
    }
    __syncthreads();
#pragma unroll
    for (int i = 0; i < 8; ++i) { const int r = ty * 8 + i; if (r < nrows) epi(r, tx * 4, acc[i]); }
}
struct BGU { const float* Wg; const float* Wu; int ldb; int ff0; __device__ __forceinline__ const float* operator()(int j) const { const int ff = ff0 + (j >> 2) * 2 + (j & 1); const uintptr_t a = (uintptr_t)Wg, b = (uintptr_t)Wu; return (const float*)((j & 2) ? b : a) + ff; } };
struct BPlain { const float* B; int ldb; int col0, ncols; __device__ __forceinline__ const float* operator()(int j) const { const int c = col0 + j; return B + (c < ncols ? c : 0); } };

template <int DQK, class KeyTile, class Bias>
__device__ __forceinline__ void nattn_unit(float* lds, const act_t* Q, long ldq, const act_t* K1, long ldk1, const act_t* K2, long ldk2, const act_t* V, long ldv,
                                           int ntiles, const KeyTile& keytile, float scale, const Bias& bias, act_t* O, long ldo) {
    constexpr int QS = DQK + 4;
    float* Qs = lds; float* Ks = Qs + 64 * QS; float* Vs = Ks + 64 * QS; float* Ss = Vs + 64 * 132;
    const int tid = threadIdx.x, r = tid >> 3, s = tid & 7;
    __syncthreads();
    for (int idx = tid; idx < 64 * DQK; idx += 512) { const int row = idx / DQK, d = idx % DQK; Qs[row * QS + d] = ldf(Q + (long)row * ldq + d); }
    float m = -INFINITY, l = 0.f; float o[16];
#pragma unroll
    for (int d = 0; d < 16; ++d) o[d] = 0.f;
    for (int t = 0; t < ntiles; ++t) {
        const int k0 = keytile(t);
        __syncthreads();
        for (int idx = tid; idx < 64 * 128; idx += 512) { const int row = idx >> 7, d = idx & 127;
            Ks[row * QS + d] = ldf(K1 + (long)(k0 + row) * ldk1 + d); Vs[row * 132 + d] = ldf(V + (long)(k0 + row) * ldv + d); }
        if (DQK > 128) for (int idx = tid; idx < 64 * (DQK - 128); idx += 512) { const int row = idx / (DQK - 128), d = idx % (DQK - 128);
            Ks[row * QS + 128 + d] = ldf(K2 + (long)(k0 + row) * ldk2 + d); }
        __syncthreads();
#pragma unroll
        for (int jj = 0; jj < 8; ++jj) { const int key = s + 8 * jj; float dot = 0.f;
#pragma unroll 8
            for (int d = 0; d < DQK; d += 4) { const f32x4 q = *(const f32x4*)(Qs + r * QS + d), k = *(const f32x4*)(Ks + key * QS + d); dot += q.x * k.x + q.y * k.y + q.z * k.z + q.w * k.w; }
            Ss[r * 65 + key] = dot * scale + bias(r, t, key); }
        __syncthreads();
        float mt = -INFINITY;
        for (int k = 0; k < 64; ++k) mt = fmaxf(mt, Ss[r * 65 + k]);
        const float mn = fmaxf(m, mt), alpha = expf(m - mn);
        float ladd = 0.f;
#pragma unroll
        for (int d = 0; d < 16; ++d) o[d] *= alpha;
        for (int k = 0; k < 64; ++k) { const float pk = expf(Ss[r * 65 + k] - mn); ladd += pk;
#pragma unroll
            for (int d = 0; d < 16; d += 4) { const f32x4 v = *(const f32x4*)(Vs + k * 132 + s * 16 + d); o[d] += pk * v.x; o[d + 1] += pk * v.y; o[d + 2] += pk * v.z; o[d + 3] += pk * v.w; } }
        m = mn; l = l * alpha + ladd;
    }
    const float il = 1.0f / l;
#pragma unroll
    for (int d = 0; d < 16; ++d) stf(O + (long)r * ldo + s * 16 + d, o[d] * il);
}

struct MoeTab { int* cnt; int* mtp; int* offh; };
__device__ __forceinline__ MoeTab moe_tables(int* tab, const unsigned* gcnt, int tile_m) {
    MoeTab T; T.cnt = tab; T.mtp = tab + 80; T.offh = tab + 160;
    __syncthreads();
    if (threadIdx.x == 0) {
        int pm = 0, po = 0;
        for (int e = 0; e <= NE; ++e) { const int c = (e < NE) ? (int)gcnt[e] : NTOK; T.cnt[e] = c; T.mtp[e] = pm; T.offh[e] = po; pm += (c + tile_m - 1) / tile_m; po += c; }
        T.mtp[NE + 1] = pm;
    }
    __syncthreads();
    return T;
}

namespace fg {
constexpr int BM = 256, BK = 64, HALF = 128, HTB = HALF * BK * 2, STAGE_BYTES = 8 * HTB;
__device__ __forceinline__ int lds_byte(int r, int c) { const int st = (r >> 4) * 2 + (c >> 5), rr = r & 15, cc = c & 31, ob = rr * 64 + cc * 2; return st * 1024 + (ob ^ (((ob >> 9) & 1) << 5)); }
__device__ __forceinline__ void stage_rc(int b, int& R, int& C) { const int st = b / 1024, sb = b % 1024, swz = sb ^ (((sb >> 9) & 1) << 5); R = (st >> 1) * 16 + swz / 64; C = (st & 1) * 32 + (swz % 64) / 2; }
__device__ __forceinline__ int perm32(int rho) { const int n = rho >> 4, i = rho & 15; return 8 * (i >> 2) + 4 * n + (i & 3); }
__device__ __forceinline__ unsigned cvt_pk_bf16(float lo, float hi) { unsigned r; asm volatile("v_cvt_pk_bf16_f32 %0, %1, %2" : "=v"(r) : "v"(lo), "v"(hi)); return r; }

__device__ __forceinline__ unsigned pk4_fp8(float a, float b, float c, float d) { int w = 0; w = __builtin_amdgcn_cvt_pk_fp8_f32(a, b, w, false); w = __builtin_amdgcn_cvt_pk_fp8_f32(c, d, w, true); return (unsigned)w; }
constexpr float H_SCALE = 4.0f, WD_SCALE = 32.0f, WGU_SCALE = 64.0f, T_SCALE = 2.0f, Y_SCALE = 16.0f;
struct Unit { const char* A; const char* B; const int* rows; int nkt, nvalid, pm, pn, e, arow0; };

template <class Epi, class Sched, bool GATHER, bool FP8 = false, bool SP2 = false>
__device__ __forceinline__ void gemm_phase(LAS unsigned char* lds, const Sched& S, const Epi& E, const int lda, const int ldb, const int var_in = 0) {
#ifdef PROBE_PH
    const int var = var_in;
#else
    constexpr int var = 0; (void)var_in;
#endif
    int tid = threadIdx.x; asm volatile("" : "+v"(tid));
    const int wid = __builtin_amdgcn_readfirstlane(tid >> 6), lane = tid & 63, wr = wid >> 2, wc = wid & 3, fr = lane & 15, fq = lane >> 4;
    unsigned voffB[2][2], voffA[2][2];
#pragma unroll
    for (int i = 0; i < 2; ++i) { int sR, sC; stage_rc(tid * 16 + i * 8192, sR, sC);
#pragma unroll
        for (int hb = 0; hb < 2; ++hb) { int Rb;
            if (Epi::PERM == 2) Rb = 64 * (sR >> 5) + 16 * ((sR >> 2) & 3) + 8 * hb + 4 * ((sR >> 4) & 1) + (sR & 3);
            else Rb = 128 * hb + (Epi::PERM == 1 ? ((sR & ~31) + perm32(sR & 31)) : sR);
            voffB[hb][i] = (unsigned)((Rb >> 6) * ldb * 64 + (Rb & 63) * 64 + sC) * 2u; }
#pragma unroll
        for (int h = 0; h < 2; ++h) voffA[h][i] = (unsigned)((sR + HALF * h) * lda + sC) * 2u; }
    const size_t kstep = (size_t)(BK * 2), kstepB = 8192;
    const unsigned ldsw = (unsigned)wid * 1024u;
    const int aoff = FP8 ? lds_byte(wr * 64 + fr, fq * 16) : lds_byte(wr * 64 + fr, fq * 8), boff = FP8 ? lds_byte(wc * 32 + fr, fq * 16) : lds_byte(wc * 32 + fr, fq * 8);
#define FG_SA(b, h) (((b) * 2 + (h)) * HTB)
#define FG_SB(b, h) ((4 + (b) * 2 + (h)) * HTB)
#define FG_STAGE2(bufoff, gbase, v0, v1) do { \
        __builtin_amdgcn_global_load_lds((const unsigned*)((const char*)(gbase) + (v0)), (LAS unsigned*)(lds + (bufoff) + ldsw), 16, 0, 0); \
        __builtin_amdgcn_global_load_lds((const unsigned*)((const char*)(gbase) + (v1)), (LAS unsigned*)(lds + (bufoff) + ldsw + 8192), 16, 0, 0); } while (0)
#define FG_STAGEB(bufoff, gbase, hb) FG_STAGE2(bufoff, gbase, voffB[hb][0], voffB[hb][1])
#define FG_STAGEA(bufoff, gbase, h) FG_STAGE2(bufoff, gbase, voffA[h][0], voffA[h][1])
#define FG_LD8(base_) __builtin_shufflevector(*(const LAS v4i_t*)(base_), *(const LAS v4i_t*)((base_) + 16), 0, 1, 2, 3, 4, 5, 6, 7)
#define FG_LDA(dst, b, h) do { if (FP8) { _Pragma("unroll") for (int m = 0; m < 4; ++m) dst##8[m] = FG_LD8(lds + FG_SA(b, h) + aoff + m * 2048); } \
      else { _Pragma("unroll") for (int m = 0; m < 4; ++m) _Pragma("unroll") for (int k = 0; k < 2; ++k) dst[m][k] = *(const LAS bf16x8*)(lds + FG_SA(b, h) + aoff + m * 2048 + k * 1024); } } while (0)
#define FG_LDB(dst, b, h) do { if (FP8) { _Pragma("unroll") for (int n = 0; n < 2; ++n) dst##8[n] = FG_LD8(lds + FG_SB(b, h) + boff + n * 2048); } \
      else { _Pragma("unroll") for (int n = 0; n < 2; ++n) _Pragma("unroll") for (int k = 0; k < 2; ++k) dst[n][k] = *(const LAS bf16x8*)(lds + FG_SB(b, h) + boff + n * 2048 + k * 1024); } } while (0)
#define FG_MMA(ai, bj, At, Bt) do { __builtin_amdgcn_s_setprio(1); if (FP8) { _Pragma("unroll") for (int m = 0; m < 4; ++m) _Pragma("unroll") for (int n = 0; n < 2; ++n) \
        asm volatile("v_mfma_scale_f32_16x16x128_f8f6f4 %0, %1, %2, %0, %3, %3 op_sel_hi:[0,0,0]" : "+v"(acc[ai][bj][m][n]) : "v"(Bt##8[n]), "v"(At##8[m]), "v"(sc127)); } \
      else { _Pragma("unroll") for (int m = 0; m < 4; ++m) _Pragma("unroll") for (int n = 0; n < 2; ++n) _Pragma("unroll") for (int k = 0; k < 2; ++k) \
        acc[ai][bj][m][n] = __builtin_amdgcn_mfma_f32_16x16x32_bf16(Bt[n][k], At[m][k], acc[ai][bj][m][n], 0, 0, 0); } __builtin_amdgcn_s_setprio(0); } while (0)
#define FG_WAIT_V(n) asm volatile("s_waitcnt vmcnt(" #n ")" ::: "memory")
#define FG_WAIT_L(n) asm volatile("s_waitcnt lgkmcnt(" #n ")" ::: "memory")
#define FG_BAR __builtin_amdgcn_s_barrier()
#define FG_SCHED __builtin_amdgcn_sched_barrier(0)
#define FG_GATHER(dst, u) do { if (GATHER) { int tz = threadIdx.x; asm volatile("" : "+v"(tz)); _Pragma("unroll") for (int i = 0; i < 2; ++i) { int sR, sC; stage_rc(tz * 16 + i * 8192, sR, sC); \
        _Pragma("unroll") for (int h = 0; h < 2; ++h) { int rr = sR + HALF * h; rr = rr < (u).nvalid ? rr : 0; const int tok = (u).rows ? (u).rows[rr] : ((u).arow0 + rr); dst[h][i] = (unsigned)(tok * lda + sC) * 2u; } } } } while (0)
    Unit cur, nxt; int ui = 0;
    if (!S.next(0, cur)) return;
    f32x4 acc[2][2][4][2];
#pragma unroll
    for (int a = 0; a < 2; ++a)
#pragma unroll
        for (int b = 0; b < 2; ++b)
#pragma unroll
            for (int m = 0; m < 4; ++m)
#pragma unroll
                for (int n = 0; n < 2; ++n) acc[a][b][m][n] = (f32x4){0.f, 0.f, 0.f, 0.f};
    const int sc127 = 127;
    bf16x8 At[4][2], B0[2][2], B1[2][2]; v8i_t At8[4], B08[2], B18[2];
    const char* cA = cur.A; const char* cB = cur.B;
    typename Epi::Pre pre; E.prefetch(pre, cur, wr, fr);
    FG_GATHER(voffA, cur);
    if (SP2) {
    FG_STAGEB(FG_SB(0, 0), cB, 0); FG_STAGEB(FG_SB(0, 1), cB, 1); FG_STAGEA(FG_SA(0, 0), cA, 0); FG_STAGEA(FG_SA(0, 1), cA, 1);
    if (wr == 1) FG_BAR;
    FG_WAIT_V(2); FG_BAR;
    FG_STAGEB(FG_SB(1, 0), cB + kstepB, 0); FG_STAGEA(FG_SA(1, 0), cA + kstep, 0); FG_STAGEB(FG_SB(1, 1), cB + kstepB, 1);
    FG_WAIT_V(6); FG_BAR;
    } else {
    FG_STAGEB(FG_SB(0, 0), cB, 0); FG_STAGEA(FG_SA(0, 0), cA, 0); FG_STAGEB(FG_SB(0, 1), cB, 1); FG_STAGEA(FG_SA(0, 1), cA, 1);
    if (wr == 1) FG_BAR;
    FG_WAIT_V(4); FG_BAR;
    FG_STAGEB(FG_SB(1, 0), cB + kstepB, 0); FG_STAGEA(FG_SA(1, 0), cA + kstep, 0); FG_STAGEB(FG_SB(1, 1), cB + kstepB, 1);
    FG_WAIT_V(6); FG_BAR;
    }
    for (;;) {
        const bool has_next = S.next(ui + 1, nxt);
        const char* nA = has_next ? nxt.A : cA; const char* nB = has_next ? nxt.B : cB;
        const int nt = cur.nkt;
#pragma unroll 1
        for (int t = 0; t < nt; t += 2) {
            const bool last = (t == nt - 2);
            const char* a1 = cA + (size_t)(t + 1) * kstep;
            const char* a2 = last ? nA : cA + (size_t)(t + 2) * kstep; const char* b2 = last ? nB : cB + (size_t)(t + 2) * kstepB;
            const char* a3 = a2 + kstep; const char* b3 = b2 + kstepB;
            if (SP2) {
            FG_LDB(B0, 0, 0); FG_LDB(B1, 0, 1); FG_SCHED; FG_LDA(At, 0, 0); FG_STAGEA(FG_SA(1, 1), a1, 1);
            if (GATHER && last && has_next) { FG_GATHER(voffA, nxt); }
            FG_WAIT_V(8); FG_WAIT_L(0); FG_BAR; FG_MMA(0, 0, At, B0); FG_MMA(0, 1, At, B1); FG_BAR; FG_SCHED;
            FG_LDA(At, 0, 1); FG_STAGEB(FG_SB(0, 0), b2, 0); FG_STAGEB(FG_SB(0, 1), b2, 1); FG_STAGEA(FG_SA(0, 0), a2, 0);
            FG_WAIT_V(8); FG_WAIT_L(0); FG_BAR; FG_MMA(1, 0, At, B0); FG_MMA(1, 1, At, B1); FG_BAR; FG_SCHED;
            FG_LDB(B0, 1, 0); FG_LDB(B1, 1, 1); FG_SCHED; FG_LDA(At, 1, 0); FG_STAGEA(FG_SA(0, 1), a2, 1);
            FG_WAIT_V(8); FG_WAIT_L(0); FG_BAR; FG_MMA(0, 0, At, B0); FG_MMA(0, 1, At, B1); FG_BAR; FG_SCHED;
            FG_LDA(At, 1, 1); FG_STAGEB(FG_SB(1, 0), b3, 0); FG_STAGEB(FG_SB(1, 1), b3, 1); FG_STAGEA(FG_SA(1, 0), a3, 0);
            FG_WAIT_V(8); FG_WAIT_L(0); FG_BAR; FG_MMA(1, 0, At, B0); FG_MMA(1, 1, At, B1); FG_BAR; FG_SCHED;
            } else {
            FG_LDB(B0, 0, 0); FG_SCHED; FG_LDA(At, 0, 0); FG_STAGEA(FG_SA(1, 1), a1, 1);
            if (GATHER && last && has_next) { FG_GATHER(voffA, nxt); }
            FG_WAIT_L(8); FG_BAR; FG_WAIT_L(0); if (var < 4) FG_MMA(0, 0, At, B0); FG_BAR; FG_SCHED;
            FG_LDB(B1, 0, 1); FG_STAGEB(FG_SB(0, 0), b2, 0);
            FG_BAR; FG_WAIT_L(0); if (var < 3) FG_MMA(0, 1, At, B1); FG_BAR;
            FG_LDA(At, 0, 1); FG_STAGEA(FG_SA(0, 0), a2, 0);
            FG_BAR; FG_WAIT_L(0); if (var < 4) FG_MMA(1, 0, At, B0); FG_BAR; FG_SCHED;
            FG_STAGEB(FG_SB(0, 1), b2, 1);
            FG_WAIT_V(6); FG_BAR; if (var < 3) FG_MMA(1, 1, At, B1); FG_BAR;
            FG_LDB(B0, 1, 0); FG_SCHED; FG_LDA(At, 1, 0); FG_STAGEA(FG_SA(0, 1), a2, 1);
            FG_WAIT_L(8); FG_BAR; FG_WAIT_L(0); if (var < 4) FG_MMA(0, 0, At, B0); FG_BAR; FG_SCHED;
            FG_LDB(B1, 1, 1); FG_STAGEB(FG_SB(1, 0), b3, 0);
            FG_BAR; FG_WAIT_L(0); if (var < 3) FG_MMA(0, 1, At, B1); FG_BAR;
            FG_LDA(At, 1, 1); FG_STAGEA(FG_SA(1, 0), a3, 0);
            FG_BAR; FG_WAIT_L(0); if (var < 4) FG_MMA(1, 0, At, B0); FG_BAR; FG_SCHED;
            FG_STAGEB(FG_SB(1, 1), b3, 1);
            FG_WAIT_V(6); FG_BAR; if (var < 3) FG_MMA(1, 1, At, B1); FG_BAR;
                    }
}
        if (SP2) { if (wr == 0) FG_BAR; }
        { int tz = threadIdx.x; asm volatile("" : "+v"(tz));
          const int wz = __builtin_amdgcn_readfirstlane(tz >> 6), lz = tz & 63; if (var != 2 && var != 9) E(acc, cur, wz >> 2, wz & 3, lz & 15, lz >> 4, pre); }
        if (!has_next) break;
#pragma unroll
        for (int a = 0; a < 2; ++a)
#pragma unroll
            for (int b = 0; b < 2; ++b)
#pragma unroll
                for (int m = 0; m < 4; ++m)
#pragma unroll
                    for (int n = 0; n < 2; ++n) acc[a][b][m][n] = (f32x4){0.f, 0.f, 0.f, 0.f};
        cur = nxt; cA = nA; cB = nB; ++ui;
        { int tz = threadIdx.x; asm volatile("" : "+v"(tz)); E.prefetch(pre, cur, __builtin_amdgcn_readfirstlane(tz >> 6) >> 2, tz & 15); }
        if (SP2) { if (wr == 1) FG_BAR; }
    }
    FG_WAIT_V(0);
    if (!SP2) { if (wr == 0) FG_BAR; }
    FG_BAR;
#undef FG_SA
#undef FG_SB
#undef FG_STAGE2
#undef FG_STAGEB
#undef FG_STAGEA
#undef FG_STAGEAX
#undef FG_LDA
#undef FG_LDB
#undef FG_MMA
#undef FG_LD8
#undef FG_WAIT_V
#undef FG_WAIT_L
#undef FG_BAR
#undef FG_SCHED
#undef FG_GATHER
}

struct DenseSched {
    const char* A; const char* B; int lda, ldb, nM, nN, nS, nkt, G, c, first;
    __device__ __forceinline__ bool next(int i, Unit& u) const {
        const int total = nM * nN * nS; const int per = (total + 7) / 8;
        int L;
        if (first == 1) {
            const int x = c & 7, r = c >> 3; if (r >= 16) { if (i >= 3) return false; L = x * 64 + (r - 16) * 3 + i; } else { if (i >= 1) return false; L = x * 64 + 48 + r; }
        } else {
        const int j = i * G + c; const int x = j & 7, q = j >> 3;
        if (q >= per) return false; L = x * per + q; if (L >= total) return false; }
        const int ks = L % nS, t2 = L / nS;
        const int nig = 8 * nN, gid = t2 / nig, fm = gid * 8, gsz = (nM - fm) < 8 ? (nM - fm) : 8;
        const int pm = fm + (t2 % nig) % gsz, pn = (t2 % nig) / gsz;
        u.A = A + ((size_t)pm * BM * lda + (size_t)ks * nkt * BK) * 2; u.B = B + ((size_t)pn * BM * ldb + (size_t)ks * nkt * 4096) * 2;
        if (first == 2) { u.A = A; u.B = B; }
        u.rows = nullptr; u.nkt = nkt; u.nvalid = BM; u.pm = pm; u.pn = pn; u.e = ks; u.arow0 = pm * BM; return true;
    }
};
struct NoPre {};
struct EpiBf16 {
    static constexpr int PERM = 1; typedef NoPre Pre; __device__ __forceinline__ void prefetch(Pre&, const Unit&, int, int) const {}
    bf16_t* O; int ldc, ncols; float scale;
    __device__ __forceinline__ void operator()(const f32x4 (&acc)[2][2][4][2], const Unit& u, int wr, int wc, int fr, int fq, const Pre& pre) const {
        const int row0 = u.pm * BM + wr * 64 + fr, col0 = u.pn * BM + wc * 32 + 8 * fq;
#pragma unroll
        for (int ai = 0; ai < 2; ++ai)
#pragma unroll
            for (int m = 0; m < 4; ++m) { bf16_t* rowp = O + (size_t)(row0 + ai * HALF + m * 16) * ldc + col0;
#pragma unroll
                for (int bj = 0; bj < 2; ++bj) { const f32x4 v0 = acc[ai][bj][m][0] * scale, v1 = acc[ai][bj][m][1] * scale;
                    u32x4 w; w.x = cvt_pk_bf16(v0[0], v0[1]); w.y = cvt_pk_bf16(v0[2], v0[3]); w.z = cvt_pk_bf16(v1[0], v1[1]); w.w = cvt_pk_bf16(v1[2], v1[3]);
                    if (col0 + bj * HALF + 8 <= ncols) *(u32x4*)(rowp + bj * HALF) = w; } }
    }
};
struct EpiBf16N {
    static constexpr int PERM = 1; typedef NoPre Pre; __device__ __forceinline__ void prefetch(Pre&, const Unit&, int, int) const {}
    bf16_t* O; int ldc, ncols; float scale;
    const float* gA; int pnA_end; const float* gB; int pnB_end; int half0_only; LAS float* part;
    __device__ __forceinline__ void operator()(const f32x4 (&acc)[2][2][4][2], const Unit& u, int wr, int wc, int fr, int fq, const Pre& pre) const {
        const int rt0 = wr * 64 + fr, row0 = u.pm * BM + rt0, col0 = u.pn * BM + wc * 32 + 8 * fq;
        const bool do_norm = u.pn < pnB_end;
        if (do_norm) {
#pragma unroll
            for (int ai = 0; ai < 2; ++ai)
#pragma unroll
                for (int m = 0; m < 4; ++m)
#pragma unroll
                    for (int bj = 0; bj < 2; ++bj) { if (half0_only && bj == 1) continue;
                        const f32x4 v0 = acc[ai][bj][m][0] * scale, v1 = acc[ai][bj][m][1] * scale;
                        float ss = (v0.x * v0.x + v0.y * v0.y) + (v0.z * v0.z + v0.w * v0.w) + (v1.x * v1.x + v1.y * v1.y) + (v1.z * v1.z + v1.w * v1.w);
                        ss += __shfl_xor(ss, 16); ss += __shfl_xor(ss, 32);
                        if (fq == 0) part[((rt0 + ai * HALF + m * 16) * 2 + bj) * 4 + wc] = ss; }
            asm volatile("s_waitcnt lgkmcnt(0)" ::: "memory"); __builtin_amdgcn_s_barrier(); asm volatile("" ::: "memory");
        }
        const float* g = (u.pn < pnA_end) ? gA : gB;
        f32x4 g0 = (f32x4){1.f, 1.f, 1.f, 1.f}, g1 = g0;
        if (do_norm) { g0 = *(const f32x4*)(g + wc * 32 + 8 * fq); g1 = *(const f32x4*)(g + wc * 32 + 8 * fq + 4); }
#pragma unroll
        for (int ai = 0; ai < 2; ++ai)
#pragma unroll
            for (int m = 0; m < 4; ++m) { const int rt = rt0 + ai * HALF + m * 16; bf16_t* rowp = O + (size_t)(row0 + ai * HALF + m * 16) * ldc + col0;
#pragma unroll
                for (int bj = 0; bj < 2; ++bj) { f32x4 v0 = acc[ai][bj][m][0] * scale, v1 = acc[ai][bj][m][1] * scale;
                    if (do_norm && !(half0_only && bj == 1)) { const f32x4 p4 = *(const LAS f32x4*)(part + (rt * 2 + bj) * 4);
                        const float r = 1.0f / sqrtf(((p4.x + p4.y) + (p4.z + p4.w)) * (1.0f / 128.f) + 1e-6f); v0 = v0 * r * g0; v1 = v1 * r * g1; }
                    u32x4 w; w.x = cvt_pk_bf16(v0[0], v0[1]); w.y = cvt_pk_bf16(v0[2], v0[3]); w.z = cvt_pk_bf16(v1[0], v1[1]); w.w = cvt_pk_bf16(v1[2], v1[3]);
                    if (col0 + bj * HALF + 8 <= ncols) *(u32x4*)(rowp + bj * HALF) = w; } }
    }
};
template <bool HAS_RES> struct EpiF32Res {
    static constexpr int PERM = 0; typedef NoPre Pre; __device__ __forceinline__ void prefetch(Pre&, const Unit&, int, int) const {}
    float* __restrict__ C; const float* __restrict__ res; int ldc; size_t slab; float scale;
    __device__ __forceinline__ void operator()(const f32x4 (&acc)[2][2][4][2], const Unit& u, int wr, int wc, int fr, int fq, const Pre& pre) const {
        const int row0 = u.pm * BM + wr * 64 + fr, col0 = u.pn * BM + wc * 32 + 4 * fq;
        float* __restrict__ Cb = C + (size_t)u.e * slab;
#pragma unroll
        for (int ai = 0; ai < 2; ++ai) {
            f32x4 r[4][2][2];
            if (HAS_RES) {
#pragma unroll
                for (int m = 0; m < 4; ++m) { const size_t o = (size_t)(row0 + ai * HALF + m * 16) * ldc + col0;
#pragma unroll
                    for (int bj = 0; bj < 2; ++bj)
#pragma unroll
                        for (int n = 0; n < 2; ++n) r[m][bj][n] = __builtin_nontemporal_load((const f32x4*)(res + o + bj * HALF + n * 16)); }
            }
#pragma unroll
            for (int m = 0; m < 4; ++m) { const size_t o = (size_t)(row0 + ai * HALF + m * 16) * ldc + col0;
#pragma unroll
                for (int bj = 0; bj < 2; ++bj)
#pragma unroll
                    for (int n = 0; n < 2; ++n) { f32x4 v = acc[ai][bj][m][n] * scale; if (HAS_RES) v = v + r[m][bj][n]; *(f32x4*)(Cb + o + bj * HALF + n * 16) = v; } }
        }
    }
};
struct MoeTabs { const LAS int* cnt; const LAS int* mtp; };
template <int PHASE  >
struct MoeSched {
    MoeTabs T; const char* A; const char* B; const int* rowtok; int G, c;
    __device__ __forceinline__ bool next(int i, Unit& u) const {
        constexpr int NT = (PHASE == 1) ? 4 : 16;
        const int nm = T.mtp[(PHASE == 1) ? 65 : 64], total = nm * NT, per = (total + 7) / 8;
        const int j = i * G + c, x = j & 7, q = j >> 3;
        if (q >= per) return false; const int L = x * per + q; if (L >= total) return false;
        int mti, pn;
        if (PHASE == 1) { mti = L / NT; pn = L % NT; }
        else { mti = L / NT; pn = 0; }
        int e = 0;
#pragma unroll 1
        for (int s2 = 32; s2 >= 1; s2 >>= 1) { if (e + s2 <= 64 && T.mtp[e + s2] <= mti) e += s2; }
        while (T.mtp[e + 1] <= mti) ++e;
        e = __builtin_amdgcn_readfirstlane(e);
        int mt = mti - T.mtp[e];
        if (PHASE == 2) {
            const int nme = T.mtp[e + 1] - T.mtp[e], r = L - T.mtp[e] * NT, ph = r / (nme * 8), r2 = r % (nme * 8);
            mt = r2 >> 3; pn = ph * 8 + (r2 & 7); mti = T.mtp[e] + mt; }
        int nv = T.cnt[e] - mt * 256; nv = nv < 256 ? nv : 256;
        u.nvalid = nv; u.pm = mti; u.pn = pn; u.e = e;
        if (PHASE == 1) { u.A = A; u.B = B + ((size_t)e * 1024 + (size_t)pn * 256) * DM; u.rows = (e < NE) ? rowtok + e * CAP + mt * 256 : nullptr; u.arow0 = mt * 256; u.nkt = DM / 128; }
        else { u.A = A + (size_t)mti * 256 * EFF; u.B = B + ((size_t)e * DM + (size_t)pn * 256) * EFF; u.rows = nullptr; u.arow0 = mt * 256; u.nkt = EFF / 128; }
        return true;
    }
};
struct EpiSwiglu {
    static constexpr int PERM = 1;
    struct Pre { float ssv[2][4]; };
    bf16_t* H; const float* ss;
    __device__ __forceinline__ void prefetch(Pre& pre, const Unit& u, int wr, int fr) const {
        const int r0 = wr * 64 + fr;
#pragma unroll
        for (int ai = 0; ai < 2; ++ai)
#pragma unroll
            for (int m = 0; m < 4; ++m) { int rr = r0 + ai * HALF + m * 16; rr = rr < u.nvalid ? rr : 0; const int tok = u.rows ? u.rows[rr] : (u.arow0 + rr); pre.ssv[ai][m] = ss[tok]; } }
    __device__ __forceinline__ void operator()(const f32x4 (&acc)[2][2][4][2], const Unit& u, int wr, int wc, int fr, int fq, const Pre& pre) const {
        const int r0 = wr * 64 + fr, col0 = u.pn * 128 + wc * 32 + 8 * fq;
#pragma unroll
        for (int ai = 0; ai < 2; ++ai)
#pragma unroll
            for (int m = 0; m < 4; ++m) { const int r = r0 + ai * HALF + m * 16;
                const float rs = pre.ssv[ai][m] * (1.0f / (T_SCALE * WGU_SCALE));
                float h[8];
#pragma unroll
                for (int n = 0; n < 2; ++n)
#pragma unroll
                    for (int j = 0; j < 4; ++j) { const float g = acc[ai][0][m][n][j] * rs, up = acc[ai][1][m][n][j] * rs; h[n * 4 + j] = g * __builtin_amdgcn_rcpf(1.0f + __expf(-g)) * up; }
                u32x2 w; w.x = pk4_fp8(h[0] * H_SCALE, h[1] * H_SCALE, h[2] * H_SCALE, h[3] * H_SCALE); w.y = pk4_fp8(h[4] * H_SCALE, h[5] * H_SCALE, h[6] * H_SCALE, h[7] * H_SCALE);
                if (r < u.nvalid) *(u32x2*)((unsigned char*)H + ((size_t)u.pm * 256 + r) * EFF + col0) = w; }
    }
};
struct EpiScatter {
    static constexpr int PERM = 2;
    struct Pre { int dst[2][4]; float gt[2][4]; };
    unsigned char* Y; const int* rowdst; const float* rowgate; const LAS int* mtp;
    __device__ __forceinline__ void prefetch(Pre& pre, const Unit& u, int wr, int fr) const {
        const int r0 = wr * 64 + fr, lbase = u.e * CAP + (u.pm - mtp[u.e]) * 256;
#pragma unroll
        for (int ai = 0; ai < 2; ++ai)
#pragma unroll
            for (int m = 0; m < 4; ++m) { const int r = r0 + ai * HALF + m * 16; const bool ok = r < u.nvalid; pre.dst[ai][m] = ok ? rowdst[lbase + r] : -1; pre.gt[ai][m] = ok ? rowgate[lbase + r] : 0.f; } }
    __device__ __forceinline__ void operator()(const f32x4 (&acc)[2][2][4][2], const Unit& u, int wr, int wc, int fr, int fq, const Pre& pre) const {
        const int col0 = u.pn * BM + wc * 64 + 16 * fq;
#pragma unroll
        for (int ai = 0; ai < 2; ++ai)
#pragma unroll
            for (int m = 0; m < 4; ++m) { if (pre.dst[ai][m] >= 0) { const float g = pre.gt[ai][m] * (Y_SCALE / (H_SCALE * WD_SCALE));
                const f32x4 v0 = acc[ai][0][m][0] * g, v1 = acc[ai][0][m][1] * g, v2 = acc[ai][1][m][0] * g, v3 = acc[ai][1][m][1] * g;
                u32x4 w; w.x = pk4_fp8(v0[0], v0[1], v0[2], v0[3]); w.y = pk4_fp8(v1[0], v1[1], v1[2], v1[3]); w.z = pk4_fp8(v2[0], v2[1], v2[2], v2[3]); w.w = pk4_fp8(v3[0], v3[1], v3[2], v3[3]);
                *(u32x4*)(Y + (size_t)pre.dst[ai][m] * DM + col0) = w; } }
    }
};
struct EpiShared {
    static constexpr int PERM = 2; typedef NoPre Pre; __device__ __forceinline__ void prefetch(Pre&, const Unit&, int, int) const {}
    unsigned char* Y9;
    __device__ __forceinline__ void operator()(const f32x4 (&acc)[2][2][4][2], const Unit& u, int wr, int wc, int fr, int fq, const Pre& pre) const {
        const int col0 = u.pn * BM + wc * 64 + 16 * fq; const float g = Y_SCALE / (H_SCALE * WD_SCALE);
#pragma unroll
        for (int ai = 0; ai < 2; ++ai)
#pragma unroll
            for (int m = 0; m < 4; ++m) { const int row = u.pm * BM + ai * HALF + wr * 64 + m * 16 + fr;
                const f32x4 v0 = acc[ai][0][m][0] * g, v1 = acc[ai][0][m][1] * g, v2 = acc[ai][1][m][0] * g, v3 = acc[ai][1][m][1] * g;
                u32x4 w; w.x = pk4_fp8(v0[0], v0[1], v0[2], v0[3]); w.y = pk4_fp8(v1[0], v1[1], v1[2], v1[3]); w.z = pk4_fp8(v2[0], v2[1], v2[2], v2[3]); w.w = pk4_fp8(v3[0], v3[1], v3[2], v3[3]);
                *(u32x4*)(Y9 + (size_t)row * DM + col0) = w; }
    }
};
struct EpiResStat {
    static constexpr int PERM = 0; typedef NoPre Pre; __device__ __forceinline__ void prefetch(Pre&, const Unit&, int, int) const {}
    const float* __restrict__ res; bf16_t* __restrict__ Xb; float* ss; int ldc; float scale;
    __device__ __forceinline__ void operator()(const f32x4 (&acc)[2][2][4][2], const Unit& u, int wr, int wc, int fr, int fq, const Pre& pre) const {
        const int row0 = u.pm * BM + wr * 64 + fr, col0 = u.pn * BM + wc * 32 + 4 * fq;
#pragma unroll
        for (int ah = 0; ah < 4; ++ah) { const int ai = ah >> 1, mb = (ah & 1) * 2;
            f32x4 r[4][2][2];
#pragma unroll
            for (int m = mb; m < mb + 2; ++m) { const size_t o = (size_t)(row0 + ai * HALF + m * 16) * ldc + col0;
#pragma unroll
                for (int bj = 0; bj < 2; ++bj)
#pragma unroll
                    for (int n = 0; n < 2; ++n) r[m][bj][n] = __builtin_nontemporal_load((const f32x4*)(res + o + bj * HALF + n * 16)); }
#pragma unroll
            for (int m = mb; m < mb + 2; ++m) { const int row = row0 + ai * HALF + m * 16; const size_t o = (size_t)row * ldc + col0; float sq = 0.f;
#pragma unroll
                for (int bj = 0; bj < 2; ++bj)
#pragma unroll
                    for (int n = 0; n < 2; ++n) { const f32x4 v = acc[ai][bj][m][n] * scale + r[m][bj][n];
                        sq += (v.x * v.x + v.y * v.y) + (v.z * v.z + v.w * v.w);
                        u32x2 pk; pk.x = cvt_pk_bf16(v.x, v.y); pk.y = cvt_pk_bf16(v.z, v.w); *(u32x2*)(Xb + o + bj * HALF + n * 16) = pk; }
                sq += __shfl_xor(sq, 16); sq += __shfl_xor(sq, 32);
                if (fq == 0) ss[(size_t)row * 64 + u.pn * 4 + wc] = sq; }
        }
    }
};
struct EpiX2 {
    static constexpr int PERM = 1; typedef NoPre Pre; __device__ __forceinline__ void prefetch(Pre&, const Unit&, int, int) const {}
    const bf16_t* __restrict__ res; bf16_t* __restrict__ Th; bf16_t* __restrict__ Tl; unsigned char* __restrict__ T8; float* ss; int ldc;
    __device__ __forceinline__ void operator()(const f32x4 (&acc)[2][2][4][2], const Unit& u, int wr, int wc, int fr, int fq, const Pre& pre) const {
        const int row0 = u.pm * BM + wr * 64 + fr, col0 = u.pn * BM + wc * 32 + 8 * fq;
#pragma unroll
        for (int ah = 0; ah < 2; ++ah) { const int ai = ah;
            u32x4 r[4][2];
#pragma unroll
            for (int m = 0; m < 4; ++m) { const size_t o = (size_t)(row0 + ai * HALF + m * 16) * ldc + col0;
#pragma unroll
                for (int bj = 0; bj < 2; ++bj) r[m][bj] = __builtin_nontemporal_load((const u32x4*)(res + o + bj * HALF)); }
#pragma unroll
            for (int m = 0; m < 4; ++m) { const int row = row0 + ai * HALF + m * 16; const size_t o = (size_t)row * ldc + col0; float sq = 0.f;
#pragma unroll
                for (int bj = 0; bj < 2; ++bj) { const u32x4 rr = r[m][bj];
                    const f32x4 r0 = (f32x4){__uint_as_float(rr.x << 16), __uint_as_float(rr.x & 0xffff0000u), __uint_as_float(rr.y << 16), __uint_as_float(rr.y & 0xffff0000u)};
                    const f32x4 r1 = (f32x4){__uint_as_float(rr.z << 16), __uint_as_float(rr.z & 0xffff0000u), __uint_as_float(rr.w << 16), __uint_as_float(rr.w & 0xffff0000u)};
                    const f32x4 w0 = acc[ai][bj][m][0] + r0, w1 = acc[ai][bj][m][1] + r1;
                    sq += (w0.x * w0.x + w0.y * w0.y) + (w0.z * w0.z + w0.w * w0.w) + (w1.x * w1.x + w1.y * w1.y) + (w1.z * w1.z + w1.w * w1.w);
                    u32x4 h; h.x = cvt_pk_bf16(w0.x, w0.y); h.y = cvt_pk_bf16(w0.z, w0.w); h.z = cvt_pk_bf16(w1.x, w1.y); h.w = cvt_pk_bf16(w1.z, w1.w);
                    u32x4 l; l.x = cvt_pk_bf16(w0.x - __uint_as_float(h.x << 16), w0.y - __uint_as_float(h.x & 0xffff0000u)); l.y = cvt_pk_bf16(w0.z - __uint_as_float(h.y << 16), w0.w - __uint_as_float(h.y & 0xffff0000u));
                    l.z = cvt_pk_bf16(w1.x - __uint_as_float(h.z << 16), w1.y - __uint_as_float(h.z & 0xffff0000u)); l.w = cvt_pk_bf16(w1.z - __uint_as_float(h.w << 16), w1.w - __uint_as_float(h.w & 0xffff0000u));
                    u32x2 q8; q8.x = pk4_fp8(w0.x * T_SCALE, w0.y * T_SCALE, w0.z * T_SCALE, w0.w * T_SCALE); q8.y = pk4_fp8(w1.x * T_SCALE, w1.y * T_SCALE, w1.z * T_SCALE, w1.w * T_SCALE);
                    *(u32x4*)(Th + o + bj * HALF) = h; *(u32x4*)(Tl + o + bj * HALF) = l; *(u32x2*)(T8 + o + bj * HALF) = q8; }
                sq += __shfl_xor(sq, 16); sq += __shfl_xor(sq, 32);
                if (fq == 0) ss[(size_t)row * 64 + u.pn * 4 + wc] = sq; }
        }
    }
};
}

namespace fa {
typedef short s16x4 __attribute__((ext_vector_type(4)));
typedef float f32x16 __attribute__((ext_vector_type(16)));
constexpr int SHM_V = 16384, SHM_K = 16384, SHM_K2 = 8192;
constexpr int OFF_V = 0, OFF_K = 2 * SHM_V, OFF_K2 = OFF_K + 2 * SHM_K, OFF_WS = OFF_K2 + 2 * SHM_K2, OFF_TBL = OFF_WS + 8 * 64 * 4, OFF_QPE = OFF_TBL + 1024, LDS_ATTN = OFF_QPE + 8 * 4096;
#define KSWZ(row, colB) ((row) * 256 + ((colB) ^ (((row) & 7) << 4)))
#define KSWZ2(row, colB) ((row) * 128 + ((colB) ^ (((row) & 7) << 4)))
#define SBAR() __builtin_amdgcn_sched_barrier(0)
__device__ __forceinline__ int crow(int r, int hi) { return (r & 3) + 8 * (r >> 2) + 4 * hi; }
__device__ __forceinline__ unsigned cvtpk(float lo, float hi) { unsigned r; asm volatile("v_cvt_pk_bf16_f32 %0, %1, %2" : "=v"(r) : "v"(lo), "v"(hi)); return r; }
constexpr float MIX_SCALE = 64.0f;
__device__ __forceinline__ unsigned fg_pk4_fp8(float a, float b, float c, float d) { int w = 0; w = __builtin_amdgcn_cvt_pk_fp8_f32(a, b, w, false); w = __builtin_amdgcn_cvt_pk_fp8_f32(c, d, w, true); return (unsigned)w; }
template <int MODE> struct Cf { static constexpr float SCALE = (MODE == 1) ? 0.07216878364870323f : 0.08838834764831845f; static constexpr float C = SCALE * 1.4426950408889634f; static constexpr float THRS = 8.0f / SCALE; };

template <int MODE>
__device__ __forceinline__ void partialSM(f32x16& p0, f32x16& p1, float& m_reg, float& mn, float& alpha) {
  constexpr float C = Cf<MODE>::C;
  float pmax = p0[0];
#pragma unroll
  for (int r = 1; r < 16; ++r) pmax = fmaxf(pmax, p0[r]);
#pragma unroll
  for (int r = 0; r < 16; ++r) pmax = fmaxf(pmax, p1[r]);
  { auto rr = __builtin_amdgcn_permlane32_swap(__float_as_uint(pmax), __float_as_uint(pmax), false, false);
    pmax = fmaxf(__uint_as_float(rr[0]), __uint_as_float(rr[1])); }
  if (__builtin_expect(__all(pmax - m_reg <= Cf<MODE>::THRS), 1)) { mn = m_reg; alpha = 1.f; }
  else { mn = fmaxf(m_reg, pmax); alpha = __builtin_amdgcn_exp2f((m_reg - mn) * C); m_reg = mn; }
  const float mnC = -mn * C;
#pragma unroll
  for (int r = 0; r < 16; ++r) p0[r] = fmaf(p0[r], C, mnC);
#pragma unroll
  for (int r = 0; r < 16; ++r) p1[r] = fmaf(p1[r], C, mnC);
#pragma unroll
  for (int r = 0; r < 16; ++r) p0[r] = __builtin_amdgcn_exp2f(p0[r]);
}
__device__ __forceinline__ void finishSM(f32x16& p0, f32x16& p1, float alpha, float& l_reg, bf16x8& pa0, bf16x8& pa1, bf16x8& pa2, bf16x8& pa3) {
#pragma unroll
  for (int r = 0; r < 16; ++r) p1[r] = __builtin_amdgcn_exp2f(p1[r]);
  float ps = 0;
#pragma unroll
  for (int r = 0; r < 16; ++r) ps += p0[r];
#pragma unroll
  for (int r = 0; r < 16; ++r) ps += p1[r];
  { auto rr = __builtin_amdgcn_permlane32_swap(__float_as_uint(ps), __float_as_uint(ps), false, false);
    ps = __uint_as_float(rr[0]) + __uint_as_float(rr[1]); }
  l_reg = l_reg * alpha + ps;
#define PK4(P, BASE, OUT) do { unsigned a0 = cvtpk(P[BASE + 0], P[BASE + 1]), a1 = cvtpk(P[BASE + 2], P[BASE + 3]);   \
    unsigned b0 = cvtpk(P[BASE + 4], P[BASE + 5]), b1 = cvtpk(P[BASE + 6], P[BASE + 7]);                              \
    auto r0 = __builtin_amdgcn_permlane32_swap(a0, b0, false, false); auto r1 = __builtin_amdgcn_permlane32_swap(a1, b1, false, false); \
    u32x4 w = {r0[0], r1[0], r0[1], r1[1]}; OUT = *reinterpret_cast<bf16x8*>(&w); } while (0)
  PK4(p0, 0, pa0); PK4(p0, 8, pa1); PK4(p1, 0, pa2); PK4(p1, 8, pa3);
#undef PK4
}
template <int MODE>
__device__ __forceinline__ void qkt(f32x16& p0, f32x16& p1, const LAS char* Ks, const LAS char* K2s, const bf16x8* qr, int r32, int hi, const LAS char* qpe) {
  p0 = f32x16{}; p1 = f32x16{};
#pragma unroll
  for (int d0 = 0; d0 < 8; ++d0) { const int cb = (d0 * 16 + hi * 8) * 2;
    const bf16x8 b0 = *reinterpret_cast<const LAS bf16x8*>(Ks + KSWZ(r32, cb));
    const bf16x8 b1 = *reinterpret_cast<const LAS bf16x8*>(Ks + KSWZ(32 + r32, cb));
    p0 = __builtin_amdgcn_mfma_f32_32x32x16_bf16(b0, qr[d0], p0, 0, 0, 0);
    p1 = __builtin_amdgcn_mfma_f32_32x32x16_bf16(b1, qr[d0], p1, 0, 0, 0); }
  if (MODE == 1) {
#pragma unroll
    for (int d0 = 0; d0 < 4; ++d0) { const int cb = (d0 * 16 + hi * 8) * 2;
      const bf16x8 b0 = *reinterpret_cast<const LAS bf16x8*>(K2s + KSWZ2(r32, cb));
      const bf16x8 b1 = *reinterpret_cast<const LAS bf16x8*>(K2s + KSWZ2(32 + r32, cb));
      const bf16x8 qp = *reinterpret_cast<const LAS bf16x8*>(qpe + d0 * 1024);
      p0 = __builtin_amdgcn_mfma_f32_32x32x16_bf16(b0, qp, p0, 0, 0, 0);
      p1 = __builtin_amdgcn_mfma_f32_32x32x16_bf16(b1, qp, p1, 0, 0, 0); }
  }
}
__device__ __forceinline__ int v_st(int k, int c) { const int kk = (k & ~0xC) | ((k & 4) << 1) | ((k & 8) >> 1); return ((kk >> 3) * 4 + (c >> 5)) * 512 + ((kk & 7) * 32 + (c & 31)) * 2; }
__device__ __forceinline__ int v_rd_base(int lane) { return ((lane & 3) << 3) | (((lane >> 2) & 3) << 6) | (((lane >> 4) & 1) << 5) | (((lane >> 5) & 1) << 8); }
constexpr int v_rd_off(int d0, int ks, int half) { return d0 * 512 + ks * 4096 + half * 2048; }
template <int OFF> __device__ __forceinline__ s16x4 tr_read(int vb) { s16x4 r; asm volatile("ds_read_b64_tr_b16 %0, %1 offset:%2" : "=&v"(r) : "v"(vb), "i"(OFF) : "memory"); return r; }
template <int D0> __device__ __forceinline__ void pv_one(f32x16& od, int vb, bf16x8 pa0, bf16x8 pa1, bf16x8 pa2, bf16x8 pa3) {
  const s16x4 l0 = tr_read<v_rd_off(D0, 0, 0)>(vb), h0 = tr_read<v_rd_off(D0, 0, 1)>(vb), l1 = tr_read<v_rd_off(D0, 1, 0)>(vb), h1 = tr_read<v_rd_off(D0, 1, 1)>(vb);
  const s16x4 l2 = tr_read<v_rd_off(D0, 2, 0)>(vb), h2 = tr_read<v_rd_off(D0, 2, 1)>(vb), l3 = tr_read<v_rd_off(D0, 3, 0)>(vb), h3 = tr_read<v_rd_off(D0, 3, 1)>(vb);
  asm volatile("s_waitcnt lgkmcnt(0)" ::: "memory"); SBAR();
#define PK(L, H) (bf16x8){L[0], L[1], L[2], L[3], H[0], H[1], H[2], H[3]}
  od = __builtin_amdgcn_mfma_f32_32x32x16_bf16(pa0, PK(l0, h0), od, 0, 0, 0);
  od = __builtin_amdgcn_mfma_f32_32x32x16_bf16(pa1, PK(l1, h1), od, 0, 0, 0);
  od = __builtin_amdgcn_mfma_f32_32x32x16_bf16(pa2, PK(l2, h2), od, 0, 0, 0);
  od = __builtin_amdgcn_mfma_f32_32x32x16_bf16(pa3, PK(l3, h3), od, 0, 0, 0);
#undef PK
}
__device__ __forceinline__ void pv_d0(f32x16* o, int vb, bf16x8 pa0, bf16x8 pa1, bf16x8 pa2, bf16x8 pa3) {
  pv_one<0>(o[0], vb, pa0, pa1, pa2, pa3); pv_one<1>(o[1], vb, pa0, pa1, pa2, pa3); pv_one<2>(o[2], vb, pa0, pa1, pa2, pa3); pv_one<3>(o[3], vb, pa0, pa1, pa2, pa3);
}
struct Args { const bf16_t* Q; const bf16_t* K1; const bf16_t* K2; const bf16_t* V; bf16_t* O; int kt0, NT, qch0; const float* aux; };
template <int MODE> struct St {
    static constexpr int LDQ = (MODE == 0) ? INW : (MODE == 1 ? 3072 : 512), LDK1 = (MODE == 0) ? INW : (MODE == 1 ? 4096 : 1024), LDK2 = INW, LDV = LDK1, LDO = (MODE == 2) ? 512 : DM; };
template <int MODE>
__device__ __forceinline__ void mask_bias(f32x16& p0, f32x16& p1, int qch, int kch, int qpos, int hi, const LAS float* tbl) {
  const bool valid = (MODE == 2) || ((kch <= qch) && (MODE == 1 || kch >= qch - 8));
  if (!valid) {
#pragma unroll
    for (int r = 0; r < 16; ++r) { p0[r] = -INFINITY; p1[r] = -INFINITY; }
  } else if (MODE == 0) {
    if (qch - kch >= 3) { const float b = tbl[191];
#pragma unroll
      for (int r = 0; r < 16; ++r) { p0[r] += b; p1[r] += b; }
    } else { const int base = qpos - kch * 64 + 63 - 4 * hi;
#pragma unroll
      for (int g = 0; g < 4; ++g) {
#pragma unroll
        for (int r = 4 * g; r < 4 * g + 4; ++r) { int d0 = base - ((r & 3) + 8 * (r >> 2)), d1 = d0 - 32;
          d0 = d0 < 0 ? 0 : (d0 > 191 ? 191 : d0); d1 = d1 < 0 ? 0 : (d1 > 191 ? 191 : d1);
          p0[r] += tbl[d0]; p1[r] += tbl[d1]; }
        SBAR();
      }
    }
  }
}
template <int MODE>
__device__ __forceinline__ void attn_body(const Args& a, LAS char* lds) {
  constexpr int NQ = 8;
  int tid = threadIdx.x; asm volatile("" : "+v"(tid));
  const int wid = tid >> 6, lane = tid & 63, r32 = lane & 31, hi = lane >> 5;
  LAS char* V_lds = lds + OFF_V; LAS char* K_lds = lds + OFF_K; LAS char* K2_lds = lds + OFF_K2;
  LAS float* ws = (LAS float*)(lds + OFF_WS) + wid * 64; LAS float* li_l = ws; LAS float* al_l = ws + 32;
  const LAS float* tbl = (const LAS float*)(lds + OFF_TBL);
  float m_reg = -1e30f, l_reg = 0; f32x16 o[4] = {}; bf16x8 qr[NQ];
  const bf16_t* Qw = a.Q + (wid * 32 + r32) * St<MODE>::LDQ + hi * 8;
  if (MODE == 2) {
    const float* Qf = (const float*)a.Q + (size_t)(wid * 32 + r32) * 512 + hi * 8;
    const float* ssp = (const float*)a.K2 + (size_t)(wid * 32 + r32) * 64 + hi * 32;
    float s1 = 0.f;
#pragma unroll
    for (int q = 0; q < 8; ++q) { const f32x4 t = *(const f32x4*)(ssp + 4 * q); s1 += (t.x + t.y) + (t.z + t.w); }
    s1 += __shfl_xor(s1, 32);
    const float rs1 = 1.0f / sqrtf(s1 * (1.0f / 4096.f) + 1e-6f);
    f32x4 qa[NQ][2]; float ssq = 0.f;
#pragma unroll
    for (int d0 = 0; d0 < NQ; ++d0)
#pragma unroll
      for (int hf = 0; hf < 2; ++hf) { const float* sp = Qf + d0 * 16 + hf * 4; constexpr size_t SL = (size_t)NTOK * 512;
        const f32x4 v = ((*(const f32x4*)sp + *(const f32x4*)(sp + SL)) + (*(const f32x4*)(sp + 2 * SL) + *(const f32x4*)(sp + 3 * SL))) * rs1;
        qa[d0][hf] = v; ssq += (v.x * v.x + v.y * v.y) + (v.z * v.z + v.w * v.w); }
    ssq += __shfl_xor(ssq, 32);
    const float rq = 1.0f / sqrtf(ssq * (1.0f / 128.f) + 1e-6f);
#pragma unroll
    for (int d0 = 0; d0 < NQ; ++d0) { const f32x4 g0 = *(const f32x4*)(a.aux + hi * 8 + d0 * 16), g1 = *(const f32x4*)(a.aux + hi * 8 + d0 * 16 + 4);
      const f32x4 v0 = qa[d0][0] * rq * g0, v1 = qa[d0][1] * rq * g1;
      u32x4 w; w.x = cvtpk(v0.x, v0.y); w.y = cvtpk(v0.z, v0.w); w.z = cvtpk(v1.x, v1.y); w.w = cvtpk(v1.z, v1.w); qr[d0] = *reinterpret_cast<bf16x8*>(&w); }
  } else {
#pragma unroll
  for (int d0 = 0; d0 < NQ; ++d0) qr[d0] = *reinterpret_cast<const bf16x8*>(Qw + d0 * 16);
  }
  const LAS char* qpe = lds + OFF_QPE + wid * 4096 + lane * 16;
  if (MODE == 1) {
#pragma unroll
    for (int d0 = 0; d0 < 4; ++d0) *(LAS bf16x8*)(lds + OFF_QPE + wid * 4096 + lane * 16 + d0 * 1024) = *reinterpret_cast<const bf16x8*>(Qw + 128 + d0 * 16);
  }
  const int sr = tid >> 4, sc = (tid & 15) * 8, vst0 = v_st(sr, sc), vst1 = v_st(32 + sr, sc);
  const int s2r = tid >> 3, s2c = (tid & 7) * 8;
  const int vb0 = (int)(uintptr_t)V_lds + v_rd_base(lane);
  const int qch = a.qch0 + (wid >> 1), qpos = a.qch0 * 64 + wid * 32 + r32;
  bf16x8 vs0, vs1, ks0, ks1, k2s;
  const unsigned ovk = (unsigned)(sr * St<MODE>::LDK1 + sc) * 2u, ok2 = (unsigned)(s2r * St<MODE>::LDK2 + s2c) * 2u;
#define SLOAD(j) do { const size_t k0_ = (size_t)(a.kt0 + (j)) * 64; \
    const char* vt_ = (const char*)(a.V + k0_ * St<MODE>::LDV); const char* kt_ = (const char*)(a.K1 + k0_ * St<MODE>::LDK1); \
    vs0 = *reinterpret_cast<const bf16x8*>(vt_ + ovk); vs1 = *reinterpret_cast<const bf16x8*>(vt_ + 64 * St<MODE>::LDV + ovk); \
    ks0 = *reinterpret_cast<const bf16x8*>(kt_ + ovk); ks1 = *reinterpret_cast<const bf16x8*>(kt_ + 64 * St<MODE>::LDK1 + ovk); \
    if (MODE == 1) k2s = *reinterpret_cast<const bf16x8*>((const char*)(a.K2 + k0_ * St<MODE>::LDK2) + ok2); } while (0)
#define SWRITE(b) do { *(LAS bf16x8*)(V_lds + (b) * SHM_V + vst0) = vs0; *(LAS bf16x8*)(V_lds + (b) * SHM_V + vst1) = vs1; const int kc = sc * 2; \
    *(LAS bf16x8*)(K_lds + (b) * SHM_K + KSWZ(sr, kc)) = ks0; *(LAS bf16x8*)(K_lds + (b) * SHM_K + KSWZ(32 + sr, kc)) = ks1; \
    if (MODE == 1) *(LAS bf16x8*)(K2_lds + (b) * SHM_K2 + KSWZ2(s2r, s2c * 2)) = k2s; } while (0)
#define SWAIT() asm volatile("s_waitcnt vmcnt(0)" ::: "memory")
#define RESC(al) do { if (__any((al) < 1.f)) { if (hi == 0) al_l[r32] = (al); asm volatile("s_waitcnt lgkmcnt(0)" ::: "memory"); \
    _Pragma("unroll") for (int d = 0; d < 4; ++d) _Pragma("unroll") for (int r = 0; r < 16; ++r) o[d][r] *= al_l[crow(r, hi)]; } } while (0)
  f32x16 pA0, pA1, pB0, pB1; float mnA, mnB, alA, alB; bf16x8 pa0, pa1, pa2, pa3; const int NT = a.NT;
  SLOAD(0); SWAIT(); SWRITE(0); __syncthreads();
  qkt<MODE>(pA0, pA1, K_lds, K2_lds, qr, r32, hi, qpe); mask_bias<MODE>(pA0, pA1, qch, a.kt0, qpos, hi, tbl); partialSM<MODE>(pA0, pA1, m_reg, mnA, alA);
  SLOAD(1);
  SWAIT(); SWRITE(1); __syncthreads();
  for (int j = 1; j + 1 < NT; j += 2) {
    SBAR(); qkt<MODE>(pB0, pB1, K_lds + SHM_K, K2_lds + SHM_K2, qr, r32, hi, qpe); mask_bias<MODE>(pB0, pB1, qch, a.kt0 + j, qpos, hi, tbl);
    finishSM(pA0, pA1, alA, l_reg, pa0, pa1, pa2, pa3); SBAR();
    SLOAD(j + 1); SBAR();
    pv_d0(o, vb0, pa0, pa1, pa2, pa3); partialSM<MODE>(pB0, pB1, m_reg, mnB, alB);
    __syncthreads(); SWAIT(); SWRITE(0);
    RESC(alB); __syncthreads();
    SBAR(); qkt<MODE>(pA0, pA1, K_lds, K2_lds, qr, r32, hi, qpe); mask_bias<MODE>(pA0, pA1, qch, a.kt0 + j + 1, qpos, hi, tbl);
    finishSM(pB0, pB1, alB, l_reg, pa0, pa1, pa2, pa3); SBAR();
    SLOAD(j + 2); SBAR();
    pv_d0(o, vb0 + SHM_V, pa0, pa1, pa2, pa3); partialSM<MODE>(pA0, pA1, m_reg, mnA, alA);
    __syncthreads(); SWAIT(); SWRITE(1);
    RESC(alA); __syncthreads();
  }
  SBAR(); qkt<MODE>(pB0, pB1, K_lds + SHM_K, K2_lds + SHM_K2, qr, r32, hi, qpe); mask_bias<MODE>(pB0, pB1, qch, a.kt0 + NT - 1, qpos, hi, tbl);
  finishSM(pA0, pA1, alA, l_reg, pa0, pa1, pa2, pa3); SBAR();
  pv_d0(o, vb0, pa0, pa1, pa2, pa3); partialSM<MODE>(pB0, pB1, m_reg, mnB, alB);
  __syncthreads(); RESC(alB);
  finishSM(pB0, pB1, alB, l_reg, pa0, pa1, pa2, pa3); SBAR();
  pv_d0(o, vb0 + SHM_V, pa0, pa1, pa2, pa3);
  if (hi == 0) li_l[r32] = l_reg; asm volatile("s_waitcnt lgkmcnt(0)" ::: "memory");
  if (MODE != 2) {
    unsigned char* Ow8 = (unsigned char*)a.O + (size_t)(wid * 32) * DM;
    const int qi = lane & 3;
#pragma unroll
    for (int rg = 0; rg < 4; ++rg) {
      float rl[4];
#pragma unroll
      for (int j = 0; j < 4; ++j) rl[j] = __builtin_amdgcn_rcpf(li_l[crow(4 * rg + j, hi)]) * MIX_SCALE;
#pragma unroll
      for (int d0 = 0; d0 < 4; ++d0) { float v[4];
#pragma unroll
        for (int j = 0; j < 4; ++j) v[j] = o[d0][4 * rg + j] * rl[j];
        { const float s0 = (qi & 1) ? v[0] : v[1], s1 = (qi & 1) ? v[2] : v[3]; const float t0 = __shfl_xor(s0, 1), t1 = __shfl_xor(s1, 1);
          if (qi & 1) { v[0] = t0; v[2] = t1; } else { v[1] = t0; v[3] = t1; } }
        { const float s0 = (qi & 2) ? v[0] : v[2], s1 = (qi & 2) ? v[1] : v[3]; const float t0 = __shfl_xor(s0, 2), t1 = __shfl_xor(s1, 2);
          if (qi & 2) { v[0] = t0; v[1] = t1; } else { v[2] = t0; v[3] = t1; } }
        const int orow = 8 * rg + 4 * hi + qi;
        *(unsigned*)(Ow8 + (size_t)orow * DM + d0 * 32 + (r32 & ~3)) = fg_pk4_fp8(v[0], v[1], v[2], v[3]); } }
  } else {
  bf16_t* Ow = a.O + (wid * 32) * St<MODE>::LDO;
  const int odd = lane & 1;
#pragma unroll
  for (int r = 0; r < 16; r += 2) { const float ra = __builtin_amdgcn_rcpf(li_l[crow(r, hi)]), rb = __builtin_amdgcn_rcpf(li_l[crow(r + 1, hi)]);
#pragma unroll
    for (int d0 = 0; d0 < 4; ++d0) { const float vA = o[d0][r] * ra, vB = o[d0][r + 1] * rb;
      const float pA = __shfl_xor(vA, 1), pB = __shfl_xor(vB, 1);
      const unsigned w = odd ? cvtpk(pB, vB) : cvtpk(vA, pA);
      const int orow = odd ? crow(r + 1, hi) : crow(r, hi);
      *(unsigned*)(Ow + orow * St<MODE>::LDO + d0 * 32 + (r32 & ~1)) = w; } }
  }
  __syncthreads();
#undef SLOAD
#undef SWRITE
#undef SWAIT
#undef RESC
}
#undef KSWZ
#undef KSWZ2
#undef SBAR
template <int MODE> __device__ __forceinline__ void attn_call(const bf16_t* Q, const bf16_t* K1, const bf16_t* K2, const bf16_t* V, bf16_t* O, int kt0, int NT, int qch0, LAS char* lds, const float* aux = nullptr) {
  Args a{Q, K1, K2, V, O, kt0, NT, qch0, aux}; attn_body<MODE>(a, lds);
}
}

#ifndef TVAR
#define TVAR 0
#endif
template <int VAR = 0, bool GK = false>
__device__ __forceinline__ void transpose_item(const float* W, int K, int N, bf16_t* WT, int k0, int n0, int drow0, LAS float* scr, int lane, const float* gk = nullptr) {
    float v[64];
    const float* src = W + (size_t)k0 * N + n0 + lane;
#pragma unroll
    for (int i = 0; i < 64; ++i) v[i] = __builtin_nontemporal_load(src + (size_t)i * N);
    if (VAR == 1) {
#pragma unroll
        for (int i = 0; i < 64; ++i) asm volatile("" :: "v"(v[i]));
        return; }
#pragma unroll
    for (int i = 0; i < 64; ++i) scr[i * 65 + lane] = GK ? v[i] * gk[k0 + i] : v[i];
    asm volatile("s_waitcnt lgkmcnt(0)" ::: "memory");
    if (VAR == 2) { drow0 = 0; k0 = 0; }
    const int c = lane & 7;
#pragma unroll
    for (int j = 0; j < 8; ++j) { const int n = (lane >> 3) + 8 * j; const LAS float* sp = scr + (8 * c) * 65 + n;
        u32x4 o; o.x = fg::cvt_pk_bf16(sp[0 * 65], sp[1 * 65]); o.y = fg::cvt_pk_bf16(sp[2 * 65], sp[3 * 65]); o.z = fg::cvt_pk_bf16(sp[4 * 65], sp[5 * 65]); o.w = fg::cvt_pk_bf16(sp[6 * 65], sp[7 * 65]);
        *(u32x4*)(WT + ((size_t)(drow0 >> 6) * (K >> 6) + (k0 >> 6)) * 4096 + n * 64 + 8 * c) = o; }
    asm volatile("s_waitcnt lgkmcnt(0)" ::: "memory");
}
__device__ __forceinline__ fg::MoeTabs moe_tables_fast(LAS int* tab, const unsigned* gcnt) {
    fg::MoeTabs T; T.cnt = tab; T.mtp = tab + 80;
    __syncthreads();
    if (threadIdx.x == 0) { int pm = 0;
        for (int e = 0; e <= NE; ++e) { const int c = (e < NE) ? (int)gcnt[64 * e] : NTOK; tab[e] = c; tab[80 + e] = pm; pm += (c + 255) / 256; }
        tab[80 + NE + 1] = pm; }
    __syncthreads();
    return T;
}
template <bool GK = false>
__device__ __forceinline__ void transpose_item_fp8(const float* W, int K, int N, unsigned char* WT, int k0, int n0, int drow0, float scale, LAS float* scr, int lane, const float* gk = nullptr) {
    float v[64];
    const float* src = W + (size_t)k0 * N + n0 + lane;
#pragma unroll
    for (int i = 0; i < 64; ++i) v[i] = __builtin_nontemporal_load(src + (size_t)i * N);
#pragma unroll
    for (int i = 0; i < 64; ++i) scr[i * 65 + lane] = GK ? v[i] * (scale * gk[k0 + i]) : v[i] * scale;
    asm volatile("s_waitcnt lgkmcnt(0)" ::: "memory");
    const int c = lane & 3;
    unsigned char* tile = WT + ((size_t)(drow0 >> 6) * (K >> 7) + (k0 >> 7)) * 8192 + (k0 & 64);
#pragma unroll
    for (int j = 0; j < 4; ++j) { const int n = (lane >> 2) + 16 * j; const LAS float* sp = scr + (16 * c) * 65 + n;
        u32x4 o; o.x = fg::pk4_fp8(sp[0 * 65], sp[1 * 65], sp[2 * 65], sp[3 * 65]); o.y = fg::pk4_fp8(sp[4 * 65], sp[5 * 65], sp[6 * 65], sp[7 * 65]);
        o.z = fg::pk4_fp8(sp[8 * 65], sp[9 * 65], sp[10 * 65], sp[11 * 65]); o.w = fg::pk4_fp8(sp[12 * 65], sp[13 * 65], sp[14 * 65], sp[15 * 65]);
        *(u32x4*)(tile + n * 128 + 16 * c) = o; }
    asm volatile("s_waitcnt lgkmcnt(0)" ::: "memory");
}
__device__ __forceinline__ void transpose_item_hilo(const float* W, int K, bf16_t* WH, bf16_t* WL, int k0, LAS float* scr, int lane, const float* gk) {
    float v[64];
    const float* src = W + (size_t)k0 * 64 + lane;
#pragma unroll
    for (int i = 0; i < 64; ++i) v[i] = src[(size_t)i * 64];
#pragma unroll
    for (int i = 0; i < 64; ++i) scr[i * 65 + lane] = v[i] * gk[k0 + i];
    asm volatile("s_waitcnt lgkmcnt(0)" ::: "memory");
    const int c = lane & 7;
#pragma unroll
    for (int j = 0; j < 8; ++j) { const int n = (lane >> 3) + 8 * j; const LAS float* sp = scr + (8 * c) * 65 + n;
        float f[8], l[8];
#pragma unroll
        for (int q = 0; q < 8; ++q) f[q] = sp[q * 65];
        u32x4 o; o.x = fg::cvt_pk_bf16(f[0], f[1]); o.y = fg::cvt_pk_bf16(f[2], f[3]); o.z = fg::cvt_pk_bf16(f[4], f[5]); o.w = fg::cvt_pk_bf16(f[6], f[7]);
        l[0] = f[0] - __uint_as_float(o.x << 16); l[1] = f[1] - __uint_as_float(o.x & 0xffff0000u); l[2] = f[2] - __uint_as_float(o.y << 16); l[3] = f[3] - __uint_as_float(o.y & 0xffff0000u);
        l[4] = f[4] - __uint_as_float(o.z << 16); l[5] = f[5] - __uint_as_float(o.z & 0xffff0000u); l[6] = f[6] - __uint_as_float(o.w << 16); l[7] = f[7] - __uint_as_float(o.w & 0xffff0000u);
        u32x4 ol; ol.x = fg::cvt_pk_bf16(l[0], l[1]); ol.y = fg::cvt_pk_bf16(l[2], l[3]); ol.z = fg::cvt_pk_bf16(l[4], l[5]); ol.w = fg::cvt_pk_bf16(l[6], l[7]);
        const size_t off = (size_t)(k0 >> 6) * 4096 + n * 64 + 8 * c;
        *(u32x4*)(WH + off) = o; *(u32x4*)(WL + off) = ol; }
    asm volatile("s_waitcnt lgkmcnt(0)" ::: "memory");
}
constexpr int N_EXPERT_ITEMS = 65 * 1536;
__device__ __forceinline__ void expert_item(const Params& p, unsigned char* ws, int r0, LAS float* scr, int lane) {
    bf16_t* wguT = (bf16_t*)(ws + WS_WGU); bf16_t* wdT = (bf16_t*)(ws + WS_WD);
    const int e = r0 / 1536, r = r0 % 1536, mat = r >> 9, item = r & 511;
    if (mat < 2) { const float* W = (e < NE) ? p.in[mat ? I_WEXU : I_WEXG] + (size_t)e * DM * EFF : p.in[mat ? I_WSHU : I_WSHG];
        const int kb = (item & 7) + 8 * (item >> 6), nb = (item >> 3) & 7, n0 = nb * 64;
        transpose_item_fp8<true>(W, DM, EFF, (unsigned char*)wguT + (size_t)e * 1024 * DM, kb * 64, n0, (n0 >> 7) * 256 + mat * 128 + (n0 & 127), fg::WGU_SCALE, scr, lane, p.in[I_GFFN]);
    } else { const float* W = (e < NE) ? p.in[I_WEXD] + (size_t)e * EFF * DM : p.in[I_WSHD];
        const int kb = item & 7, nb = item >> 3;
        transpose_item_fp8(W, EFF, DM, (unsigned char*)wdT + (size_t)e * DM * EFF, kb * 64, nb * 64, nb * 64, fg::WD_SCALE, scr, lane); }
}
__device__ __forceinline__ void expert_conv_loop(const Params& p, unsigned char* ws, unsigned* qhead, LAS float* scr, int lane) {
    for (;;) {
        unsigned start = 0; if (lane == 0) start = xb_add(qhead, 8u);
        start = (unsigned)__builtin_amdgcn_readfirstlane((int)start);
        if (start >= (unsigned)N_EXPERT_ITEMS) break;
        for (int q = 0; q < 8; ++q) expert_item(p, ws, (int)start + q, scr, lane);
    }
}
template <int VAR>
__device__ __forceinline__ void p0_items(const Params& p, unsigned char* ws, LAS float* scr, int lane, int gw, int NGW) {
    bf16_t* winT = (bf16_t*)(ws + WS_WIN); bf16_t* wuqT = (bf16_t*)(ws + WS_WUQ); bf16_t* wukvT = (bf16_t*)(ws + WS_WUKV); bf16_t* woT = (bf16_t*)(ws + WS_WO);
    bf16_t* wxqT = (bf16_t*)(ws + WS_WXQ); bf16_t* wxkvT = (bf16_t*)(ws + WS_WXKV); bf16_t* wxoT = (bf16_t*)(ws + WS_WXO); bf16_t* wguT = (bf16_t*)(ws + WS_WGU); bf16_t* wdT = (bf16_t*)(ws + WS_WD);
            constexpr int I0 = (DM / 64) * (INW / 64), I1 = I0 + (DM / 64) * (DM / 64), I2 = I1 + (QLORA / 64) * (3072 / 64), I3 = I2 + (KVLORA / 64) * (4096 / 64),
                          I4 = I3 + (DM / 64) * (512 / 64), I5 = I4 + (DM / 64) * (1024 / 64), I6 = I5 + (512 / 64) * (DM / 64);
            constexpr int IR = I6, ITOT = IR + DM / 64;
            for (int it = gw; it < ITOT; it += NGW) {
                if (it < I0) { const int nb = it % (INW / 64), kb = it / (INW / 64); transpose_item_fp8(p.in[I_WIN], DM, INW, (unsigned char*)winT, kb * 64, nb * 64, nb * 64, 64.0f, scr, lane); }
                else if (it < I1) { const int r = it - I0, nb = r % 64, kb = r / 64; transpose_item_fp8(p.in[I_WO], DM, DM, (unsigned char*)woT, kb * 64, nb * 64, nb * 64, 64.0f, scr, lane); }
                else if (it < I2) { const int r = it - I1, nb = r % 48, kb = r / 48; transpose_item_fp8(p.in[I_WUQ], QLORA, 3072, (unsigned char*)wuqT, kb * 64, nb * 64, nb * 64, 64.0f, scr, lane); }
                else if (it < I3) { const int r = it - I2, nb = r % 64, kb = r / 64; transpose_item_fp8(p.in[I_WUKV], KVLORA, 4096, (unsigned char*)wukvT, kb * 64, nb * 64, nb * 64, 64.0f, scr, lane); }
                else if (it < I4) { const int r = it - I3, nb = r % 8, kb = r / 8; transpose_item<VAR, true>(p.in[I_WXQ], DM, 512, wxqT, kb * 64, nb * 64, nb * 64, scr, lane, p.in[I_GCROSS]); }
                else if (it < I5) { const int r = it - I4, nb = r % 16, kb = r / 16; transpose_item<VAR>(p.in[I_WXKV], DM, 1024, wxkvT, kb * 64, nb * 64, nb * 64, scr, lane); }
                else if (it < I6) { const int r = it - I5, nb = r % 64, kb = r / 64; transpose_item<VAR>(p.in[I_WXO], 512, DM, wxoT, kb * 64, nb * 64, nb * 64, scr, lane); }
                else if (it >= IR) { transpose_item_hilo(p.in[I_WROUTER], DM, (bf16_t*)(ws + WS_WR), (bf16_t*)(ws + WS_WR + (size_t)(DM / 64) * 8192), (it - IR) * 64, scr, lane, p.in[I_GFFN]); }
            }
}
__device__ __forceinline__ void unpack8(const u32x4 w, float (&f)[8]) {
    f[0] = __uint_as_float(w.x << 16); f[1] = __uint_as_float(w.x & 0xffff0000u); f[2] = __uint_as_float(w.y << 16); f[3] = __uint_as_float(w.y & 0xffff0000u);
    f[4] = __uint_as_float(w.z << 16); f[5] = __uint_as_float(w.z & 0xffff0000u); f[6] = __uint_as_float(w.w << 16); f[7] = __uint_as_float(w.w & 0xffff0000u); }
__device__ __forceinline__ u32x4 pack8(const float (&f)[8]) { u32x4 w; w.x = fg::cvt_pk_bf16(f[0], f[1]); w.y = fg::cvt_pk_bf16(f[2], f[3]); w.z = fg::cvt_pk_bf16(f[4], f[5]); w.w = fg::cvt_pk_bf16(f[6], f[7]); return w; }
__device__ __forceinline__ float sumsq8(const float (&f)[8]) { return (f[0] * f[0] + f[1] * f[1]) + (f[2] * f[2] + f[3] * f[3]) + (f[4] * f[4] + f[5] * f[5]) + (f[6] * f[6] + f[7] * f[7]); }
template <int W> __device__ __forceinline__ float group_sum(float v) {
#pragma unroll
    for (int o = 1; o < W; o <<= 1) v += __shfl_xor(v, o);
    return v;
}
__device__ __forceinline__ void load8f(const float* g, float (&f)[8]) { const f32x4 a = *(const f32x4*)g, b = *(const f32x4*)(g + 4); f[0] = a.x; f[1] = a.y; f[2] = a.z; f[3] = a.w; f[4] = b.x; f[5] = b.y; f[6] = b.z; f[7] = b.w; }
__device__ __forceinline__ void scale8(float (&f)[8], float r, const float (&g)[8]) {
#pragma unroll
    for (int i = 0; i < 8; ++i) f[i] = f[i] * r * g[i]; }
        struct RouterSched { const char* th; const char* tl; const char* wh; const char* wl; int G, c;
            __device__ __forceinline__ bool next(int i, fg::Unit& u) const {
                const int total = (NTOK / 256) * 8, per = (total + 7) / 8; const int j = i * G + c, x = j & 7, q = j >> 3;
                if (q >= per) return false; const int L = x * per + q; if (L >= total) return false;
                const int pm = L / 8, slab = L % 8, term = slab >> 2, kq = slab & 3;
                u.A = (term == 1 ? tl : th) + ((size_t)pm * 256 * DM + (size_t)kq * 1024) * 2; u.B = wh + (size_t)kq * 16 * 8192;
                u.rows = nullptr; u.nkt = 16; u.nvalid = 256; u.pm = pm; u.pn = 0; u.e = slab; u.arow0 = pm * 256; return true; } };
        struct EpiLogits { static constexpr int PERM = 0; typedef fg::NoPre Pre; __device__ __forceinline__ void prefetch(Pre&, const fg::Unit&, int, int) const {} float* C;
            __device__ __forceinline__ void operator()(const f32x4 (&acc)[2][2][4][2], const fg::Unit& u, int wr, int wc, int fr, int fq, const Pre& pre) const {
                { float* Cb = C + (size_t)u.e * NTOK * 128;
#pragma unroll
                    for (int ai = 0; ai < 2; ++ai)
#pragma unroll
                        for (int m = 0; m < 4; ++m)
#pragma unroll
                            for (int n = 0; n < 2; ++n) *(f32x4*)(Cb + (size_t)(u.pm * 256 + ai * 128 + wr * 64 + m * 16 + fr) * 128 + wc * 32 + n * 16 + 4 * fq) = acc[ai][0][m][n]; } } };
constexpr int NPHASE = 18;
template <unsigned PMASK>
__global__ void __launch_bounds__(512, 2) fwd(Params p) {
    extern __shared__ __attribute__((aligned(16))) unsigned char lds_raw[];
    float* ldsf = (float*)lds_raw;
    const int tid = threadIdx.x, lane = tid & 63, wave = tid >> 6;
    const int G = gridDim.x; int bid = blockIdx.x;
    const int gw = bid * 8 + wave, NGW = G * 8;
    unsigned char* ws = p.ws;
    unsigned* ctl = (unsigned*)(ws + WS_CTL);
    volatile LAS unsigned* misc = (volatile LAS unsigned*)((LAS unsigned char*)lds_raw + LDS_MISC);
    if (tid < 16) misc[tid] = 0u;
    __syncthreads();
    XcdBarrier bar = xcd_barrier_post(ctl + CW_BAR, misc);
    const int lo = p.ph_lo, hi = p.ph_hi;
    if (tid == 0) { const unsigned x = xb_xcc_id() & 15u; misc[4] = x; misc[5] = xb_add(ctl + CW_TICKET + 64 * x, 1u); }
#define IN(k) (((PMASK >> (k)) & 1u) && lo <= (k) && (k) < hi)
#ifndef DUP_PHASE
#define DUP_PHASE -1
#endif
#define REP(k) for (int rep_ = 0; rep_ < ((DUP_PHASE == (k)) ? 2 : 1); ++rep_)
#define SEAM(k) do { if (IN(k) && IN((k) + 1)) xcd_barrier(bar); } while (0)

    const float* x = p.in[I_X];
    act_t* hbuf = (act_t*)(ws + WS_H); act_t* memn = (act_t*)(ws + WS_MEMN); act_t* p1 = (act_t*)(ws + WS_P1); act_t* kvm = (act_t*)(ws + WS_KVM);
    act_t* qb = (act_t*)(ws + WS_QB); act_t* kvb = (act_t*)(ws + WS_KVB); act_t* mixed = (act_t*)(ws + WS_MIXED); float* x1 = (float*)(ws + WS_X1);
    act_t* hc = (act_t*)(ws + WS_HC); act_t* qx = (act_t*)(ws + WS_QX); act_t* ox = (act_t*)(ws + WS_OX); float* x2 = (float*)(ws + WS_X2);
    act_t* tb = (act_t*)(ws + WS_T); act_t* hh = (act_t*)(ws + WS_HH);
    unsigned char* cq8 = ws + WS_X1; unsigned char* ckv8 = ws + WS_X1 + (size_t)NTOK * QLORA;
    LAS unsigned char* lds = (LAS unsigned char*)lds_raw;
    bf16_t* winT = (bf16_t*)(ws + WS_WIN); bf16_t* wuqT = (bf16_t*)(ws + WS_WUQ); bf16_t* wukvT = (bf16_t*)(ws + WS_WUKV); bf16_t* woT = (bf16_t*)(ws + WS_WO);
    bf16_t* wxqT = (bf16_t*)(ws + WS_WXQ); bf16_t* wxkvT = (bf16_t*)(ws + WS_WXKV); bf16_t* wxoT = (bf16_t*)(ws + WS_WXO); bf16_t* wguT = (bf16_t*)(ws + WS_WGU); bf16_t* wdT = (bf16_t*)(ws + WS_WD);
    float* qxp = (float*)(ws + WS_QXP); bf16_t* ybuf = (bf16_t*)(ws + WS_Y);
    int* rowtok = (int*)(ws + WS_ROWTOK); float* rowgate = (float*)(ws + WS_ROWGATE); int* rowdst = (int*)(ws + WS_ROWDST);
    unsigned* gcnt = ctl + CW_CNT;
    const int* positions = (const int*)p.in[I_POS];

    if (IN(0)) REP(0) {
        for (int m = gw; m < NTOK; m += NGW) {
            const float* xr = x + (size_t)m * DM; f32x4 v[16]; float ssq = 0.f;
#pragma unroll
            for (int j = 0; j < 16; ++j) { v[j] = __builtin_nontemporal_load((const f32x4*)xr + lane + 64 * j); ssq += v[j].x * v[j].x + v[j].y * v[j].y + v[j].z * v[j].z + v[j].w * v[j].w; }
            ssq = wave_sum(ssq); const float r = 2.0f / sqrtf(ssq * (1.0f / 4096.f) + EPS);
#pragma unroll
            for (int j = 0; j < 16; ++j) v[j] = v[j] * r * __builtin_nontemporal_load((const f32x4*)p.in[I_GMIX] + lane + 64 * j);
            asm volatile("s_waitcnt vmcnt(0)" ::: "memory");
#pragma unroll
            for (int j = 0; j < 16; ++j) *(unsigned*)((unsigned char*)hbuf + (size_t)m * DM + (lane + 64 * j) * 4) = fg::pk4_fp8(v[j].x, v[j].y, v[j].z, v[j].w);
        }
        for (int m = gw; m < NMEM; m += NGW) rms_row_4096<act_t>(p.in[I_MEM] + (size_t)m * DM, p.in[I_GMEM], memn + (size_t)m * DM, lane, nullptr);
#if FAST_GEMM
        {
            LAS float* scr = (LAS float*)(lds + wave * 16640);
            p0_items<0>(p, ws, scr, lane, gw, NGW);
        }
#endif
    }
    SEAM(0);
    if (IN(0) && IN(1) && G == 256) {
        if (tid == 0) { bool even = true;
            for (int j2 = 0; j2 < 8; ++j2) even = even && (xb_ld(ctl + CW_TICKET + 64 * j2) == 32u);
            misc[6] = (even && misc[4] < 8u && misc[5] < 32u) ? (misc[4] + 8u * misc[5]) : (unsigned)blockIdx.x; }
        __syncthreads();
        bid = __builtin_amdgcn_readfirstlane((int)misc[6]);
    }
    if (IN(1)) REP(1) {
#if FAST_GEMM
        { fg::DenseSched S{(const char*)hbuf, (const char*)winT, DM / 2, DM / 2, NTOK / 256, INWP / 256, 1, DM / 128, G, bid, (p.var == 10) ? 2 : 0};
          fg::EpiBf16N E{p1, INW, INW, 1.0f / (2.0f * 64.0f), p.in[I_GQA], 8, p.in[I_GKA], 16, 0, (LAS float*)(lds + 131072 + 2048)};
          fg::gemm_phase<fg::EpiBf16N, fg::DenseSched, false, true, true>(lds, S, E, DM / 2, DM / 2, p.var); }
        { fg::DenseSched S{(const char*)memn, (const char*)wxkvT, DM, PK(DM), NMEM / 256, 1024 / 256, 1, DM / 64, G, (bid + G - 224) % G, 0};
          fg::EpiBf16 E{kvm, 1024, 1024, 1.0f};
          fg::gemm_phase<fg::EpiBf16, fg::DenseSched, false, false, true>(lds, S, E, DM, PK(DM)); }
#else
        constexpr int NT1 = (INW + 127) / 128, U1 = (NTOK / 128) * NT1, U2 = (NMEM / 128) * (1024 / 128);
        for (int u = bid; u < U1 + U2; u += G) {
            if (u < U1) { const int mt = u / NT1, nt = u % NT1;
                BPlain bc{p.in[I_WIN], INW, nt * 128, INW};
                auto epi = [&](int r, int c, const float (&v)[4]) { const int col = nt * 128 + c; if (col < INW) { act_t* o = p1 + (size_t)(mt * 128 + r) * INW + col; stf(o, v[0]); stf(o + 1, v[1]); stf(o + 2, v[2]); stf(o + 3, v[3]); } };
                ngemm_tile<act_t>(ldsf, hbuf, DM, nullptr, mt * 128, 128, DM, bc, epi);
            } else { const int v2 = u - U1, mt = v2 / 8, nt = v2 % 8;
                BPlain bc{p.in[I_WXKV], 1024, nt * 128, 1024};
                auto epi = [&](int r, int c, const float (&v)[4]) { act_t* o = kvm + (size_t)(mt * 128 + r) * 1024 + nt * 128 + c; stf(o, v[0]); stf(o + 1, v[1]); stf(o + 2, v[2]); stf(o + 3, v[3]); };
                ngemm_tile<act_t>(ldsf, memn, DM, nullptr, mt * 128, 128, DM, bc, epi);
            }
        }
    #endif
    }
    SEAM(1);
    if (IN(2)) {
#if FAST_GEMM
        {
            float gcq0[8], gcq1[8], gckv[8];
            load8f(p.in[I_GCQ] + lane * 8, gcq0); load8f(p.in[I_GCQ] + 512 + lane * 8, gcq1); load8f(p.in[I_GCKV] + lane * 8, gckv);
            for (int m = gw; m < NTOK; m += NGW) {
                act_t* row = p1 + (size_t)m * INW;
                u32x4 cq[2], ckv;
                cq[0] = *(const u32x4*)(row + C_CQ + lane * 8); cq[1] = *(const u32x4*)(row + C_CQ + 512 + lane * 8); ckv = *(const u32x4*)(row + C_CKV + lane * 8);
                const int pos = positions[m];
                asm volatile("s_waitcnt vmcnt(0)" ::: "memory");
                { float f0[8], f1[8]; unpack8(cq[0], f0); unpack8(cq[1], f1); const float ss = wave_sum(sumsq8(f0) + sumsq8(f1)); const float r = 1.0f / sqrtf(ss * (1.0f / 1024.f) + EPS);
                  scale8(f0, r * 2.0f, gcq0); scale8(f1, r * 2.0f, gcq1);
                  u32x2 a, b; a.x = fg::pk4_fp8(f0[0], f0[1], f0[2], f0[3]); a.y = fg::pk4_fp8(f0[4], f0[5], f0[6], f0[7]); b.x = fg::pk4_fp8(f1[0], f1[1], f1[2], f1[3]); b.y = fg::pk4_fp8(f1[4], f1[5], f1[6], f1[7]);
                  *(u32x2*)(cq8 + (size_t)m * QLORA + lane * 8) = a; *(u32x2*)(cq8 + (size_t)m * QLORA + 512 + lane * 8) = b; }
                { float f[8]; unpack8(ckv, f); const float ss = wave_sum(sumsq8(f)); const float r = 1.0f / sqrtf(ss * (1.0f / 512.f) + EPS); scale8(f, r * 2.0f, gckv);
                  u32x2 a; a.x = fg::pk4_fp8(f[0], f[1], f[2], f[3]); a.y = fg::pk4_fp8(f[4], f[5], f[6], f[7]); *(u32x2*)(ckv8 + (size_t)m * KVLORA + lane * 8) = a; }
                rms_rope64_inplace(row + C_KPE, p.in[I_GKB] + 128, pos, lane);
            }
            float gkx[8]; load8f(p.in[I_GKX] + (lane & 15) * 8, gkx);
            for (int m = gw; m < NMEM; m += NGW) { act_t* row = kvm + (size_t)m * 1024;
                u32x4 w = *(const u32x4*)(row + lane * 8); float f[8]; unpack8(w, f); const float ss = group_sum<16>(sumsq8(f)); const float r = 1.0f / sqrtf(ss * (1.0f / 128.f) + EPS);
                scale8(f, r, gkx); *(u32x4*)(row + lane * 8) = pack8(f); }
        }
#else
        for (int m = gw; m < NTOK; m += NGW) {
            act_t* row = p1 + (size_t)m * INW;
            for (int h = 0; h < HA; ++h) { rms_inplace<128>(row + C_Q0 + h * HD, p.in[I_GQA], lane); rms_inplace<128>(row + C_K0 + h * HD, p.in[I_GKA], lane); }
            rms_inplace<QLORA>(row + C_CQ, p.in[I_GCQ], lane);
            rms_inplace<KVLORA>(row + C_CKV, p.in[I_GCKV], lane);
            rms_rope64_inplace(row + C_KPE, p.in[I_GKB] + 128, positions[m], lane);
        }
        for (int m = gw; m < NMEM; m += NGW) for (int h = 0; h < MH; ++h) rms_inplace<128>(kvm + (size_t)m * 1024 + h * 128, p.in[I_GKX], lane);
#endif
    }
    SEAM(2);
    if (IN(3)) REP(3) {
#if FAST_GEMM
        { fg::DenseSched S{(const char*)cq8, (const char*)wuqT, QLORA / 2, QLORA / 2, NTOK / 256, 3072 / 256, 1, QLORA / 128, G, bid, 0};
          fg::EpiBf16 E{qb, 3072, 3072, 1.0f / 128.0f};
          fg::gemm_phase<fg::EpiBf16, fg::DenseSched, false, true, true>(lds, S, E, QLORA / 2, QLORA / 2); }
        { fg::DenseSched S{(const char*)ckv8, (const char*)wukvT, KVLORA / 2, KVLORA / 2, NTOK / 256, 4096 / 256, 1, KVLORA / 128, G, bid, (G == 256) ? 1 : 0};
          fg::EpiBf16N E{kvb, 4096, 4096, 1.0f / 128.0f, p.in[I_GKB], 16, p.in[I_GKB], 16, 1, (LAS float*)(lds + 131072 + 2048)};
          fg::gemm_phase<fg::EpiBf16N, fg::DenseSched, false, true, true>(lds, S, E, KVLORA / 2, KVLORA / 2); }
#else
        constexpr int UA = (NTOK / 128) * (3072 / 128), UB = (NTOK / 128) * (4096 / 128);
        for (int u = bid; u < UA + UB; u += G) {
            if (u < UA) { const int mt = u / 24, nt = u % 24;
                BPlain bc{p.in[I_WUQ], 3072, nt * 128, 3072};
                auto epi = [&](int r, int c, const float (&v)[4]) { act_t* o = qb + (size_t)(mt * 128 + r) * 3072 + nt * 128 + c; stf(o, v[0]); stf(o + 1, v[1]); stf(o + 2, v[2]); stf(o + 3, v[3]); };
                ngemm_tile<act_t>(ldsf, p1 + C_CQ, INW, nullptr, mt * 128, 128, QLORA, bc, epi);
            } else { const int v2 = u - UA, mt = v2 / 32, nt = v2 % 32;
                BPlain bc{p.in[I_WUKV], 4096, nt * 128, 4096};
                auto epi = [&](int r, int c, const float (&v)[4]) { act_t* o = kvb + (size_t)(mt * 128 + r) * 4096 + nt * 128 + c; stf(o, v[0]); stf(o + 1, v[1]); stf(o + 2, v[2]); stf(o + 3, v[3]); };
                ngemm_tile<act_t>(ldsf, p1 + C_CKV, INW, nullptr, mt * 128, 128, KVLORA, bc, epi);
            }
        }
    #endif
    }
    SEAM(3);
    if (IN(4)) {
#if FAST_GEMM
        {
            float gqn[8], gqp[8];
            load8f(p.in[I_GQB] + (lane & 15) * 8, gqn); load8f(p.in[I_GQB] + 128 + (lane & 7) * 8, gqp);
            for (int m = gw; m < NTOK; m += NGW) {
                act_t* qrow = qb + (size_t)m * 3072;
                u32x4 qn[4], qp[2];
#pragma unroll
                for (int j = 0; j < 4; ++j) qn[j] = *(const u32x4*)(qrow + (j * 4 + (lane >> 4)) * QKB + (lane & 15) * 8);
#pragma unroll
                for (int j = 0; j < 2; ++j) qp[j] = *(const u32x4*)(qrow + (j * 8 + (lane >> 3)) * QKB + 128 + (lane & 7) * 8);
                float cs[8], sn[8];
                { const int fi = lane & 31; const float inv_freq = powf(10000.0f, -(float)(2 * fi) / 64.0f); const float ang = (float)positions[m] * inv_freq; float s1, c1; sincosf(ang, &s1, &c1);
#pragma unroll
                  for (int i = 0; i < 8; ++i) { const int src = ((lane & 3) * 8 + i); cs[i] = __shfl(c1, src); sn[i] = __shfl(s1, src); } }
                asm volatile("s_waitcnt vmcnt(0)" ::: "memory");
#pragma unroll
                for (int j = 0; j < 4; ++j) { float f[8]; unpack8(qn[j], f); const float ss = group_sum<16>(sumsq8(f)); const float r = 1.0f / sqrtf(ss * (1.0f / 128.f) + EPS); scale8(f, r, gqn); qn[j] = pack8(f); }
#pragma unroll
                for (int j = 0; j < 2; ++j) { float f[8]; unpack8(qp[j], f); const float ss = group_sum<8>(sumsq8(f)); const float r = 1.0f / sqrtf(ss * (1.0f / 64.f) + EPS); scale8(f, r, gqp);
                    const bool lowhalf = ((lane & 7) < 4);
#pragma unroll
                    for (int i = 0; i < 8; ++i) { const float other = __shfl_xor(f[i], 4); f[i] = lowhalf ? (f[i] * cs[i] - other * sn[i]) : (f[i] * cs[i] + other * sn[i]); }
                    qp[j] = pack8(f); }
#pragma unroll
                for (int j = 0; j < 4; ++j) *(u32x4*)(qrow + (j * 4 + (lane >> 4)) * QKB + (lane & 15) * 8) = qn[j];
#pragma unroll
                for (int j = 0; j < 2; ++j) *(u32x4*)(qrow + (j * 8 + (lane >> 3)) * QKB + 128 + (lane & 7) * 8) = qp[j];
            }
        }
#else
        for (int m = gw; m < NTOK; m += NGW) {
            const int pos = positions[m];
            for (int h = 0; h < HB; ++h) {
                rms_inplace<128>(qb + (size_t)m * 3072 + h * QKB, p.in[I_GQB], lane);
                rms_rope64_inplace(qb + (size_t)m * 3072 + h * QKB + 128, p.in[I_GQB] + 128, pos, lane);
                rms_inplace<128>(kvb + (size_t)m * 4096 + h * 256, p.in[I_GKB], lane);
            }
        }
#endif
    }
    SEAM(4);
    if (IN(5)) {
#if FAST_ATTN
        {
            constexpr int NA_BLK = 176;
            LAS char* al = (LAS char*)lds;
            LAS float* scr = (LAS float*)(lds + wave * 16640);
            if (bid >= NA_BLK) { expert_conv_loop(p, ws, ctl + CW_QCONV, scr, lane); }
            for (;;) {
                __syncthreads(); if (tid == 0) misc[7] = xb_add(ctl + CW_QB, 1u); __syncthreads();
                const int q = (int)misc[7]; if (q >= 512) break;
                const int grp = q >> 8, idx = q & 255, pair = idx >> 2, qbk = (grp == 0 ? 7 : 3) - (idx & 3), b = pair >> 4, h = pair & 15;
                const int c0 = qbk * 4; const size_t tok0 = (size_t)b * SEQ + (size_t)qbk * 256;
                const act_t* kb = kvb + (size_t)b * SEQ * 4096;
                fa::attn_call<1>(qb + tok0 * 3072 + h * QKB, kb + h * 256, p1 + (size_t)b * SEQ * INW + C_KPE, kb + h * 256 + 128, (bf16_t*)((unsigned char*)mixed + tok0 * DM + WA + h * HD), 0, c0 + 4, c0, al);
            }
            for (;;) {
                __syncthreads(); if (tid == 0) misc[7] = xb_add(ctl + CW_QA, 1u); __syncthreads();
                const int q = (int)misc[7]; if (q >= 512) break;
                const int grp = q >> 8, idx = q & 255, pair = idx >> 2, qbk = (grp == 0 ? 7 : 3) - (idx & 3), b = pair >> 4, h = pair & 15;
                { LAS float* tbl = (LAS float*)(al + fa::OFF_TBL); if (tid < NREL) tbl[tid] = p.in[I_RELB][h * NREL + tid] * 11.313708498984761f; }
                const int c0 = qbk * 4; const size_t tok0 = (size_t)b * SEQ + (size_t)qbk * 256;
                const int kt0 = (c0 - LEFT) > 0 ? (c0 - LEFT) : 0;
                const act_t* base = p1 + (size_t)b * SEQ * INW;
                fa::attn_call<0>(p1 + tok0 * INW + C_Q0 + h * HD, base + C_K0 + h * HD, nullptr, base + C_V0 + h * HD, (bf16_t*)((unsigned char*)mixed + tok0 * DM + h * HD), kt0, c0 + 4 - kt0, c0, al);
            }
            __syncthreads();
            expert_conv_loop(p, ws, ctl + CW_QCONV, scr, lane);
        }
#else
        for (int u = bid; u < 4096; u += G) {
            const int c = 31 - (u >> 7), rem = u & 127, type = rem >> 6, b = (rem >> 4) & 3, h = rem & 15;
            const size_t tok0 = (size_t)b * SEQ + (size_t)c * CHUNK;
            if (type == 0) {
                const int t0 = (c - LEFT) > 0 ? (c - LEFT) : 0, nt = c - t0 + 1;
                const float* rb = p.in[I_RELB] + h * NREL;
                auto keytile = [&](int t) { return (t0 + t) * CHUNK; };
                auto bias = [&](int r, int t, int key) { int dist = (c * CHUNK + r) - ((t0 + t) * CHUNK + key); dist = dist < -(CHUNK - 1) ? -(CHUNK - 1) : (dist > 128 ? 128 : dist); return rb[dist + CHUNK - 1]; };
                const act_t* base = p1 + (size_t)b * SEQ * INW;
                nattn_unit<128>(ldsf, p1 + tok0 * INW + C_Q0 + h * HD, INW, base + C_K0 + h * HD, INW, nullptr, 0, base + C_V0 + h * HD, INW,
                                nt, keytile, 0.08838834764831845f, bias, mixed + tok0 * DM + h * HD, DM);
            } else {
                auto keytile = [&](int t) { return t * CHUNK; };
                auto bias = [&](int, int, int) { return 0.f; };
                const act_t* kb = kvb + (size_t)b * SEQ * 4096;
                nattn_unit<192>(ldsf, qb + tok0 * 3072 + h * QKB, 3072, kb + h * 256, 4096, p1 + (size_t)b * SEQ * INW + C_KPE, INW, kb + h * 256 + 128, 4096,
                                c + 1, keytile, 0.07216878364870323f, bias, mixed + tok0 * DM + WA + h * HD, DM);
            }
        }
    #endif
    }
    SEAM(5);
    if (IN(6)) REP(6) {
#if FAST_GEMM
        { fg::DenseSched S{(const char*)mixed, (const char*)woT, DM / 2, DM / 2, NTOK / 256, DM / 256, 1, DM / 128, G, bid, 0};
          fg::EpiResStat E{x, hc, (float*)(ws + WS_SSP1), DM, 1.0f / (fa::MIX_SCALE * 64.0f)};
          fg::gemm_phase<fg::EpiResStat, fg::DenseSched, false, true, true>(lds, S, E, DM / 2, DM / 2); }
#else
        for (int u = bid; u < (NTOK / 128) * (DM / 128); u += G) { const int mt = u / 32, nt = u % 32;
            BPlain bc{p.in[I_WO], DM, nt * 128, DM};
            auto epi = [&](int r, int c, const float (&v)[4]) { const size_t o = (size_t)(mt * 128 + r) * DM + nt * 128 + c;
                const f32x4 xv = *(const f32x4*)(x + o); *(f32x4*)(x1 + o) = (f32x4){xv.x + v[0], xv.y + v[1], xv.z + v[2], xv.w + v[3]}; };
            ngemm_tile<act_t>(ldsf, mixed, DM, nullptr, mt * 128, 128, DM, bc, epi);
        }
    #endif
    }
    SEAM(6);
    if (IN(8)) REP(8) {
#if FAST_GEMM
        { fg::DenseSched S{(const char*)hc, (const char*)wxqT, DM, PK(DM), NTOK / 256, 512 / 256, 4, DM / 64 / 4, G, bid, 0};
          fg::EpiF32Res<false> E{qxp, nullptr, 512, (size_t)NTOK * 512, 1.0f};
          fg::gemm_phase<fg::EpiF32Res<false>, fg::DenseSched, false, false, true>(lds, S, E, DM, PK(DM)); }
#else
        for (int u = bid; u < (NTOK / 128) * 4; u += G) { const int mt = u / 4, nt = u % 4;
            BPlain bc{p.in[I_WXQ], 512, nt * 128, 512};
            auto epi = [&](int r, int c, const float (&v)[4]) { act_t* o = qx + (size_t)(mt * 128 + r) * 512 + nt * 128 + c; stf(o, v[0]); stf(o + 1, v[1]); stf(o + 2, v[2]); stf(o + 3, v[3]); };
            ngemm_tile<act_t>(ldsf, hc, DM, nullptr, mt * 128, 128, DM, bc, epi);
        }
    #endif
    }
    SEAM(8);
    if (IN(10)) REP(10) {
#if FAST_ATTN
        for (int u = bid; u < NB * MH * (SEQ / 256); u += G) { const int qbk = u & 7, h = (u >> 3) & 3, b = u >> 5;
            const size_t tok0 = (size_t)b * SEQ + (size_t)qbk * 256;
            const act_t* kb = kvm + (size_t)b * MEMT * 1024;
            fa::attn_call<2>((const bf16_t*)(qxp + tok0 * 512 + h * 128), kb + h * 128, (const bf16_t*)((const float*)(ws + WS_SSP1) + tok0 * 64), kb + 512 + h * 128, ox + tok0 * 512 + h * 128, 0, 4, 0, (LAS char*)lds, p.in[I_GQX]);
        }
#else
        for (int u = bid; u < NB * MH * (SEQ / 64); u += G) { const int c = u & 31, h = (u >> 5) & 3, b = u >> 7;
            const size_t tok0 = (size_t)b * SEQ + (size_t)c * 64;
            auto keytile = [&](int t) { return t * 64; };
            auto bias = [&](int, int, int) { return 0.f; };
            const act_t* kb = kvm + (size_t)b * MEMT * 1024;
            nattn_unit<128>(ldsf, qx + tok0 * 512 + h * 128, 512, kb + h * 128, 1024, nullptr, 0, kb + 512 + h * 128, 1024, 4, keytile, 0.08838834764831845f, bias, ox + tok0 * 512 + h * 128, 512);
        }
    #endif
    }
    SEAM(10);
    if (IN(11)) REP(11) {
#if FAST_GEMM
        { fg::DenseSched S{(const char*)ox, (const char*)wxoT, 512, PK(512), NTOK / 256, DM / 256, 1, 512 / 64, G, bid, 0};
          fg::EpiX2 E{hc, tb, (bf16_t*)hh, ws + WS_T8, (float*)(ws + WS_SSP2), DM};
          fg::gemm_phase<fg::EpiX2, fg::DenseSched, false, false, true>(lds, S, E, 512, PK(512)); }
#else
        for (int u = bid; u < (NTOK / 128) * (DM / 128); u += G) { const int mt = u / 32, nt = u % 32;
            BPlain bc{p.in[I_WXO], DM, nt * 128, DM};
            auto epi = [&](int r, int c, const float (&v)[4]) { const size_t o = (size_t)(mt * 128 + r) * DM + nt * 128 + c;
                const f32x4 xv = *(const f32x4*)(x1 + o); const f32x4 y = (f32x4){xv.x + v[0], xv.y + v[1], xv.z + v[2], xv.w + v[3]}; *(f32x4*)(x2 + o) = y; *(f32x4*)(p.out + o) = y; };
            ngemm_tile<act_t>(ldsf, ox, 512, nullptr, mt * 128, 128, 512, bc, epi);
        }
    #endif
    }
    SEAM(11);
    if (IN(13)) {
        RouterSched S{(const char*)tb, (const char*)hh, (const char*)(ws + WS_WR), nullptr, G, bid};
        EpiLogits E{(float*)(ws + WS_Y)};
        fg::gemm_phase<EpiLogits, RouterSched, false, false, true>(lds, S, E, DM, DM);
    }
    SEAM(13);
    if (IN(14)) {
        const float* lgp = (const float*)(ws + WS_Y);
        const float rb = p.in[I_RBIAS][lane];
        const int g = lane >> 3;
        float lgA[16];
#pragma unroll
        for (int sl = 0; sl < 16; ++sl) lgA[sl] = (gw < NTOK) ? lgp[((size_t)(sl >> 1) * NTOK + gw) * 128 + (sl & 1) * 64 + lane] : 0.f;
        int pm_ = -1, psel = 0, prank = 0; float pgate = 0.f; unsigned ppos = 0u;
        for (int m = gw; m < NTOK; m += NGW) {
            float lgB[16]; const int mn = m + NGW;
#pragma unroll
            for (int sl = 0; sl < 16; ++sl) lgB[sl] = (mn < NTOK) ? lgp[((size_t)(sl >> 1) * NTOK + mn) * 128 + (sl & 1) * 64 + lane] : 0.f;
            const float rs2 = 1.0f / sqrtf(wave_sum(((const float*)(ws + WS_SSP2))[(size_t)m * 64 + lane]) * (1.0f / 4096.f) + EPS);
            if (lane == 0) ((float*)(ws + WS_RS2))[m] = rs2;
            const float logit = ((((lgA[0] + lgA[1]) + (lgA[2] + lgA[3])) + ((lgA[4] + lgA[5]) + (lgA[6] + lgA[7]))) + (((lgA[8] + lgA[9]) + (lgA[10] + lgA[11])) + ((lgA[12] + lgA[13]) + (lgA[14] + lgA[15])))) * rs2;
            const float score = 1.0f / (1.0f + expf(-logit));
            const float choice = score + rb;
            float gm1 = fmaxf(choice, __shfl_xor(choice, 1)); gm1 = fmaxf(gm1, __shfl_xor(gm1, 2)); gm1 = fmaxf(gm1, __shfl_xor(gm1, 4));
            const unsigned long long eq = __ballot(choice == gm1);
            const unsigned gbits = (unsigned)(eq >> (8 * g)) & 0xffu;
            const bool is_first = (lane & 7) == (__builtin_ctz(gbits | 0x100u));
            float v2 = is_first ? -INFINITY : choice;
            v2 = fmaxf(v2, __shfl_xor(v2, 1)); v2 = fmaxf(v2, __shfl_xor(v2, 2)); v2 = fmaxf(v2, __shfl_xor(v2, 4));
            const float gscore = gm1 + v2;
            int grank = 0;
#pragma unroll
            for (int j2 = 0; j2 < 8; ++j2) { const float gj = __int_as_float(__builtin_amdgcn_readlane(__float_as_int(gscore), 8 * j2)); grank += ((gj > gscore) || (gj == gscore && j2 < g)) ? 1 : 0; }
            const bool gsel = grank < 4;
            const float mv = gsel ? choice : -INFINITY;
            int rank = 0;
#pragma unroll
            for (int i2 = 0; i2 < 64; ++i2) { const float vi = __int_as_float(__builtin_amdgcn_readlane(__float_as_int(mv), i2)); rank += ((vi > mv) || (vi == mv && i2 < lane)) ? 1 : 0; }
            const bool sel = gsel && rank < 8;
            const float wsum = wave_sum(sel ? score : 0.f);
            if (pm_ >= 0 && psel) { rowtok[lane * CAP + ppos] = pm_; rowgate[lane * CAP + ppos] = pgate; rowdst[lane * CAP + ppos] = pm_ * 8 + prank; }
            ppos = 0u; if (sel) ppos = atomicAdd(&gcnt[64 * lane], 1u);
            pm_ = m; psel = sel ? 1 : 0; prank = rank; pgate = score * 2.5f / (wsum + 1e-20f);
#pragma unroll
            for (int sl = 0; sl < 16; ++sl) lgA[sl] = lgB[sl];
        }
        if (pm_ >= 0 && psel) { rowtok[lane * CAP + ppos] = pm_; rowgate[lane * CAP + ppos] = pgate; rowdst[lane * CAP + ppos] = pm_ * 8 + prank; }
    }
    SEAM(14);
    if (IN(15)) REP(15) {
#if FAST_MOE
        { const fg::MoeTabs T = moe_tables_fast((LAS int*)(lds + 131072), gcnt);
          fg::MoeSched<1> S{T, (const char*)(ws + WS_T8), (const char*)wguT, rowtok, G, bid};
          fg::EpiSwiglu E{hh, (const float*)(ws + WS_RS2)};
          fg::gemm_phase<fg::EpiSwiglu, fg::MoeSched<1>, true, true, true>(lds, S, E, DM / 2, DM / 2, p.var); }
#else
        int* tab = (int*)(ldsf + 2 * 16 * 132);
        const MoeTab T = moe_tables(tab, gcnt, 128);
        const int nunits = T.mtp[NE + 1] * 8;
        for (int u = bid; u < nunits; u += G) {
            const int mti = u >> 3, nt = u & 7; int e = 0; while (T.mtp[e + 1] <= mti) ++e;
            const int mt = mti - T.mtp[e], nrows = (T.cnt[e] - mt * 128) < 128 ? (T.cnt[e] - mt * 128) : 128;
            const float* Wg = (e < NE) ? p.in[I_WEXG] + (size_t)e * DM * EFF : p.in[I_WSHG];
            const float* Wu = (e < NE) ? p.in[I_WEXU] + (size_t)e * DM * EFF : p.in[I_WSHU];
            BGU bc{Wg, Wu, EFF, nt * 64};
            const size_t hrow0 = (size_t)T.offh[e] + (size_t)mt * 128;
            auto epi = [&](int r, int c, const float (&v)[4]) { act_t* o = hh + (hrow0 + r) * EFF + nt * 64 + (c >> 2) * 2;
                stf(o, v[0] / (1.0f + expf(-v[0])) * v[2]); stf(o + 1, v[1] / (1.0f + expf(-v[1])) * v[3]); };
            ngemm_tile<act_t>(ldsf, tb, DM, (e < NE) ? rowtok + e * CAP : nullptr, mt * 128, nrows, DM, bc, epi);
        }
    #endif
    }
    SEAM(15);
    if (IN(16)) REP(16) {
#if FAST_MOE
        { const fg::MoeTabs T = moe_tables_fast((LAS int*)(lds + 131072), gcnt);
          { fg::MoeSched<2> S{T, (const char*)hh, (const char*)wdT, rowtok, G, bid};
            fg::EpiScatter E{(unsigned char*)ybuf, rowdst, rowgate, T.mtp};
            fg::gemm_phase<fg::EpiScatter, fg::MoeSched<2>, false, true, true>(lds, S, E, EFF / 2, EFF / 2, p.var); }
          { fg::DenseSched S{(const char*)hh + (size_t)T.mtp[64] * 256 * EFF, (const char*)wdT + (size_t)64 * DM * EFF, EFF / 2, EFF / 2, NTOK / 256, DM / 256, 1, EFF / 128, G, bid, 0};
            fg::EpiShared E{(unsigned char*)ybuf + (size_t)NTOK * 8 * DM};
            fg::gemm_phase<fg::EpiShared, fg::DenseSched, false, true, true>(lds, S, E, EFF / 2, EFF / 2); } }
#else
        int* tab = (int*)(ldsf + 2 * 16 * 132);
        const MoeTab T = moe_tables(tab, gcnt, 128);
        const int nunits = T.mtp[NE + 1] * 32;
        for (int u = bid; u < nunits; u += G) {
            const int mti = u >> 5, nt = u & 31; int e = 0; while (T.mtp[e + 1] <= mti) ++e;
            const int mt = mti - T.mtp[e], nrows = (T.cnt[e] - mt * 128) < 128 ? (T.cnt[e] - mt * 128) : 128;
            const float* Wd = (e < NE) ? p.in[I_WEXD] + (size_t)e * EFF * DM : p.in[I_WSHD];
            BPlain bc{Wd, DM, nt * 128, DM};
            const int hrow0 = T.offh[e] + mt * 128;
            auto epi = [&](int r, int c, const float (&v)[4]) {
                int tok; float g; if (e < NE) { tok = rowtok[e * CAP + mt * 128 + r]; g = rowgate[e * CAP + mt * 128 + r]; } else { tok = mt * 128 + r; g = 1.0f; }
                float* o = p.out + (size_t)tok * DM + nt * 128 + c;
                atomicAdd(o, v[0] * g); atomicAdd(o + 1, v[1] * g); atomicAdd(o + 2, v[2] * g); atomicAdd(o + 3, v[3] * g); };
            ngemm_tile<act_t>(ldsf, hh, EFF, nullptr, hrow0, nrows, EFF, bc, epi);
        }
    #endif
    }
    SEAM(16);
    if (IN(17)) REP(17) {
#if FAST_MOE
        for (int m = gw; m < NTOK; m += NGW) {
            const unsigned char* y8 = (const unsigned char*)ybuf + (size_t)m * 8 * DM;
#pragma unroll 2
            for (int j = 0; j < 4; ++j) { const int c0 = lane * 16 + 1024 * j;
                const bf16_t* sp = tb + (size_t)m * DM + c0; float* op = p.out + (size_t)m * DM + c0;
                f32x4 sv[4];
#pragma unroll
                for (int q = 0; q < 2; ++q) { const u32x4 t = __builtin_nontemporal_load((const u32x4*)(sp + 8 * q));
                    sv[2 * q] = (f32x4){__uint_as_float(t.x << 16), __uint_as_float(t.x & 0xffff0000u), __uint_as_float(t.y << 16), __uint_as_float(t.y & 0xffff0000u)};
                    sv[2 * q + 1] = (f32x4){__uint_as_float(t.z << 16), __uint_as_float(t.z & 0xffff0000u), __uint_as_float(t.w << 16), __uint_as_float(t.w & 0xffff0000u)}; }
                u32x4 y[9];
#pragma unroll
                for (int k = 0; k < 8; ++k) y[k] = __builtin_nontemporal_load((const u32x4*)(y8 + (size_t)k * DM + c0));
                y[8] = __builtin_nontemporal_load((const u32x4*)((const unsigned char*)ybuf + (size_t)NTOK * 8 * DM + (size_t)m * DM + c0));
                float a[16];
#pragma unroll
                for (int q = 0; q < 16; ++q) a[q] = 0.f;
#pragma unroll
                for (int k = 0; k < 9; ++k) {
#pragma unroll
                    for (int q = 0; q < 4; ++q) { const int w = (int)y[k][q]; const auto lo = __builtin_amdgcn_cvt_pk_f32_fp8(w, false); const auto hi2 = __builtin_amdgcn_cvt_pk_f32_fp8(w, true);
                        a[4 * q] += lo[0]; a[4 * q + 1] += lo[1]; a[4 * q + 2] += hi2[0]; a[4 * q + 3] += hi2[1]; } }
#pragma unroll
                for (int q = 0; q < 4; ++q) { f32x4 o; o.x = sv[q].x + a[4 * q] * (1.0f / fg::Y_SCALE); o.y = sv[q].y + a[4 * q + 1] * (1.0f / fg::Y_SCALE); o.z = sv[q].z + a[4 * q + 2] * (1.0f / fg::Y_SCALE); o.w = sv[q].w + a[4 * q + 3] * (1.0f / fg::Y_SCALE);
                    *(f32x4*)(op + 4 * q) = o; } }
        }
#endif
    }
#undef IN
#undef SEAM
}

#if TVAR
__global__ void __launch_bounds__(512, 2) probe_k(Params p) {
    extern __shared__ __attribute__((aligned(16))) unsigned char lds_raw[];
    const int tid = threadIdx.x, lane = tid & 63, wave = tid >> 6;
    p0_items<TVAR>(p, p.ws, (LAS float*)((LAS unsigned char*)lds_raw + wave * 16640), lane, blockIdx.x * 8 + wave, gridDim.x * 8);
}
#endif
typedef void (*kern_t)(Params);
template <int PH> struct KTab { static void fill(kern_t* t) { t[PH] = fwd<(1u << PH)>; KTab<PH - 1>::fill(t); } };
template <> struct KTab<-1> { static void fill(kern_t*) {} };
extern "C" void kernel_launch(void* const* d_in, const int* in_sizes, int n_in, void* d_out, int out_size, void* d_ws, size_t ws_size, hipStream_t stream) {
    static int grid = 0;
    static kern_t ktab[NPHASE + 1];
    if (grid == 0) {
        if (n_in != 31 || out_size != NTOK * DM || ws_size < WS_END) { fprintf(stderr, "kernel_launch: bad shapes n_in %d out %d ws %zu (need %zu)\n", n_in, out_size, ws_size, (size_t)WS_END); grid = -1; return; }
        int dev = 0, cus = 0;
        if (hipGetDevice(&dev) != hipSuccess || hipDeviceGetAttribute(&cus, hipDeviceAttributeMultiprocessorCount, dev) != hipSuccess) { grid = -1; return; }
#if N_LAUNCH_PER_PHASE
        KTab<NPHASE - 1>::fill(ktab);
#else
        ktab[NPHASE] = fwd<0xFFFFFFFFu>;
#endif
#if N_LAUNCH_PER_PHASE
        for (int i = 0; i < NPHASE; ++i)
#else
        for (int i = NPHASE; i <= NPHASE; ++i)
#endif
            if (hipFuncSetAttribute((const void*)ktab[i], hipFuncAttributeMaxDynamicSharedMemorySize, LDS_BYTES) != hipSuccess) { fprintf(stderr, "kernel_launch: hipFuncSetAttribute failed\n"); grid = -1; return; }
        (void)hipGetLastError();
        grid = cus;
    }
    if (grid < 0) return;
    (void)hipMemsetAsync((char*)d_ws + WS_CTL, 0, CTL_BYTES, stream);
    Params p{};
    for (int i = 0; i < 31; ++i) p.in[i] = (const float*)d_in[i];
    p.out = (float*)d_out; p.ws = (unsigned char*)d_ws;
#if TVAR
    { static int once = 0; if (!once) { (void)hipFuncSetAttribute((const void*)probe_k, hipFuncAttributeMaxDynamicSharedMemorySize, LDS_BYTES); once = 1; } p.ph_lo = 0; p.ph_hi = 0; hipLaunchKernelGGL(probe_k, dim3(grid), dim3(512), LDS_BYTES, stream, p); }
#endif
#if N_LAUNCH_PER_PHASE
    for (int ph = 0; ph < NPHASE; ++ph) { p.ph_lo = ph; p.ph_hi = ph + 1; hipLaunchKernelGGL(ktab[ph], dim3(grid), dim3(512), LDS_BYTES, stream, p); }
#else
    p.ph_lo = 0; p.ph_hi = NPHASE; hipLaunchKernelGGL(ktab[NPHASE], dim3(grid), dim3(512), LDS_BYTES, stream, p);
#endif
#ifdef PROBE_PH
#ifndef PROBE_VAR
#define PROBE_VAR 0
#endif
    (void)hipMemsetAsync((char*)d_ws + WS_CTL + (size_t)CW_QCONV * 4, 0, 1024, stream);
    (void)hipMemsetAsync((char*)d_ws + WS_CTL + (size_t)CW_QCONV * 4, 0, 1024, stream);
    p.ph_lo = PROBE_PH; p.ph_hi = PROBE_PH + 1; p.var = PROBE_VAR; hipLaunchKernelGGL(ktab[NPHASE], dim3(grid), dim3(512), LDS_BYTES, stream, p);
#endif
    const hipError_t le = hipPeekAtLastError();
    if (le != hipSuccess) fprintf(stderr, "kernel_launch: launch failed: %s\n", hipGetErrorName(le));
}
```

```cpp
#include <hip/hip_runtime.h>
#include <cstdio>
#include <cstdint>

#define LAS __attribute__((address_space(3)))
typedef unsigned short bf16_t;
typedef float f32x4 __attribute__((ext_vector_type(4)));
typedef short bf16x8 __attribute__((ext_vector_type(8)));
typedef unsigned u32x4 __attribute__((ext_vector_type(4)));
typedef unsigned u32x2 __attribute__((ext_vector_type(2)));
typedef int v4i_t __attribute__((ext_vector_type(4)));
typedef int v8i_t __attribute__((ext_vector_type(8)));
#ifndef FAST_GEMM
#define FAST_GEMM 1
#endif
#ifndef FAST_MOE
#define FAST_MOE 1
#endif
#ifndef FAST_ATTN
#define FAST_ATTN 1
#endif

#ifndef ACT_F32
#define ACT_F32 0
#endif
#if ACT_F32
typedef float act_t;
#else
typedef bf16_t act_t;
#endif
#ifndef N_LAUNCH_PER_PHASE
#define N_LAUNCH_PER_PHASE 0
#endif

constexpr int NB = 4, SEQ = 2048, DM = 4096, NTOK = NB * SEQ;
constexpr int CHUNK = 64, LEFT = 8, NREL = 192;
constexpr int HD = 128, HA = 16, HB = 16, QLORA = 1024, KVLORA = 512, QKB = 192;
constexpr int MEMT = 256, MH = 4, NE = 64, EFF = 512;
constexpr int WA = HA * HD;
constexpr int INW = 3 * WA + QLORA + KVLORA + 64;
constexpr int NMEM = NB * MEMT;
constexpr int C_Q0 = 0, C_K0 = WA, C_V0 = 2 * WA, C_CQ = 3 * WA, C_CKV = 3 * WA + QLORA, C_KPE = 3 * WA + QLORA + KVLORA;
constexpr float EPS = 1e-6f;
constexpr int CAP = NTOK;

constexpr size_t MiB = 1u << 20;
constexpr size_t AS = sizeof(act_t);
constexpr size_t al(size_t x) { return (x + 255) / 256 * 256; }
constexpr size_t WS_CTL = 0, CTL_BYTES = 1 * MiB;
constexpr size_t WS_ROWTOK = 1 * MiB, WS_ROWGATE = 3 * MiB, WS_ROWDST = 5 * MiB;
constexpr int PK(int K) { return K; }
constexpr int INWP = 7936;
constexpr size_t WS_WR = 8 * MiB;
constexpr size_t WS_WIN = 12 * MiB;
constexpr size_t WS_WUQ = WS_WIN + al((size_t)INWP * PK(DM) * 2);
constexpr size_t WS_WUKV = WS_WUQ + al((size_t)3072 * PK(QLORA) * 2);
constexpr size_t WS_WO = WS_WUKV + al((size_t)4096 * PK(KVLORA) * 2);
constexpr size_t WS_WXQ = WS_WO + al((size_t)DM * PK(DM) * 2);
constexpr size_t WS_WXKV = WS_WXQ + al((size_t)512 * PK(DM) * 2);
constexpr size_t WS_WXO = WS_WXKV + al((size_t)1024 * PK(DM) * 2);
constexpr size_t WS_WGU = WS_WXO + al((size_t)DM * PK(512) * 2);
constexpr size_t WS_WD = WS_WGU + al((size_t)65 * 1024 * DM);
constexpr size_t WS_T8 = WS_WD + al((size_t)65 * DM * EFF);
constexpr size_t WS_SSP1 = WS_T8 + al((size_t)NTOK * DM);
constexpr size_t WS_SSP2 = WS_SSP1 + (size_t)NTOK * 64 * 4;
constexpr size_t WS_RS2 = WS_SSP2 + (size_t)NTOK * 64 * 4;
constexpr size_t WS_X1 = WS_RS2 + al((size_t)NTOK * 4);
constexpr size_t WS_X2 = WS_X1 + al((size_t)NTOK * DM * 4);
constexpr size_t WS_T = WS_X2 + al((size_t)NTOK * DM * 4);
constexpr int HH_ROWS = NTOK * 8 + NE * 256 + NTOK;
constexpr size_t WS_HH = WS_T + al((size_t)NTOK * DM * AS);
constexpr size_t WS_Y = WS_HH + al((size_t)HH_ROWS * EFF * AS);
constexpr size_t WS_H = WS_Y;
constexpr size_t WS_MEMN = WS_H + al((size_t)NTOK * DM * AS);
constexpr size_t WS_P1 = WS_MEMN + al((size_t)NMEM * DM * AS);
constexpr size_t WS_KVM = WS_P1 + al((size_t)NTOK * INW * AS);
constexpr size_t WS_QB = WS_KVM + al((size_t)NMEM * 1024 * AS);
constexpr size_t WS_KVB = WS_QB + al((size_t)NTOK * 3072 * AS);
constexpr size_t WS_MIXED = WS_KVB + al((size_t)NTOK * 4096 * AS);
constexpr size_t WS_HC = WS_MIXED + al((size_t)NTOK * DM * AS);
constexpr size_t WS_QXP = WS_HC + al((size_t)NTOK * DM * AS);
constexpr size_t WS_QX = WS_QXP + al((size_t)4 * NTOK * 512 * 4);
constexpr size_t WS_OX = WS_QX + al((size_t)NTOK * 512 * AS);
constexpr size_t WS_END0 = WS_OX + al((size_t)NTOK * 512 * AS);
constexpr size_t WS_YEND = WS_Y + al((size_t)NTOK * 8 * DM * 2);
constexpr size_t WS_END = WS_END0 > WS_YEND ? WS_END0 : WS_YEND;
static_assert(WS_END <= 2147483648ull, "workspace map exceeds the guaranteed 2 GiB");
constexpr int CW_BAR = 4096;
constexpr int CW_CNT = 16384;
constexpr int CW_QCONV = 26624, CW_QB = 26688, CW_QA = 26752;
constexpr int CW_SS1 = 32768, CW_SS2 = 40960;
constexpr int CW_TDONE = 65536;
constexpr int CW_TICKET = 24576;

constexpr int LDS_BYTES = 163840;
constexpr int LDS_MISC = LDS_BYTES - 64;

__device__ __forceinline__ unsigned f2bf(float f) { unsigned u = __builtin_bit_cast(unsigned, f); return (u + 0x7fffu + ((u >> 16) & 1u)) >> 16; }
__device__ __forceinline__ float ldf(const float* p) { return *p; }
__device__ __forceinline__ float ldf(const bf16_t* p) { return __uint_as_float(((unsigned)*p) << 16); }
__device__ __forceinline__ void stf(float* p, float v) { *p = v; }
__device__ __forceinline__ void stf(bf16_t* p, float v) { *p = (bf16_t)f2bf(v); }
__device__ __forceinline__ float wave_sum(float v) {
#pragma unroll
    for (int o = 1; o < 64; o <<= 1) v += __shfl_xor(v, o);
    return v;
}

#define XB_TMO      128
#define XB_XCNT(j)  (256  + 64 * (j))
#define XB_XSUB(j)  (1280 + 64 * (j))
#define XB_XGEN(j)  (2304 + 64 * (j))
#define XB_TOP      3328
#define XB_TOPGEN   3392
#define XCD_BAR_WORDS 3456
#define XB_SPIN_CAP (1u << 18)
__device__ __forceinline__ unsigned xb_ld(unsigned* p)              { return __hip_atomic_load(p, __ATOMIC_RELAXED, __HIP_MEMORY_SCOPE_AGENT); }
__device__ __forceinline__ unsigned xb_add(unsigned* p, unsigned v) { return __hip_atomic_fetch_add(p, v, __ATOMIC_RELAXED, __HIP_MEMORY_SCOPE_AGENT); }
__device__ __forceinline__ unsigned xb_xcc_id() { return (unsigned)__builtin_amdgcn_s_getreg((3 << 11) | 20) & 0xFu; }
#define XB_SPIN(cond, bar) do { unsigned _sp = 0; while (cond) { __builtin_amdgcn_s_sleep(1); \
    if ((++_sp & 255u) == 0u) { if (xb_ld(&(bar)[XB_TMO])) break; if (_sp > XB_SPIN_CAP) { atomicAdd(&(bar)[XB_TMO], 1u); break; } } } } while (0)
struct XcdBarrier { unsigned* bar; unsigned x; volatile LAS unsigned* st; };
__device__ __forceinline__ XcdBarrier xcd_barrier_post(unsigned* bar, volatile LAS unsigned* st) {
    XcdBarrier b; b.bar = bar; b.x = xb_xcc_id(); b.st = st;
    if (threadIdx.x == 0) (void)xb_add(&bar[XB_XCNT(b.x)], 1u);
    return b;
}
__device__ __forceinline__ void xcd_barrier_complete(unsigned* bar, unsigned x, unsigned& nloc, unsigned& nx) {
    const unsigned G = gridDim.x * gridDim.y * gridDim.z;
    unsigned sum, cnt, mine, sp = 0u;
    for (;;) {
        sum = 0u; cnt = 0u; mine = 0u;
#pragma unroll
        for (unsigned j = 0; j < 16; ++j) { const unsigned c = xb_ld(&bar[XB_XCNT(j)]); sum += c; cnt += (c > 0u) ? 1u : 0u; mine = (j == x) ? c : mine; }
        if (sum == G) break;
        __builtin_amdgcn_s_sleep(1);
        if ((++sp & 255u) == 0u) { if (xb_ld(&bar[XB_TMO])) break; if (sp > XB_SPIN_CAP) { atomicAdd(&bar[XB_TMO], 1u); break; } }
    }
    nloc = mine > 0u ? mine : 1u; nx = cnt > 0u ? cnt : 1u;
}
__device__ __forceinline__ void xcd_barrier(const XcdBarrier& b) {
    asm volatile("s_waitcnt vmcnt(0)" ::: "memory");
    __syncthreads();
    if (threadIdx.x == 0) {
        unsigned* bar = b.bar;
        __builtin_amdgcn_s_waitcnt(0);
        unsigned nloc = b.st[0], nx = b.st[1];
        if (nloc == 0u) { xcd_barrier_complete(bar, b.x, nloc, nx); b.st[0] = nloc; b.st[1] = nx; }
        const unsigned old = xb_add(&bar[XB_XSUB(b.x)], 1u);
        const unsigned gen = old / nloc;
        if (old + 1u == (gen + 1u) * nloc) {
            __builtin_amdgcn_fence(__ATOMIC_RELEASE, "agent");
            asm volatile("s_waitcnt vmcnt(0)" ::: "memory");
            const unsigned og = xb_add(&bar[XB_TOP], 1u);
            const unsigned tg = og / nx;
            if (og + 1u == (tg + 1u) * nx) xb_add(&bar[XB_TOPGEN], 1u);
            else XB_SPIN(xb_ld(&bar[XB_TOPGEN]) == tg, bar);
            __builtin_amdgcn_fence(__ATOMIC_ACQUIRE, "agent");
            xb_add(&bar[XB_XGEN(b.x)], 1u);
            asm volatile("s_waitcnt vmcnt(0)" ::: "memory");
        } else {
            XB_SPIN(xb_ld(&bar[XB_XGEN(b.x)]) == gen, bar);
            __builtin_amdgcn_fence(__ATOMIC_ACQUIRE, "agent");
            asm volatile("s_waitcnt vmcnt(0)" ::: "memory");
        }
    }
    __syncthreads();
}

struct Params {
    const float* in[31];
    float* out;
    unsigned char* ws;
    int ph_lo, ph_hi, var, pad;
};
enum { I_X = 0, I_MEM, I_POS, I_GMIX, I_WIN, I_GQA, I_GKA, I_RELB, I_GCQ, I_WUQ, I_GCKV, I_WUKV, I_GQB, I_GKB, I_WO, I_GCROSS, I_GMEM, I_WXQ, I_WXKV,
       I_GQX, I_GKX, I_WXO, I_GFFN, I_WROUTER, I_RBIAS, I_WSHG, I_WSHU, I_WSHD, I_WEXG, I_WEXU, I_WEXD };

template <class OT>
__device__ __forceinline__ void rms_row_4096(const float* x, const float* g, OT* o, int lane, float* keep  ) {
    f32x4 v[16]; float s = 0.f;
#pragma unroll
    for (int j = 0; j < 16; ++j) { v[j] = ((const f32x4*)x)[lane + 64 * j]; s += v[j].x * v[j].x + v[j].y * v[j].y + v[j].z * v[j].z + v[j].w * v[j].w; }
    s = wave_sum(s);
    const float r = 1.0f / sqrtf(s * (1.0f / 4096.f) + EPS);
#pragma unroll
    for (int j = 0; j < 16; ++j) v[j] = v[j] * r * __builtin_nontemporal_load((const f32x4*)g + lane + 64 * j);
    asm volatile("s_waitcnt vmcnt(0)" ::: "memory");
#pragma unroll
    for (int j = 0; j < 16; ++j) {
        const f32x4 y = v[j];
        const int c = (lane + 64 * j) * 4;
        stf(o + c, y.x); stf(o + c + 1, y.y); stf(o + c + 2, y.z); stf(o + c + 3, y.w);
        if (keep) { keep[c] = y.x; keep[c + 1] = y.y; keep[c + 2] = y.z; keep[c + 3] = y.w; }
    }
}
template <int N>
__device__ __forceinline__ void rms_inplace(act_t* p, const float* g, int lane) {
    float v[N / 64]; float s = 0.f;
#pragma unroll
    for (int j = 0; j < N / 64; ++j) { v[j] = ldf(p + lane + 64 * j); s += v[j] * v[j]; }
    s = wave_sum(s);
    const float r = 1.0f / sqrtf(s * (1.0f / N) + EPS);
#pragma unroll
    for (int j = 0; j < N / 64; ++j) stf(p + lane + 64 * j, v[j] * r * g[lane + 64 * j]);
}
__device__ __forceinline__ void rms_rope64_inplace(act_t* p, const float* g, int pos, int lane) {
    float v = ldf(p + lane);
    float s = wave_sum(v * v);
    const float r = 1.0f / sqrtf(s * (1.0f / 64.f) + EPS);
    v = v * r * g[lane];
    const int fi = lane & 31;
    const float inv_freq = powf(10000.0f, -(float)(2 * fi) / 64.0f);
    const float ang = (float)pos * inv_freq;
    float sn, cs; sincosf(ang, &sn, &cs);
    const float other = __shfl_xor(v, 32);
    const float y = (lane < 32) ? (v * cs - other * sn) : (v * cs + other * sn);
    stf(p + lane, y);
}

template <class AT, class BCol, class Epi>
__device__ __forceinline__ void ngemm_tile(float* lds, const AT* A, long lda, const int* rowlist, int row0, int nrows, int K, const BCol& bcol, const Epi& epi) {
    const int tid = threadIdx.x, tx = tid & 31, ty = tid >> 5;
    float* As = lds; float* Bs = lds + 16 * 132;
    const int arow = tid >> 2, akq = (tid & 3) * 4;
    int grow; { const int rr = (arow < nrows) ? arow : 0; grow = rowlist ? rowlist[row0 + rr] : (row0 + rr); }
    const AT* Ap = A + (long)grow * lda + akq;
    const int bj = tid & 127, bk = tid >> 7;
    const float* Bp = bcol(bj) + (long)bk * bcol.ldb;
    float acc[8][4];
#pragma unroll
    for (int i = 0; i < 8; ++i)
#pragma unroll
        for (int j = 0; j < 4; ++j) acc[i][j] = 0.f;
    for (int k0 = 0; k0 < K; k0 += 16) {
        float a0 = ldf(Ap + k0), a1 = ldf(Ap + k0 + 1), a2 = ldf(Ap + k0 + 2), a3 = ldf(Ap + k0 + 3);
        float b0 = Bp[(long)(k0) * bcol.ldb], b1 = Bp[(long)(k0 + 4) * bcol.ldb], b2 = Bp[(long)(k0 + 8) * bcol.ldb], b3 = Bp[(long)(k0 + 12) * bcol.ldb];
        __syncthreads();
        As[(akq + 0) * 132 + arow] = a0; As[(akq + 1) * 132 + arow] = a1; As[(akq + 2) * 132 + arow] = a2; As[(akq + 3) * 132 + arow] = a3;
        Bs[(bk + 0) * 132 + bj] = b0; Bs[(bk + 4) * 132 + bj] = b1; Bs[(bk + 8) * 132 + bj] = b2; Bs[(bk + 12) * 132 + bj] = b3;
        __syncthreads();
#pragma unroll
        for (int kk = 0; kk < 16; ++kk) {
            const f32x4 al = *(const f32x4*)(As + kk * 132 + ty * 8), ah = *(const f32x4*)(As + kk * 132 + ty * 8 + 4);
            const f32x4 b = *(const f32x4*)(Bs + kk * 132 + tx * 4);
            const float a[8] = {al.x, al.y, al.z, al.w, ah.x, ah.y, ah.z, ah.w};
#pragma unroll
            for (int i = 0; i < 8; ++i) { acc[i][0] += a[i] * b.x; acc[i][1] += a[i] * b.y; acc[i][2] += a[i] * b.z; acc[i][3] += a[i] * b.w; }
        }
    }
    __syncthreads();
#pragma unroll
    for (int i = 0; i < 8; ++i) { const int r = ty * 8 + i; if (r < nrows) epi(r, tx * 4, acc[i]); }
}
struct BGU { const float* Wg; const float* Wu; int ldb; int ff0; __device__ __forceinline__ const float* operator()(int j) const { const int ff = ff0 + (j >> 2) * 2 + (j & 1); const uintptr_t a = (uintptr_t)Wg, b = (uintptr_t)Wu; return (const float*)((j & 2) ? b : a) + ff; } };
struct BPlain { const float* B; int ldb; int col0, ncols; __device__ __forceinline__ const float* operator()(int j) const { const int c = col0 + j; return B + (c < ncols ? c : 0); } };

template <int DQK, class KeyTile, class Bias>
__device__ __forceinline__ void nattn_unit(float* lds, const act_t* Q, long ldq, const act_t* K1, long ldk1, const act_t* K2, long ldk2, const act_t* V, long ldv,
                                           int ntiles, const KeyTile& keytile, float scale, const Bias& bias, act_t* O, long ldo) {
    constexpr int QS = DQK + 4;
    float* Qs = lds; float* Ks = Qs + 64 * QS; float* Vs = Ks + 64 * QS; float* Ss = Vs + 64 * 132;
    const int tid = threadIdx.x, r = tid >> 3, s = tid & 7;
    __syncthreads();
    for (int idx = tid; idx < 64 * DQK; idx += 512) { const int row = idx / DQK, d = idx % DQK; Qs[row * QS + d] = ldf(Q + (long)row * ldq + d); }
    float m = -INFINITY, l = 0.f; float o[16];
#pragma unroll
    for (int d = 0; d < 16; ++d) o[d] = 0.f;
    for (int t = 0; t < ntiles; ++t) {
        const int k0 = keytile(t);
        __syncthreads();
        for (int idx = tid; idx < 64 * 128; idx += 512) { const int row = idx >> 7, d = idx & 127;
            Ks[row * QS + d] = ldf(K1 + (long)(k0 + row) * ldk1 + d); Vs[row * 132 + d] = ldf(V + (long)(k0 + row) * ldv + d); }
        if (DQK > 128) for (int idx = tid; idx < 64 * (DQK - 128); idx += 512) { const int row = idx / (DQK - 128), d = idx % (DQK - 128);
            Ks[row * QS + 128 + d] = ldf(K2 + (long)(k0 + row) * ldk2 + d); }
        __syncthreads();
#pragma unroll
        for (int jj = 0; jj < 8; ++jj) { const int key = s + 8 * jj; float dot = 0.f;
#pragma unroll 8
            for (int d = 0; d < DQK; d += 4) { const f32x4 q = *(const f32x4*)(Qs + r * QS + d), k = *(const f32x4*)(Ks + key * QS + d); dot += q.x * k.x + q.y * k.y + q.z * k.z + q.w * k.w; }
            Ss[r * 65 + key] = dot * scale + bias(r, t, key); }
        __syncthreads();
        float mt = -INFINITY;
        for (int k = 0; k < 64; ++k) mt = fmaxf(mt, Ss[r * 65 + k]);
        const float mn = fmaxf(m, mt), alpha = expf(m - mn);
        float ladd = 0.f;
#pragma unroll
        for (int d = 0; d < 16; ++d) o[d] *= alpha;
        for (int k = 0; k < 64; ++k) { const float pk = expf(Ss[r * 65 + k] - mn); ladd += pk;
#pragma unroll
            for (int d = 0; d < 16; d += 4) { const f32x4 v = *(const f32x4*)(Vs + k * 132 + s * 16 + d); o[d] += pk * v.x; o[d + 1] += pk * v.y; o[d + 2] += pk * v.z; o[d + 3] += pk * v.w; } }
        m = mn; l = l * alpha + ladd;
    }
    const float il = 1.0f / l;
#pragma unroll
    for (int d = 0; d < 16; ++d) stf(O + (long)r * ldo + s * 16 + d, o[d] * il);
}

struct MoeTab { int* cnt; int* mtp; int* offh; };
__device__ __forceinline__ MoeTab moe_tables(int* tab, const unsigned* gcnt, int tile_m) {
    MoeTab T; T.cnt = tab; T.mtp = tab + 80; T.offh = tab + 160;
    __syncthreads();
    if (threadIdx.x == 0) {
        int pm = 0, po = 0;
        for (int e = 0; e <= NE; ++e) { const int c = (e < NE) ? (int)gcnt[e] : NTOK; T.cnt[e] = c; T.mtp[e] = pm; T.offh[e] = po; pm += (c + tile_m - 1) / tile_m; po += c; }
        T.mtp[NE + 1] = pm;
    }
    __syncthreads();
    return T;
}

namespace fg {
constexpr int BM = 256, BK = 64, HALF = 128, HTB = HALF * BK * 2, STAGE_BYTES = 8 * HTB;
__device__ __forceinline__ int lds_byte(int r, int c) { const int st = (r >> 4) * 2 + (c >> 5), rr = r & 15, cc = c & 31, ob = rr * 64 + cc * 2; return st * 1024 + (ob ^ (((ob >> 9) & 1) << 5)); }
__device__ __forceinline__ void stage_rc(int b, int& R, int& C) { const int st = b / 1024, sb = b % 1024, swz = sb ^ (((sb >> 9) & 1) << 5); R = (st >> 1) * 16 + swz / 64; C = (st & 1) * 32 + (swz % 64) / 2; }
__device__ __forceinline__ int perm32(int rho) { const int n = rho >> 4, i = rho & 15; return 8 * (i >> 2) + 4 * n + (i & 3); }
__device__ __forceinline__ unsigned cvt_pk_bf16(float lo, float hi) { unsigned r; asm volatile("v_cvt_pk_bf16_f32 %0, %1, %2" : "=v"(r) : "v"(lo), "v"(hi)); return r; }

template <class E> __device__ __forceinline__ auto epi_done_impl(const E& e, int pm, int lane, int) -> decltype((void)e.tdone) { asm volatile("s_waitcnt vmcnt(0)" ::: "memory"); if (lane == 0) atomicAdd(e.tdone + pm * 64, 1u); }
template <class E> __device__ __forceinline__ void epi_done_impl(const E&, int, int, long) {}
__device__ __forceinline__ unsigned pk4_fp8(float a, float b, float c, float d) { int w = 0; w = __builtin_amdgcn_cvt_pk_fp8_f32(a, b, w, false); w = __builtin_amdgcn_cvt_pk_fp8_f32(c, d, w, true); return (unsigned)w; }
constexpr float H_SCALE = 4.0f, WD_SCALE = 32.0f, WGU_SCALE = 64.0f, T_SCALE = 2.0f, Y_SCALE = 16.0f;
struct Unit { const char* A; const char* B; const int* rows; int nkt, nvalid, pm, pn, e, arow0; unsigned ready; };
template <class S> __device__ __forceinline__ auto sched_wait_impl(const S& s, Unit& u, int) -> decltype(s.wait(u)) { s.wait(u); }
template <class S> __device__ __forceinline__ void sched_wait_impl(const S&, Unit&, long) {}

template <class Epi, class Sched, bool GATHER, bool FP8 = false, bool SP2 = false>
__device__ __forceinline__ void gemm_phase(LAS unsigned char* lds, const Sched& S, const Epi& E, const int lda, const int ldb, const int var_in = 0) {
#ifdef PROBE_PH
    const int var = var_in;
#else
    constexpr int var = 0; (void)var_in;
#endif
    int tid = threadIdx.x; asm volatile("" : "+v"(tid));
    const int wid = __builtin_amdgcn_readfirstlane(tid >> 6), lane = tid & 63, wr = wid >> 2, wc = wid & 3, fr = lane & 15, fq = lane >> 4;
    unsigned voffB[2][2], voffA[2][2];
#pragma unroll
    for (int i = 0; i < 2; ++i) { int sR, sC; stage_rc(tid * 16 + i * 8192, sR, sC);
#pragma unroll
        for (int hb = 0; hb < 2; ++hb) { int Rb;
            if (Epi::PERM == 2) Rb = 64 * (sR >> 5) + 16 * ((sR >> 2) & 3) + 8 * hb + 4 * ((sR >> 4) & 1) + (sR & 3);
            else Rb = 128 * hb + (Epi::PERM == 1 ? ((sR & ~31) + perm32(sR & 31)) : sR);
            voffB[hb][i] = (unsigned)((Rb >> 6) * ldb * 64 + (Rb & 63) * 64 + sC) * 2u; }
#pragma unroll
        for (int h = 0; h < 2; ++h) voffA[h][i] = (unsigned)((sR + HALF * h) * lda + sC) * 2u; }
    const size_t kstep = (size_t)(BK * 2), kstepB = 8192;
    const unsigned ldsw = (unsigned)wid * 1024u;
    const int aoff = FP8 ? lds_byte(wr * 64 + fr, fq * 16) : lds_byte(wr * 64 + fr, fq * 8), boff = FP8 ? lds_byte(wc * 32 + fr, fq * 16) : lds_byte(wc * 32 + fr, fq * 8);
#define FG_SA(b, h) (((b) * 2 + (h)) * HTB)
#define FG_SB(b, h) ((4 + (b) * 2 + (h)) * HTB)
#define FG_STAGE2(bufoff, gbase, v0, v1) do { \
        __builtin_amdgcn_global_load_lds((const unsigned*)((const char*)(gbase) + (v0)), (LAS unsigned*)(lds + (bufoff) + ldsw), 16, 0, 0); \
        __builtin_amdgcn_global_load_lds((const unsigned*)((const char*)(gbase) + (v1)), (LAS unsigned*)(lds + (bufoff) + ldsw + 8192), 16, 0, 0); } while (0)
#define FG_STAGEB(bufoff, gbase, hb) FG_STAGE2(bufoff, gbase, voffB[hb][0], voffB[hb][1])
#define FG_STAGEA(bufoff, gbase, h) FG_STAGE2(bufoff, gbase, voffA[h][0], voffA[h][1])
#define FG_LD8(base_) __builtin_shufflevector(*(const LAS v4i_t*)(base_), *(const LAS v4i_t*)((base_) + 16), 0, 1, 2, 3, 4, 5, 6, 7)
#define FG_LDA(dst, b, h) do { if (FP8) { _Pragma("unroll") for (int m = 0; m < 4; ++m) dst##8[m] = FG_LD8(lds + FG_SA(b, h) + aoff + m * 2048); } \
      else { _Pragma("unroll") for (int m = 0; m < 4; ++m) _Pragma("unroll") for (int k = 0; k < 2; ++k) dst[m][k] = *(const LAS bf16x8*)(lds + FG_SA(b, h) + aoff + m * 2048 + k * 1024); } } while (0)
#define FG_LDB(dst, b, h) do { if (FP8) { _Pragma("unroll") for (int n = 0; n < 2; ++n) dst##8[n] = FG_LD8(lds + FG_SB(b, h) + boff + n * 2048); } \
      else { _Pragma("unroll") for (int n = 0; n < 2; ++n) _Pragma("unroll") for (int k = 0; k < 2; ++k) dst[n][k] = *(const LAS bf16x8*)(lds + FG_SB(b, h) + boff + n * 2048 + k * 1024); } } while (0)
#define FG_MMA(ai, bj, At, Bt) do { __builtin_amdgcn_s_setprio(1); if (FP8) { _Pragma("unroll") for (int m = 0; m < 4; ++m) _Pragma("unroll") for (int n = 0; n < 2; ++n) \
        asm volatile("v_mfma_scale_f32_16x16x128_f8f6f4 %0, %1, %2, %0, %3, %3 op_sel_hi:[0,0,0]" : "+v"(acc[ai][bj][m][n]) : "v"(Bt##8[n]), "v"(At##8[m]), "v"(sc127)); } \
      else { _Pragma("unroll") for (int m = 0; m < 4; ++m) _Pragma("unroll") for (int n = 0; n < 2; ++n) _Pragma("unroll") for (int k = 0; k < 2; ++k) \
        acc[ai][bj][m][n] = __builtin_amdgcn_mfma_f32_16x16x32_bf16(Bt[n][k], At[m][k], acc[ai][bj][m][n], 0, 0, 0); } __builtin_amdgcn_s_setprio(0); } while (0)
#define FG_WAIT_V(n) asm volatile("s_waitcnt vmcnt(" #n ")" ::: "memory")
#define FG_WAIT_L(n) asm volatile("s_waitcnt lgkmcnt(" #n ")" ::: "memory")
#define FG_BAR __builtin_amdgcn_s_barrier()
#define FG_SCHED __builtin_amdgcn_sched_barrier(0)
#define FG_GATHER(dst, u) do { if (GATHER) { int tz = threadIdx.x; asm volatile("" : "+v"(tz)); _Pragma("unroll") for (int i = 0; i < 2; ++i) { int sR, sC; stage_rc(tz * 16 + i * 8192, sR, sC); \
        _Pragma("unroll") for (int h = 0; h < 2; ++h) { int rr = sR + HALF * h; rr = rr < (u).nvalid ? rr : 0; const int tok = (u).rows ? (u).rows[rr] : ((u).arow0 + rr); dst[h][i] = (unsigned)(tok * lda + sC) * 2u; } } } } while (0)
    Unit cur, nxt; int ui = 0;
    if (!S.next(0, cur)) return;
    sched_wait_impl(S, cur, 0);
    f32x4 acc[2][2][4][2];
#pragma unroll
    for (int a = 0; a < 2; ++a)
#pragma unroll
        for (int b = 0; b < 2; ++b)
#pragma unroll
            for (int m = 0; m < 4; ++m)
#pragma unroll
                for (int n = 0; n < 2; ++n) acc[a][b][m][n] = (f32x4){0.f, 0.f, 0.f, 0.f};
    const int sc127 = 127;
    bf16x8 At[4][2], B0[2][2], B1[2][2]; v8i_t At8[4], B08[2], B18[2];
    const char* cA = cur.A; const char* cB = cur.B;
    typename Epi::Pre pre; E.prefetch(pre, cur, wr, fr);
    FG_GATHER(voffA, cur);
    if (SP2) {
    FG_STAGEB(FG_SB(0, 0), cB, 0); FG_STAGEB(FG_SB(0, 1), cB, 1); FG_STAGEA(FG_SA(0, 0), cA, 0); FG_STAGEA(FG_SA(0, 1), cA, 1);
    if (wr == 1) FG_BAR;
    FG_WAIT_V(2); FG_BAR;
    FG_STAGEB(FG_SB(1, 0), cB + kstepB, 0); FG_STAGEA(FG_SA(1, 0), cA + kstep, 0); FG_STAGEB(FG_SB(1, 1), cB + kstepB, 1);
    FG_WAIT_V(6); FG_BAR;
    } else {
    FG_STAGEB(FG_SB(0, 0), cB, 0); FG_STAGEA(FG_SA(0, 0), cA, 0); FG_STAGEB(FG_SB(0, 1), cB, 1); FG_STAGEA(FG_SA(0, 1), cA, 1);
    if (wr == 1) FG_BAR;
    FG_WAIT_V(4); FG_BAR;
    FG_STAGEB(FG_SB(1, 0), cB + kstepB, 0); FG_STAGEA(FG_SA(1, 0), cA + kstep, 0); FG_STAGEB(FG_SB(1, 1), cB + kstepB, 1);
    FG_WAIT_V(6); FG_BAR;
    }
    for (;;) {
        const bool has_next = S.next(ui + 1, nxt);
        const char* nA = has_next ? nxt.A : cA; const char* nB = has_next ? nxt.B : cB;
        const int nt = cur.nkt;
#pragma unroll 1
        for (int t = 0; t < nt; t += 2) {
            const bool last = (t == nt - 2);
            const char* a1 = cA + (size_t)(t + 1) * kstep;
            const char* a2 = last ? nA : cA + (size_t)(t + 2) * kstep; const char* b2 = last ? nB : cB + (size_t)(t + 2) * kstepB;
            const char* a3 = a2 + kstep; const char* b3 = b2 + kstepB;
            if (last && has_next) sched_wait_impl(S, nxt, 0);
            if (SP2) {
            FG_LDB(B0, 0, 0); FG_LDB(B1, 0, 1); FG_SCHED; FG_LDA(At, 0, 0); FG_STAGEA(FG_SA(1, 1), a1, 1);
            if (GATHER && last && has_next) { FG_GATHER(voffA, nxt); }
            FG_WAIT_V(8); FG_WAIT_L(0); FG_BAR; FG_MMA(0, 0, At, B0); FG_MMA(0, 1, At, B1); FG_BAR; FG_SCHED;
            FG_LDA(At, 0, 1); FG_STAGEB(FG_SB(0, 0), b2, 0); FG_STAGEB(FG_SB(0, 1), b2, 1); FG_STAGEA(FG_SA(0, 0), a2, 0);
            FG_WAIT_V(8); FG_WAIT_L(0); FG_BAR; FG_MMA(1, 0, At, B0); FG_MMA(1, 1, At, B1); FG_BAR; FG_SCHED;
            FG_LDB(B0, 1, 0); FG_LDB(B1, 1, 1); FG_SCHED; FG_LDA(At, 1, 0); FG_STAGEA(FG_SA(0, 1), a2, 1);
            FG_WAIT_V(8); FG_WAIT_L(0); FG_BAR; FG_MMA(0, 0, At, B0); FG_MMA(0, 1, At, B1); FG_BAR; FG_SCHED;
            FG_LDA(At, 1, 1); FG_STAGEB(FG_SB(1, 0), b3, 0); FG_STAGEB(FG_SB(1, 1), b3, 1); FG_STAGEA(FG_SA(1, 0), a3, 0);
            FG_WAIT_V(8); FG_WAIT_L(0); FG_BAR; FG_MMA(1, 0, At, B0); FG_MMA(1, 1, At, B1); FG_BAR; FG_SCHED;
            } else {
            FG_LDB(B0, 0, 0); FG_SCHED; FG_LDA(At, 0, 0); FG_STAGEA(FG_SA(1, 1), a1, 1);
            if (GATHER && last && has_next) { FG_GATHER(voffA, nxt); }
            FG_WAIT_L(8); FG_BAR; FG_WAIT_L(0); if (var < 4) FG_MMA(0, 0, At, B0); FG_BAR; FG_SCHED;
            FG_LDB(B1, 0, 1); FG_STAGEB(FG_SB(0, 0), b2, 0);
            FG_BAR; FG_WAIT_L(0); if (var < 3) FG_MMA(0, 1, At, B1); FG_BAR;
            FG_LDA(At, 0, 1); FG_STAGEA(FG_SA(0, 0), a2, 0);
            FG_BAR; FG_WAIT_L(0); if (var < 4) FG_MMA(1, 0, At, B0); FG_BAR; FG_SCHED;
            FG_STAGEB(FG_SB(0, 1), b2, 1);
            FG_WAIT_V(6); FG_BAR; if (var < 3) FG_MMA(1, 1, At, B1); FG_BAR;
            FG_LDB(B0, 1, 0); FG_SCHED; FG_LDA(At, 1, 0); FG_STAGEA(FG_SA(0, 1), a2, 1);
            FG_WAIT_L(8); FG_BAR; FG_WAIT_L(0); if (var < 4) FG_MMA(0, 0, At, B0); FG_BAR; FG_SCHED;
            FG_LDB(B1, 1, 1); FG_STAGEB(FG_SB(1, 0), b3, 0);
            FG_BAR; FG_WAIT_L(0); if (var < 3) FG_MMA(0, 1, At, B1); FG_BAR;
            FG_LDA(At, 1, 1); FG_STAGEA(FG_SA(1, 0), a3, 0);
            FG_BAR; FG_WAIT_L(0); if (var < 4) FG_MMA(1, 0, At, B0); FG_BAR; FG_SCHED;
            FG_STAGEB(FG_SB(1, 1), b3, 1);
            FG_WAIT_V(6); FG_BAR; if (var < 3) FG_MMA(1, 1, At, B1); FG_BAR;
                    }
}
        if (SP2) { if (wr == 0) FG_BAR; }
        { int tz = threadIdx.x; asm volatile("" : "+v"(tz));
          const int wz = __builtin_amdgcn_readfirstlane(tz >> 6), lz = tz & 63; if (var != 2 && var != 9) E(acc, cur, wz >> 2, wz & 3, lz & 15, lz >> 4, pre);
          epi_done_impl(E, cur.pm, lz, 0); }
        if (!has_next) break;
#pragma unroll
        for (int a = 0; a < 2; ++a)
#pragma unroll
            for (int b = 0; b < 2; ++b)
#pragma unroll
                for (int m = 0; m < 4; ++m)
#pragma unroll
                    for (int n = 0; n < 2; ++n) acc[a][b][m][n] = (f32x4){0.f, 0.f, 0.f, 0.f};
        cur = nxt; cA = nA; cB = nB; ++ui;
        { int tz = threadIdx.x; asm volatile("" : "+v"(tz)); E.prefetch(pre, cur, __builtin_amdgcn_readfirstlane(tz >> 6) >> 2, tz & 15); }
        if (SP2) { if (wr == 1) FG_BAR; }
    }
    FG_WAIT_V(0);
    if (!SP2) { if (wr == 0) FG_BAR; }
    FG_BAR;
#undef FG_SA
#undef FG_SB
#undef FG_STAGE2
#undef FG_STAGEB
#undef FG_STAGEA
#undef FG_STAGEAX
#undef FG_LDA
#undef FG_LDB
#undef FG_MMA
#undef FG_LD8
#undef FG_WAIT_V
#undef FG_WAIT_L
#undef FG_BAR
#undef FG_SCHED
#undef FG_GATHER
}

struct DenseSched {
    const char* A; const char* B; int lda, ldb, nM, nN, nS, nkt, G, c, first;
    __device__ __forceinline__ bool next(int i, Unit& u) const {
        const int total = nM * nN * nS; const int per = (total + 7) / 8;
        int L;
        if (first == 1) {
            const int x = c & 7, r = c >> 3; if (r >= 16) { if (i >= 3) return false; L = x * 64 + (r - 16) * 3 + i; } else { if (i >= 1) return false; L = x * 64 + 48 + r; }
        } else {
        const int j = i * G + c; const int x = j & 7, q = j >> 3;
        if (q >= per) return false; L = x * per + q; if (L >= total) return false; }
        const int ks = L % nS, t2 = L / nS;
        const int nig = 8 * nN, gid = t2 / nig, fm = gid * 8, gsz = (nM - fm) < 8 ? (nM - fm) : 8;
        const int pm = fm + (t2 % nig) % gsz, pn = (t2 % nig) / gsz;
        u.A = A + ((size_t)pm * BM * lda + (size_t)ks * nkt * BK) * 2; u.B = B + ((size_t)pn * BM * ldb + (size_t)ks * nkt * 4096) * 2;
        if (first == 2) { u.A = A; u.B = B; }
        u.rows = nullptr; u.nkt = nkt; u.nvalid = BM; u.pm = pm; u.pn = pn; u.e = ks; u.arow0 = pm * BM; return true;
    }
};
struct NoPre {};
struct EpiBf16 {
    static constexpr int PERM = 1; typedef NoPre Pre; __device__ __forceinline__ void prefetch(Pre&, const Unit&, int, int) const {}
    bf16_t* O; int ldc, ncols; float scale; size_t slab;
    __device__ __forceinline__ void operator()(const f32x4 (&acc)[2][2][4][2], const Unit& u, int wr, int wc, int fr, int fq, const Pre& pre) const {
        const int row0 = u.pm * BM + wr * 64 + fr, col0 = u.pn * BM + wc * 32 + 8 * fq;
#pragma unroll
        for (int ai = 0; ai < 2; ++ai)
#pragma unroll
            for (int m = 0; m < 4; ++m) { bf16_t* rowp = O + (size_t)u.e * slab + (size_t)(row0 + ai * HALF + m * 16) * ldc + col0;
#pragma unroll
                for (int bj = 0; bj < 2; ++bj) { const f32x4 v0 = acc[ai][bj][m][0] * scale, v1 = acc[ai][bj][m][1] * scale;
                    u32x4 w; w.x = cvt_pk_bf16(v0[0], v0[1]); w.y = cvt_pk_bf16(v0[2], v0[3]); w.z = cvt_pk_bf16(v1[0], v1[1]); w.w = cvt_pk_bf16(v1[2], v1[3]);
                    if (col0 + bj * HALF + 8 <= ncols) *(u32x4*)(rowp + bj * HALF) = w; } }
    }
};
struct EpiBf16N {
    static constexpr int PERM = 1; typedef NoPre Pre; __device__ __forceinline__ void prefetch(Pre&, const Unit&, int, int) const {}
    bf16_t* O; int ldc, ncols; float scale;
    const float* gA; int pnA_end; const float* gB; int pnB_end; int half0_only; LAS float* part;
    __device__ __forceinline__ void operator()(const f32x4 (&acc)[2][2][4][2], const Unit& u, int wr, int wc, int fr, int fq, const Pre& pre) const {
        const int rt0 = wr * 64 + fr, row0 = u.pm * BM + rt0, col0 = u.pn * BM + wc * 32 + 8 * fq;
        const bool do_norm = u.pn < pnB_end;
        if (do_norm) {
#pragma unroll
            for (int ai = 0; ai < 2; ++ai)
#pragma unroll
                for (int m = 0; m < 4; ++m)
#pragma unroll
                    for (int bj = 0; bj < 2; ++bj) { if (half0_only && bj == 1) continue;
                        const f32x4 v0 = acc[ai][bj][m][0] * scale, v1 = acc[ai][bj][m][1] * scale;
                        float ss = (v0.x * v0.x + v0.y * v0.y) + (v0.z * v0.z + v0.w * v0.w) + (v1.x * v1.x + v1.y * v1.y) + (v1.z * v1.z + v1.w * v1.w);
                        ss += __shfl_xor(ss, 16); ss += __shfl_xor(ss, 32);
                        if (fq == 0) part[((rt0 + ai * HALF + m * 16) * 2 + bj) * 4 + wc] = ss; }
            asm volatile("s_waitcnt lgkmcnt(0)" ::: "memory"); __builtin_amdgcn_s_barrier(); asm volatile("" ::: "memory");
        }
        const float* g = (u.pn < pnA_end) ? gA : gB;
        f32x4 g0 = (f32x4){1.f, 1.f, 1.f, 1.f}, g1 = g0;
        if (do_norm) { g0 = *(const f32x4*)(g + wc * 32 + 8 * fq); g1 = *(const f32x4*)(g + wc * 32 + 8 * fq + 4); }
#pragma unroll
        for (int ai = 0; ai < 2; ++ai)
#pragma unroll
            for (int m = 0; m < 4; ++m) { const int rt = rt0 + ai * HALF + m * 16; bf16_t* rowp = O + (size_t)(row0 + ai * HALF + m * 16) * ldc + col0;
#pragma unroll
                for (int bj = 0; bj < 2; ++bj) { f32x4 v0 = acc[ai][bj][m][0] * scale, v1 = acc[ai][bj][m][1] * scale;
                    if (do_norm && !(half0_only && bj == 1)) { const f32x4 p4 = *(const LAS f32x4*)(part + (rt * 2 + bj) * 4);
                        const float r = 1.0f / sqrtf(((p4.x + p4.y) + (p4.z + p4.w)) * (1.0f / 128.f) + 1e-6f); v0 = v0 * r * g0; v1 = v1 * r * g1; }
                    u32x4 w; w.x = cvt_pk_bf16(v0[0], v0[1]); w.y = cvt_pk_bf16(v0[2], v0[3]); w.z = cvt_pk_bf16(v1[0], v1[1]); w.w = cvt_pk_bf16(v1[2], v1[3]);
                    if (col0 + bj * HALF + 8 <= ncols) *(u32x4*)(rowp + bj * HALF) = w; } }
    }
};
template <bool HAS_RES> struct EpiF32Res {
    static constexpr int PERM = 0; typedef NoPre Pre; __device__ __forceinline__ void prefetch(Pre&, const Unit&, int, int) const {}
    float* __restrict__ C; const float* __restrict__ res; int ldc; size_t slab; float scale;
    __device__ __forceinline__ void operator()(const f32x4 (&acc)[2][2][4][2], const Unit& u, int wr, int wc, int fr, int fq, const Pre& pre) const {
        const int row0 = u.pm * BM + wr * 64 + fr, col0 = u.pn * BM + wc * 32 + 4 * fq;
        float* __restrict__ Cb = C + (size_t)u.e * slab;
#pragma unroll
        for (int ai = 0; ai < 2; ++ai) {
            f32x4 r[4][2][2];
            if (HAS_RES) {
#pragma unroll
                for (int m = 0; m < 4; ++m) { const size_t o = (size_t)(row0 + ai * HALF + m * 16) * ldc + col0;
#pragma unroll
                    for (int bj = 0; bj < 2; ++bj)
#pragma unroll
                        for (int n = 0; n < 2; ++n) r[m][bj][n] = __builtin_nontemporal_load((const f32x4*)(res + o + bj * HALF + n * 16)); }
            }
#pragma unroll
            for (int m = 0; m < 4; ++m) { const size_t o = (size_t)(row0 + ai * HALF + m * 16) * ldc + col0;
#pragma unroll
                for (int bj = 0; bj < 2; ++bj)
#pragma unroll
                    for (int n = 0; n < 2; ++n) { f32x4 v = acc[ai][bj][m][n] * scale; if (HAS_RES) v = v + r[m][bj][n]; *(f32x4*)(Cb + o + bj * HALF + n * 16) = v; } }
        }
    }
};
struct MoeTabs { const LAS int* cnt; const LAS int* mtp; };
template <int PHASE  >
struct MoeSched {
    MoeTabs T; const char* A; const char* B; const int* rowtok; int G, c; unsigned* tdone; mutable int ehint = 0;
    __device__ __forceinline__ bool next(int i, Unit& u) const {
        constexpr int NT = (PHASE == 1) ? 4 : 16;
        const int nm = T.mtp[(PHASE == 1) ? 65 : 64], total = nm * NT, per = (total + 7) / 8;
        const int x = c & 7; int q = i * (G >> 3) + (c >> 3);
        if (PHASE == 2 && G == 256) {
            const int per1 = (T.mtp[65] * 4 + 7) / 8; int nl = per1 - 160; nl = nl < 0 ? 0 : (nl > 32 ? 32 : nl);
            const int r = c >> 3;
            if (r < nl) q = 5 * (32 - nl) + i * 32 + r; else q = (i < 5) ? i * (32 - nl) + (r - nl) : 5 * (32 - nl) + (i - 5) * 32 + r; }
        if (q >= per) return false; const int L = x * per + q; if (L >= total) return false;
        int mti, pn;
        if (PHASE == 1) { mti = L / NT; pn = L % NT; }
        else { mti = L / NT; pn = 0; }
        int e = 0;
        if (i == 0) {
#pragma unroll 1
        for (int s2 = 32; s2 >= 1; s2 >>= 1) { if (e + s2 <= 64 && T.mtp[e + s2] <= mti) e += s2; }
        } else e = ehint;
        while (T.mtp[e + 1] <= mti) ++e;
        e = __builtin_amdgcn_readfirstlane(e); ehint = e;
        int mt = mti - T.mtp[e];
        if (PHASE == 2) {
            const int nme = T.mtp[e + 1] - T.mtp[e], r = L - T.mtp[e] * NT, ph = r / (nme * 8), r2 = r % (nme * 8);
            mt = r2 >> 3; pn = ph * 8 + (r2 & 7); mti = T.mtp[e] + mt; }
        int nv = T.cnt[e] - mt * 256; nv = nv < 256 ? nv : 256;
        u.nvalid = nv; u.pm = mti; u.pn = pn; u.e = e;
        if (PHASE == 2) u.ready = __hip_atomic_load(tdone + mti * 64, __ATOMIC_RELAXED, __HIP_MEMORY_SCOPE_AGENT);
        if (PHASE == 1) { u.A = A; u.B = B + ((size_t)e * 1024 + (size_t)pn * 256) * DM; u.rows = (e < NE) ? rowtok + e * CAP + mt * 256 : nullptr; u.arow0 = mt * 256; u.nkt = DM / 128; }
        else { u.A = A + (size_t)mti * 256 * EFF; u.B = B + ((size_t)e * DM + (size_t)pn * 256) * EFF; u.rows = nullptr; u.arow0 = mt * 256; u.nkt = EFF / 128; }
        return true;
    }
    __device__ __forceinline__ void wait(Unit& u) const {
        if (PHASE == 2) { unsigned v = u.ready, sp = 0; while (v < 32u) { __builtin_amdgcn_s_sleep(4); v = __hip_atomic_load(tdone + u.pm * 64, __ATOMIC_RELAXED, __HIP_MEMORY_SCOPE_AGENT); if (++sp > (1u << 24)) break; }
            asm volatile("" ::: "memory"); }
    }
};
struct EpiSwiglu {
    static constexpr int PERM = 1;
    struct Pre { float ssv[2][4]; };
    bf16_t* H; const float* ss; unsigned* tdone;
    __device__ __forceinline__ void prefetch(Pre& pre, const Unit& u, int wr, int fr) const {
        const int r0 = wr * 64 + fr;
#pragma unroll
        for (int ai = 0; ai < 2; ++ai)
#pragma unroll
            for (int m = 0; m < 4; ++m) { int rr = r0 + ai * HALF + m * 16; rr = rr < u.nvalid ? rr : 0; const int tok = u.rows ? u.rows[rr] : (u.arow0 + rr); pre.ssv[ai][m] = ss[tok]; } }
    __device__ __forceinline__ void operator()(const f32x4 (&acc)[2][2][4][2], const Unit& u, int wr, int wc, int fr, int fq, const Pre& pre) const {
        const int r0 = wr * 64 + fr, col0 = u.pn * 128 + wc * 32 + 8 * fq;
#pragma unroll
        for (int ai = 0; ai < 2; ++ai)
#pragma unroll
            for (int m = 0; m < 4; ++m) { const int r = r0 + ai * HALF + m * 16;
                const float rs = pre.ssv[ai][m] * (1.0f / (T_SCALE * WGU_SCALE));
                float h[8];
#pragma unroll
                for (int n = 0; n < 2; ++n)
#pragma unroll
                    for (int j = 0; j < 4; ++j) { const float g = acc[ai][0][m][n][j] * rs, up = acc[ai][1][m][n][j] * rs; h[n * 4 + j] = g * __builtin_amdgcn_rcpf(1.0f + __expf(-g)) * up; }
                u32x2 w; w.x = pk4_fp8(h[0] * H_SCALE, h[1] * H_SCALE, h[2] * H_SCALE, h[3] * H_SCALE); w.y = pk4_fp8(h[4] * H_SCALE, h[5] * H_SCALE, h[6] * H_SCALE, h[7] * H_SCALE);
                if (r < u.nvalid) __hip_atomic_store((unsigned long long*)((unsigned char*)H + ((size_t)u.pm * 256 + r) * EFF + col0), ((unsigned long long)w.y << 32) | w.x, __ATOMIC_RELAXED, __HIP_MEMORY_SCOPE_AGENT); }
    }
};
struct EpiScatter {
    static constexpr int PERM = 2;
    struct Pre { int dst[2][4]; float gt[2][4]; };
    unsigned char* Y; const int* rowdst; const float* rowgate; const LAS int* mtp;
    __device__ __forceinline__ void prefetch(Pre& pre, const Unit& u, int wr, int fr) const {
        const int r0 = wr * 64 + fr, lbase = u.e * CAP + (u.pm - mtp[u.e]) * 256;
#pragma unroll
        for (int ai = 0; ai < 2; ++ai)
#pragma unroll
            for (int m = 0; m < 4; ++m) { const int r = r0 + ai * HALF + m * 16; const bool ok = r < u.nvalid; pre.dst[ai][m] = ok ? rowdst[lbase + r] : -1; pre.gt[ai][m] = ok ? rowgate[lbase + r] : 0.f; } }
    __device__ __forceinline__ void operator()(const f32x4 (&acc)[2][2][4][2], const Unit& u, int wr, int wc, int fr, int fq, const Pre& pre) const {
        const int col0 = u.pn * BM + wc * 64 + 16 * fq;
#pragma unroll
        for (int ai = 0; ai < 2; ++ai)
#pragma unroll
            for (int m = 0; m < 4; ++m) { if (pre.dst[ai][m] >= 0) { const float g = pre.gt[ai][m] * (Y_SCALE / (H_SCALE * WD_SCALE));
                const f32x4 v0 = acc[ai][0][m][0] * g, v1 = acc[ai][0][m][1] * g, v2 = acc[ai][1][m][0] * g, v3 = acc[ai][1][m][1] * g;
                u32x4 w; w.x = pk4_fp8(v0[0], v0[1], v0[2], v0[3]); w.y = pk4_fp8(v1[0], v1[1], v1[2], v1[3]); w.z = pk4_fp8(v2[0], v2[1], v2[2], v2[3]); w.w = pk4_fp8(v3[0], v3[1], v3[2], v3[3]);
                *(u32x4*)(Y + (size_t)pre.dst[ai][m] * DM + col0) = w; } }
    }
};
struct EpiShared {
    static constexpr int PERM = 2; typedef NoPre Pre; __device__ __forceinline__ void prefetch(Pre&, const Unit&, int, int) const {}
    unsigned char* Y9;
    __device__ __forceinline__ void operator()(const f32x4 (&acc)[2][2][4][2], const Unit& u, int wr, int wc, int fr, int fq, const Pre& pre) const {
        const int col0 = u.pn * BM + wc * 64 + 16 * fq; const float g = Y_SCALE / (H_SCALE * WD_SCALE);
#pragma unroll
        for (int ai = 0; ai < 2; ++ai)
#pragma unroll
            for (int m = 0; m < 4; ++m) { const int row = u.pm * BM + ai * HALF + wr * 64 + m * 16 + fr;
                const f32x4 v0 = acc[ai][0][m][0] * g, v1 = acc[ai][0][m][1] * g, v2 = acc[ai][1][m][0] * g, v3 = acc[ai][1][m][1] * g;
                u32x4 w; w.x = pk4_fp8(v0[0], v0[1], v0[2], v0[3]); w.y = pk4_fp8(v1[0], v1[1], v1[2], v1[3]); w.z = pk4_fp8(v2[0], v2[1], v2[2], v2[3]); w.w = pk4_fp8(v3[0], v3[1], v3[2], v3[3]);
                *(u32x4*)(Y9 + (size_t)row * DM + col0) = w; }
    }
};
struct EpiResStat {
    static constexpr int PERM = 0; typedef NoPre Pre; __device__ __forceinline__ void prefetch(Pre&, const Unit&, int, int) const {}
    const float* __restrict__ res; bf16_t* __restrict__ Xb; float* ss; int ldc; float scale;
    __device__ __forceinline__ void operator()(const f32x4 (&acc)[2][2][4][2], const Unit& u, int wr, int wc, int fr, int fq, const Pre& pre) const {
        const int row0 = u.pm * BM + wr * 64 + fr, col0 = u.pn * BM + wc * 32 + 4 * fq;
#pragma unroll
        for (int ah = 0; ah < 4; ++ah) { const int ai = ah >> 1, mb = (ah & 1) * 2;
            f32x4 r[4][2][2];
#pragma unroll
            for (int m = mb; m < mb + 2; ++m) { const size_t o = (size_t)(row0 + ai * HALF + m * 16) * ldc + col0;
#pragma unroll
                for (int bj = 0; bj < 2; ++bj)
#pragma unroll
                    for (int n = 0; n < 2; ++n) r[m][bj][n] = __builtin_nontemporal_load((const f32x4*)(res + o + bj * HALF + n * 16)); }
#pragma unroll
            for (int m = mb; m < mb + 2; ++m) { const int row = row0 + ai * HALF + m * 16; const size_t o = (size_t)row * ldc + col0; float sq = 0.f;
#pragma unroll
                for (int bj = 0; bj < 2; ++bj)
#pragma unroll
                    for (int n = 0; n < 2; ++n) { const f32x4 v = acc[ai][bj][m][n] * scale + r[m][bj][n];
                        sq += (v.x * v.x + v.y * v.y) + (v.z * v.z + v.w * v.w);
                        u32x2 pk; pk.x = cvt_pk_bf16(v.x, v.y); pk.y = cvt_pk_bf16(v.z, v.w); *(u32x2*)(Xb + o + bj * HALF + n * 16) = pk; }
                sq += __shfl_xor(sq, 16); sq += __shfl_xor(sq, 32);
                if (fq == 0) ss[(size_t)row * 64 + u.pn * 4 + wc] = sq; }
        }
    }
};
struct EpiX2 {
    static constexpr int PERM = 1; typedef NoPre Pre; __device__ __forceinline__ void prefetch(Pre&, const Unit&, int, int) const {}
    const bf16_t* __restrict__ res; bf16_t* __restrict__ Th; bf16_t* __restrict__ Tl; unsigned char* __restrict__ T8; float* ss; int ldc; float scale;
    __device__ __forceinline__ void operator()(const f32x4 (&acc)[2][2][4][2], const Unit& u, int wr, int wc, int fr, int fq, const Pre& pre) const {
        const int row0 = u.pm * BM + wr * 64 + fr, col0 = u.pn * BM + wc * 32 + 8 * fq;
#pragma unroll
        for (int ah = 0; ah < 2; ++ah) { const int ai = ah;
            u32x4 r[4][2];
#pragma unroll
            for (int m = 0; m < 4; ++m) { const size_t o = (size_t)(row0 + ai * HALF + m * 16) * ldc + col0;
#pragma unroll
                for (int bj = 0; bj < 2; ++bj) r[m][bj] = __builtin_nontemporal_load((const u32x4*)(res + o + bj * HALF)); }
#pragma unroll
            for (int m = 0; m < 4; ++m) { const int row = row0 + ai * HALF + m * 16; const size_t o = (size_t)row * ldc + col0; float sq = 0.f;
#pragma unroll
                for (int bj = 0; bj < 2; ++bj) { const u32x4 rr = r[m][bj];
                    const f32x4 r0 = (f32x4){__uint_as_float(rr.x << 16), __uint_as_float(rr.x & 0xffff0000u), __uint_as_float(rr.y << 16), __uint_as_float(rr.y & 0xffff0000u)};
                    const f32x4 r1 = (f32x4){__uint_as_float(rr.z << 16), __uint_as_float(rr.z & 0xffff0000u), __uint_as_float(rr.w << 16), __uint_as_float(rr.w & 0xffff0000u)};
                    const f32x4 w0 = acc[ai][bj][m][0] * scale + r0, w1 = acc[ai][bj][m][1] * scale + r1;
                    sq += (w0.x * w0.x + w0.y * w0.y) + (w0.z * w0.z + w0.w * w0.w) + (w1.x * w1.x + w1.y * w1.y) + (w1.z * w1.z + w1.w * w1.w);
                    u32x4 h; h.x = cvt_pk_bf16(w0.x, w0.y); h.y = cvt_pk_bf16(w0.z, w0.w); h.z = cvt_pk_bf16(w1.x, w1.y); h.w = cvt_pk_bf16(w1.z, w1.w);
                    u32x4 l; l.x = cvt_pk_bf16(w0.x - __uint_as_float(h.x << 16), w0.y - __uint_as_float(h.x & 0xffff0000u)); l.y = cvt_pk_bf16(w0.z - __uint_as_float(h.y << 16), w0.w - __uint_as_float(h.y & 0xffff0000u));
                    l.z = cvt_pk_bf16(w1.x - __uint_as_float(h.z << 16), w1.y - __uint_as_float(h.z & 0xffff0000u)); l.w = cvt_pk_bf16(w1.z - __uint_as_float(h.w << 16), w1.w - __uint_as_float(h.w & 0xffff0000u));
                    u32x2 q8; q8.x = pk4_fp8(w0.x * T_SCALE, w0.y * T_SCALE, w0.z * T_SCALE, w0.w * T_SCALE); q8.y = pk4_fp8(w1.x * T_SCALE, w1.y * T_SCALE, w1.z * T_SCALE, w1.w * T_SCALE);
                    *(u32x4*)(Th + o + bj * HALF) = h; *(u32x4*)(Tl + o + bj * HALF) = l; *(u32x2*)(T8 + o + bj * HALF) = q8; }
                sq += __shfl_xor(sq, 16); sq += __shfl_xor(sq, 32);
                if (fq == 0) ss[(size_t)row * 64 + u.pn * 4 + wc] = sq; }
        }
    }
};
}

namespace fa {
typedef short s16x4 __attribute__((ext_vector_type(4)));
typedef float f32x16 __attribute__((ext_vector_type(16)));
constexpr int SHM_V = 16384, SHM_K = 16384, SHM_K2 = 8192;
constexpr int OFF_V = 0, OFF_K = 2 * SHM_V, OFF_K2 = OFF_K + 2 * SHM_K, OFF_WS = OFF_K2 + 2 * SHM_K2, OFF_TBL = OFF_WS + 8 * 64 * 4, OFF_QPE = OFF_TBL + 1024, LDS_ATTN = OFF_QPE + 8 * 4096;
#define KSWZ(row, colB) ((row) * 256 + ((colB) ^ (((row) & 7) << 4)))
#define KSWZ2(row, colB) ((row) * 128 + ((colB) ^ (((row) & 7) << 4)))
#define SBAR() __builtin_amdgcn_sched_barrier(0)
__device__ __forceinline__ int crow(int r, int hi) { return (r & 3) + 8 * (r >> 2) + 4 * hi; }
__device__ __forceinline__ unsigned cvtpk(float lo, float hi) { unsigned r; asm volatile("v_cvt_pk_bf16_f32 %0, %1, %2" : "=v"(r) : "v"(lo), "v"(hi)); return r; }
constexpr float MIX_SCALE = 64.0f;
__device__ __forceinline__ unsigned fg_pk4_fp8(float a, float b, float c, float d) { int w = 0; w = __builtin_amdgcn_cvt_pk_fp8_f32(a, b, w, false); w = __builtin_amdgcn_cvt_pk_fp8_f32(c, d, w, true); return (unsigned)w; }
template <int MODE> struct Cf { static constexpr float SCALE = (MODE == 1) ? 0.07216878364870323f : 0.08838834764831845f; static constexpr float C = SCALE * 1.4426950408889634f; static constexpr float THRS = 8.0f / SCALE; };

template <int MODE>
__device__ __forceinline__ void partialSM(f32x16& p0, f32x16& p1, float& m_reg, float& mn, float& alpha) {
  constexpr float C = Cf<MODE>::C;
  float pmax = p0[0];
#pragma unroll
  for (int r = 1; r < 16; ++r) pmax = fmaxf(pmax, p0[r]);
#pragma unroll
  for (int r = 0; r < 16; ++r) pmax = fmaxf(pmax, p1[r]);
  { auto rr = __builtin_amdgcn_permlane32_swap(__float_as_uint(pmax), __float_as_uint(pmax), false, false);
    pmax = fmaxf(__uint_as_float(rr[0]), __uint_as_float(rr[1])); }
  if (__builtin_expect(__all(pmax - m_reg <= Cf<MODE>::THRS), 1)) { mn = m_reg; alpha = 1.f; }
  else { mn = fmaxf(m_reg, pmax); alpha = __builtin_amdgcn_exp2f((m_reg - mn) * C); m_reg = mn; }
  const float mnC = -mn * C;
#pragma unroll
  for (int r = 0; r < 16; ++r) p0[r] = fmaf(p0[r], C, mnC);
#pragma unroll
  for (int r = 0; r < 16; ++r) p1[r] = fmaf(p1[r], C, mnC);
#pragma unroll
  for (int r = 0; r < 16; ++r) p0[r] = __builtin_amdgcn_exp2f(p0[r]);
}
__device__ __forceinline__ void finishSM(f32x16& p0, f32x16& p1, float alpha, float& l_reg, bf16x8& pa0, bf16x8& pa1, bf16x8& pa2, bf16x8& pa3) {
#pragma unroll
  for (int r = 0; r < 16; ++r) p1[r] = __builtin_amdgcn_exp2f(p1[r]);
  float ps = 0;
#pragma unroll
  for (int r = 0; r < 16; ++r) ps += p0[r];
#pragma unroll
  for (int r = 0; r < 16; ++r) ps += p1[r];
  { auto rr = __builtin_amdgcn_permlane32_swap(__float_as_uint(ps), __float_as_uint(ps), false, false);
    ps = __uint_as_float(rr[0]) + __uint_as_float(rr[1]); }
  l_reg = l_reg * alpha + ps;
#define PK4(P, BASE, OUT) do { unsigned a0 = cvtpk(P[BASE + 0], P[BASE + 1]), a1 = cvtpk(P[BASE + 2], P[BASE + 3]);   \
    unsigned b0 = cvtpk(P[BASE + 4], P[BASE + 5]), b1 = cvtpk(P[BASE + 6], P[BASE + 7]);                              \
    auto r0 = __builtin_amdgcn_permlane32_swap(a0, b0, false, false); auto r1 = __builtin_amdgcn_permlane32_swap(a1, b1, false, false); \
    u32x4 w = {r0[0], r1[0], r0[1], r1[1]}; OUT = *reinterpret_cast<bf16x8*>(&w); } while (0)
  PK4(p0, 0, pa0); PK4(p0, 8, pa1); PK4(p1, 0, pa2); PK4(p1, 8, pa3);
#undef PK4
}
template <int MODE>
__device__ __forceinline__ void qkt(f32x16& p0, f32x16& p1, const LAS char* Ks, const LAS char* K2s, const bf16x8* qr, int r32, int hi, const LAS char* qpe) {
  p0 = f32x16{}; p1 = f32x16{};
#pragma unroll
  for (int d0 = 0; d0 < 8; ++d0) { const int cb = (d0 * 16 + hi * 8) * 2;
    const bf16x8 b0 = *reinterpret_cast<const LAS bf16x8*>(Ks + KSWZ(r32, cb));
    const bf16x8 b1 = *reinterpret_cast<const LAS bf16x8*>(Ks + KSWZ(32 + r32, cb));
    p0 = __builtin_amdgcn_mfma_f32_32x32x16_bf16(b0, qr[d0], p0, 0, 0, 0);
    p1 = __builtin_amdgcn_mfma_f32_32x32x16_bf16(b1, qr[d0], p1, 0, 0, 0); }
  if (MODE == 1) {
#pragma unroll
    for (int d0 = 0; d0 < 4; ++d0) { const int cb = (d0 * 16 + hi * 8) * 2;
      const bf16x8 b0 = *reinterpret_cast<const LAS bf16x8*>(K2s + KSWZ2(r32, cb));
      const bf16x8 b1 = *reinterpret_cast<const LAS bf16x8*>(K2s + KSWZ2(32 + r32, cb));
      const bf16x8 qp = *reinterpret_cast<const LAS bf16x8*>(qpe + d0 * 1024);
      p0 = __builtin_amdgcn_mfma_f32_32x32x16_bf16(b0, qp, p0, 0, 0, 0);
      p1 = __builtin_amdgcn_mfma_f32_32x32x16_bf16(b1, qp, p1, 0, 0, 0); }
  }
}
__device__ __forceinline__ int v_st(int k, int c) { const int kk = (k & ~0xC) | ((k & 4) << 1) | ((k & 8) >> 1); return ((kk >> 3) * 4 + (c >> 5)) * 512 + ((kk & 7) * 32 + (c & 31)) * 2; }
__device__ __forceinline__ int v_rd_base(int lane) { return ((lane & 3) << 3) | (((lane >> 2) & 3) << 6) | (((lane >> 4) & 1) << 5) | (((lane >> 5) & 1) << 8); }
constexpr int v_rd_off(int d0, int ks, int half) { return d0 * 512 + ks * 4096 + half * 2048; }
template <int OFF> __device__ __forceinline__ s16x4 tr_read(int vb) { s16x4 r; asm volatile("ds_read_b64_tr_b16 %0, %1 offset:%2" : "=&v"(r) : "v"(vb), "i"(OFF) : "memory"); return r; }
template <int D0> __device__ __forceinline__ void pv_one(f32x16& od, int vb, bf16x8 pa0, bf16x8 pa1, bf16x8 pa2, bf16x8 pa3) {
  const s16x4 l0 = tr_read<v_rd_off(D0, 0, 0)>(vb), h0 = tr_read<v_rd_off(D0, 0, 1)>(vb), l1 = tr_read<v_rd_off(D0, 1, 0)>(vb), h1 = tr_read<v_rd_off(D0, 1, 1)>(vb);
  const s16x4 l2 = tr_read<v_rd_off(D0, 2, 0)>(vb), h2 = tr_read<v_rd_off(D0, 2, 1)>(vb), l3 = tr_read<v_rd_off(D0, 3, 0)>(vb), h3 = tr_read<v_rd_off(D0, 3, 1)>(vb);
  asm volatile("s_waitcnt lgkmcnt(0)" ::: "memory"); SBAR();
#define PK(L, H) (bf16x8){L[0], L[1], L[2], L[3], H[0], H[1], H[2], H[3]}
  od = __builtin_amdgcn_mfma_f32_32x32x16_bf16(pa0, PK(l0, h0), od, 0, 0, 0);
  od = __builtin_amdgcn_mfma_f32_32x32x16_bf16(pa1, PK(l1, h1), od, 0, 0, 0);
  od = __builtin_amdgcn_mfma_f32_32x32x16_bf16(pa2, PK(l2, h2), od, 0, 0, 0);
  od = __builtin_amdgcn_mfma_f32_32x32x16_bf16(pa3, PK(l3, h3), od, 0, 0, 0);
#undef PK
}
__device__ __forceinline__ void pv_d0(f32x16* o, int vb, bf16x8 pa0, bf16x8 pa1, bf16x8 pa2, bf16x8 pa3) {
  pv_one<0>(o[0], vb, pa0, pa1, pa2, pa3); pv_one<1>(o[1], vb, pa0, pa1, pa2, pa3); pv_one<2>(o[2], vb, pa0, pa1, pa2, pa3); pv_one<3>(o[3], vb, pa0, pa1, pa2, pa3);
}
struct Args { const bf16_t* Q; const bf16_t* K1; const bf16_t* K2; const bf16_t* V; bf16_t* O; int kt0, NT, qch0; const float* aux; };
template <int MODE> struct St {
    static constexpr int LDQ = (MODE == 0) ? INW : (MODE == 1 ? 3072 : 512), LDK1 = (MODE == 0) ? INW : (MODE == 1 ? 4096 : 1024), LDK2 = INW, LDV = LDK1, LDO = (MODE == 2) ? 512 : DM; };
template <int MODE>
__device__ __forceinline__ void mask_bias(f32x16& p0, f32x16& p1, int qch, int kch, int qpos, int hi, const LAS float* tbl) {
  const bool valid = (MODE == 2) || ((kch <= qch) && (MODE == 1 || kch >= qch - 8));
  if (!valid) {
#pragma unroll
    for (int r = 0; r < 16; ++r) { p0[r] = -INFINITY; p1[r] = -INFINITY; }
  } else if (MODE == 0) {
    if (qch - kch >= 3) { const float b = tbl[191];
#pragma unroll
      for (int r = 0; r < 16; ++r) { p0[r] += b; p1[r] += b; }
    } else { const int base = qpos - kch * 64 + 63 - 4 * hi;
#pragma unroll
      for (int g = 0; g < 4; ++g) {
#pragma unroll
        for (int r = 4 * g; r < 4 * g + 4; ++r) { int d0 = base - ((r & 3) + 8 * (r >> 2)), d1 = d0 - 32;
          d0 = d0 < 0 ? 0 : (d0 > 191 ? 191 : d0); d1 = d1 < 0 ? 0 : (d1 > 191 ? 191 : d1);
          p0[r] += tbl[d0]; p1[r] += tbl[d1]; }
        SBAR();
      }
    }
  }
}
template <int MODE>
__device__ __forceinline__ void attn_body(const Args& a, LAS char* lds) {
  constexpr int NQ = 8;
  int tid = threadIdx.x; asm volatile("" : "+v"(tid));
  const int wid = tid >> 6, lane = tid & 63, r32 = lane & 31, hi = lane >> 5;
  LAS char* V_lds = lds + OFF_V; LAS char* K_lds = lds + OFF_K; LAS char* K2_lds = lds + OFF_K2;
  LAS float* ws = (LAS float*)(lds + OFF_WS) + wid * 64; LAS float* li_l = ws; LAS float* al_l = ws + 32;
  const LAS float* tbl = (const LAS float*)(lds + OFF_TBL);
  float m_reg = -1e30f, l_reg = 0; f32x16 o[4] = {}; bf16x8 qr[NQ];
  const bf16_t* Qw = a.Q + (wid * 32 + r32) * St<MODE>::LDQ + hi * 8;
  if (MODE == 2) {
    const bf16_t* Qs = a.Q + (size_t)(wid * 32 + r32) * 512 + hi * 8;
    const float* ssp = (const float*)a.K2 + (size_t)(wid * 32 + r32) * 64 + hi * 32;
    float s1 = 0.f;
#pragma unroll
    for (int q = 0; q < 8; ++q) { const f32x4 t = *(const f32x4*)(ssp + 4 * q); s1 += (t.x + t.y) + (t.z + t.w); }
    s1 += __shfl_xor(s1, 32);
    const float rs1 = 1.0f / sqrtf(s1 * (1.0f / 4096.f) + 1e-6f);
    f32x4 qa[NQ][2]; float ssq = 0.f;
#pragma unroll
    for (int d0 = 0; d0 < NQ; ++d0) { constexpr size_t SL = (size_t)NTOK * 512; u32x4 w[4];
#pragma unroll
      for (int sl = 0; sl < 4; ++sl) w[sl] = *(const u32x4*)(Qs + d0 * 16 + sl * SL);
#pragma unroll
      for (int hf = 0; hf < 2; ++hf) { f32x4 t[4];
#pragma unroll
        for (int sl = 0; sl < 4; ++sl) { const unsigned lo = hf ? w[sl].z : w[sl].x, hi2 = hf ? w[sl].w : w[sl].y; t[sl] = (f32x4){__uint_as_float(lo << 16), __uint_as_float(lo & 0xffff0000u), __uint_as_float(hi2 << 16), __uint_as_float(hi2 & 0xffff0000u)}; }
        const f32x4 v = ((t[0] + t[1]) + (t[2] + t[3])) * rs1;
        qa[d0][hf] = v; ssq += (v.x * v.x + v.y * v.y) + (v.z * v.z + v.w * v.w); } }
    ssq += __shfl_xor(ssq, 32);
    const float rq = 1.0f / sqrtf(ssq * (1.0f / 128.f) + 1e-6f);
#pragma unroll
    for (int d0 = 0; d0 < NQ; ++d0) { const f32x4 g0 = *(const f32x4*)(a.aux + hi * 8 + d0 * 16), g1 = *(const f32x4*)(a.aux + hi * 8 + d0 * 16 + 4);
      const f32x4 v0 = qa[d0][0] * rq * g0, v1 = qa[d0][1] * rq * g1;
      u32x4 w; w.x = cvtpk(v0.x, v0.y); w.y = cvtpk(v0.z, v0.w); w.z = cvtpk(v1.x, v1.y); w.w = cvtpk(v1.z, v1.w); qr[d0] = *reinterpret_cast<bf16x8*>(&w); }
  } else {
#pragma unroll
  for (int d0 = 0; d0 < NQ; ++d0) qr[d0] = *reinterpret_cast<const bf16x8*>(Qw + d0 * 16);
  }
  const LAS char* qpe = lds + OFF_QPE + wid * 4096 + lane * 16;
  if (MODE == 1) {
#pragma unroll
    for (int d0 = 0; d0 < 4; ++d0) *(LAS bf16x8*)(lds + OFF_QPE + wid * 4096 + lane * 16 + d0 * 1024) = *reinterpret_cast<const bf16x8*>(Qw + 128 + d0 * 16);
  }
  const int sr = tid >> 4, sc = (tid & 15) * 8, vst0 = v_st(sr, sc), vst1 = v_st(32 + sr, sc);
  const int s2r = tid >> 3, s2c = (tid & 7) * 8;
  const int vb0 = (int)(uintptr_t)V_lds + v_rd_base(lane);
  const int qch = a.qch0 + (wid >> 1), qpos = a.qch0 * 64 + wid * 32 + r32;
  bf16x8 vs0, vs1, ks0, ks1, k2s;
  const unsigned ovk = (unsigned)(sr * St<MODE>::LDK1 + sc) * 2u, ok2 = (unsigned)(s2r * St<MODE>::LDK2 + s2c) * 2u;
#define SLOAD(j) do { const size_t k0_ = (size_t)(a.kt0 + (j)) * 64; \
    const char* vt_ = (const char*)(a.V + k0_ * St<MODE>::LDV); const char* kt_ = (const char*)(a.K1 + k0_ * St<MODE>::LDK1); \
    vs0 = *reinterpret_cast<const bf16x8*>(vt_ + ovk); vs1 = *reinterpret_cast<const bf16x8*>(vt_ + 64 * St<MODE>::LDV + ovk); \
    ks0 = *reinterpret_cast<const bf16x8*>(kt_ + ovk); ks1 = *reinterpret_cast<const bf16x8*>(kt_ + 64 * St<MODE>::LDK1 + ovk); \
    if (MODE == 1) k2s = *reinterpret_cast<const bf16x8*>((const char*)(a.K2 + k0_ * St<MODE>::LDK2) + ok2); } while (0)
#define SWRITE(b) do { *(LAS bf16x8*)(V_lds + (b) * SHM_V + vst0) = vs0; *(LAS bf16x8*)(V_lds + (b) * SHM_V + vst1) = vs1; const int kc = sc * 2; \
    *(LAS bf16x8*)(K_lds + (b) * SHM_K + KSWZ(sr, kc)) = ks0; *(LAS bf16x8*)(K_lds + (b) * SHM_K + KSWZ(32 + sr, kc)) = ks1; \
    if (MODE == 1) *(LAS bf16x8*)(K2_lds + (b) * SHM_K2 + KSWZ2(s2r, s2c * 2)) = k2s; } while (0)
#define SWAIT() asm volatile("s_waitcnt vmcnt(0)" ::: "memory")
#define RESC(al) do { if (__any((al) < 1.f)) { if (hi == 0) al_l[r32] = (al); asm volatile("s_waitcnt lgkmcnt(0)" ::: "memory"); \
    _Pragma("unroll") for (int d = 0; d < 4; ++d) _Pragma("unroll") for (int r = 0; r < 16; ++r) o[d][r] *= al_l[crow(r, hi)]; } } while (0)
  f32x16 pA0, pA1, pB0, pB1; float mnA, mnB, alA, alB; bf16x8 pa0, pa1, pa2, pa3; const int NT = a.NT;
  SLOAD(0); SWAIT(); SWRITE(0); __syncthreads();
  qkt<MODE>(pA0, pA1, K_lds, K2_lds, qr, r32, hi, qpe); mask_bias<MODE>(pA0, pA1, qch, a.kt0, qpos, hi, tbl); partialSM<MODE>(pA0, pA1, m_reg, mnA, alA);
  SLOAD(1);
  SWAIT(); SWRITE(1); __syncthreads();
  for (int j = 1; j + 1 < NT; j += 2) {
    SBAR(); qkt<MODE>(pB0, pB1, K_lds + SHM_K, K2_lds + SHM_K2, qr, r32, hi, qpe); mask_bias<MODE>(pB0, pB1, qch, a.kt0 + j, qpos, hi, tbl);
    finishSM(pA0, pA1, alA, l_reg, pa0, pa1, pa2, pa3); SBAR();
    SLOAD(j + 1); SBAR();
    pv_d0(o, vb0, pa0, pa1, pa2, pa3); partialSM<MODE>(pB0, pB1, m_reg, mnB, alB);
    __syncthreads(); SWAIT(); SWRITE(0);
    RESC(alB); __syncthreads();
    SBAR(); qkt<MODE>(pA0, pA1, K_lds, K2_lds, qr, r32, hi, qpe); mask_bias<MODE>(pA0, pA1, qch, a.kt0 + j + 1, qpos, hi, tbl);
    finishSM(pB0, pB1, alB, l_reg, pa0, pa1, pa2, pa3); SBAR();
    SLOAD(j + 2); SBAR();
    pv_d0(o, vb0 + SHM_V, pa0, pa1, pa2, pa3); partialSM<MODE>(pA0, pA1, m_reg, mnA, alA);
    __syncthreads(); SWAIT(); SWRITE(1);
    RESC(alA); __syncthreads();
  }
  SBAR(); qkt<MODE>(pB0, pB1, K_lds + SHM_K, K2_lds + SHM_K2, qr, r32, hi, qpe); mask_bias<MODE>(pB0, pB1, qch, a.kt0 + NT - 1, qpos, hi, tbl);
  finishSM(pA0, pA1, alA, l_reg, pa0, pa1, pa2, pa3); SBAR();
  pv_d0(o, vb0, pa0, pa1, pa2, pa3); partialSM<MODE>(pB0, pB1, m_reg, mnB, alB);
  __syncthreads(); RESC(alB);
  finishSM(pB0, pB1, alB, l_reg, pa0, pa1, pa2, pa3); SBAR();
  pv_d0(o, vb0 + SHM_V, pa0, pa1, pa2, pa3);
  if (hi == 0) li_l[r32] = l_reg; asm volatile("s_waitcnt lgkmcnt(0)" ::: "memory");
  {
    constexpr int LDO8 = (MODE == 2) ? 512 : DM;
    unsigned char* Ow8 = (unsigned char*)a.O + (size_t)(wid * 32) * LDO8;
    const int qi = lane & 3;
#pragma unroll
    for (int rg = 0; rg < 4; ++rg) {
      float rl[4];
#pragma unroll
      for (int j = 0; j < 4; ++j) rl[j] = __builtin_amdgcn_rcpf(li_l[crow(4 * rg + j, hi)]) * MIX_SCALE;
#pragma unroll
      for (int d0 = 0; d0 < 4; ++d0) { float v[4];
#pragma unroll
        for (int j = 0; j < 4; ++j) v[j] = o[d0][4 * rg + j] * rl[j];
        { const float s0 = (qi & 1) ? v[0] : v[1], s1 = (qi & 1) ? v[2] : v[3]; const float t0 = __shfl_xor(s0, 1), t1 = __shfl_xor(s1, 1);
          if (qi & 1) { v[0] = t0; v[2] = t1; } else { v[1] = t0; v[3] = t1; } }
        { const float s0 = (qi & 2) ? v[0] : v[2], s1 = (qi & 2) ? v[1] : v[3]; const float t0 = __shfl_xor(s0, 2), t1 = __shfl_xor(s1, 2);
          if (qi & 2) { v[0] = t0; v[1] = t1; } else { v[2] = t0; v[3] = t1; } }
        const int orow = 8 * rg + 4 * hi + qi;
        *(unsigned*)(Ow8 + (size_t)orow * LDO8 + d0 * 32 + (r32 & ~3)) = fg_pk4_fp8(v[0], v[1], v[2], v[3]); } }
  }
  __syncthreads();
#undef SLOAD
#undef SWRITE
#undef SWAIT
#undef RESC
}
#undef KSWZ
#undef KSWZ2
#undef SBAR
template <int MODE> __device__ __forceinline__ void attn_call(const bf16_t* Q, const bf16_t* K1, const bf16_t* K2, const bf16_t* V, bf16_t* O, int kt0, int NT, int qch0, LAS char* lds, const float* aux = nullptr) {
  Args a{Q, K1, K2, V, O, kt0, NT, qch0, aux}; attn_body<MODE>(a, lds);
}
}

#ifndef TVAR
#define TVAR 0
#endif
template <int VAR = 0, bool GK = false>
__device__ __forceinline__ void transpose_item(const float* W, int K, int N, bf16_t* WT, int k0, int n0, int drow0, LAS float* scr, int lane, const float* gk = nullptr) {
    float v[64];
    const float* src = W + (size_t)k0 * N + n0 + lane;
#pragma unroll
    for (int i = 0; i < 64; ++i) v[i] = __builtin_nontemporal_load(src + (size_t)i * N);
    if (VAR == 1) {
#pragma unroll
        for (int i = 0; i < 64; ++i) asm volatile("" :: "v"(v[i]));
        return; }
#pragma unroll
    for (int i = 0; i < 64; ++i) scr[i * 65 + lane] = GK ? v[i] * gk[k0 + i] : v[i];
    asm volatile("s_waitcnt lgkmcnt(0)" ::: "memory");
    if (VAR == 2) { drow0 = 0; k0 = 0; }
    const int c = lane & 7;
#pragma unroll
    for (int j = 0; j < 8; ++j) { const int n = (lane >> 3) + 8 * j; const LAS float* sp = scr + (8 * c) * 65 + n;
        u32x4 o; o.x = fg::cvt_pk_bf16(sp[0 * 65], sp[1 * 65]); o.y = fg::cvt_pk_bf16(sp[2 * 65], sp[3 * 65]); o.z = fg::cvt_pk_bf16(sp[4 * 65], sp[5 * 65]); o.w = fg::cvt_pk_bf16(sp[6 * 65], sp[7 * 65]);
        *(u32x4*)(WT + ((size_t)(drow0 >> 6) * (K >> 6) + (k0 >> 6)) * 4096 + n * 64 + 8 * c) = o; }
    asm volatile("s_waitcnt lgkmcnt(0)" ::: "memory");
}
__device__ __forceinline__ fg::MoeTabs moe_tables_fast(LAS int* tab, const unsigned* gcnt) {
    fg::MoeTabs T; T.cnt = tab; T.mtp = tab + 80;
    __syncthreads();
    if (threadIdx.x == 0) { int pm = 0;
        for (int e = 0; e <= NE; ++e) { const int c = (e < NE) ? (int)gcnt[64 * e] : NTOK; tab[e] = c; tab[80 + e] = pm; pm += (c + 255) / 256; }
        tab[80 + NE + 1] = pm; }
    __syncthreads();
    return T;
}
template <bool GK = false>
__device__ __forceinline__ void transpose_item_fp8(const float* W, int K, int N, unsigned char* WT, int k0, int n0, int drow0, float scale, LAS float* scr, int lane, const float* gk = nullptr) {
    float v[64];
    const float* src = W + (size_t)k0 * N + n0 + lane;
#pragma unroll
    for (int i = 0; i < 64; ++i) v[i] = __builtin_nontemporal_load(src + (size_t)i * N);
#pragma unroll
    for (int i = 0; i < 64; ++i) scr[i * 65 + lane] = GK ? v[i] * (scale * gk[k0 + i]) : v[i] * scale;
    asm volatile("s_waitcnt lgkmcnt(0)" ::: "memory");
    const int c = lane & 3;
    unsigned char* tile = WT + ((size_t)(drow0 >> 6) * (K >> 7) + (k0 >> 7)) * 8192 + (k0 & 64);
#pragma unroll
    for (int j = 0; j < 4; ++j) { const int n = (lane >> 2) + 16 * j; const LAS float* sp = scr + (16 * c) * 65 + n;
        u32x4 o; o.x = fg::pk4_fp8(sp[0 * 65], sp[1 * 65], sp[2 * 65], sp[3 * 65]); o.y = fg::pk4_fp8(sp[4 * 65], sp[5 * 65], sp[6 * 65], sp[7 * 65]);
        o.z = fg::pk4_fp8(sp[8 * 65], sp[9 * 65], sp[10 * 65], sp[11 * 65]); o.w = fg::pk4_fp8(sp[12 * 65], sp[13 * 65], sp[14 * 65], sp[15 * 65]);
        *(u32x4*)(tile + n * 128 + 16 * c) = o; }
    asm volatile("s_waitcnt lgkmcnt(0)" ::: "memory");
}
__device__ __forceinline__ void transpose_item_hilo(const float* W, int K, bf16_t* WH, bf16_t* WL, int k0, LAS float* scr, int lane, const float* gk) {
    float v[64];
    const float* src = W + (size_t)k0 * 64 + lane;
#pragma unroll
    for (int i = 0; i < 64; ++i) v[i] = src[(size_t)i * 64];
#pragma unroll
    for (int i = 0; i < 64; ++i) scr[i * 65 + lane] = v[i] * gk[k0 + i];
    asm volatile("s_waitcnt lgkmcnt(0)" ::: "memory");
    const int c = lane & 7;
#pragma unroll
    for (int j = 0; j < 8; ++j) { const int n = (lane >> 3) + 8 * j; const LAS float* sp = scr + (8 * c) * 65 + n;
        float f[8], l[8];
#pragma unroll
        for (int q = 0; q < 8; ++q) f[q] = sp[q * 65];
        u32x4 o; o.x = fg::cvt_pk_bf16(f[0], f[1]); o.y = fg::cvt_pk_bf16(f[2], f[3]); o.z = fg::cvt_pk_bf16(f[4], f[5]); o.w = fg::cvt_pk_bf16(f[6], f[7]);
        l[0] = f[0] - __uint_as_float(o.x << 16); l[1] = f[1] - __uint_as_float(o.x & 0xffff0000u); l[2] = f[2] - __uint_as_float(o.y << 16); l[3] = f[3] - __uint_as_float(o.y & 0xffff0000u);
        l[4] = f[4] - __uint_as_float(o.z << 16); l[5] = f[5] - __uint_as_float(o.z & 0xffff0000u); l[6] = f[6] - __uint_as_float(o.w << 16); l[7] = f[7] - __uint_as_float(o.w & 0xffff0000u);
        u32x4 ol; ol.x = fg::cvt_pk_bf16(l[0], l[1]); ol.y = fg::cvt_pk_bf16(l[2], l[3]); ol.z = fg::cvt_pk_bf16(l[4], l[5]); ol.w = fg::cvt_pk_bf16(l[6], l[7]);
        const size_t off = (size_t)(k0 >> 6) * 4096 + n * 64 + 8 * c;
        *(u32x4*)(WH + off) = o; *(u32x4*)(WL + off) = ol; }
    asm volatile("s_waitcnt lgkmcnt(0)" ::: "memory");
}
constexpr int N_EXPERT_ITEMS = 65 * 1536;
__device__ __forceinline__ void expert_item(const Params& p, unsigned char* ws, int r0, LAS float* scr, int lane) {
    bf16_t* wguT = (bf16_t*)(ws + WS_WGU); bf16_t* wdT = (bf16_t*)(ws + WS_WD);
    const int e = r0 / 1536, r = r0 % 1536, mat = r >> 9, item = r & 511;
    if (mat < 2) { const float* W = (e < NE) ? p.in[mat ? I_WEXU : I_WEXG] + (size_t)e * DM * EFF : p.in[mat ? I_WSHU : I_WSHG];
        const int kb = (item & 7) + 8 * (item >> 6), nb = (item >> 3) & 7, n0 = nb * 64;
        transpose_item_fp8<true>(W, DM, EFF, (unsigned char*)wguT + (size_t)e * 1024 * DM, kb * 64, n0, (n0 >> 7) * 256 + mat * 128 + (n0 & 127), fg::WGU_SCALE, scr, lane, p.in[I_GFFN]);
    } else { const float* W = (e < NE) ? p.in[I_WEXD] + (size_t)e * EFF * DM : p.in[I_WSHD];
        const int kb = item & 7, nb = item >> 3;
        transpose_item_fp8(W, EFF, DM, (unsigned char*)wdT + (size_t)e * DM * EFF, kb * 64, nb * 64, nb * 64, fg::WD_SCALE, scr, lane); }
}
__device__ __forceinline__ void expert_conv_loop(const Params& p, unsigned char* ws, unsigned* qhead, LAS float* scr, int lane) {
    for (;;) {
        unsigned start = 0; if (lane == 0) start = xb_add(qhead, 8u);
        start = (unsigned)__builtin_amdgcn_readfirstlane((int)start);
        if (start >= (unsigned)N_EXPERT_ITEMS) break;
        for (int q = 0; q < 8; ++q) expert_item(p, ws, (int)start + q, scr, lane);
    }
}
template <int VAR>
__device__ __forceinline__ void p0_items(const Params& p, unsigned char* ws, LAS float* scr, int lane, int gw, int NGW) {
    bf16_t* winT = (bf16_t*)(ws + WS_WIN); bf16_t* wuqT = (bf16_t*)(ws + WS_WUQ); bf16_t* wukvT = (bf16_t*)(ws + WS_WUKV); bf16_t* woT = (bf16_t*)(ws + WS_WO);
    bf16_t* wxqT = (bf16_t*)(ws + WS_WXQ); bf16_t* wxkvT = (bf16_t*)(ws + WS_WXKV); bf16_t* wxoT = (bf16_t*)(ws + WS_WXO); bf16_t* wguT = (bf16_t*)(ws + WS_WGU); bf16_t* wdT = (bf16_t*)(ws + WS_WD);
            constexpr int I0 = (DM / 64) * (INW / 64), I1 = I0 + (DM / 64) * (DM / 64), I2 = I1 + (QLORA / 64) * (3072 / 64), I3 = I2 + (KVLORA / 64) * (4096 / 64),
                          I4 = I3 + (DM / 64) * (512 / 64), I5 = I4 + (DM / 64) * (1024 / 64), I6 = I5 + (512 / 64) * (DM / 64);
            constexpr int IR = I6, ITOT = IR + DM / 64;
            for (int it = gw; it < ITOT; it += NGW) {
                if (it < I0) { const int nb = it % (INW / 64), kb = it / (INW / 64); transpose_item_fp8(p.in[I_WIN], DM, INW, (unsigned char*)winT, kb * 64, nb * 64, nb * 64, 64.0f, scr, lane); }
                else if (it < I1) { const int r = it - I0, nb = r % 64, kb = r / 64; transpose_item_fp8(p.in[I_WO], DM, DM, (unsigned char*)woT, kb * 64, nb * 64, nb * 64, 64.0f, scr, lane); }
                else if (it < I2) { const int r = it - I1, nb = r % 48, kb = r / 48; transpose_item_fp8(p.in[I_WUQ], QLORA, 3072, (unsigned char*)wuqT, kb * 64, nb * 64, nb * 64, 64.0f, scr, lane); }
                else if (it < I3) { const int r = it - I2, nb = r % 64, kb = r / 64; transpose_item_fp8(p.in[I_WUKV], KVLORA, 4096, (unsigned char*)wukvT, kb * 64, nb * 64, nb * 64, 64.0f, scr, lane); }
                else if (it < I4) { const int r = it - I3, nb = r % 8, kb = r / 8; transpose_item<VAR, true>(p.in[I_WXQ], DM, 512, wxqT, kb * 64, nb * 64, nb * 64, scr, lane, p.in[I_GCROSS]); }
                else if (it < I5) { const int r = it - I4, nb = r % 16, kb = r / 16; transpose_item_fp8(p.in[I_WXKV], DM, 1024, (unsigned char*)wxkvT, kb * 64, nb * 64, nb * 64, 64.0f, scr, lane); }
                else if (it < I6) { const int r = it - I5, nb = r % 64, kb = r / 64; transpose_item_fp8(p.in[I_WXO], 512, DM, (unsigned char*)wxoT, kb * 64, nb * 64, nb * 64, 64.0f, scr, lane); }
                else if (it >= IR) { transpose_item_hilo(p.in[I_WROUTER], DM, (bf16_t*)(ws + WS_WR), (bf16_t*)(ws + WS_WR + (size_t)(DM / 64) * 8192), (it - IR) * 64, scr, lane, p.in[I_GFFN]); }
            }
}
__device__ __forceinline__ void unpack8(const u32x4 w, float (&f)[8]) {
    f[0] = __uint_as_float(w.x << 16); f[1] = __uint_as_float(w.x & 0xffff0000u); f[2] = __uint_as_float(w.y << 16); f[3] = __uint_as_float(w.y & 0xffff0000u);
    f[4] = __uint_as_float(w.z << 16); f[5] = __uint_as_float(w.z & 0xffff0000u); f[6] = __uint_as_float(w.w << 16); f[7] = __uint_as_float(w.w & 0xffff0000u); }
__device__ __forceinline__ u32x4 pack8(const float (&f)[8]) { u32x4 w; w.x = fg::cvt_pk_bf16(f[0], f[1]); w.y = fg::cvt_pk_bf16(f[2], f[3]); w.z = fg::cvt_pk_bf16(f[4], f[5]); w.w = fg::cvt_pk_bf16(f[6], f[7]); return w; }
__device__ __forceinline__ float sumsq8(const float (&f)[8]) { return (f[0] * f[0] + f[1] * f[1]) + (f[2] * f[2] + f[3] * f[3]) + (f[4] * f[4] + f[5] * f[5]) + (f[6] * f[6] + f[7] * f[7]); }
template <int W> __device__ __forceinline__ float group_sum(float v) {
#pragma unroll
    for (int o = 1; o < W; o <<= 1) v += __shfl_xor(v, o);
    return v;
}
__device__ __forceinline__ void load8f(const float* g, float (&f)[8]) { const f32x4 a = *(const f32x4*)g, b = *(const f32x4*)(g + 4); f[0] = a.x; f[1] = a.y; f[2] = a.z; f[3] = a.w; f[4] = b.x; f[5] = b.y; f[6] = b.z; f[7] = b.w; }
__device__ __forceinline__ void scale8(float (&f)[8], float r, const float (&g)[8]) {
#pragma unroll
    for (int i = 0; i < 8; ++i) f[i] = f[i] * r * g[i]; }
        struct RouterSched { const char* th; const char* tl; const char* wh; const char* wl; int G, c;
            __device__ __forceinline__ bool next(int i, fg::Unit& u) const {
                const int total = (NTOK / 256) * 8, per = (total + 7) / 8; const int j = i * G + c, x = j & 7, q = j >> 3;
                if (q >= per) return false; const int L = x * per + q; if (L >= total) return false;
                const int pm = L / 8, slab = L % 8, term = slab >> 2, kq = slab & 3;
                u.A = (term == 1 ? tl : th) + ((size_t)pm * 256 * DM + (size_t)kq * 1024) * 2; u.B = wh + (size_t)kq * 16 * 8192;
                u.rows = nullptr; u.nkt = 16; u.nvalid = 256; u.pm = pm; u.pn = 0; u.e = slab; u.arow0 = pm * 256; return true; } };
        struct EpiLogits { static constexpr int PERM = 0; typedef fg::NoPre Pre; __device__ __forceinline__ void prefetch(Pre&, const fg::Unit&, int, int) const {} float* C;
            __device__ __forceinline__ void operator()(const f32x4 (&acc)[2][2][4][2], const fg::Unit& u, int wr, int wc, int fr, int fq, const Pre& pre) const {
                { float* Cb = C + (size_t)u.e * NTOK * 128;
#pragma unroll
                    for (int ai = 0; ai < 2; ++ai)
#pragma unroll
                        for (int m = 0; m < 4; ++m)
#pragma unroll
                            for (int n = 0; n < 2; ++n) *(f32x4*)(Cb + (size_t)(u.pm * 256 + ai * 128 + wr * 64 + m * 16 + fr) * 128 + wc * 32 + n * 16 + 4 * fq) = acc[ai][0][m][n]; } } };
constexpr int NPHASE = 18;
template <unsigned PMASK>
__global__ void __launch_bounds__(512, 2) fwd(Params p) {
    extern __shared__ __attribute__((aligned(16))) unsigned char lds_raw[];
    float* ldsf = (float*)lds_raw;
    const int tid = threadIdx.x, lane = tid & 63, wave = tid >> 6;
    const int G = gridDim.x; int bid = blockIdx.x;
    const int gw = bid * 8 + wave, NGW = G * 8;
    unsigned char* ws = p.ws;
    unsigned* ctl = (unsigned*)(ws + WS_CTL);
    volatile LAS unsigned* misc = (volatile LAS unsigned*)((LAS unsigned char*)lds_raw + LDS_MISC);
    if (tid < 16) misc[tid] = 0u;
    __syncthreads();
    XcdBarrier bar = xcd_barrier_post(ctl + CW_BAR, misc);
    const int lo = p.ph_lo, hi = p.ph_hi;
    if (tid == 0) { const unsigned x = xb_xcc_id() & 15u; misc[4] = x; misc[5] = xb_add(ctl + CW_TICKET + 64 * x, 1u); }
#define IN(k) (((PMASK >> (k)) & 1u) && lo <= (k) && (k) < hi)
#ifndef DUP_PHASE
#define DUP_PHASE -1
#endif
#define REP(k) for (int rep_ = 0; rep_ < ((DUP_PHASE == (k)) ? 2 : 1); ++rep_)
#define SEAM(k) do { if (IN(k) && IN((k) + 1)) xcd_barrier(bar); } while (0)

    const float* x = p.in[I_X];
    act_t* hbuf = (act_t*)(ws + WS_H); act_t* memn = (act_t*)(ws + WS_MEMN); act_t* p1 = (act_t*)(ws + WS_P1); act_t* kvm = (act_t*)(ws + WS_KVM);
    act_t* qb = (act_t*)(ws + WS_QB); act_t* kvb = (act_t*)(ws + WS_KVB); act_t* mixed = (act_t*)(ws + WS_MIXED); float* x1 = (float*)(ws + WS_X1);
    act_t* hc = (act_t*)(ws + WS_HC); act_t* qx = (act_t*)(ws + WS_QX); act_t* ox = (act_t*)(ws + WS_OX); float* x2 = (float*)(ws + WS_X2);
    act_t* tb = (act_t*)(ws + WS_T); act_t* hh = (act_t*)(ws + WS_HH);
    unsigned char* cq8 = ws + WS_X1; unsigned char* ckv8 = ws + WS_X1 + (size_t)NTOK * QLORA;
    LAS unsigned char* lds = (LAS unsigned char*)lds_raw;
    bf16_t* winT = (bf16_t*)(ws + WS_WIN); bf16_t* wuqT = (bf16_t*)(ws + WS_WUQ); bf16_t* wukvT = (bf16_t*)(ws + WS_WUKV); bf16_t* woT = (bf16_t*)(ws + WS_WO);
    bf16_t* wxqT = (bf16_t*)(ws + WS_WXQ); bf16_t* wxkvT = (bf16_t*)(ws + WS_WXKV); bf16_t* wxoT = (bf16_t*)(ws + WS_WXO); bf16_t* wguT = (bf16_t*)(ws + WS_WGU); bf16_t* wdT = (bf16_t*)(ws + WS_WD);
    float* qxp = (float*)(ws + WS_QXP); bf16_t* ybuf = (bf16_t*)(ws + WS_Y);
    int* rowtok = (int*)(ws + WS_ROWTOK); float* rowgate = (float*)(ws + WS_ROWGATE); int* rowdst = (int*)(ws + WS_ROWDST);
    unsigned* gcnt = ctl + CW_CNT;
    const int* positions = (const int*)p.in[I_POS];

    if (IN(0)) REP(0) {
        for (int m = gw; m < NTOK; m += NGW) {
            const float* xr = x + (size_t)m * DM; f32x4 v[16]; float ssq = 0.f;
#pragma unroll
            for (int j = 0; j < 16; ++j) { v[j] = __builtin_nontemporal_load((const f32x4*)xr + lane + 64 * j); ssq += v[j].x * v[j].x + v[j].y * v[j].y + v[j].z * v[j].z + v[j].w * v[j].w; }
            ssq = wave_sum(ssq); const float r = 2.0f / sqrtf(ssq * (1.0f / 4096.f) + EPS);
#pragma unroll
            for (int j = 0; j < 16; ++j) v[j] = v[j] * r * __builtin_nontemporal_load((const f32x4*)p.in[I_GMIX] + lane + 64 * j);
            asm volatile("s_waitcnt vmcnt(0)" ::: "memory");
#pragma unroll
            for (int j = 0; j < 16; ++j) *(unsigned*)((unsigned char*)hbuf + (size_t)m * DM + (lane + 64 * j) * 4) = fg::pk4_fp8(v[j].x, v[j].y, v[j].z, v[j].w);
        }
        for (int m = gw; m < NMEM; m += NGW) {
            const float* xr = p.in[I_MEM] + (size_t)m * DM; f32x4 v[16]; float ssq = 0.f;
#pragma unroll
            for (int j = 0; j < 16; ++j) { v[j] = __builtin_nontemporal_load((const f32x4*)xr + lane + 64 * j); ssq += v[j].x * v[j].x + v[j].y * v[j].y + v[j].z * v[j].z + v[j].w * v[j].w; }
            ssq = wave_sum(ssq); const float r = 2.0f / sqrtf(ssq * (1.0f / 4096.f) + EPS);
#pragma unroll
            for (int j = 0; j < 16; ++j) v[j] = v[j] * r * __builtin_nontemporal_load((const f32x4*)p.in[I_GMEM] + lane + 64 * j);
            asm volatile("s_waitcnt vmcnt(0)" ::: "memory");
#pragma unroll
            for (int j = 0; j < 16; ++j) *(unsigned*)((unsigned char*)memn + (size_t)m * DM + (lane + 64 * j) * 4) = fg::pk4_fp8(v[j].x, v[j].y, v[j].z, v[j].w);
        }
#if FAST_GEMM
        {
            LAS float* scr = (LAS float*)(lds + wave * 16640);
            p0_items<0>(p, ws, scr, lane, gw, NGW);
        }
#endif
    }
    SEAM(0);
    if (IN(0) && IN(1) && G == 256) {
        if (tid == 0) { bool even = true;
            for (int j2 = 0; j2 < 8; ++j2) even = even && (xb_ld(ctl + CW_TICKET + 64 * j2) == 32u);
            misc[6] = (even && misc[4] < 8u && misc[5] < 32u) ? (misc[4] + 8u * misc[5]) : (unsigned)blockIdx.x; }
        __syncthreads();
        bid = __builtin_amdgcn_readfirstlane((int)misc[6]);
    }
    if (IN(1)) REP(1) {
#if FAST_GEMM
        { fg::DenseSched S{(const char*)hbuf, (const char*)winT, DM / 2, DM / 2, NTOK / 256, INWP / 256, 1, DM / 128, G, bid, (p.var == 10) ? 2 : 0};
          fg::EpiBf16N E{p1, INW, INW, 1.0f / (2.0f * 64.0f), p.in[I_GQA], 8, p.in[I_GKA], 16, 0, (LAS float*)(lds + 131072 + 2048)};
          fg::gemm_phase<fg::EpiBf16N, fg::DenseSched, false, true, true>(lds, S, E, DM / 2, DM / 2, p.var); }
        { fg::DenseSched S{(const char*)memn, (const char*)wxkvT, DM / 2, DM / 2, NMEM / 256, 1024 / 256, 1, DM / 128, G, (bid + G - 224) % G, 0};
          fg::EpiBf16 E{kvm, 1024, 1024, 1.0f / (2.0f * 64.0f)};
          fg::gemm_phase<fg::EpiBf16, fg::DenseSched, false, true, true>(lds, S, E, DM / 2, DM / 2); }
#else
        constexpr int NT1 = (INW + 127) / 128, U1 = (NTOK / 128) * NT1, U2 = (NMEM / 128) * (1024 / 128);
        for (int u = bid; u < U1 + U2; u += G) {
            if (u < U1) { const int mt = u / NT1, nt = u % NT1;
                BPlain bc{p.in[I_WIN], INW, nt * 128, INW};
                auto epi = [&](int r, int c, const float (&v)[4]) { const int col = nt * 128 + c; if (col < INW) { act_t* o = p1 + (size_t)(mt * 128 + r) * INW + col; stf(o, v[0]); stf(o + 1, v[1]); stf(o + 2, v[2]); stf(o + 3, v[3]); } };
                ngemm_tile<act_t>(ldsf, hbuf, DM, nullptr, mt * 128, 128, DM, bc, epi);
            } else { const int v2 = u - U1, mt = v2 / 8, nt = v2 % 8;
                BPlain bc{p.in[I_WXKV], 1024, nt * 128, 1024};
                auto epi = [&](int r, int c, const float (&v)[4]) { act_t* o = kvm + (size_t)(mt * 128 + r) * 1024 + nt * 128 + c; stf(o, v[0]); stf(o + 1, v[1]); stf(o + 2, v[2]); stf(o + 3, v[3]); };
                ngemm_tile<act_t>(ldsf, memn, DM, nullptr, mt * 128, 128, DM, bc, epi);
            }
        }
    #endif
    }
    SEAM(1);
    if (IN(2)) {
#if FAST_GEMM
        {
            float gcq0[8], gcq1[8], gckv[8];
            load8f(p.in[I_GCQ] + lane * 8, gcq0); load8f(p.in[I_GCQ] + 512 + lane * 8, gcq1); load8f(p.in[I_GCKV] + lane * 8, gckv);
            for (int m = gw; m < NTOK; m += NGW) {
                act_t* row = p1 + (size_t)m * INW;
                u32x4 cq[2], ckv;
                cq[0] = *(const u32x4*)(row + C_CQ + lane * 8); cq[1] = *(const u32x4*)(row + C_CQ + 512 + lane * 8); ckv = *(const u32x4*)(row + C_CKV + lane * 8);
                const int pos = positions[m];
                asm volatile("s_waitcnt vmcnt(0)" ::: "memory");
                { float f0[8], f1[8]; unpack8(cq[0], f0); unpack8(cq[1], f1); const float ss = wave_sum(sumsq8(f0) + sumsq8(f1)); const float r = 1.0f / sqrtf(ss * (1.0f / 1024.f) + EPS);
                  scale8(f0, r * 2.0f, gcq0); scale8(f1, r * 2.0f, gcq1);
                  u32x2 a, b; a.x = fg::pk4_fp8(f0[0], f0[1], f0[2], f0[3]); a.y = fg::pk4_fp8(f0[4], f0[5], f0[6], f0[7]); b.x = fg::pk4_fp8(f1[0], f1[1], f1[2], f1[3]); b.y = fg::pk4_fp8(f1[4], f1[5], f1[6], f1[7]);
                  *(u32x2*)(cq8 + (size_t)m * QLORA + lane * 8) = a; *(u32x2*)(cq8 + (size_t)m * QLORA + 512 + lane * 8) = b; }
                { float f[8]; unpack8(ckv, f); const float ss = wave_sum(sumsq8(f)); const float r = 1.0f / sqrtf(ss * (1.0f / 512.f) + EPS); scale8(f, r * 2.0f, gckv);
                  u32x2 a; a.x = fg::pk4_fp8(f[0], f[1], f[2], f[3]); a.y = fg::pk4_fp8(f[4], f[5], f[6], f[7]); *(u32x2*)(ckv8 + (size_t)m * KVLORA + lane * 8) = a; }
                rms_rope64_inplace(row + C_KPE, p.in[I_GKB] + 128, pos, lane);
            }
            float gkx[8]; load8f(p.in[I_GKX] + (lane & 15) * 8, gkx);
            for (int m = gw; m < NMEM; m += NGW) { act_t* row = kvm + (size_t)m * 1024;
                u32x4 w = *(const u32x4*)(row + lane * 8); float f[8]; unpack8(w, f); const float ss = group_sum<16>(sumsq8(f)); const float r = 1.0f / sqrtf(ss * (1.0f / 128.f) + EPS);
                scale8(f, r, gkx); *(u32x4*)(row + lane * 8) = pack8(f); }
        }
#else
        for (int m = gw; m < NTOK; m += NGW) {
            act_t* row = p1 + (size_t)m * INW;
            for (int h = 0; h < HA; ++h) { rms_inplace<128>(row + C_Q0 + h * HD, p.in[I_GQA], lane); rms_inplace<128>(row + C_K0 + h * HD, p.in[I_GKA], lane); }
            rms_inplace<QLORA>(row + C_CQ, p.in[I_GCQ], lane);
            rms_inplace<KVLORA>(row + C_CKV, p.in[I_GCKV], lane);
            rms_rope64_inplace(row + C_KPE, p.in[I_GKB] + 128, positions[m], lane);
        }
        for (int m = gw; m < NMEM; m += NGW) for (int h = 0; h < MH; ++h) rms_inplace<128>(kvm + (size_t)m * 1024 + h * 128, p.in[I_GKX], lane);
#endif
    }
    SEAM(2);
    if (IN(3)) REP(3) {
#if FAST_GEMM
        { fg::DenseSched S{(const char*)cq8, (const char*)wuqT, QLORA / 2, QLORA / 2, NTOK / 256, 3072 / 256, 1, QLORA / 128, G, bid, 0};
          fg::EpiBf16 E{qb, 3072, 3072, 1.0f / 128.0f};
          fg::gemm_phase<fg::EpiBf16, fg::DenseSched, false, true, true>(lds, S, E, QLORA / 2, QLORA / 2); }
        { fg::DenseSched S{(const char*)ckv8, (const char*)wukvT, KVLORA / 2, KVLORA / 2, NTOK / 256, 4096 / 256, 1, KVLORA / 128, G, bid, (G == 256) ? 1 : 0};
          fg::EpiBf16N E{kvb, 4096, 4096, 1.0f / 128.0f, p.in[I_GKB], 16, p.in[I_GKB], 16, 1, (LAS float*)(lds + 131072 + 2048)};
          fg::gemm_phase<fg::EpiBf16N, fg::DenseSched, false, true, true>(lds, S, E, KVLORA / 2, KVLORA / 2); }
#else
        constexpr int UA = (NTOK / 128) * (3072 / 128), UB = (NTOK / 128) * (4096 / 128);
        for (int u = bid; u < UA + UB; u += G) {
            if (u < UA) { const int mt = u / 24, nt = u % 24;
                BPlain bc{p.in[I_WUQ], 3072, nt * 128, 3072};
                auto epi = [&](int r, int c, const float (&v)[4]) { act_t* o = qb + (size_t)(mt * 128 + r) * 3072 + nt * 128 + c; stf(o, v[0]); stf(o + 1, v[1]); stf(o + 2, v[2]); stf(o + 3, v[3]); };
                ngemm_tile<act_t>(ldsf, p1 + C_CQ, INW, nullptr, mt * 128, 128, QLORA, bc, epi);
            } else { const int v2 = u - UA, mt = v2 / 32, nt = v2 % 32;
                BPlain bc{p.in[I_WUKV], 4096, nt * 128, 4096};
                auto epi = [&](int r, int c, const float (&v)[4]) { act_t* o = kvb + (size_t)(mt * 128 + r) * 4096 + nt * 128 + c; stf(o, v[0]); stf(o + 1, v[1]); stf(o + 2, v[2]); stf(o + 3, v[3]); };
                ngemm_tile<act_t>(ldsf, p1 + C_CKV, INW, nullptr, mt * 128, 128, KVLORA, bc, epi);
            }
        }
    #endif
    }
    SEAM(3);
    if (IN(4)) {
#if FAST_GEMM
        {
            float gqn[8], gqp[8];
            load8f(p.in[I_GQB] + (lane & 15) * 8, gqn); load8f(p.in[I_GQB] + 128 + (lane & 7) * 8, gqp);
            for (int m = gw; m < NTOK; m += NGW) {
                act_t* qrow = qb + (size_t)m * 3072;
                u32x4 qn[4], qp[2];
#pragma unroll
                for (int j = 0; j < 4; ++j) qn[j] = *(const u32x4*)(qrow + (j * 4 + (lane >> 4)) * QKB + (lane & 15) * 8);
#pragma unroll
                for (int j = 0; j < 2; ++j) qp[j] = *(const u32x4*)(qrow + (j * 8 + (lane >> 3)) * QKB + 128 + (lane & 7) * 8);
                float cs[8], sn[8];
                { const int fi = lane & 31; const float inv_freq = powf(10000.0f, -(float)(2 * fi) / 64.0f); const float ang = (float)positions[m] * inv_freq; float s1, c1; sincosf(ang, &s1, &c1);
#pragma unroll
                  for (int i = 0; i < 8; ++i) { const int src = ((lane & 3) * 8 + i); cs[i] = __shfl(c1, src); sn[i] = __shfl(s1, src); } }
                asm volatile("s_waitcnt vmcnt(0)" ::: "memory");
#pragma unroll
                for (int j = 0; j < 4; ++j) { float f[8]; unpack8(qn[j], f); const float ss = group_sum<16>(sumsq8(f)); const float r = 1.0f / sqrtf(ss * (1.0f / 128.f) + EPS); scale8(f, r, gqn); qn[j] = pack8(f); }
#pragma unroll
                for (int j = 0; j < 2; ++j) { float f[8]; unpack8(qp[j], f); const float ss = group_sum<8>(sumsq8(f)); const float r = 1.0f / sqrtf(ss * (1.0f / 64.f) + EPS); scale8(f, r, gqp);
                    const bool lowhalf = ((lane & 7) < 4);
#pragma unroll
                    for (int i = 0; i < 8; ++i) { const float other = __shfl_xor(f[i], 4); f[i] = lowhalf ? (f[i] * cs[i] - other * sn[i]) : (f[i] * cs[i] + other * sn[i]); }
                    qp[j] = pack8(f); }
#pragma unroll
                for (int j = 0; j < 4; ++j) *(u32x4*)(qrow + (j * 4 + (lane >> 4)) * QKB + (lane & 15) * 8) = qn[j];
#pragma unroll
                for (int j = 0; j < 2; ++j) *(u32x4*)(qrow + (j * 8 + (lane >> 3)) * QKB + 128 + (lane & 7) * 8) = qp[j];
            }
        }
#else
        for (int m = gw; m < NTOK; m += NGW) {
            const int pos = positions[m];
            for (int h = 0; h < HB; ++h) {
                rms_inplace<128>(qb + (size_t)m * 3072 + h * QKB, p.in[I_GQB], lane);
                rms_rope64_inplace(qb + (size_t)m * 3072 + h * QKB + 128, p.in[I_GQB] + 128, pos, lane);
                rms_inplace<128>(kvb + (size_t)m * 4096 + h * 256, p.in[I_GKB], lane);
            }
        }
#endif
    }
    SEAM(4);
    if (IN(5)) {
#if FAST_ATTN
        {
            constexpr int NA_BLK = 176;
            LAS char* al = (LAS char*)lds;
            LAS float* scr = (LAS float*)(lds + wave * 16640);
            if (bid >= NA_BLK) { expert_conv_loop(p, ws, ctl + CW_QCONV, scr, lane); }
            for (;;) {
                __syncthreads(); if (tid == 0) misc[7] = xb_add(ctl + CW_QB, 1u); __syncthreads();
                const int q = (int)misc[7]; if (q >= 512) break;
                const int grp = q >> 8, idx = q & 255, pair = idx >> 2, qbk = (grp == 0 ? 7 : 3) - (idx & 3), b = pair >> 4, h = pair & 15;
                const int c0 = qbk * 4; const size_t tok0 = (size_t)b * SEQ + (size_t)qbk * 256;
                const act_t* kb = kvb + (size_t)b * SEQ * 4096;
                fa::attn_call<1>(qb + tok0 * 3072 + h * QKB, kb + h * 256, p1 + (size_t)b * SEQ * INW + C_KPE, kb + h * 256 + 128, (bf16_t*)((unsigned char*)mixed + tok0 * DM + WA + h * HD), 0, c0 + 4, c0, al);
            }
            for (;;) {
                __syncthreads(); if (tid == 0) misc[7] = xb_add(ctl + CW_QA, 1u); __syncthreads();
                const int q = (int)misc[7]; if (q >= 512) break;
                const int grp = q >> 8, idx = q & 255, pair = idx >> 2, qbk = (grp == 0 ? 7 : 3) - (idx & 3), b = pair >> 4, h = pair & 15;
                { LAS float* tbl = (LAS float*)(al + fa::OFF_TBL); if (tid < NREL) tbl[tid] = p.in[I_RELB][h * NREL + tid] * 11.313708498984761f; }
                const int c0 = qbk * 4; const size_t tok0 = (size_t)b * SEQ + (size_t)qbk * 256;
                const int kt0 = (c0 - LEFT) > 0 ? (c0 - LEFT) : 0;
                const act_t* base = p1 + (size_t)b * SEQ * INW;
                fa::attn_call<0>(p1 + tok0 * INW + C_Q0 + h * HD, base + C_K0 + h * HD, nullptr, base + C_V0 + h * HD, (bf16_t*)((unsigned char*)mixed + tok0 * DM + h * HD), kt0, c0 + 4 - kt0, c0, al);
            }
            __syncthreads();
            expert_conv_loop(p, ws, ctl + CW_QCONV, scr, lane);
        }
#else
        for (int u = bid; u < 4096; u += G) {
            const int c = 31 - (u >> 7), rem = u & 127, type = rem >> 6, b = (rem >> 4) & 3, h = rem & 15;
            const size_t tok0 = (size_t)b * SEQ + (size_t)c * CHUNK;
            if (type == 0) {
                const int t0 = (c - LEFT) > 0 ? (c - LEFT) : 0, nt = c - t0 + 1;
                const float* rb = p.in[I_RELB] + h * NREL;
                auto keytile = [&](int t) { return (t0 + t) * CHUNK; };
                auto bias = [&](int r, int t, int key) { int dist = (c * CHUNK + r) - ((t0 + t) * CHUNK + key); dist = dist < -(CHUNK - 1) ? -(CHUNK - 1) : (dist > 128 ? 128 : dist); return rb[dist + CHUNK - 1]; };
                const act_t* base = p1 + (size_t)b * SEQ * INW;
                nattn_unit<128>(ldsf, p1 + tok0 * INW + C_Q0 + h * HD, INW, base + C_K0 + h * HD, INW, nullptr, 0, base + C_V0 + h * HD, INW,
                                nt, keytile, 0.08838834764831845f, bias, mixed + tok0 * DM + h * HD, DM);
            } else {
                auto keytile = [&](int t) { return t * CHUNK; };
                auto bias = [&](int, int, int) { return 0.f; };
                const act_t* kb = kvb + (size_t)b * SEQ * 4096;
                nattn_unit<192>(ldsf, qb + tok0 * 3072 + h * QKB, 3072, kb + h * 256, 4096, p1 + (size_t)b * SEQ * INW + C_KPE, INW, kb + h * 256 + 128, 4096,
                                c + 1, keytile, 0.07216878364870323f, bias, mixed + tok0 * DM + WA + h * HD, DM);
            }
        }
    #endif
    }
    SEAM(5);
    if (IN(6)) REP(6) {
#if FAST_GEMM
        { fg::DenseSched S{(const char*)mixed, (const char*)woT, DM / 2, DM / 2, NTOK / 256, DM / 256, 1, DM / 128, G, bid, 0};
          fg::EpiResStat E{x, hc, (float*)(ws + WS_SSP1), DM, 1.0f / (fa::MIX_SCALE * 64.0f)};
          fg::gemm_phase<fg::EpiResStat, fg::DenseSched, false, true, true>(lds, S, E, DM / 2, DM / 2); }
#else
        for (int u = bid; u < (NTOK / 128) * (DM / 128); u += G) { const int mt = u / 32, nt = u % 32;
            BPlain bc{p.in[I_WO], DM, nt * 128, DM};
            auto epi = [&](int r, int c, const float (&v)[4]) { const size_t o = (size_t)(mt * 128 + r) * DM + nt * 128 + c;
                const f32x4 xv = *(const f32x4*)(x + o); *(f32x4*)(x1 + o) = (f32x4){xv.x + v[0], xv.y + v[1], xv.z + v[2], xv.w + v[3]}; };
            ngemm_tile<act_t>(ldsf, mixed, DM, nullptr, mt * 128, 128, DM, bc, epi);
        }
    #endif
    }
    SEAM(6);
    if (IN(8)) REP(8) {
#if FAST_GEMM
        { fg::DenseSched S{(const char*)hc, (const char*)wxqT, DM, PK(DM), NTOK / 256, 512 / 256, 4, DM / 64 / 4, G, bid, 0};
          fg::EpiBf16 E{(bf16_t*)qxp, 512, 512, 1.0f, (size_t)NTOK * 512};
          fg::gemm_phase<fg::EpiBf16, fg::DenseSched, false, false, true>(lds, S, E, DM, PK(DM)); }
#else
        for (int u = bid; u < (NTOK / 128) * 4; u += G) { const int mt = u / 4, nt = u % 4;
            BPlain bc{p.in[I_WXQ], 512, nt * 128, 512};
            auto epi = [&](int r, int c, const float (&v)[4]) { act_t* o = qx + (size_t)(mt * 128 + r) * 512 + nt * 128 + c; stf(o, v[0]); stf(o + 1, v[1]); stf(o + 2, v[2]); stf(o + 3, v[3]); };
            ngemm_tile<act_t>(ldsf, hc, DM, nullptr, mt * 128, 128, DM, bc, epi);
        }
    #endif
    }
    SEAM(8);
    if (IN(10)) REP(10) {
#if FAST_ATTN
        for (int u = bid; u < NB * MH * (SEQ / 256); u += G) { const int qbk = u & 7, h = (u >> 3) & 3, b = u >> 5;
            const size_t tok0 = (size_t)b * SEQ + (size_t)qbk * 256;
            const act_t* kb = kvm + (size_t)b * MEMT * 1024;
            fa::attn_call<2>((const bf16_t*)qxp + tok0 * 512 + h * 128, kb + h * 128, (const bf16_t*)((const float*)(ws + WS_SSP1) + tok0 * 64), kb + 512 + h * 128, (bf16_t*)((unsigned char*)ox + tok0 * 512 + h * 128), 0, 4, 0, (LAS char*)lds, p.in[I_GQX]);
        }
#else
        for (int u = bid; u < NB * MH * (SEQ / 64); u += G) { const int c = u & 31, h = (u >> 5) & 3, b = u >> 7;
            const size_t tok0 = (size_t)b * SEQ + (size_t)c * 64;
            auto keytile = [&](int t) { return t * 64; };
            auto bias = [&](int, int, int) { return 0.f; };
            const act_t* kb = kvm + (size_t)b * MEMT * 1024;
            nattn_unit<128>(ldsf, qx + tok0 * 512 + h * 128, 512, kb + h * 128, 1024, nullptr, 0, kb + 512 + h * 128, 1024, 4, keytile, 0.08838834764831845f, bias, ox + tok0 * 512 + h * 128, 512);
        }
    #endif
    }
    SEAM(10);
    if (IN(11)) REP(11) {
#if FAST_GEMM
        { fg::DenseSched S{(const char*)ox, (const char*)wxoT, 256, 256, NTOK / 256, DM / 256, 1, 512 / 128, G, bid, 0};
          fg::EpiX2 E{hc, tb, (bf16_t*)(ws + WS_X2), ws + WS_T8, (float*)(ws + WS_SSP2), DM, 1.0f / (fa::MIX_SCALE * 64.0f)};
          fg::gemm_phase<fg::EpiX2, fg::DenseSched, false, true, true>(lds, S, E, 256, 256); }
#else
        for (int u = bid; u < (NTOK / 128) * (DM / 128); u += G) { const int mt = u / 32, nt = u % 32;
            BPlain bc{p.in[I_WXO], DM, nt * 128, DM};
            auto epi = [&](int r, int c, const float (&v)[4]) { const size_t o = (size_t)(mt * 128 + r) * DM + nt * 128 + c;
                const f32x4 xv = *(const f32x4*)(x1 + o); const f32x4 y = (f32x4){xv.x + v[0], xv.y + v[1], xv.z + v[2], xv.w + v[3]}; *(f32x4*)(x2 + o) = y; *(f32x4*)(p.out + o) = y; };
            ngemm_tile<act_t>(ldsf, ox, 512, nullptr, mt * 128, 128, 512, bc, epi);
        }
    #endif
    }
    SEAM(11);
    if (IN(13)) {
        RouterSched S{(const char*)tb, (const char*)(ws + WS_X2), (const char*)(ws + WS_WR), nullptr, G, bid};
        EpiLogits E{(float*)(ws + WS_Y)};
        fg::gemm_phase<EpiLogits, RouterSched, false, false, true>(lds, S, E, DM, DM);
    }
    SEAM(13);
    if (IN(14)) {
        const float* lgp = (const float*)(ws + WS_Y);
        const float rb = p.in[I_RBIAS][lane];
        const int g = lane >> 3;
        float lgA[16];
#pragma unroll
        for (int sl = 0; sl < 16; ++sl) lgA[sl] = (gw < NTOK) ? lgp[((size_t)(sl >> 1) * NTOK + gw) * 128 + (sl & 1) * 64 + lane] : 0.f;
        LAS unsigned* lcnt = (LAS unsigned*)(lds + 1024); LAS unsigned* lbase = lcnt + 64;
        LAS u32x2* stg = (LAS u32x2*)(lds + 2048) + wave * (8 * 64);
        if (tid < 128) lcnt[tid] = 0u;
        __syncthreads();
        int jt = 0;
        for (int m = gw; m < NTOK; m += NGW, ++jt) {
            float lgB[16]; const int mn = m + NGW;
#pragma unroll
            for (int sl = 0; sl < 16; ++sl) lgB[sl] = (mn < NTOK) ? lgp[((size_t)(sl >> 1) * NTOK + mn) * 128 + (sl & 1) * 64 + lane] : 0.f;
            const float rs2 = 1.0f / sqrtf(wave_sum(((const float*)(ws + WS_SSP2))[(size_t)m * 64 + lane]) * (1.0f / 4096.f) + EPS);
            if (lane == 0) ((float*)(ws + WS_RS2))[m] = rs2;
            const float logit = ((((lgA[0] + lgA[1]) + (lgA[2] + lgA[3])) + ((lgA[4] + lgA[5]) + (lgA[6] + lgA[7]))) + (((lgA[8] + lgA[9]) + (lgA[10] + lgA[11])) + ((lgA[12] + lgA[13]) + (lgA[14] + lgA[15])))) * rs2;
            const float score = 1.0f / (1.0f + expf(-logit));
            const float choice = score + rb;
            float gm1 = fmaxf(choice, __shfl_xor(choice, 1)); gm1 = fmaxf(gm1, __shfl_xor(gm1, 2)); gm1 = fmaxf(gm1, __shfl_xor(gm1, 4));
            const unsigned long long eq = __ballot(choice == gm1);
            const unsigned gbits = (unsigned)(eq >> (8 * g)) & 0xffu;
            const bool is_first = (lane & 7) == (__builtin_ctz(gbits | 0x100u));
            float v2 = is_first ? -INFINITY : choice;
            v2 = fmaxf(v2, __shfl_xor(v2, 1)); v2 = fmaxf(v2, __shfl_xor(v2, 2)); v2 = fmaxf(v2, __shfl_xor(v2, 4));
            const float gscore = gm1 + v2;
            int grank = 0;
#pragma unroll
            for (int j2 = 0; j2 < 8; ++j2) { const float gj = __int_as_float(__builtin_amdgcn_readlane(__float_as_int(gscore), 8 * j2)); grank += ((gj > gscore) || (gj == gscore && j2 < g)) ? 1 : 0; }
            const bool gsel = grank < 4;
            const float mv = gsel ? choice : -INFINITY;
            int rank = 0;
#pragma unroll
            for (int i2 = 0; i2 < 64; ++i2) { const float vi = __int_as_float(__builtin_amdgcn_readlane(__float_as_int(mv), i2)); rank += ((vi > mv) || (vi == mv && i2 < lane)) ? 1 : 0; }
            const bool sel = gsel && rank < 8;
            const float wsum = wave_sum(sel ? score : 0.f);
            unsigned lpos = 0u; if (sel) lpos = __hip_atomic_fetch_add(lcnt + lane, 1u, __ATOMIC_RELAXED, __HIP_MEMORY_SCOPE_WORKGROUP);
            u32x2 e; e.x = __float_as_uint(score * 2.5f / (wsum + 1e-20f)); e.y = (sel ? 0x80000000u : 0u) | ((unsigned)(rank & 15) << 16) | lpos;
            stg[(jt & 7) * 64 + lane] = e;
#pragma unroll
            for (int sl = 0; sl < 16; ++sl) lgA[sl] = lgB[sl];
        }
        __syncthreads();
        if (wave == 0) { const unsigned c = lcnt[lane]; lbase[lane] = c ? atomicAdd(&gcnt[64 * lane], c) : 0u; }
        __syncthreads();
        { const unsigned base = lbase[lane]; jt = 0;
          for (int m = gw; m < NTOK; m += NGW, ++jt) { const u32x2 e = stg[(jt & 7) * 64 + lane];
              if (e.y & 0x80000000u) { const unsigned pos = base + (e.y & 0xffffu); rowtok[lane * CAP + pos] = m; rowgate[lane * CAP + pos] = __uint_as_float(e.x); rowdst[lane * CAP + pos] = m * 8 + (int)((e.y >> 16) & 15u); } } }
    }
    SEAM(14);
    if (IN(15)) REP(15) {
#if FAST_MOE
        { const fg::MoeTabs T = moe_tables_fast((LAS int*)(lds + 131072), gcnt);
          fg::MoeSched<1> S{T, (const char*)(ws + WS_T8), (const char*)wguT, rowtok, G, bid, ctl + CW_TDONE};
          fg::EpiSwiglu E{hh, (const float*)(ws + WS_RS2), ctl + CW_TDONE};
          fg::gemm_phase<fg::EpiSwiglu, fg::MoeSched<1>, true, true, true>(lds, S, E, DM / 2, DM / 2, p.var); }
#else
        int* tab = (int*)(ldsf + 2 * 16 * 132);
        const MoeTab T = moe_tables(tab, gcnt, 128);
        const int nunits = T.mtp[NE + 1] * 8;
        for (int u = bid; u < nunits; u += G) {
            const int mti = u >> 3, nt = u & 7; int e = 0; while (T.mtp[e + 1] <= mti) ++e;
            const int mt = mti - T.mtp[e], nrows = (T.cnt[e] - mt * 128) < 128 ? (T.cnt[e] - mt * 128) : 128;
            const float* Wg = (e < NE) ? p.in[I_WEXG] + (size_t)e * DM * EFF : p.in[I_WSHG];
            const float* Wu = (e < NE) ? p.in[I_WEXU] + (size_t)e * DM * EFF : p.in[I_WSHU];
            BGU bc{Wg, Wu, EFF, nt * 64};
            const size_t hrow0 = (size_t)T.offh[e] + (size_t)mt * 128;
            auto epi = [&](int r, int c, const float (&v)[4]) { act_t* o = hh + (hrow0 + r) * EFF + nt * 64 + (c >> 2) * 2;
                stf(o, v[0] / (1.0f + expf(-v[0])) * v[2]); stf(o + 1, v[1] / (1.0f + expf(-v[1])) * v[3]); };
            ngemm_tile<act_t>(ldsf, tb, DM, (e < NE) ? rowtok + e * CAP : nullptr, mt * 128, nrows, DM, bc, epi);
        }
    #endif
    }
    if (IN(16)) REP(16) {
#if FAST_MOE
        { const fg::MoeTabs T = moe_tables_fast((LAS int*)(lds + 131072), gcnt);
          { fg::MoeSched<2> S{T, (const char*)hh, (const char*)wdT, rowtok, G, bid, ctl + CW_TDONE};
            fg::EpiScatter E{(unsigned char*)ybuf, rowdst, rowgate, T.mtp};
            fg::gemm_phase<fg::EpiScatter, fg::MoeSched<2>, false, true, true>(lds, S, E, EFF / 2, EFF / 2, p.var); }
          { { unsigned* td = ctl + CW_TDONE; const int t0 = T.mtp[64], nsh = T.mtp[65] - T.mtp[64]; unsigned sp = 0;
              for (;;) { unsigned v = 32u; if (lane < nsh) v = __hip_atomic_load(td + (t0 + lane) * 64, __ATOMIC_RELAXED, __HIP_MEMORY_SCOPE_AGENT);
                  if (__all(v >= 32u)) break; __builtin_amdgcn_s_sleep(4); if (++sp > (1u << 24)) break; }
              asm volatile("" ::: "memory"); }
            fg::DenseSched S{(const char*)hh + (size_t)T.mtp[64] * 256 * EFF, (const char*)wdT + (size_t)64 * DM * EFF, EFF / 2, EFF / 2, NTOK / 256, DM / 256, 1, EFF / 128, G, bid, 0};
            fg::EpiShared E{(unsigned char*)ybuf + (size_t)NTOK * 8 * DM};
            fg::gemm_phase<fg::EpiShared, fg::DenseSched, false, true, true>(lds, S, E, EFF / 2, EFF / 2); } }
#else
        int* tab = (int*)(ldsf + 2 * 16 * 132);
        const MoeTab T = moe_tables(tab, gcnt, 128);
        const int nunits = T.mtp[NE + 1] * 32;
        for (int u = bid; u < nunits; u += G) {
            const int mti = u >> 5, nt = u & 31; int e = 0; while (T.mtp[e + 1] <= mti) ++e;
            const int mt = mti - T.mtp[e], nrows = (T.cnt[e] - mt * 128) < 128 ? (T.cnt[e] - mt * 128) : 128;
            const float* Wd = (e < NE) ? p.in[I_WEXD] + (size_t)e * EFF * DM : p.in[I_WSHD];
            BPlain bc{Wd, DM, nt * 128, DM};
            const int hrow0 = T.offh[e] + mt * 128;
            auto epi = [&](int r, int c, const float (&v)[4]) {
                int tok; float g; if (e < NE) { tok = rowtok[e * CAP + mt * 128 + r]; g = rowgate[e * CAP + mt * 128 + r]; } else { tok = mt * 128 + r; g = 1.0f; }
                float* o = p.out + (size_t)tok * DM + nt * 128 + c;
                atomicAdd(o, v[0] * g); atomicAdd(o + 1, v[1] * g); atomicAdd(o + 2, v[2] * g); atomicAdd(o + 3, v[3] * g); };
            ngemm_tile<act_t>(ldsf, hh, EFF, nullptr, hrow0, nrows, EFF, bc, epi);
        }
    #endif
    }
    SEAM(16);
    if (IN(17)) REP(17) {
#if FAST_MOE
        for (int m = gw; m < NTOK; m += NGW) {
            const unsigned char* y8 = (const unsigned char*)ybuf + (size_t)m * 8 * DM;
#pragma unroll 2
            for (int j = 0; j < 4; ++j) { const int c0 = lane * 16 + 1024 * j;
                const bf16_t* sp = tb + (size_t)m * DM + c0; float* op = p.out + (size_t)m * DM + c0;
                f32x4 sv[4];
#pragma unroll
                for (int q = 0; q < 2; ++q) { const u32x4 t = __builtin_nontemporal_load((const u32x4*)(sp + 8 * q));
                    sv[2 * q] = (f32x4){__uint_as_float(t.x << 16), __uint_as_float(t.x & 0xffff0000u), __uint_as_float(t.y << 16), __uint_as_float(t.y & 0xffff0000u)};
                    sv[2 * q + 1] = (f32x4){__uint_as_float(t.z << 16), __uint_as_float(t.z & 0xffff0000u), __uint_as_float(t.w << 16), __uint_as_float(t.w & 0xffff0000u)}; }
                u32x4 y[9];
#pragma unroll
                for (int k = 0; k < 8; ++k) y[k] = __builtin_nontemporal_load((const u32x4*)(y8 + (size_t)k * DM + c0));
                y[8] = __builtin_nontemporal_load((const u32x4*)((const unsigned char*)ybuf + (size_t)NTOK * 8 * DM + (size_t)m * DM + c0));
                float a[16];
#pragma unroll
                for (int q = 0; q < 16; ++q) a[q] = 0.f;
#pragma unroll
                for (int k = 0; k < 9; ++k) {
#pragma unroll
                    for (int q = 0; q < 4; ++q) { const int w = (int)y[k][q]; const auto lo = __builtin_amdgcn_cvt_pk_f32_fp8(w, false); const auto hi2 = __builtin_amdgcn_cvt_pk_f32_fp8(w, true);
                        a[4 * q] += lo[0]; a[4 * q + 1] += lo[1]; a[4 * q + 2] += hi2[0]; a[4 * q + 3] += hi2[1]; } }
#pragma unroll
                for (int q = 0; q < 4; ++q) { f32x4 o; o.x = sv[q].x + a[4 * q] * (1.0f / fg::Y_SCALE); o.y = sv[q].y + a[4 * q + 1] * (1.0f / fg::Y_SCALE); o.z = sv[q].z + a[4 * q + 2] * (1.0f / fg::Y_SCALE); o.w = sv[q].w + a[4 * q + 3] * (1.0f / fg::Y_SCALE);
                    *(f32x4*)(op + 4 * q) = o; } }
        }
#endif
    }
#undef IN
#undef SEAM
}

#if TVAR
__global__ void __launch_bounds__(512, 2) probe_k(Params p) {
    extern __shared__ __attribute__((aligned(16))) unsigned char lds_raw[];
    const int tid = threadIdx.x, lane = tid & 63, wave = tid >> 6;
    p0_items<TVAR>(p, p.ws, (LAS float*)((LAS unsigned char*)lds_raw + wave * 16640), lane, blockIdx.x * 8 + wave, gridDim.x * 8);
}
#endif
typedef void (*kern_t)(Params);
template <int PH> struct KTab { static void fill(kern_t* t) { t[PH] = fwd<(1u << PH)>; KTab<PH - 1>::fill(t); } };
template <> struct KTab<-1> { static void fill(kern_t*) {} };
extern "C" void kernel_launch(void* const* d_in, const int* in_sizes, int n_in, void* d_out, int out_size, void* d_ws, size_t ws_size, hipStream_t stream) {
    static int grid = 0;
    static kern_t ktab[NPHASE + 1];
    if (grid == 0) {
        if (n_in != 31 || out_size != NTOK * DM || ws_size < WS_END) { fprintf(stderr, "kernel_launch: bad shapes n_in %d out %d ws %zu (need %zu)\n", n_in, out_size, ws_size, (size_t)WS_END); grid = -1; return; }
        int dev = 0, cus = 0;
        if (hipGetDevice(&dev) != hipSuccess || hipDeviceGetAttribute(&cus, hipDeviceAttributeMultiprocessorCount, dev) != hipSuccess) { grid = -1; return; }
#if N_LAUNCH_PER_PHASE
        KTab<NPHASE - 1>::fill(ktab);
#else
        ktab[NPHASE] = fwd<0xFFFFFFFFu>;
#endif
#if N_LAUNCH_PER_PHASE
        for (int i = 0; i < NPHASE; ++i)
#else
        for (int i = NPHASE; i <= NPHASE; ++i)
#endif
            if (hipFuncSetAttribute((const void*)ktab[i], hipFuncAttributeMaxDynamicSharedMemorySize, LDS_BYTES) != hipSuccess) { fprintf(stderr, "kernel_launch: hipFuncSetAttribute failed\n"); grid = -1; return; }
        (void)hipGetLastError();
        grid = cus;
    }
    if (grid < 0) return;
    (void)hipMemsetAsync((char*)d_ws + WS_CTL, 0, CTL_BYTES, stream);
    Params p{};
    for (int i = 0; i < 31; ++i) p.in[i] = (const float*)d_in[i];
    p.out = (float*)d_out; p.ws = (unsigned char*)d_ws;
#if TVAR
    { static int once = 0; if (!once) { (void)hipFuncSetAttribute((const void*)probe_k, hipFuncAttributeMaxDynamicSharedMemorySize, LDS_BYTES); once = 1; } p.ph_lo = 0; p.ph_hi = 0; hipLaunchKernelGGL(probe_k, dim3(grid), dim3(512), LDS_BYTES, stream, p); }
#endif
#if N_LAUNCH_PER_PHASE
    for (int ph = 0; ph < NPHASE; ++ph) { p.ph_lo = ph; p.ph_hi = ph + 1; hipLaunchKernelGGL(ktab[ph], dim3(grid), dim3(512), LDS_BYTES, stream, p); }
#else
    p.ph_lo = 0; p.ph_hi = NPHASE; hipLaunchKernelGGL(ktab[NPHASE], dim3(grid), dim3(512), LDS_BYTES, stream, p);
#endif
#ifdef PROBE_PH
#ifndef PROBE_VAR
#define PROBE_VAR 0
#endif
    (void)hipMemsetAsync((char*)d_ws + WS_CTL + (size_t)CW_QCONV * 4, 0, 1024, stream);
    (void)hipMemsetAsync((char*)d_ws + WS_CTL + (size_t)CW_QCONV * 4, 0, 1024, stream);
    p.ph_lo = PROBE_PH; p.ph_hi = PROBE_PH + 1; p.var = PROBE_VAR; hipLaunchKernelGGL(ktab[NPHASE], dim3(grid), dim3(512), LDS_BYTES, stream, p);
#endif
    const hipError_t le = hipPeekAtLastError();
    if (le != hipSuccess) fprintf(stderr, "kernel_launch: launch failed: %s\n", hipGetErrorName(le));
}
```
